# Optimizing an MI355X kernel written in HIP

```python
import numpy as np
import jax
import jax.numpy as jnp
from jax import lax

D_MODEL = 1024
BATCH = 4
SEQ = 4096
DEPTH = 1

HEAD_DIM = 64
Q_BLOCK = 128
ROPE_THETA = 10000.0
RMS_EPS = 1e-5
NEG_INF = -1e30
FORCE_SCORE = 1e4
NSA_HEADS = 8
NSA_GROUPS = 2
NSA_REP = NSA_HEADS // NSA_GROUPS
NSA_BRANCHES = 3
CMP_LEN = 32
CMP_STRIDE = 16
SEL_BLOCK = 64
SEL_TOPK = 16
WINDOW = 512
FOX_HEADS = 8
MEM_HEADS = 4
MEM_HEAD_DIM = 128
MEM_LEN = 256
N_MIXERS = 3
N_EXPERTS = 32
TOP_K = 4
D_EXPERT = D_MODEL
SWIGLU_LIMIT = 7.0
SWIGLU_ALPHA = 1.702
MOE_BLOCK = 128

NSA_Q_W = NSA_HEADS * HEAD_DIM
NSA_KV_W = NSA_GROUPS * HEAD_DIM
FOX_W = FOX_HEADS * HEAD_DIM
MEM_W = MEM_HEADS * MEM_HEAD_DIM
IN_SPLITS = (
    NSA_Q_W,
    NSA_KV_W, NSA_KV_W,
    NSA_KV_W, NSA_KV_W,
    NSA_KV_W, NSA_KV_W,
    NSA_BRANCHES * NSA_HEADS,
    FOX_W, FOX_W, FOX_W,
    FOX_HEADS,
    MEM_W,
    N_MIXERS * D_MODEL,
)
D_IN = sum(IN_SPLITS)
IN_OFFSETS = tuple(int(o) for o in np.cumsum(IN_SPLITS)[:-1])

kernel_name = 'hybrid_nsa_fox_memory_moe_block'


def rms_norm(x, g):
    x32 = x.astype(jnp.float32)
    y = x32 * lax.rsqrt(jnp.mean(x32 * x32, axis=-1, keepdims=True) + RMS_EPS)
    return (y * g.astype(jnp.float32)).astype(x.dtype)


def rope_tables(seq, dim, dtype):
    inv = ROPE_THETA ** (-jnp.arange(0, dim, 2, dtype=jnp.float32) / dim)
    ang = jnp.arange(seq, dtype=jnp.float32)[:, None] * inv[None, :]
    return jnp.cos(ang).astype(dtype), jnp.sin(ang).astype(dtype)


def apply_rope(x, cos, sin):
    x1, x2 = jnp.split(x, 2, axis=-1)
    c = cos[:, None, :]
    s = sin[:, None, :]
    return jnp.concatenate([x1 * c - x2 * s, x2 * c + x1 * s], axis=-1)


def masked_softmax(s, mask):
    s = jnp.where(mask, s.astype(jnp.float32), NEG_INF)
    m = jnp.max(s, axis=-1, keepdims=True)
    e = jnp.where(mask, jnp.exp(s - m), 0.0)
    return e / jnp.maximum(jnp.sum(e, axis=-1, keepdims=True), 1e-30)


def compress_blocks(kv, pe, w1, w2):
    b, s, g, d = kv.shape
    kb = kv.reshape(b, s // CMP_STRIDE, CMP_STRIDE, g, d)
    blocks = jnp.concatenate([kb[:, :-1], kb[:, 1:]], axis=2)
    z = jnp.einsum('bnlgd,lde->bnge', blocks + pe[:, None, :], w1)
    return jax.nn.silu(z) @ w2


def nsa_mixer(q, kc, vc, ks, vs, kw, vw, gate_logits, pe_k, w1_k, w2_k, pe_v, w1_v, w2_v):
    b, s, h, d = q.shape
    scale = d ** -0.5
    nq = s // Q_BLOCK
    qg = q.reshape(b, s, NSA_GROUPS, NSA_REP, d)
    tpos = jnp.arange(s)

    kcmp = compress_blocks(kc, pe_k, w1_k, w2_k)
    vcmp = compress_blocks(vc, pe_v, w1_v, w2_v)
    n_cmp = kcmp.shape[1]
    cstart = jnp.arange(n_cmp) * CMP_STRIDE
    cmask = (cstart + CMP_LEN - 1)[None, :] <= tpos[:, None]
    s_c = jnp.einsum('bsgrd,bngd->bgrsn', qg, kcmp).astype(jnp.float32) * scale
    p_c = masked_softmax(s_c, cmask)
    o_cmp = jnp.einsum('bgrsn,bngd->bsgrd', p_c.astype(vcmp.dtype), vcmp)

    n_sel_blk = s // SEL_BLOCK
    n_top = min(SEL_TOPK, n_sel_blk)
    blk = jnp.arange(n_sel_blk)
    overlap = ((cstart[:, None] < (blk[None, :] + 1) * SEL_BLOCK)
               & (cstart[:, None] + CMP_LEN > blk[None, :] * SEL_BLOCK)).astype(jnp.float32)
    imp = jnp.einsum('bgrsn,nj->bgsj', p_c, overlap)
    cur = (tpos // SEL_BLOCK)[:, None]
    forced = (blk[None, :] == 0) | (blk[None, :] == cur) | (blk[None, :] == cur - 1)
    future = blk[None, :] * SEL_BLOCK > tpos[:, None]
    imp = jnp.where(forced, FORCE_SCORE, jnp.where(future, -FORCE_SCORE, imp))
    _, sel = lax.top_k(imp, n_top)

    kblk = ks.reshape(b, n_sel_blk, SEL_BLOCK, NSA_GROUPS, d).transpose(0, 3, 1, 2, 4)
    vblk = vs.reshape(b, n_sel_blk, SEL_BLOCK, NSA_GROUPS, d).transpose(0, 3, 1, 2, 4)
    bi = jnp.arange(b)[:, None, None, None]
    gi = jnp.arange(NSA_GROUPS)[None, :, None, None]
    offs = jnp.arange(SEL_BLOCK)
    n_keys = n_top * SEL_BLOCK
    q_chunks = qg.reshape(b, nq, Q_BLOCK, NSA_GROUPS, NSA_REP, d).transpose(1, 0, 2, 3, 4, 5)
    sel_chunks = sel.reshape(b, NSA_GROUPS, nq, Q_BLOCK, n_top).transpose(2, 0, 1, 3, 4)

    def sel_chunk(args):
        qi, si, ci = args
        kk = kblk[bi, gi, si].reshape(b, NSA_GROUPS, Q_BLOCK, n_keys, d)
        vv = vblk[bi, gi, si].reshape(b, NSA_GROUPS, Q_BLOCK, n_keys, d)
        kpos = (si[..., None] * SEL_BLOCK + offs).reshape(b, NSA_GROUPS, Q_BLOCK, n_keys)
        qpos = ci * Q_BLOCK + jnp.arange(Q_BLOCK)
        mask = (kpos <= qpos[None, None, :, None])[:, :, None]
        sc = jnp.einsum('btgrd,bgtkd->bgrtk', qi, kk).astype(jnp.float32) * scale
        p = masked_softmax(sc, mask)
        return jnp.einsum('bgrtk,bgtkd->btgrd', p.astype(vv.dtype), vv)

    o_slc = lax.map(sel_chunk, (q_chunks, sel_chunks, jnp.arange(nq)))
    o_slc = o_slc.transpose(1, 0, 2, 3, 4, 5).reshape(b, s, NSA_GROUPS, NSA_REP, d)

    n_prev = WINDOW // Q_BLOCK
    pad = ((0, 0), (WINDOW, 0), (0, 0), (0, 0))
    kwb = jnp.pad(kw, pad).reshape(b, nq + n_prev, Q_BLOCK, NSA_GROUPS, d)
    vwb = jnp.pad(vw, pad).reshape(b, nq + n_prev, Q_BLOCK, NSA_GROUPS, d)
    kband = jnp.concatenate([kwb[:, i:i + nq] for i in range(n_prev + 1)], axis=2)
    vband = jnp.concatenate([vwb[:, i:i + nq] for i in range(n_prev + 1)], axis=2)
    qb = qg.reshape(b, nq, Q_BLOCK, NSA_GROUPS, NSA_REP, d)
    qpos = jnp.arange(nq)[:, None] * Q_BLOCK + jnp.arange(Q_BLOCK)[None, :]
    kpos = jnp.arange(nq)[:, None] * Q_BLOCK - WINDOW + jnp.arange((n_prev + 1) * Q_BLOCK)[None, :]
    diff = qpos[:, :, None] - kpos[:, None, :]
    wmask = (diff >= 0) & (diff < WINDOW) & (kpos[:, None, :] >= 0)
    sw = jnp.einsum('bctgrd,bckgd->bcgrtk', qb, kband).astype(jnp.float32) * scale
    pw = masked_softmax(sw, wmask[None, :, None, None])
    o_win = jnp.einsum('bcgrtk,bckgd->bctgrd', pw.astype(vband.dtype), vband)
    o_win = o_win.reshape(b, s, NSA_GROUPS, NSA_REP, d)

    g = jax.nn.sigmoid(gate_logits.astype(jnp.float32)).astype(q.dtype)
    g = g.reshape(b, s, NSA_GROUPS, NSA_REP, NSA_BRANCHES)
    o = g[..., 0:1] * o_cmp + g[..., 1:2] * o_slc + g[..., 2:3] * o_win
    return o.reshape(b, s, h * d)


def fox_mixer(q, k, v, f_logits, b_forget):
    b, s, h, d = q.shape
    scale = d ** -0.5
    nq = s // Q_BLOCK
    logf = jax.nn.log_sigmoid(f_logits.astype(jnp.float32) + b_forget.astype(jnp.float32))
    cum = jnp.cumsum(logf, axis=1).transpose(0, 2, 1)
    q_chunks = q.reshape(b, nq, Q_BLOCK, h, d).transpose(1, 0, 2, 3, 4)
    c_chunks = cum.reshape(b, h, nq, Q_BLOCK).transpose(2, 0, 1, 3)
    kpos = jnp.arange(s)

    def block(args):
        qi, ci, idx = args
        sc = (jnp.einsum('bthd,bshd->bhts', qi, k).astype(jnp.float32) * scale
              + ci[..., None] - cum[:, :, None, :])
        qpos = idx * Q_BLOCK + jnp.arange(Q_BLOCK)
        p = masked_softmax(sc, kpos[None, :] <= qpos[:, None])
        return jnp.einsum('bhts,bshd->bthd', p.astype(v.dtype), v)

    o = lax.map(block, (q_chunks, c_chunks, jnp.arange(nq)))
    return o.transpose(1, 0, 2, 3, 4).reshape(b, s, h * d)


def memory_mixer(q, mem_h, w_mem_kv):
    b, s, h, d = q.shape
    m = mem_h.shape[1]
    k, v = jnp.split(mem_h @ w_mem_kv, 2, axis=-1)
    k = k.reshape(b, m, h, d)
    v = v.reshape(b, m, h, d)
    sc = jnp.einsum('bshd,bmhd->bhsm', q, k).astype(jnp.float32) * (d ** -0.5)
    p = jax.nn.softmax(sc, axis=-1)
    o = jnp.einsum('bhsm,bmhd->bshd', p.astype(v.dtype), v)
    return o.reshape(b, s, h * d)


def moe_ffn(h, w_router, b_router, w_gate_up, b_gate_up, w_down, b_down):
    b, s, d = h.shape
    t = b * s
    hf = h.reshape(t, d)
    logits = (hf @ w_router + b_router).astype(jnp.float32)
    top_val, top_idx = lax.top_k(logits, TOP_K)
    gate = jax.nn.softmax(top_val, axis=-1)
    n_assign = t * TOP_K
    e_flat = top_idx.reshape(n_assign)
    tok_flat = jnp.repeat(jnp.arange(t, dtype=jnp.int32), TOP_K)
    g_flat = gate.reshape(n_assign)
    order = jnp.argsort(e_flat, stable=True)
    e_sorted = e_flat[order]
    counts = jnp.bincount(e_flat, length=N_EXPERTS)
    starts = jnp.cumsum(counts) - counts
    padded = (counts + MOE_BLOCK - 1) // MOE_BLOCK * MOE_BLOCK
    pad_ends = jnp.cumsum(padded)
    pad_starts = pad_ends - padded
    dest = pad_starts[e_sorted] + jnp.arange(n_assign) - starts[e_sorted]
    n_blocks = -(-(n_assign + N_EXPERTS * (MOE_BLOCK - 1)) // MOE_BLOCK)
    n_slots = n_blocks * MOE_BLOCK
    slot_tok = jnp.full((n_slots,), t, jnp.int32).at[dest].set(tok_flat[order])
    slot_gate = jnp.zeros((n_slots,), jnp.float32).at[dest].set(g_flat[order])
    block_exp = jnp.minimum(
        jnp.searchsorted(pad_ends, jnp.arange(n_blocks) * MOE_BLOCK, side='right'), N_EXPERTS - 1)
    h_pad = jnp.concatenate([hf, jnp.zeros((1, d), hf.dtype)], axis=0)

    def expert_block(args):
        e, toks = args
        xt = h_pad[toks]
        gu = xt @ w_gate_up[e] + b_gate_up[e]
        g = jnp.minimum(gu[:, 0::2], SWIGLU_LIMIT)
        u = jnp.clip(gu[:, 1::2], -SWIGLU_LIMIT, SWIGLU_LIMIT)
        act = (u + 1.0) * g * jax.nn.sigmoid(SWIGLU_ALPHA * g)
        return act @ w_down[e] + b_down[e]

    out = lax.map(expert_block, (block_exp, slot_tok.reshape(n_blocks, MOE_BLOCK)))
    out = out.reshape(n_slots, d) * slot_gate[:, None].astype(out.dtype)
    y = jax.ops.segment_sum(out, slot_tok, num_segments=t + 1)[:t]
    return y.reshape(b, s, d)


def setup_inputs(seed: int = 0) -> dict:
    key = jax.random.key(seed)
    ks = jax.random.split(key, 32)
    L = DEPTH
    F = D_EXPERT

    def nrm(k, shape, scale):
        return jax.random.normal(k, shape, jnp.float32) * scale

    def gain(k, shape):
        return 1.0 + 0.02 * jax.random.normal(k, shape, jnp.float32)

    return {
        'x': nrm(ks[0], (BATCH, SEQ, D_MODEL), 1.0),
        'mem': nrm(ks[1], (BATCH, MEM_LEN, D_MODEL), 1.0),
        'g_mix': gain(ks[2], (L, D_MODEL)),
        'w_in': nrm(ks[3], (L, D_MODEL, D_IN), D_MODEL ** -0.5),
        'b_forget': jax.random.uniform(ks[4], (L, FOX_HEADS), jnp.float32, 1.0, 6.0),
        'b_merge': nrm(ks[5], (L, N_MIXERS * D_MODEL), 0.02),
        'nsa_pe_k': nrm(ks[6], (L, CMP_LEN, HEAD_DIM), 0.02),
        'nsa_w1_k': nrm(ks[7], (L, CMP_LEN, HEAD_DIM, HEAD_DIM), (CMP_LEN * HEAD_DIM) ** -0.5),
        'nsa_w2_k': nrm(ks[8], (L, HEAD_DIM, HEAD_DIM), HEAD_DIM ** -0.5),
        'nsa_pe_v': nrm(ks[9], (L, CMP_LEN, HEAD_DIM), 0.02),
        'nsa_w1_v': nrm(ks[10], (L, CMP_LEN, HEAD_DIM, HEAD_DIM), (CMP_LEN * HEAD_DIM) ** -0.5),
        'nsa_w2_v': nrm(ks[11], (L, HEAD_DIM, HEAD_DIM), HEAD_DIM ** -0.5),
        'g_mem': gain(ks[12], (L, D_MODEL)),
        'w_mem_kv': nrm(ks[13], (L, D_MODEL, 2 * MEM_W), D_MODEL ** -0.5),
        'w_branch_nsa': nrm(ks[14], (L, NSA_Q_W, D_MODEL), NSA_Q_W ** -0.5),
        'w_branch_fox': nrm(ks[15], (L, FOX_W, D_MODEL), FOX_W ** -0.5),
        'w_branch_mem': nrm(ks[16], (L, MEM_W, D_MODEL), MEM_W ** -0.5),
        'w_out': nrm(ks[17], (L, D_MODEL, D_MODEL), D_MODEL ** -0.5),
        'g_ffn': gain(ks[18], (L, D_MODEL)),
        'w_router': nrm(ks[19], (L, D_MODEL, N_EXPERTS), D_MODEL ** -0.5),
        'b_router': nrm(ks[20], (L, N_EXPERTS), 0.01),
        'w_gate_up': nrm(ks[21], (L, N_EXPERTS, D_MODEL, 2 * F), D_MODEL ** -0.5),
        'b_gate_up': nrm(ks[22], (L, N_EXPERTS, 2 * F), 0.02),
        'w_down': nrm(ks[23], (L, N_EXPERTS, F, D_MODEL), F ** -0.5),
        'b_down': nrm(ks[24], (L, N_EXPERTS, D_MODEL), 0.02),
        'g_final': gain(ks[25], (D_MODEL,)),
    }


def reference(x, mem, g_mix, w_in, b_forget, b_merge, nsa_pe_k, nsa_w1_k, nsa_w2_k, nsa_pe_v,
              nsa_w1_v, nsa_w2_v, g_mem, w_mem_kv, w_branch_nsa, w_branch_fox, w_branch_mem, w_out,
              g_ffn, w_router, b_router, w_gate_up, b_gate_up, w_down, b_down, g_final):
    b, s, _ = x.shape
    cos, sin = rope_tables(s, HEAD_DIM, x.dtype)

    def heads(t, n, d):
        return t.reshape(b, s, n, d)

    for l in range(DEPTH):
        h = rms_norm(x, g_mix[l])
        parts = jnp.split(h @ w_in[l], IN_OFFSETS, axis=-1)
        (q_a, k_c, v_c, k_s, v_s, k_w, v_w, nsa_gl,
         q_f, k_f, v_f, f_l, q_m, merge_l) = parts

        o_nsa = nsa_mixer(
            apply_rope(heads(q_a, NSA_HEADS, HEAD_DIM), cos, sin),
            apply_rope(heads(k_c, NSA_GROUPS, HEAD_DIM), cos, sin), heads(v_c, NSA_GROUPS, HEAD_DIM),
            apply_rope(heads(k_s, NSA_GROUPS, HEAD_DIM), cos, sin), heads(v_s, NSA_GROUPS, HEAD_DIM),
            apply_rope(heads(k_w, NSA_GROUPS, HEAD_DIM), cos, sin), heads(v_w, NSA_GROUPS, HEAD_DIM),
            nsa_gl, nsa_pe_k[l], nsa_w1_k[l], nsa_w2_k[l], nsa_pe_v[l], nsa_w1_v[l], nsa_w2_v[l])
        o_fox = fox_mixer(heads(q_f, FOX_HEADS, HEAD_DIM), heads(k_f, FOX_HEADS, HEAD_DIM),
                          heads(v_f, FOX_HEADS, HEAD_DIM), f_l, b_forget[l])
        o_mem = memory_mixer(heads(q_m, MEM_HEADS, MEM_HEAD_DIM), rms_norm(mem, g_mem[l]), w_mem_kv[l])

        gates = jax.nn.sigmoid((merge_l + b_merge[l]).astype(jnp.float32)).astype(x.dtype)
        g_nsa, g_fox, g_mem_br = jnp.split(gates, N_MIXERS, axis=-1)
        merged = (g_nsa * (o_nsa @ w_branch_nsa[l])
                  + g_fox * (o_fox @ w_branch_fox[l])
                  + g_mem_br * (o_mem @ w_branch_mem[l]))
        x = x + merged @ w_out[l]

        x = x + moe_ffn(rms_norm(x, g_ffn[l]), w_router[l], b_router[l], w_gate_up[l],
                        b_gate_up[l], w_down[l], b_down[l])

    return rms_norm(x, g_final)
```

```cpp
#include <hip/hip_runtime.h>
#include <hip/hip_cooperative_groups.h>
#include <cstdio>
#include <cstdint>
#include <cmath>
namespace cg = cooperative_groups;

#define LAS __attribute__((address_space(3)))
typedef unsigned short bf16;
typedef short bf16x8 __attribute__((ext_vector_type(8)));
typedef short s16x4 __attribute__((ext_vector_type(4)));
typedef float f32x4 __attribute__((ext_vector_type(4)));
typedef float f32x2 __attribute__((ext_vector_type(2)));
typedef float f32x16 __attribute__((ext_vector_type(16)));
typedef unsigned u32x4 __attribute__((ext_vector_type(4)));
typedef unsigned u32x2 __attribute__((ext_vector_type(2)));
typedef __bf16 bf16x2_t __attribute__((ext_vector_type(2)));

constexpr int NB = 4, SEQ = 4096, DM = 1024, NTOK = NB * SEQ;
constexpr int DIN = 6432, NIN = 6656;
constexpr int MEMLEN = 256, NMEMROW = NB * MEMLEN;
constexpr int NEXP = 32, TOPK = 4, FEXP = 1024;
constexpr int MAXSLOT = NTOK * TOPK + NEXP * 256;
constexpr float RMS_EPS = 1e-5f;
constexpr float LOG2E = 1.4426950408889634f;
constexpr float C2_64 = 0.125f * LOG2E;
constexpr float C2_128 = 0.08838834764831845f * LOG2E;
constexpr float NEGBIG = -1e30f;
constexpr float W8_SCALE = 32.0f, ACT8_SCALE = 4.0f;

constexpr size_t MiB = 1u << 20;
constexpr size_t WS_CTL = 0;
constexpr size_t CTL_BYTES = 64 * 1024;
constexpr size_t WS_ROPE_C = 1 * MiB, WS_ROPE_S = WS_ROPE_C + 512 * 1024;
constexpr size_t WS_W1T_K = 2 * MiB, WS_W1T_V = WS_W1T_K + 256 * 1024;
constexpr size_t WS_W2T_K = WS_W1T_V + 256 * 1024, WS_W2T_V = WS_W2T_K + 8192;
constexpr size_t WS_CPE = WS_W2T_V + 8192;
constexpr size_t WS_KCMP = 3 * MiB;
constexpr size_t WS_VCMP = WS_KCMP + 256 * 1024;
constexpr size_t WS_CUM = 4 * MiB;
constexpr size_t WS_KMAX = 4 * MiB + 512 * 1024;
constexpr size_t WS_KMEM = 5 * MiB, WS_VMEM = 6 * MiB;
constexpr size_t WS_ORDER = 7 * MiB;
constexpr size_t WS_BLKCNT = 7 * MiB + 64 * 1024;
constexpr size_t WS_TILE_E = 7 * MiB + 128 * 1024;
constexpr size_t WS_WRT = 7 * MiB + 256 * 1024;
constexpr size_t WS_RSTD = 7 * MiB + 512 * 1024;
constexpr size_t WS_RSLOT = 8 * MiB;
constexpr size_t WS_SLOTTOK = 8 * MiB + 512 * 1024;
constexpr size_t WS_WIN_T = 9 * MiB;
constexpr size_t WS_WBR_T = 24 * MiB;
constexpr size_t WS_WOUT_T = 27 * MiB;
constexpr size_t WS_WGU_T = 32 * MiB;
constexpr size_t WS_WD_T = 160 * MiB;
constexpr size_t WS_HA = 224 * MiB;
constexpr size_t WS_ETOK = 224 * MiB, WS_ERSTD = 226 * MiB;
constexpr int MT_OFF = 131072;
constexpr size_t WS_QA = 258 * MiB;
constexpr size_t WS_KV6 = 274 * MiB;
constexpr size_t WS_QM = 298 * MiB;
constexpr size_t WS_LG = 314 * MiB;
constexpr size_t WS_GATES = 316 * MiB;
constexpr size_t WS_QF = 412 * MiB, WS_KF = 428 * MiB, WS_VF = 444 * MiB;
constexpr size_t WS_ACT = 316 * MiB;
constexpr size_t WS_OBR = 460 * MiB;
constexpr size_t WS_MERGED = 508 * MiB;
constexpr size_t WS_H2 = 540 * MiB;
constexpr size_t WS_ROUTE = 572 * MiB;
constexpr size_t WS_AMOE = 576 * MiB;
constexpr size_t WS_END = 720 * MiB;
static_assert(WS_ACT + (size_t)MAXSLOT * 1024 * 2 <= WS_OBR && WS_AMOE + (size_t)MAXSLOT * 1024 * 2 <= WS_END, "ws map");
constexpr int CW_QATTN = 64;
constexpr int CW_DONE8 = 12288;
constexpr int CW_GCNT = 9216;
constexpr int CW_XBAR = 1024;

constexpr int LDS_BYTES = 155648;
constexpr int NWAVES = 8, NTHREADS = 512;

__device__ __forceinline__ unsigned cvtpk(float lo, float hi) { f32x2 v = {lo, hi}; bf16x2_t b = __builtin_convertvector(v, bf16x2_t); return __builtin_bit_cast(unsigned, b); }
__device__ __forceinline__ float bf2f(unsigned short h) { return __builtin_bit_cast(float, (unsigned)h << 16); }
__device__ __forceinline__ float bflo(unsigned u) { return __builtin_bit_cast(float, u << 16); }
__device__ __forceinline__ float bfhi(unsigned u) { return __builtin_bit_cast(float, u & 0xffff0000u); }
__device__ __forceinline__ float wave_sum(float v) {
#pragma unroll
    for (int o = 1; o < 64; o <<= 1) v += __shfl_xor(v, o);
    return v;
}
__device__ __forceinline__ float fast_sigmoid(float x) { return __builtin_amdgcn_rcpf(1.0f + __builtin_amdgcn_exp2f(-LOG2E * x)); }
__device__ __forceinline__ unsigned pk_fp8x4(float a, float b, float c, float d) {
    a = fminf(fmaxf(a, -448.f), 448.f); b = fminf(fmaxf(b, -448.f), 448.f); c = fminf(fmaxf(c, -448.f), 448.f); d = fminf(fmaxf(d, -448.f), 448.f);
    int p = __builtin_amdgcn_cvt_pk_fp8_f32(a, b, 0, false); p = __builtin_amdgcn_cvt_pk_fp8_f32(c, d, p, true); return (unsigned)p;
}
namespace pg8 {
#define PG8_LAS __attribute__((address_space(3)))
typedef unsigned short bf16_t;
typedef short bf16x8 __attribute__((ext_vector_type(8)));
typedef float f32x4 __attribute__((ext_vector_type(4)));
typedef unsigned u32x4 __attribute__((ext_vector_type(4)));
typedef unsigned u32x2 __attribute__((ext_vector_type(2)));
typedef int i32x8 __attribute__((ext_vector_type(8)));
typedef int i32x4 __attribute__((ext_vector_type(4)));
constexpr int BM = 256, BK = 64, HALF = 128, HTB = HALF * BK * 2  , STAGE_BYTES = 8 * HTB;

__host__ __device__ __forceinline__ int lds_byte(int r, int c) { const int st = (r >> 4) * 2 + (c >> 5), rr = r & 15, cc = c & 31, ob = rr * 64 + cc * 2; return st * 1024 + (ob ^ (((ob >> 9) & 1) << 5)); }
__host__ __device__ __forceinline__ void stage_rc(int b, int& R, int& C) { const int st = b / 1024, sb = b % 1024, swz = sb ^ (((sb >> 9) & 1) << 5); R = (st >> 1) * 16 + swz / 64; C = (st & 1) * 32 + (swz % 64) / 2; }
__host__ __device__ __forceinline__ int perm32(int rho) { const int n = rho >> 4, i = rho & 15; return 8 * (i >> 2) + 4 * n + (i & 3); }

struct Unit { int pm, pn; };

template <bool F8, class Epi, class Sched>
__device__ __forceinline__ void gemm_phase(PG8_LAS unsigned char* lds, const int K, const Sched& S, const Epi& E) {
    const int tid = threadIdx.x, wid = __builtin_amdgcn_readfirstlane(tid >> 6), lane = tid & 63, wr = wid >> 2, wc = wid & 3, fr = lane & 15, fq = lane >> 4;
    const int nt = K / BK;
    unsigned voffB[2]; int RA[2], CA[2];
    { int R, C; stage_rc(tid * 16, R, C); const int Rb = (R & ~31) + perm32(R & 31);
      RA[0] = R; CA[0] = C; RA[1] = R + 64; CA[1] = C; voffB[0] = (unsigned)(Rb * K + C) * 2u; voffB[1] = voffB[0] + (unsigned)(64 * K * 2); }
    constexpr bool GATHER = Sched::GATHER;
    unsigned cofA[2][2], nofA[2][2];
#define PG8_AOFF(dst, u) do { _Pragma("unroll") for (int h_ = 0; h_ < 2; ++h_) _Pragma("unroll") for (int i_ = 0; i_ < 2; ++i_) dst[h_][i_] = S.a_voff(u, h_, RA[i_], CA[i_], K); } while (0)
    const size_t kstep = (size_t)(BK * 2);
    const size_t hstep = (size_t)HALF * K * 2;
    const unsigned ldsw = (unsigned)wid * 1024u;
    const int aoff = lds_byte(wr * 64 + fr, fq * 8), boff = lds_byte(wc * 32 + fr, fq * 8);
    const int aoff8 = lds_byte(wr * 64 + fr, fq * 16), boff8 = lds_byte(wc * 32 + fr, fq * 16);
#define PG8_SA(b, h) (((b) * 2 + (h)) * HTB)
#define PG8_SB(b, h) ((4 + (b) * 2 + (h)) * HTB)
#define PG8_STAGE(bufoff, gbase, voff) do { _Pragma("unroll") for (int _i = 0; _i < 2; ++_i) \
        __builtin_amdgcn_global_load_lds((const unsigned*)((const char*)(gbase) + (voff)[_i]), (PG8_LAS unsigned*)(lds + (bufoff) + ldsw + _i * 8192), 16, 0, 0); } while (0)
#define PG8_LDA(dst, b, h) do { _Pragma("unroll") for (int m = 0; m < 4; ++m) _Pragma("unroll") for (int k = 0; k < 2; ++k) dst[m][k] = *(const PG8_LAS bf16x8*)(lds + PG8_SA(b, h) + aoff + m * 2048 + k * 1024); } while (0)
#define PG8_LDB(dst, b, h) do { _Pragma("unroll") for (int n = 0; n < 2; ++n) _Pragma("unroll") for (int k = 0; k < 2; ++k) dst[n][k] = *(const PG8_LAS bf16x8*)(lds + PG8_SB(b, h) + boff + n * 2048 + k * 1024); } while (0)
#define PG8_MMA(ai, bj, At, Bt) do { __builtin_amdgcn_s_setprio(1); _Pragma("unroll") for (int m = 0; m < 4; ++m) _Pragma("unroll") for (int n = 0; n < 2; ++n) _Pragma("unroll") for (int k = 0; k < 2; ++k) \
        acc[ai][bj][m][n] = __builtin_amdgcn_mfma_f32_16x16x32_bf16(Bt[n][k], At[m][k], acc[ai][bj][m][n], 0, 0, 0); __builtin_amdgcn_s_setprio(0); } while (0)
#define PG8_LD8(dst, base, o0, cnt) do { _Pragma("unroll") for (int q_ = 0; q_ < cnt; ++q_) { const i32x4 lo_ = *(const PG8_LAS i32x4*)(lds + (base) + (o0) + q_ * 2048), hi_ = *(const PG8_LAS i32x4*)(lds + (base) + (o0) + q_ * 2048 + 16); \
        dst[q_] = (i32x8){lo_[0], lo_[1], lo_[2], lo_[3], hi_[0], hi_[1], hi_[2], hi_[3]}; } } while (0)
#define PG8_MMA8(ai, bj, At, Bt) do { __builtin_amdgcn_s_setprio(1); _Pragma("unroll") for (int m = 0; m < 4; ++m) _Pragma("unroll") for (int n = 0; n < 2; ++n) \
        asm volatile("v_mfma_scale_f32_16x16x128_f8f6f4 %0, %1, %2, %0, %3, %3 op_sel_hi:[0,0,0]" : "+v"(acc[ai][bj][m][n]) : "v"(Bt[n]), "v"(At[m]), "v"(sc8)); asm volatile("s_nop 7" ::: "memory"); __builtin_amdgcn_s_setprio(0); } while (0)
#define PG8_WAIT_V(n) asm volatile("s_waitcnt vmcnt(" #n ")" ::: "memory")
#define PG8_WAIT_L(n) asm volatile("s_waitcnt lgkmcnt(" #n ")" ::: "memory")
#define PG8_BAR __builtin_amdgcn_s_barrier()
#define PG8_SCHED __builtin_amdgcn_sched_barrier(0)
    Unit cur, nxt; int ui = 0;
    if (!S.next(0, cur)) return;
    f32x4 acc[2][2][4][2];
#pragma unroll
    for (int a = 0; a < 2; ++a)
#pragma unroll
        for (int b = 0; b < 2; ++b)
#pragma unroll
            for (int m = 0; m < 4; ++m)
#pragma unroll
                for (int n = 0; n < 2; ++n) acc[a][b][m][n] = (f32x4){0.f, 0.f, 0.f, 0.f};
    bf16x8 At[4][2], B0[2][2], B1[2][2]; i32x8 At8[4], B08[2], B18[2]; int sc8 = 0x7f7f7f7f; asm volatile("" : "+v"(sc8));
    const char* cA = S.a_base(cur); const char* cB = S.b_base(cur);
    PG8_AOFF(cofA, cur);
    PG8_STAGE(PG8_SB(0, 0), cB, voffB); PG8_STAGE(PG8_SB(0, 1), cB + hstep, voffB); PG8_STAGE(PG8_SA(0, 0), cA, cofA[0]); PG8_STAGE(PG8_SA(0, 1), cA, cofA[1]);
    if (wr == 1) PG8_BAR;
    PG8_WAIT_V(2); PG8_BAR;
    PG8_STAGE(PG8_SB(1, 0), cB + kstep, voffB); PG8_STAGE(PG8_SA(1, 0), cA + kstep, cofA[0]); PG8_STAGE(PG8_SB(1, 1), cB + hstep + kstep, voffB);
    PG8_WAIT_V(6); PG8_BAR;
    for (;;) {
        const bool has_next = S.next(ui + 1, nxt);
        const char* nA = has_next ? S.a_base(nxt) : cA; const char* nB = has_next ? S.b_base(nxt) : cB;
        if constexpr (GATHER) { if (has_next) PG8_AOFF(nofA, nxt); else { _Pragma("unroll") for (int h_ = 0; h_ < 2; ++h_) _Pragma("unroll") for (int i_ = 0; i_ < 2; ++i_) nofA[h_][i_] = cofA[h_][i_]; } }
#pragma clang loop unroll(disable)
        for (int t = 0; t < nt; t += 2) {
            const bool last = (t == nt - 2);
            const char* a1 = cA + (size_t)(t + 1) * kstep;
            const char* a2 = last ? nA : cA + (size_t)(t + 2) * kstep; const char* b2 = last ? nB : cB + (size_t)(t + 2) * kstep;
            const char* a3 = a2 + kstep; const char* b3 = b2 + kstep;
            unsigned sofA[2][2];
            _Pragma("unroll") for (int h_ = 0; h_ < 2; ++h_) _Pragma("unroll") for (int i_ = 0; i_ < 2; ++i_) sofA[h_][i_] = (GATHER && last) ? nofA[h_][i_] : cofA[h_][i_];
            if constexpr (!F8) {
            PG8_LDB(B0, 0, 0); PG8_LDB(B1, 0, 1); PG8_SCHED; PG8_LDA(At, 0, 0); PG8_STAGE(PG8_SA(1, 1), a1, cofA[1]);
            PG8_WAIT_V(8); PG8_WAIT_L(0); PG8_BAR; PG8_MMA(0, 0, At, B0); PG8_MMA(0, 1, At, B1); PG8_BAR; PG8_SCHED;
            PG8_LDA(At, 0, 1); PG8_STAGE(PG8_SB(0, 0), b2, voffB); PG8_STAGE(PG8_SB(0, 1), b2 + hstep, voffB); PG8_STAGE(PG8_SA(0, 0), a2, sofA[0]);
            PG8_WAIT_V(8); PG8_WAIT_L(0); PG8_BAR; PG8_MMA(1, 0, At, B0); PG8_MMA(1, 1, At, B1); PG8_BAR; PG8_SCHED;
            PG8_LDB(B0, 1, 0); PG8_LDB(B1, 1, 1); PG8_SCHED; PG8_LDA(At, 1, 0); PG8_STAGE(PG8_SA(0, 1), a2, sofA[1]);
            PG8_WAIT_V(8); PG8_WAIT_L(0); PG8_BAR; PG8_MMA(0, 0, At, B0); PG8_MMA(0, 1, At, B1); PG8_BAR; PG8_SCHED;
            PG8_LDA(At, 1, 1); PG8_STAGE(PG8_SB(1, 0), b3, voffB); PG8_STAGE(PG8_SB(1, 1), b3 + hstep, voffB); PG8_STAGE(PG8_SA(1, 0), a3, sofA[0]);
            PG8_WAIT_V(8); PG8_WAIT_L(0); PG8_BAR; PG8_MMA(1, 0, At, B0); PG8_MMA(1, 1, At, B1); PG8_BAR; PG8_SCHED;
            } else {
            PG8_LD8(B08, PG8_SB(0, 0), boff8, 2); PG8_LD8(B18, PG8_SB(0, 1), boff8, 2); PG8_SCHED; PG8_LD8(At8, PG8_SA(0, 0), aoff8, 4); PG8_STAGE(PG8_SA(1, 1), a1, cofA[1]);
            PG8_WAIT_V(8); PG8_WAIT_L(0); PG8_BAR; PG8_MMA8(0, 0, At8, B08); PG8_MMA8(0, 1, At8, B18); PG8_BAR; PG8_SCHED;
            PG8_LD8(At8, PG8_SA(0, 1), aoff8, 4); PG8_STAGE(PG8_SB(0, 0), b2, voffB); PG8_STAGE(PG8_SB(0, 1), b2 + hstep, voffB); PG8_STAGE(PG8_SA(0, 0), a2, sofA[0]);
            PG8_WAIT_V(8); PG8_WAIT_L(0); PG8_BAR; PG8_MMA8(1, 0, At8, B08); PG8_MMA8(1, 1, At8, B18); PG8_BAR; PG8_SCHED;
            PG8_LD8(B08, PG8_SB(1, 0), boff8, 2); PG8_LD8(B18, PG8_SB(1, 1), boff8, 2); PG8_SCHED; PG8_LD8(At8, PG8_SA(1, 0), aoff8, 4); PG8_STAGE(PG8_SA(0, 1), a2, sofA[1]);
            PG8_WAIT_V(8); PG8_WAIT_L(0); PG8_BAR; PG8_MMA8(0, 0, At8, B08); PG8_MMA8(0, 1, At8, B18); PG8_BAR; PG8_SCHED;
            PG8_LD8(At8, PG8_SA(1, 1), aoff8, 4); PG8_STAGE(PG8_SB(1, 0), b3, voffB); PG8_STAGE(PG8_SB(1, 1), b3 + hstep, voffB); PG8_STAGE(PG8_SA(1, 0), a3, sofA[0]);
            PG8_WAIT_V(8); PG8_WAIT_L(0); PG8_BAR; PG8_MMA8(1, 0, At8, B08); PG8_MMA8(1, 1, At8, B18); PG8_BAR; PG8_SCHED;
            }
        }
        if constexpr (F8) asm volatile("s_nop 15\n\ts_nop 15" ::: "memory");
        if (wr == 0) PG8_BAR;
        E(acc, cur, wr, wc, fr, fq);
        if (!has_next) break;
        cur = nxt; cA = nA; cB = nB; ++ui;
        if constexpr (GATHER) { _Pragma("unroll") for (int h_ = 0; h_ < 2; ++h_) _Pragma("unroll") for (int i_ = 0; i_ < 2; ++i_) cofA[h_][i_] = nofA[h_][i_]; }
        if (wr == 1) PG8_BAR;
    }
    PG8_WAIT_V(0);
    PG8_BAR;
#undef PG8_AOFF
#undef PG8_SA
#undef PG8_SB
#undef PG8_STAGE
#undef PG8_LDA
#undef PG8_LDB
#undef PG8_MMA
#undef PG8_MMA8
#undef PG8_LD8
#undef PG8_WAIT_V
#undef PG8_WAIT_L
#undef PG8_BAR
#undef PG8_SCHED
}
}
typedef float acc_t[2][2][4][2] __attribute__((unused));
#define ACC_ARG pg8::f32x4 (&acc)[2][2][4][2]
#define ZERO_ACC() do { _Pragma("unroll") for (int a_ = 0; a_ < 2; ++a_) _Pragma("unroll") for (int b_ = 0; b_ < 2; ++b_) _Pragma("unroll") for (int m_ = 0; m_ < 4; ++m_) _Pragma("unroll") for (int n_ = 0; n_ < 2; ++n_) acc[a_][b_][m_][n_] = (pg8::f32x4){0.f, 0.f, 0.f, 0.f}; } while (0)

__device__ __forceinline__ bool static_unit(int L, int nM, int nN, pg8::Unit& u) {
    const int nwg = nM * nN; if (L >= nwg) return false;
    int wgid = L; { const int q = nwg / 8, r = nwg % 8, xcd = wgid % 8, off = wgid / 8; wgid = (xcd < r ? xcd * (q + 1) : r * (q + 1) + (xcd - r) * q) + off; }
    const int nig = 8 * nN, gid = wgid / nig, fm = gid * 8, gsz = (nM - fm) < 8 ? (nM - fm) : 8;
    u.pm = fm + ((wgid % nig) % gsz); u.pn = (wgid % nig) / gsz; return true;
}

struct SchedIn {
    static constexpr bool GATHER = false;
    const char* A; const char* Bt; int G, c;
    __device__ __forceinline__ bool next(int i, pg8::Unit& u) const {
        const int L = i * G + c;
        if (L < 1664) return static_unit(L, 64, 26, u);
        if (L < 1680) { const int j = L - 1664; u.pm = 64 + (j >> 2); u.pn = 26 + (j & 3); return true; }
        return false;
    }
    __device__ __forceinline__ const char* a_base(const pg8::Unit& u) const { return A + (size_t)u.pm * (256 * 1024 * 2); }
    __device__ __forceinline__ const char* b_base(const pg8::Unit& u) const { return Bt + (size_t)u.pn * (256 * 1024 * 2); }
    __device__ __forceinline__ unsigned a_voff(const pg8::Unit&, int h, int R, int C, int K) const { return (unsigned)(((h * 128 + R) * K + C) * 2); }
};
struct SchedBr {
    static constexpr bool GATHER = false;
    const char* A; const char* Bt; int G, c;
    __device__ __forceinline__ bool next(int i, pg8::Unit& u) const {
        const int rnd = i / 3, br = i - rnd * 3; pg8::Unit t;
        if (!static_unit(rnd * G + c, 64, 4, t)) return false;
        u.pm = 64 * br + t.pm; u.pn = 4 * br + t.pn; return true;
    }
    __device__ __forceinline__ const char* a_base(const pg8::Unit& u) const { return A + (size_t)u.pm * (256 * 512 * 2); }
    __device__ __forceinline__ const char* b_base(const pg8::Unit& u) const { return Bt + (size_t)u.pn * (256 * 512 * 2); }
    __device__ __forceinline__ unsigned a_voff(const pg8::Unit&, int h, int R, int C, int K) const { return (unsigned)(((h * 128 + R) * K + C) * 2); }
};
struct SchedOut {
    static constexpr bool GATHER = false;
    const char* A; const char* Bt; int G, c;
    __device__ __forceinline__ bool next(int i, pg8::Unit& u) const { return static_unit(i * G + c, 64, 4, u); }
    __device__ __forceinline__ const char* a_base(const pg8::Unit& u) const { return A + (size_t)u.pm * (256 * 1024 * 2); }
    __device__ __forceinline__ const char* b_base(const pg8::Unit& u) const { return Bt + (size_t)u.pn * (256 * 1024 * 2); }
    __device__ __forceinline__ unsigned a_voff(const pg8::Unit&, int h, int R, int C, int K) const { return (unsigned)(((h * 128 + R) * K + C) * 2); }
};
template <bool G_> struct SchedMoE {
    static constexpr bool GATHER = G_;
    const char* A; const char* Bt; const LAS int* tile_e; const int* etok; int nmt, nN, G, v; size_t estride; int i0, i1;
    __device__ __forceinline__ bool next(int i, pg8::Unit& u) const {
        if (i + i0 >= i1) return false;
        const int L = (i + i0) * G + v; if (L < 0 || L >= nmt * nN) return false;
        u.pm = L / nN; u.pn = L - u.pm * nN; return true;
    }
    __device__ __forceinline__ const char* a_base(const pg8::Unit& u) const { return G_ ? A : A + (size_t)u.pm * (256 * 1024); }
    __device__ __forceinline__ const char* b_base(const pg8::Unit& u) const { return Bt + (size_t)(__builtin_amdgcn_readfirstlane(tile_e[u.pm]) & 31) * estride + (size_t)u.pn * (256 * 1024); }
    __device__ __forceinline__ unsigned a_voff(const pg8::Unit& u, int h, int R, int C, int K) const {
        if (!G_) return (unsigned)(((h * 128 + R) * K + C) * 2);
        const int te_ = __builtin_amdgcn_readfirstlane(tile_e[u.pm]);
        unsigned t = (unsigned)etok[(te_ & 31) * NTOK + (te_ >> 5) * 256 + h * 128 + R]; t = t < (unsigned)NTOK ? t : 0u;
        return (t * (unsigned)K + (unsigned)C) * 2u;
    }
};


struct EpiIn {
    bf16 *QA, *KV6, *QF, *KF, *VF, *QM, *GATES, *KMEM, *VMEM; float* LG;
    const float *ropeC, *ropeS, *b_merge;
    __device__ __forceinline__ void operator()(ACC_ARG, const pg8::Unit& u, int wr, int wc, int fr, int fq) const {
        const int pn = u.pn, rowb = u.pm * 256 + wr * 64 + fr;
        if (pn < 13) {
#pragma unroll
            for (int bj = 0; bj < 2; ++bj) {
                const int L0 = (4 * pn + 2 * bj + (wc >> 1)) * 64, a4 = 4 * (4 * (wc & 1) + fq);
                bf16* dst; int pitch, col0; bool rope = false; float sc = 1.f;
                if (L0 < 512) { dst = QA; pitch = 512; col0 = L0; rope = true; sc = C2_64; }
                else if (L0 < 1280) { const int kk = (L0 - 512) >> 7; dst = KV6 + (size_t)kk * NTOK * 128; pitch = 128; col0 = (L0 - 512) & 127; rope = !(kk & 1); }
                else if (L0 < 1792) { dst = QF; pitch = 512; col0 = L0 - 1280; sc = C2_64; }
                else if (L0 < 2304) { dst = KF; pitch = 512; col0 = L0 - 1792; }
                else if (L0 < 2816) { dst = VF; pitch = 512; col0 = L0 - 2304; }
                else { dst = QM; pitch = 512; col0 = L0 - 2816; sc = C2_128; }
                pg8::f32x4 cv[2][4], sv[2][4];
                if (rope) {
#pragma unroll
                    for (int ai = 0; ai < 2; ++ai)
#pragma unroll
                        for (int m = 0; m < 4; ++m) { const int t = (rowb + 128 * ai + 16 * m) & (SEQ - 1); cv[ai][m] = *(const pg8::f32x4*)(ropeC + t * 32 + a4); sv[ai][m] = *(const pg8::f32x4*)(ropeS + t * 32 + a4); }
                }
                __builtin_amdgcn_sched_barrier(0);
#pragma unroll
                for (int ai = 0; ai < 2; ++ai)
#pragma unroll
                    for (int m = 0; m < 4; ++m) {
                        const int r = rowb + 128 * ai + 16 * m;
                        pg8::f32x4 x1 = acc[ai][bj][m][0], x2 = acc[ai][bj][m][1];
                        if (rope) { const pg8::f32x4 c4 = cv[ai][m], s4 = sv[ai][m];
                            const pg8::f32x4 y1 = x1 * c4 - x2 * s4, y2 = x2 * c4 + x1 * s4; x1 = y1; x2 = y2; }
                        x1 = x1 * sc; x2 = x2 * sc;
                        bf16* p = dst + (size_t)r * pitch + col0 + a4;
                        *(u32x2*)p = (u32x2){cvtpk(x1[0], x1[1]), cvtpk(x1[2], x1[3])};
                        *(u32x2*)(p + 32) = (u32x2){cvtpk(x2[0], x2[1]), cvtpk(x2[2], x2[3])};
                    }
            }
        } else if (pn < 25) {
            pg8::f32x4 bv[2][2];
#pragma unroll
            for (int bj = 0; bj < 2; ++bj) { const int cg = 256 * (pn - 13) + 128 * bj + 32 * wc + 8 * fq; bv[bj][0] = *(const pg8::f32x4*)(b_merge + cg); bv[bj][1] = *(const pg8::f32x4*)(b_merge + cg + 4); }
            __builtin_amdgcn_sched_barrier(0);
#pragma unroll
            for (int bj = 0; bj < 2; ++bj) {
                const int cg = 256 * (pn - 13) + 128 * bj + 32 * wc + 8 * fq;
                const pg8::f32x4 b0 = bv[bj][0], b1 = bv[bj][1];
#pragma unroll
                for (int ai = 0; ai < 2; ++ai)
#pragma unroll
                    for (int m = 0; m < 4; ++m) {
                        const int r = rowb + 128 * ai + 16 * m;
                        const pg8::f32x4 v0 = acc[ai][bj][m][0] + b0, v1 = acc[ai][bj][m][1] + b1;
                        u32x2 w; unsigned p = 0u;
#pragma unroll
                        for (int k = 0; k < 4; ++k) p = __builtin_amdgcn_cvt_pk_u8_f32(fmaxf(255.f * fast_sigmoid(v0[k]), 1.f), k, p);
                        w.x = p; p = 0u;
#pragma unroll
                        for (int k = 0; k < 4; ++k) p = __builtin_amdgcn_cvt_pk_u8_f32(fmaxf(255.f * fast_sigmoid(v1[k]), 1.f), k, p);
                        w.y = p;
                        *(u32x2*)((unsigned char*)GATES + (size_t)r * 3072 + cg) = w;
                    }
            }
        } else if (pn == 25) {
            if (wc == 0) {
#pragma unroll
                for (int ai = 0; ai < 2; ++ai)
#pragma unroll
                    for (int m = 0; m < 4; ++m) {
                        const int r = rowb + 128 * ai + 16 * m;
                        float* p = LG + (size_t)r * 32 + 8 * fq;
                        *(pg8::f32x4*)p = acc[ai][0][m][0]; *(pg8::f32x4*)(p + 4) = acc[ai][0][m][1];
                    }
            }
        } else {
#pragma unroll
            for (int bj = 0; bj < 2; ++bj) {
                const int cgl = 256 * (pn - 26) + 128 * bj + 32 * wc + 8 * fq;
                bf16* dst = (cgl < 512) ? KMEM : VMEM; const int col = cgl & 511;
#pragma unroll
                for (int ai = 0; ai < 2; ++ai)
#pragma unroll
                    for (int m = 0; m < 4; ++m) {
                        const int r = rowb + 128 * ai + 16 * m - NTOK;
                        const pg8::f32x4 v0 = acc[ai][bj][m][0], v1 = acc[ai][bj][m][1];
                        u32x4 w; w.x = cvtpk(v0[0], v0[1]); w.y = cvtpk(v0[2], v0[3]); w.z = cvtpk(v1[0], v1[1]); w.w = cvtpk(v1[2], v1[3]);
                        *(u32x4*)(dst + (size_t)r * 512 + col) = w;
                    }
            }
        }
        ZERO_ACC();
    }
};

struct EpiBr {
    const bf16* GATES; bf16* MERGED;
    __device__ __forceinline__ void operator()(ACC_ARG, const pg8::Unit& u, int wr, int wc, int fr, int fq) const {
        const int br = u.pn >> 2, tn = u.pn & 3, tm = u.pm & 63, rowb = tm * 256 + wr * 64 + fr;
        const unsigned char* gp = (const unsigned char*)GATES + (size_t)rowb * 3072 + 1024 * br + 256 * tn + 32 * wc + 8 * fq;
        u32x2 GA[2][4][2], GB[2][4][2];
#pragma unroll
        for (int ai = 0; ai < 2; ++ai)
#pragma unroll
            for (int m = 0; m < 4; ++m)
#pragma unroll
                for (int bj = 0; bj < 2; ++bj) { const unsigned char* p = gp + (size_t)(128 * ai + 16 * m) * 3072 + 128 * bj;
                    GA[ai][m][bj] = *(const u32x2*)p; GB[ai][m][bj] = (br < 2) ? *(const u32x2*)(p + 1024) : (u32x2){0u, 0u}; }
        __builtin_amdgcn_sched_barrier(0);
#pragma unroll
        for (int ai = 0; ai < 2; ++ai)
#pragma unroll
            for (int m = 0; m < 4; ++m) {
                const int r = rowb + 128 * ai + 16 * m;
#pragma unroll
                for (int bj = 0; bj < 2; ++bj) {
                    const int c0 = 256 * tn + 128 * bj + 32 * wc + 8 * fq;
                    const u32x2 ga = GA[ai][m][bj];
                    pg8::f32x4 g0 = {(float)(ga.x & 255u), (float)((ga.x >> 8) & 255u), (float)((ga.x >> 16) & 255u), (float)(ga.x >> 24)}, g1 = {(float)(ga.y & 255u), (float)((ga.y >> 8) & 255u), (float)((ga.y >> 16) & 255u), (float)(ga.y >> 24)};
#if defined(ABL_BR)
                    if (!((ABL_BR >> br) & 1)) { acc[ai][bj][m][0] = acc[ai][bj][m][0] * 0.f; acc[ai][bj][m][1] = acc[ai][bj][m][1] * 0.f; }
#endif
                    if (br < 2) {
                        const u32x2 gb = GB[ai][m][bj];
                        const pg8::f32x4 h0 = {(float)(gb.x & 255u), (float)((gb.x >> 8) & 255u), (float)((gb.x >> 16) & 255u), (float)(gb.x >> 24)}, h1 = {(float)(gb.y & 255u), (float)((gb.y >> 8) & 255u), (float)((gb.y >> 16) & 255u), (float)(gb.y >> 24)};
#pragma unroll
                        for (int k = 0; k < 4; ++k) { g0[k] = g0[k] * __builtin_amdgcn_rcpf(fmaxf(h0[k], 1.f)); g1[k] = g1[k] * __builtin_amdgcn_rcpf(fmaxf(h1[k], 1.f)); }
                        acc[ai][bj][m][0] = acc[ai][bj][m][0] * g0; acc[ai][bj][m][1] = acc[ai][bj][m][1] * g1;
                    } else {
                        const pg8::f32x4 v0 = acc[ai][bj][m][0] * g0 * (1.f / 255.f), v1 = acc[ai][bj][m][1] * g1 * (1.f / 255.f);
                        u32x4 w; w.x = cvtpk(v0[0], v0[1]); w.y = cvtpk(v0[2], v0[3]); w.z = cvtpk(v1[0], v1[1]); w.w = cvtpk(v1[2], v1[3]);
                        *(u32x4*)(MERGED + (size_t)r * 1024 + c0) = w;
                        acc[ai][bj][m][0] = (pg8::f32x4){0.f, 0.f, 0.f, 0.f}; acc[ai][bj][m][1] = (pg8::f32x4){0.f, 0.f, 0.f, 0.f};
                    }
                }
            }
    }
};

struct EpiOut {
    const float* X; float* X1; unsigned char* XB8;
    __device__ __forceinline__ void operator()(ACC_ARG, const pg8::Unit& u, int wr, int wc, int fr, int fq) const {
        const int rowb = u.pm * 256 + wr * 64 + fr;
        const size_t ob = (size_t)rowb * 1024 + 256 * u.pn + 32 * wc + 8 * fq;
#pragma unroll
        for (int ai = 0; ai < 2; ++ai) {
            pg8::f32x4 xs[4][2][2];
#pragma unroll
            for (int m = 0; m < 4; ++m)
#pragma unroll
                for (int bj = 0; bj < 2; ++bj) { const float* p = X + ob + (size_t)(128 * ai + 16 * m) * 1024 + 128 * bj; xs[m][bj][0] = *(const pg8::f32x4*)p; xs[m][bj][1] = *(const pg8::f32x4*)(p + 4); }
            __builtin_amdgcn_sched_barrier(0);
#pragma unroll
            for (int m = 0; m < 4; ++m)
#pragma unroll
                for (int bj = 0; bj < 2; ++bj) {
                    const size_t o = ob + (size_t)(128 * ai + 16 * m) * 1024 + 128 * bj;
                    const pg8::f32x4 y0 = xs[m][bj][0] + acc[ai][bj][m][0], y1 = xs[m][bj][1] + acc[ai][bj][m][1];
                    *(pg8::f32x4*)(X1 + o) = y0; *(pg8::f32x4*)(X1 + o + 4) = y1;
                    *(u32x2*)(XB8 + o) = (u32x2){pk_fp8x4(y0[0], y0[1], y0[2], y0[3]), pk_fp8x4(y1[0], y1[1], y1[2], y1[3])};
                }
            __builtin_amdgcn_sched_barrier(0);
        }
        ZERO_ACC();
    }
};

__device__ __forceinline__ float swiglu(float g, float uu) {
    g = fminf(g, 7.0f); uu = fminf(fmaxf(uu, -7.0f), 7.0f);
    return (uu + 1.0f) * g * __builtin_amdgcn_rcpf(1.0f + __builtin_amdgcn_exp2f(-1.702f * LOG2E * g));
}
struct EpiGU {
    const float* bias; const LAS int* tile_e; unsigned char* ACT8; const float* erstd;
    __device__ __forceinline__ void operator()(ACC_ARG, const pg8::Unit& u, int wr, int wc, int fr, int fq) const {
        const int te_ = __builtin_amdgcn_readfirstlane(tile_e[u.pm]), e = te_ & 31, rowb = u.pm * 256 + wr * 64 + fr;
        const float* rslot = erstd + (size_t)e * NTOK + (te_ >> 5) * 256 - u.pm * 256;
        float rsv[2][4]; pg8::f32x4 bv[2][2];
#pragma unroll
        for (int ai = 0; ai < 2; ++ai)
#pragma unroll
            for (int m = 0; m < 4; ++m) rsv[ai][m] = rslot[rowb + 128 * ai + 16 * m];
#pragma unroll
        for (int bj = 0; bj < 2; ++bj) { const int c0 = 256 * u.pn + 128 * bj + 32 * wc + 8 * fq; bv[bj][0] = *(const pg8::f32x4*)(bias + (size_t)e * 2048 + c0); bv[bj][1] = *(const pg8::f32x4*)(bias + (size_t)e * 2048 + c0 + 4); }
        __builtin_amdgcn_sched_barrier(0);
#pragma unroll
        for (int bj = 0; bj < 2; ++bj) {
            const int c0 = 256 * u.pn + 128 * bj + 32 * wc + 8 * fq;
            const pg8::f32x4 b0 = bv[bj][0], b1 = bv[bj][1];
#pragma unroll
            for (int ai = 0; ai < 2; ++ai)
#pragma unroll
                for (int m = 0; m < 4; ++m) {
                    const int r = rowb + 128 * ai + 16 * m; const float rs = rsv[ai][m] * (1.0f / W8_SCALE);
                    const pg8::f32x4 v0 = acc[ai][bj][m][0] * rs + b0, v1 = acc[ai][bj][m][1] * rs + b1;
                    *(unsigned*)(ACT8 + (size_t)r * 1024 + (c0 >> 1)) = pk_fp8x4(ACT8_SCALE * swiglu(v0[0], v0[1]), ACT8_SCALE * swiglu(v0[2], v0[3]), ACT8_SCALE * swiglu(v1[0], v1[1]), ACT8_SCALE * swiglu(v1[2], v1[3]));
                }
        }
        ZERO_ACC();
    }
};
struct EpiDn {
    const float* bias; const LAS int* tile_e; bf16* OS;
    __device__ __forceinline__ void operator()(ACC_ARG, const pg8::Unit& u, int wr, int wc, int fr, int fq) const {
        const int e = __builtin_amdgcn_readfirstlane(tile_e[u.pm]) & 31, rowb = u.pm * 256 + wr * 64 + fr;
        pg8::f32x4 bv[2][2];
#pragma unroll
        for (int bj = 0; bj < 2; ++bj) { const int c0 = 256 * u.pn + 128 * bj + 32 * wc + 8 * fq; bv[bj][0] = *(const pg8::f32x4*)(bias + (size_t)e * 1024 + c0); bv[bj][1] = *(const pg8::f32x4*)(bias + (size_t)e * 1024 + c0 + 4); }
        __builtin_amdgcn_sched_barrier(0);
#pragma unroll
        for (int bj = 0; bj < 2; ++bj) {
            const int c0 = 256 * u.pn + 128 * bj + 32 * wc + 8 * fq;
            const pg8::f32x4 b0 = bv[bj][0], b1 = bv[bj][1];
#pragma unroll
            for (int ai = 0; ai < 2; ++ai)
#pragma unroll
                for (int m = 0; m < 4; ++m) {
                    const int r = rowb + 128 * ai + 16 * m;
                    const pg8::f32x4 v0 = acc[ai][bj][m][0] * (1.0f / (W8_SCALE * ACT8_SCALE)) + b0, v1 = acc[ai][bj][m][1] * (1.0f / (W8_SCALE * ACT8_SCALE)) + b1;
                    u32x4 w; w.x = cvtpk(v0[0], v0[1]); w.y = cvtpk(v0[2], v0[3]); w.z = cvtpk(v1[0], v1[1]); w.w = cvtpk(v1[2], v1[3]);
                    *(u32x4*)(OS + (size_t)r * 1024 + c0) = w;
                }
        }
        ZERO_ACC();
    }
};
struct KArgs { const float* in[26]; float* out; unsigned char* ws; int ph_lo, ph_hi; };
struct Frame {
    LAS unsigned char* lds;
    int tid, lane, wave, G, bid, vcu;
    const KArgs __attribute__((address_space(4)))* ka; float* out; unsigned char* ws;
};
#define WSP(T, off) ((T*)(F.ws + (off)))

__device__ __forceinline__ int win_srccol(int n) {
    if (n < 3328) { const int p = n & 63, d = 4 * (p >> 3) + (p & 3) + 32 * ((p >> 2) & 1), L = (n & ~63) + d;
        if (L < 1280) return L; if (L < 1792) return 1304 + (L - 1280); if (L < 2304) return 1816 + (L - 1792); if (L < 2816) return 2328 + (L - 2304); return 2848 + (L - 2816); }
    if (n < 6400) return 3360 + (n - 3328);
    if (n < 6424) return 1280 + (n - 6400);
    if (n < 6432) return 2840 + (n - 6424);
    return -1;
}
__device__ __forceinline__ void transpose_item(const float* __restrict__ W, int N, bf16* __restrict__ Wt, int Kd, int n0, int k0, int sc, LAS float* scr, int lane, const float* __restrict__ kscale = nullptr) {
    const float* src = W + (size_t)k0 * N + (sc >= 0 ? sc : 0);
    float v[64];
#pragma unroll
    for (int kk = 0; kk < 64; ++kk) v[kk] = src[(size_t)kk * N];
    if (kscale) {
#pragma unroll
        for (int kk = 0; kk < 64; ++kk) v[kk] *= kscale[k0 + kk];
    }
#pragma unroll
    for (int kk = 0; kk < 64; ++kk) scr[kk * 65 + lane] = (sc >= 0) ? v[kk] : 0.f;
    asm volatile("s_waitcnt lgkmcnt(0)" ::: "memory");
    const int c = lane & 7;
#pragma unroll
    for (int j = 0; j < 8; ++j) { const int n = (lane >> 3) + 8 * j; const LAS float* s = scr + (8 * c) * 65 + n;
        u32x4 o; o.x = cvtpk(s[0], s[65]); o.y = cvtpk(s[2 * 65], s[3 * 65]); o.z = cvtpk(s[4 * 65], s[5 * 65]); o.w = cvtpk(s[6 * 65], s[7 * 65]);
        *(u32x4*)(Wt + (size_t)(n0 + n) * Kd + k0 + 8 * c) = o; }
    asm volatile("s_waitcnt lgkmcnt(0)" ::: "memory");
}
__device__ __forceinline__ void transpose_item8(const float* __restrict__ W, int N, unsigned char* __restrict__ Wt8, int Kd, int n0, int k0, LAS unsigned char* scr, int lane, const float* __restrict__ kscale, float mul) {
    const float* src = W + (size_t)k0 * N + n0 + lane;
#pragma unroll
    for (int half = 0; half < 2; ++half) {
        float v[64];
#pragma unroll
        for (int kk = 0; kk < 64; ++kk) v[kk] = src[(size_t)(64 * half + kk) * N];
#pragma unroll
        for (int kk = 0; kk < 64; ++kk) v[kk] *= kscale ? mul * kscale[k0 + 64 * half + kk] : mul;
#pragma unroll
        for (int j = 0; j < 32; ++j) { const float a = fminf(fmaxf(v[2 * j], -448.f), 448.f), b = fminf(fmaxf(v[2 * j + 1], -448.f), 448.f);
            *(LAS unsigned short*)(scr + lane * 132 + 64 * half + 2 * j) = (unsigned short)__builtin_amdgcn_cvt_pk_fp8_f32(a, b, 0, false); }
    }
    asm volatile("s_waitcnt lgkmcnt(0)" ::: "memory");
    const int c = lane & 7;
#pragma unroll
    for (int j = 0; j < 8; ++j) { const int n = (lane >> 3) + 8 * j; const LAS unsigned* s = (const LAS unsigned*)(scr + n * 132 + 16 * c);
        u32x4 o; o.x = s[0]; o.y = s[1]; o.z = s[2]; o.w = s[3];
        *(u32x4*)(Wt8 + (size_t)(n0 + n) * Kd + k0 + 16 * c) = o; }
    asm volatile("s_waitcnt lgkmcnt(0)" ::: "memory");
}
__device__ __forceinline__ void rms_row_bf16(const float* __restrict__ xrow, const float* __restrict__ g, bf16* __restrict__ orow, int lane) {
    const f32x4* xr = (const f32x4*)xrow + lane; const f32x4* gr = (const f32x4*)g + lane;
    f32x4 v[4]; float s = 0.f;
#pragma unroll
    for (int j = 0; j < 4; ++j) { v[j] = xr[64 * j]; s += (v[j].x * v[j].x + v[j].y * v[j].y) + (v[j].z * v[j].z + v[j].w * v[j].w); }
    const float rstd = 1.0f / sqrtf(wave_sum(s) * (1.f / 1024.f) + RMS_EPS);
    u32x2* o8 = (u32x2*)orow + lane;
#pragma unroll
    for (int j = 0; j < 4; ++j) { const f32x4 gg = gr[64 * j]; o8[64 * j] = (u32x2){cvtpk(v[j].x * rstd * gg.x, v[j].y * rstd * gg.y), cvtpk(v[j].z * rstd * gg.z, v[j].w * rstd * gg.w)}; }
}
__device__ __forceinline__ void sincos_big(float ang, float& s, float& c) {
    const double x = (double)ang; const double kf = __builtin_rint(x * 0.63661977236758134308); const int k = (int)kf;
    const double r = (x - kf * 1.57079632679489655800) - kf * 6.123233995736766036e-17, r2 = r * r;
    const double sp = r * (1.0 + r2 * (-1.0 / 6 + r2 * (1.0 / 120 + r2 * (-1.0 / 5040 + r2 * (1.0 / 362880 - r2 * (1.0 / 39916800))))));
    const double cp = 1.0 + r2 * (-0.5 + r2 * (1.0 / 24 + r2 * (-1.0 / 720 + r2 * (1.0 / 40320 + r2 * (-1.0 / 3628800 + r2 * (1.0 / 479001600))))));
    const double ss = (k & 1) ? cp : sp, cc = (k & 1) ? sp : cp;
    s = (float)((k & 2) ? -ss : ss); c = (float)(((k + 1) & 2) ? -cc : cc);
}
__device__ __forceinline__ void attn_unit_desc(int i, unsigned& desc, int& cost) {
    if (i < 512) { const int bg = i >> 6, T = i & 63; desc = 0u | (bg << 3) | (T << 11); cost = 8 + (T + 1) + (T < 8 ? T + 1 : 9) + 2 * (T / 4 + 1); }
    else { const int j = i - 512, bh = j >> 4, qb = j & 15; desc = 1u | (bh << 3) | (qb << 11); cost = 3 + 4 * qb + 3; }
}
constexpr int N_SORTED = 1024, MAXCOST = 128, N_CVT_UNITS = 256, CVT_CHUNK = 12;
constexpr int Q_CMP0 = 0, Q_CUM0 = 128, Q_CVT0 = 132, Q_MEM0 = Q_CVT0 + N_CVT_UNITS, Q_SRT0 = Q_MEM0 + 256, N_QUEUE = Q_SRT0 + N_SORTED;
constexpr int CW_CMPDONE = 8192, CW_CUMDONE = 8192 + 64 * 8;

__device__ __forceinline__ void p0_prologue(Frame& F) {
    LAS float* scr = (LAS float*)(F.lds + F.wave * 16640);
    const int gw = F.vcu * NWAVES + F.wave, NGW = F.G * NWAVES, lane = F.lane;
    bf16* HA = WSP(bf16, WS_HA);
    for (int m0 = gw; m0 < NTOK + NMEMROW; m0 += 4 * NGW) {
        f32x4 v[4][4]; float ss[4]; const float* xr[4]; bool has[4];
#pragma unroll
        for (int q = 0; q < 4; ++q) { const int m = m0 + q * NGW; has[q] = m < NTOK + NMEMROW; const int mm = has[q] ? m : m0;
            xr[q] = (mm < NTOK) ? F.ka->in[0] + (size_t)mm * DM : F.ka->in[1] + (size_t)(mm - NTOK) * DM; }
#pragma unroll
        for (int j = 0; j < 4; ++j)
#pragma unroll
            for (int q = 0; q < 4; ++q) v[q][j] = ((const f32x4*)xr[q])[64 * j + lane];
#pragma unroll
        for (int q = 0; q < 4; ++q) { float s_ = 0.f;
#pragma unroll
            for (int j = 0; j < 4; ++j) s_ += (v[q][j].x * v[q][j].x + v[q][j].y * v[q][j].y) + (v[q][j].z * v[q][j].z + v[q][j].w * v[q][j].w);
            ss[q] = s_; }
#pragma unroll
        for (int o = 1; o < 64; o <<= 1) {
#pragma unroll
            for (int q = 0; q < 4; ++q) ss[q] += __shfl_xor(ss[q], o); }
#pragma unroll
        for (int q = 0; q < 4; ++q) { const int m = m0 + q * NGW; const float r = 1.0f / sqrtf(ss[q] * (1.f / 1024.f) + RMS_EPS);
            const f32x4* g = (const f32x4*)((m < NTOK) ? F.ka->in[2] : F.ka->in[12]);
            if (has[q]) {
#pragma unroll
                for (int j = 0; j < 4; ++j) { const f32x4 a = g[64 * j + lane];
                    ((u32x2*)(HA + (size_t)m * DM))[64 * j + lane] = (u32x2){cvtpk(v[q][j].x * r * a.x, v[q][j].y * r * a.y), cvtpk(v[q][j].z * r * a.z, v[q][j].w * r * a.w)}; } } }
    }
    constexpr int I_WIN = 104 * 16, I_MKV = 16 * 16, I_BR = 16 * 8, I_OUT = 256, I_W1 = 32, I_W2 = 1;
    constexpr int NITEMS = I_WIN + I_MKV + 3 * I_BR + I_OUT + 2 * I_W1 + 2 * I_W2;
    for (int it = gw; it < NITEMS; it += NGW) {
        int r = it;
        if (r < I_WIN) { const int kt = r / 104, nt = r - kt * 104; transpose_item(F.ka->in[3], DIN, WSP(bf16, WS_WIN_T), 1024, nt * 64, kt * 64, win_srccol(nt * 64 + lane), scr, lane); continue; } r -= I_WIN;
        if (r < I_MKV) { const int kt = r >> 4, nt = r & 15; transpose_item(F.ka->in[13], 1024, WSP(bf16, WS_WIN_T) + (size_t)NIN * 1024, 1024, nt * 64, kt * 64, nt * 64 + lane, scr, lane); continue; } r -= I_MKV;
        if (r < 3 * I_BR) { const int b = r / I_BR, q = r - b * I_BR, kt = q >> 4, nt = q & 15; transpose_item(b == 0 ? F.ka->in[14] : (b == 1 ? F.ka->in[15] : F.ka->in[16]), 1024, WSP(bf16, WS_WBR_T) + (size_t)b * 1024 * 512, 512, nt * 64, kt * 64, nt * 64 + lane, scr, lane); continue; } r -= 3 * I_BR;
        if (r < I_OUT) { const int kt = r >> 4, nt = r & 15; transpose_item(F.ka->in[17], 1024, WSP(bf16, WS_WOUT_T), 1024, nt * 64, kt * 64, nt * 64 + lane, scr, lane); continue; } r -= I_OUT;
        if (r < 2 * I_W1) { const int b = r / I_W1, kt = r - b * I_W1; transpose_item(b ? F.ka->in[10] : F.ka->in[7], 64, b ? WSP(bf16, WS_W1T_V) : WSP(bf16, WS_W1T_K), 2048, 0, kt * 64, lane, scr, lane); continue; } r -= 2 * I_W1;
        { transpose_item(r ? F.ka->in[11] : F.ka->in[8], 64, r ? WSP(bf16, WS_W2T_V) : WSP(bf16, WS_W2T_K), 64, 0, 0, lane, scr, lane); }
    }
    { float* rc = WSP(float, WS_ROPE_C); float* rs = WSP(float, WS_ROPE_S);
      for (int idx = F.bid * NTHREADS + F.tid; idx < SEQ * 32; idx += F.G * NTHREADS) { const int t = idx >> 5, i = idx & 31;
          const float inv = exp2f(-(float)i * (13.287712379549449f / 32.0f)); const float ang = (float)t * inv; float s, c; sincos_big(ang, s, c); rc[idx] = c; rs[idx] = s; } }
    { bf16* wrh = WSP(bf16, WS_WRT); const float* wr = F.ka->in[19]; const float* gf = F.ka->in[18];
      for (int idx = F.bid * NTHREADS + F.tid; idx < 32 * 1024; idx += F.G * NTHREADS) { const int e = idx >> 10, k = idx & 1023; const float v = wr[k * 32 + e] * gf[k];
          const unsigned h = cvtpk(v, 0.f) & 0xffffu; const float lo = v - bflo(h); wrh[idx] = (bf16)h; wrh[32 * 1024 + idx] = (bf16)(cvtpk(lo, 0.f) & 0xffffu); } }
    if (gw >= NGW - 128) { const int j = gw - (NGW - 128), kv = j >> 6, part = j & 63; const float* pe = kv ? F.ka->in[9] : F.ka->in[6]; const float* w1 = kv ? F.ka->in[10] : F.ka->in[7]; float a = 0.f;
#pragma unroll 16
        for (int k = part * 32; k < part * 32 + 32; ++k) a += pe[k] * w1[k * 64 + lane];
        WSP(float, WS_CPE)[(kv * 64 + part) * 64 + lane] = a; }
    if (F.bid == 0) {
        __syncthreads();
        LAS int* hist = (LAS int*)F.lds;
        LAS unsigned* sorted = (LAS unsigned*)(hist + 3 * MAXCOST);
        for (int i = F.tid; i < 3 * MAXCOST; i += NTHREADS) hist[i] = 0;
        __syncthreads();
        for (int i = F.tid; i < N_SORTED; i += NTHREADS) { unsigned d; int c; attn_unit_desc(i, d, c); atomicAdd((int*)(hist + c), 1); }
        __syncthreads();
        if (F.tid < MAXCOST) { int run = 0; for (int c = F.tid + 1; c < MAXCOST; ++c) run += hist[c]; hist[MAXCOST + F.tid] = run; }
        __syncthreads();
        for (int i = F.tid; i < N_SORTED; i += NTHREADS) { unsigned d; int c; attn_unit_desc(i, d, c); const int pos = hist[MAXCOST + c] + atomicAdd((int*)(hist + 2 * MAXCOST + c), 1); sorted[pos] = d; }
        __syncthreads();
        unsigned* order = WSP(unsigned, WS_ORDER);
        for (int i = F.tid; i < N_QUEUE; i += NTHREADS) {
            unsigned d;
            if (i < Q_CUM0) d = 3u | ((unsigned)(i >> 6) << 3) | ((unsigned)(i & 63) << 11);
            else if (i < Q_CVT0) d = 4u | ((unsigned)(i - Q_CUM0) << 3);
            else if (i < Q_MEM0) d = 5u | ((unsigned)(i - Q_CVT0) << 11);
            else if (i < Q_SRT0) { const int j = i - Q_MEM0; d = 2u | ((unsigned)(j >> 4) << 3) | ((unsigned)(j & 15) << 11); }
            else d = sorted[i - Q_SRT0];
            order[i] = d;
        }
        __syncthreads();
    }
}

struct CvtItem { const float* src; unsigned char* dst; const float* ks; int N; };
__device__ __forceinline__ CvtItem cvt_item(Frame& F, int g, int wv, int lane) {
    const int e = g / 96, q = g - e * 96; CvtItem I;
    if (q < 64) { const int kt = q >> 3, ng = (q + kt + e) & 7, k0 = kt * 128 + 16 * wv, n0 = ng * 256 + 4 * lane;
        I.src = F.ka->in[21] + (size_t)e * 1024 * 2048 + (size_t)k0 * 2048 + n0; I.N = 2048; I.dst = WSP(unsigned char, WS_WGU_T) + (size_t)e * 2048 * 1024 + (size_t)n0 * 1024 + k0; I.ks = F.ka->in[18] + k0; }
    else { const int q2 = q - 64, kt = q2 >> 2, ng = (q2 + kt + e) & 3, k0 = kt * 128 + 16 * wv, n0 = ng * 256 + 4 * lane;
        I.src = F.ka->in[23] + (size_t)e * 1024 * 1024 + (size_t)k0 * 1024 + n0; I.N = 1024; I.dst = WSP(unsigned char, WS_WD_T) + (size_t)e * 1024 * 1024 + (size_t)n0 * 1024 + k0; I.ks = nullptr; }
    return I;
}
__device__ __forceinline__ void cvt_load(f32x4 (&v)[16], const CvtItem& I) {
#pragma unroll
    for (int kk = 0; kk < 16; ++kk) v[kk] = *(const f32x4*)(I.src + (size_t)kk * I.N);
}
__device__ __forceinline__ void cvt_store(const f32x4 (&v)[16], const CvtItem& I) {
    float sc[16];
#pragma unroll
    for (int kk = 0; kk < 16; ++kk) sc[kk] = I.ks ? W8_SCALE * I.ks[kk] : W8_SCALE;
#pragma unroll
    for (int j = 0; j < 4; ++j) { u32x4 o;
#pragma unroll
        for (int q = 0; q < 4; ++q) o[q] = pk_fp8x4(v[4 * q][j] * sc[4 * q], v[4 * q + 1][j] * sc[4 * q + 1], v[4 * q + 2][j] * sc[4 * q + 2], v[4 * q + 3][j] * sc[4 * q + 3]);
        *(u32x4*)(I.dst + (size_t)j * 1024) = o; }
}
__device__ __forceinline__ void convert_unit(Frame& F, int cu) {
    int tid_ = threadIdx.x; asm volatile("" : "+v"(tid_)); const int lane = tid_ & 63, wv = __builtin_amdgcn_readfirstlane(tid_ >> 6);
    f32x4 a[16], b[16];
    CvtItem Ia = cvt_item(F, cu * CVT_CHUNK, wv, lane), Ib; cvt_load(a, Ia);
#pragma clang loop unroll(disable)
    for (int bi = 0; bi < CVT_CHUNK; bi += 2) {
        Ib = cvt_item(F, cu * CVT_CHUNK + bi + 1, wv, lane); cvt_load(b, Ib);
        cvt_store(a, Ia);
        if (bi + 2 < CVT_CHUNK) { Ia = cvt_item(F, cu * CVT_CHUNK + bi + 2, wv, lane); cvt_load(a, Ia); }
        cvt_store(b, Ib);
    }
}
__device__ __forceinline__ void q_signal(unsigned* p, int tid) {
    asm volatile("s_waitcnt vmcnt(0)" ::: "memory"); __syncthreads();
    if (tid == 0) { __builtin_amdgcn_fence(__ATOMIC_RELEASE, "agent"); asm volatile("s_waitcnt vmcnt(0)" ::: "memory"); __hip_atomic_fetch_add(p, 1u, __ATOMIC_RELAXED, __HIP_MEMORY_SCOPE_AGENT); }
}
__device__ __forceinline__ void q_wait(unsigned* p, unsigned want, int tid) {
    if (tid == 0) { unsigned sp = 0; while (__hip_atomic_load(p, __ATOMIC_RELAXED, __HIP_MEMORY_SCOPE_AGENT) < want && ++sp < (1u << 24)) __builtin_amdgcn_s_sleep(2);
        __builtin_amdgcn_fence(__ATOMIC_ACQUIRE, "agent"); asm volatile("s_waitcnt vmcnt(0)" ::: "memory"); }
    __syncthreads();
}

__device__ __forceinline__ void p2_compress_unit(Frame& F, int kv, int rt) {
    int tid_ = threadIdx.x; asm volatile("" : "+v"(tid_)); const int lane = tid_ & 63, w = __builtin_amdgcn_readfirstlane(tid_ >> 6), r32 = lane & 31, hi = lane >> 5;
    const bf16* src = WSP(bf16, WS_KV6) + (size_t)kv * NTOK * 128;
    const bf16* w1t = WSP(bf16, kv ? WS_W1T_V : WS_W1T_K); const bf16* w2t = WSP(bf16, kv ? WS_W2T_V : WS_W2T_K);
    const int R = rt * 32 + r32, bg = R >> 8, n = R & 255, b = bg >> 1, g = bg & 1;
    f32x16 acc0 = {}, acc1 = {};
#pragma unroll 4
    for (int st = 0; st < 16; ++st) {
        const int step = w * 16 + st, l = step >> 2, d = 16 * (step & 3) + 8 * hi;
        int tok = 16 * n + l; tok = tok < SEQ ? tok : SEQ - 1;
        const bf16x8 a = *(const bf16x8*)(src + ((size_t)(b * SEQ + tok)) * 128 + g * 64 + d);
        const bf16x8 b0 = *(const bf16x8*)(w1t + (size_t)r32 * 2048 + 16 * step + 8 * hi);
        const bf16x8 b1 = *(const bf16x8*)(w1t + (size_t)(32 + r32) * 2048 + 16 * step + 8 * hi);
        acc0 = __builtin_amdgcn_mfma_f32_32x32x16_bf16(a, b0, acc0, 0, 0, 0);
        acc1 = __builtin_amdgcn_mfma_f32_32x32x16_bf16(a, b1, acc1, 0, 0, 0);
    }
    LAS float* red = (LAS float*)F.lds;
    LAS bf16* zs = (LAS bf16*)(F.lds + 65536);
    __syncthreads();
#pragma unroll
    for (int r = 0; r < 16; ++r) { const int row = (r & 3) + 8 * (r >> 2) + 4 * hi; red[(w * 32 + row) * 64 + r32] = acc0[r]; red[(w * 32 + row) * 64 + 32 + r32] = acc1[r]; }
    __syncthreads();
    const float* cpe = WSP(float, WS_CPE) + kv * 4096;
    for (int idx = F.tid; idx < 2048; idx += NTHREADS) { float z = 0.f;
#pragma unroll
        for (int pp = 0; pp < 64; ++pp) z += cpe[pp * 64 + (idx & 63)];
#pragma unroll
        for (int ww = 0; ww < 8; ++ww) z += red[ww * 2048 + idx];
        const float sl = z * fast_sigmoid(z); zs[idx] = (bf16)(cvtpk(sl, 0.f) & 0xffffu); }
    __syncthreads();
    if (w < 2) {
        f32x16 o = {};
#pragma unroll
        for (int st = 0; st < 4; ++st) {
            const bf16x8 a = *(const LAS bf16x8*)(zs + r32 * 64 + 16 * st + 8 * hi);
            const bf16x8 bb = *(const bf16x8*)(w2t + (size_t)(32 * w + r32) * 64 + 16 * st + 8 * hi);
            o = __builtin_amdgcn_mfma_f32_32x32x16_bf16(a, bb, o, 0, 0, 0);
        }
        const int rbase = rt * 32;
#pragma unroll
        for (int r = 0; r < 16; ++r) { const int row = (r & 3) + 8 * (r >> 2) + 4 * hi, RR = rbase + row, nn = RR & 255;
            const float v = (nn == 255) ? 0.f : o[r];
            if (kv == 0) WSP(bf16, WS_KCMP)[(size_t)RR * 64 + 32 * w + r32] = (bf16)(cvtpk(v, 0.f) & 0xffffu);
            else WSP(bf16, WS_VCMP)[(size_t)RR * 128 + 32 * w + r32] = (bf16)(cvtpk(v, 0.f) & 0xffffu); }
    } else if (kv == 1) {
        for (int idx = F.tid - 128; idx < 2048; idx += NTHREADS - 128) { const int row = idx >> 6, j = idx & 63, RR = rt * 32 + row, nn = RR & 255;
            const bool ov = (nn != 255) && (nn >= 4 * j - 1) && (nn <= 4 * j + 3);
            WSP(bf16, WS_VCMP)[(size_t)RR * 128 + 64 + j] = ov ? (bf16)0x3f80 : (bf16)0; }
    }
    __syncthreads();
}
__device__ __forceinline__ float log_sigmoid_f(float x) { return fminf(x, 0.f) - log1pf(expf(-fabsf(x))); }
__device__ __forceinline__ void p2_cumsum_unit(Frame& F, int bh) {
    const int lane = F.lane, b = bh >> 3, h = bh & 7; const float bf = F.ka->in[4][h];
    const float* lg = WSP(float, WS_LG) + (size_t)(b * SEQ + 64 * lane) * 32 + 24 + h;
    double tot = 0.0;
    for (int i = 0; i < 64; ++i) tot += (double)log_sigmoid_f(lg[(size_t)i * 32] + bf);
    double inc = tot;
#pragma unroll
    for (int o = 1; o < 64; o <<= 1) { const double v = __shfl_up(inc, o); if (lane >= o) inc += v; }
    double run = inc - tot;
    float* cum = WSP(float, WS_CUM) + (size_t)bh * SEQ + 64 * lane;
    for (int i = 0; i < 64; ++i) { run += (double)log_sigmoid_f(lg[(size_t)i * 32] + bf); cum[i] = (float)(run * 1.4426950408889634); }
    const bf16* kf = WSP(bf16, WS_KF) + (size_t)b * SEQ * 512 + h * 64; float km = 0.f;
#pragma unroll 4
    for (int i = 0; i < 64; ++i) { const u32x4* p = (const u32x4*)(kf + (size_t)(64 * i + lane) * 512); float s = 0.f;
#pragma unroll
        for (int c = 0; c < 8; ++c) { const u32x4 v = p[c]; s += (bflo(v.x) * bflo(v.x) + bfhi(v.x) * bfhi(v.x)) + (bflo(v.y) * bflo(v.y) + bfhi(v.y) * bfhi(v.y)) + (bflo(v.z) * bflo(v.z) + bfhi(v.z) * bfhi(v.z)) + (bflo(v.w) * bflo(v.w) + bfhi(v.w) * bfhi(v.w)); }
        km = fmaxf(km, s); }
#pragma unroll
    for (int o = 1; o < 64; o <<= 1) km = fmaxf(km, __shfl_xor(km, o));
    if (lane == 0) WSP(float, WS_KMAX)[bh] = sqrtf(km) * 1.001f;
}

__device__ __forceinline__ void p6_phase(Frame& F) {
    const int lane = F.lane, w = F.wave, r32 = lane & 31, hi = lane >> 5, grp = w >> 2, kq = w & 3;
    LAS float* red = (LAS float*)F.lds;
    LAS float* ssl = (LAS float*)(F.lds + 32768);
    LAS int* lcnt = (LAS int*)(F.lds + 36864);
    const float* X1 = F.out; const float* brt = F.ka->in[20];
    const bf16* whT = WSP(bf16, WS_WRT); const bf16* wlT = whT + 32 * 1024;
    int* tope = WSP(int, WS_ROUTE); float* topg = (float*)(tope + NTOK * 4); int* lrank = tope + NTOK * 8; float* rstdg = WSP(float, WS_RSTD);
    for (int tile = F.bid; tile < NTOK / 64; tile += F.G) {
        if (F.tid < 32) lcnt[F.tid] = 0;
        const float* xrow = X1 + (size_t)(tile * 64 + grp * 32 + r32) * DM + 8 * hi + 256 * kq;
        const bf16* whp = whT + (size_t)r32 * 1024 + 8 * hi + 256 * kq; const bf16* wlp = wlT + (size_t)r32 * 1024 + 8 * hi + 256 * kq;
        f32x16 acc = f32x16{}; float ss = 0.f;
        f32x4 xa[16], xb[16];
#pragma unroll
        for (int s = 0; s < 16; ++s) { xa[s] = *(const f32x4*)(xrow + 16 * s); xb[s] = *(const f32x4*)(xrow + 16 * s + 4); }
#pragma unroll
        for (int sb = 0; sb < 2; ++sb) {
            bf16x8 wh[8], wl[8];
#pragma unroll
            for (int s = 0; s < 8; ++s) { const int o = 16 * (8 * sb + s); wh[s] = *(const bf16x8*)(whp + o); wl[s] = *(const bf16x8*)(wlp + o); }
#pragma unroll
            for (int s = 0; s < 8; ++s) {
                const f32x4 a = xa[8 * sb + s], b = xb[8 * sb + s];
                ss += (a.x * a.x + a.y * a.y) + (a.z * a.z + a.w * a.w) + (b.x * b.x + b.y * b.y) + (b.z * b.z + b.w * b.w);
                u32x4 h; h.x = cvtpk(a.x, a.y); h.y = cvtpk(a.z, a.w); h.z = cvtpk(b.x, b.y); h.w = cvtpk(b.z, b.w);
                u32x4 l; l.x = cvtpk(a.x - bflo(h.x), a.y - bfhi(h.x)); l.y = cvtpk(a.z - bflo(h.y), a.w - bfhi(h.y)); l.z = cvtpk(b.x - bflo(h.z), b.y - bfhi(h.z)); l.w = cvtpk(b.z - bflo(h.w), b.w - bfhi(h.w));
                const bf16x8 hv = __builtin_bit_cast(bf16x8, h), lv = __builtin_bit_cast(bf16x8, l);
                acc = __builtin_amdgcn_mfma_f32_32x32x16_bf16(hv, wh[s], acc, 0, 0, 0);
                acc = __builtin_amdgcn_mfma_f32_32x32x16_bf16(lv, wh[s], acc, 0, 0, 0);
                acc = __builtin_amdgcn_mfma_f32_32x32x16_bf16(hv, wl[s], acc, 0, 0, 0);
            }
        }
#pragma unroll
        for (int r = 0; r < 16; ++r) red[(w * 16 + r) * 64 + lane] = acc[r];
        ssl[w * 64 + lane] = ss;
        __syncthreads();
        LAS float* lgt = (LAS float*)(F.lds + 40960);
        LAS float* rsl = (LAS float*)(F.lds + 40960 + 64 * 33 * 4);
        LAS float* topv = rsl + 64;
        LAS int* tope_l = (LAS int*)(topv + 256);
        if (kq == 0) {
#pragma unroll
            for (int r = 0; r < 16; ++r) acc[r] = (red[(w * 16 + r) * 64 + lane] + red[((w + 1) * 16 + r) * 64 + lane]) + (red[((w + 2) * 16 + r) * 64 + lane] + red[((w + 3) * 16 + r) * 64 + lane]);
            ss = (ssl[w * 64 + lane] + ssl[(w + 1) * 64 + lane]) + (ssl[(w + 2) * 64 + lane] + ssl[(w + 3) * 64 + lane]);
            ss += __shfl_xor(ss, 32);
            const float rstd = 1.0f / sqrtf(ss * (1.f / 1024.f) + RMS_EPS);
            if (hi == 0) { rstdg[tile * 64 + grp * 32 + r32] = rstd; rsl[grp * 32 + r32] = rstd; }
#pragma unroll
            for (int r = 0; r < 16; ++r) { const int rowl = (r & 3) + 8 * (r >> 2) + 4 * hi; lgt[(grp * 32 + rowl) * 33 + r32] = acc[r]; }
        }
        __syncthreads();
#pragma unroll
        for (int it = 0; it < 4; ++it) {
            const int row = it * 16 + (F.tid >> 5), e = F.tid & 31;
            const float rs = rsl[row]; const float mine = lgt[row * 33 + e] * rs + brt[e];
            int rank = 0;
#pragma unroll
            for (int j = 0; j < 32; ++j) { const float v = lgt[row * 33 + j] * rs + brt[j]; rank += (v > mine || (v == mine && j < e)) ? 1 : 0; }
            if (rank < 4) { topv[row * 4 + rank] = mine; tope_l[row * 4 + rank] = e; }
        }
        __syncthreads();
        int ee4[4], lr4[4];
        if (F.tid < 64) { const int row = F.tid, t = tile * 64 + row;
            const float v0 = topv[row * 4], e1 = expf(topv[row * 4 + 1] - v0), e2 = expf(topv[row * 4 + 2] - v0), e3 = expf(topv[row * 4 + 3] - v0); const float inv = 1.0f / (1.0f + e1 + e2 + e3);
            const float gs[4] = {inv, e1 * inv, e2 * inv, e3 * inv};
#pragma unroll
            for (int k = 0; k < 4; ++k) { const int ee = tope_l[row * 4 + k]; tope[t * 4 + k] = ee; topg[t * 4 + k] = gs[k]; ee4[k] = ee; lr4[k] = atomicAdd((int*)(lcnt + ee), 1); } }
        __syncthreads();
        if (F.tid < 32) { const int c = lcnt[F.tid]; lcnt[32 + F.tid] = c ? (int)__hip_atomic_fetch_add(WSP(unsigned, WS_CTL) + CW_GCNT + 32 * F.tid, (unsigned)c, __ATOMIC_RELAXED, __HIP_MEMORY_SCOPE_AGENT) : 0; }
        __syncthreads();
        if (F.tid < 64) { const int row = F.tid, t = tile * 64 + row; const float rs_ = rsl[row];
#pragma unroll
            for (int k = 0; k < 4; ++k) { const int rk = lcnt[32 + ee4[k]] + lr4[k]; lrank[t * 4 + k] = rk; WSP(int, WS_ETOK)[ee4[k] * NTOK + rk] = t; WSP(float, WS_ERSTD)[ee4[k] * NTOK + rk] = rs_; } }
        __syncthreads();
    }
}

__device__ __forceinline__ void p7_phase(Frame& F) {
    LAS int* part = (LAS int*)F.lds;
    LAS int* tot = part + 1024; LAS int* pre = tot + 32; LAS int* pstart = pre + 32; LAS int* slotl = pstart + 32;
    const int* blkcnt = WSP(int, WS_BLKCNT);
    int* tope = WSP(int, WS_ROUTE); int* lrank = tope + NTOK * 8; int* slot = tope + NTOK * 12;
    const float* rstdg = WSP(float, WS_RSTD); float* rslot = WSP(float, WS_RSLOT); int* slottok = WSP(int, WS_SLOTTOK);
    for (int tile = F.bid; tile < NTOK / 64; tile += F.G) {
        __syncthreads();
        { const int e = F.tid & 31, p = F.tid >> 5; int st = 0, sp = 0;
          for (int tt = p; tt < NTOK / 64; tt += 16) { const int c = blkcnt[tt * 32 + e]; st += c; if (tt < tile) sp += c; }
          part[p * 32 + e] = st; part[512 + p * 32 + e] = sp; }
        __syncthreads();
        if (F.tid < 32) { int st = 0, sp = 0;
#pragma unroll
            for (int p = 0; p < 16; ++p) { st += part[p * 32 + F.tid]; sp += part[512 + p * 32 + F.tid]; }
            tot[F.tid] = st; pre[F.tid] = sp; }
        __syncthreads();
        if (F.tid == 0) { int run = 0; for (int e = 0; e < 32; ++e) { pstart[e] = run; run += (tot[e] + 255) & ~255; }
            if (tile == 0) { int* te = WSP(int, WS_TILE_E); int j = 0; for (int e = 0; e < 32; ++e) { const int nte = (tot[e] + 255) >> 8; for (int q = 0; q < nte; ++q) te[j++] = e; } te[500] = j; } }
        __syncthreads();
        if (F.tid < 256) { const int a = tile * 256 + F.tid; const int e = tope[a]; const int s = pstart[e] + pre[e] + lrank[a]; slot[a] = s; rslot[s] = rstdg[tile * 64 + (F.tid >> 2)]; slottok[s] = tile * 64 + (F.tid >> 2); }
    }
}

__device__ __forceinline__ void p10_phase(Frame& F, bool with_moe, float* dsto) {
    const int gw = F.vcu * NWAVES + F.wave, NGW = F.G * NWAVES, lane = F.lane;
    const int* tope = WSP(int, WS_ROUTE); const float* topg = (const float*)(tope + NTOK * 4); const int* rank = tope + NTOK * 8;
    const LAS int* pstart = (const LAS int*)(F.lds + MT_OFF) + 320;
    const bf16* OS = WSP(bf16, WS_AMOE); const float* gfin = F.ka->in[25];
    for (int t0 = gw; t0 < NTOK; t0 += 2 * NGW) {
        const int t1 = t0 + NGW; const bool has1 = t1 < NTOK; const int tt[2] = {t0, has1 ? t1 : t0};
        f32x4 v[2][4]; u32x2 o[2][4][4]; float gk[2][4];
#pragma unroll
        for (int q = 0; q < 2; ++q) {
            const f32x4* xr = (const f32x4*)((with_moe ? F.out : F.ka->in[0]) + (size_t)tt[q] * DM) + lane;
#pragma unroll
            for (int j = 0; j < 4; ++j) v[q][j] = xr[64 * j];
            if (with_moe) {
#pragma unroll
                for (int k = 0; k < 4; ++k) { gk[q][k] = topg[tt[q] * 4 + k]; const u32x2* orow = (const u32x2*)(OS + (size_t)(pstart[tope[tt[q] * 4 + k]] + rank[tt[q] * 4 + k]) * DM) + lane;
#pragma unroll
                    for (int j = 0; j < 4; ++j) o[q][k][j] = orow[64 * j]; }
            }
        }
        __builtin_amdgcn_sched_barrier(0);
        f32x4 gf[4];
#pragma unroll
        for (int j = 0; j < 4; ++j) gf[j] = ((const f32x4*)gfin)[64 * j + lane];
        float ss[2];
#pragma unroll
        for (int q = 0; q < 2; ++q) {
            if (with_moe) {
#pragma unroll
                for (int k = 0; k < 4; ++k)
#pragma unroll
                    for (int j = 0; j < 4; ++j) { const u32x2 w = o[q][k][j]; v[q][j].x += gk[q][k] * bflo(w.x); v[q][j].y += gk[q][k] * bfhi(w.x); v[q][j].z += gk[q][k] * bflo(w.y); v[q][j].w += gk[q][k] * bfhi(w.y); }
            }
            float s_ = 0.f;
#pragma unroll
            for (int j = 0; j < 4; ++j) s_ += (v[q][j].x * v[q][j].x + v[q][j].y * v[q][j].y) + (v[q][j].z * v[q][j].z + v[q][j].w * v[q][j].w);
            ss[q] = s_;
        }
#pragma unroll
        for (int of = 1; of < 64; of <<= 1) { ss[0] += __shfl_xor(ss[0], of); ss[1] += __shfl_xor(ss[1], of); }
#pragma unroll
        for (int q = 0; q < 2; ++q) {
            if (q == 1 && !has1) break;
            const float rstd = 1.0f / sqrtf(ss[q] * (1.f / 1024.f) + RMS_EPS);
            f32x4* orow = (f32x4*)(dsto + (size_t)tt[q] * DM) + lane;
#pragma unroll
            for (int j = 0; j < 4; ++j) orow[64 * j] = v[q][j] * rstd * gf[j];
        }
    }
}
constexpr int AL_RING = 0, AL_OACC = 49152, AL_BIAS = 114688, AL_WSF = AL_BIAS + 3 * 8 * 64 * 4, AL_IMP = AL_WSF + 8 * 64 * 4, AL_SELB = AL_IMP + 64 * 65 * 4, AL_UNI = AL_SELB + 512, AL_TICKET = AL_UNI + 16;
static_assert(AL_TICKET + 16 <= LDS_BYTES - 64 && AL_OACC + 65536 <= AL_BIAS, "attention LDS map");
__device__ __forceinline__ int crow(int r, int hi) { return (r & 3) + 8 * (r >> 2) + 4 * hi; }
__device__ __forceinline__ s16x4 vtr(const LAS char* p) { return __builtin_bit_cast(s16x4, __builtin_amdgcn_ds_read_tr16_b64_v4i16((LAS s16x4*)p)); }

__device__ __forceinline__ float max3f(float a, float b, float c) { float r; asm("v_max3_f32 %0, %1, %2, %3" : "=v"(r) : "v"(a), "v"(b), "v"(c)); return r; }
struct AttnCtx { LAS unsigned char* lds; int tid, lane, w, r32, hi; LAS float* wsf; };
__device__ __forceinline__ AttnCtx make_ctx(LAS unsigned char* lds) {
    int tid = threadIdx.x; asm volatile("" : "+v"(tid));
    AttnCtx C; C.lds = lds; C.tid = tid; C.lane = tid & 63; C.w = __builtin_amdgcn_readfirstlane(tid >> 6); C.r32 = tid & 31; C.hi = (tid >> 5) & 1; C.wsf = (LAS float*)(lds + AL_WSF) + C.w * 64;
    return C;
}

template <int NDB> __device__ __forceinline__ void scale_rows(const AttnCtx& C, f32x16 (&o)[NDB], float vq, int slot) {
    if (C.hi == 0) C.wsf[slot + C.r32] = vq;
#pragma unroll
    for (int rg = 0; rg < 4; ++rg) { const f32x4 a4 = *(const LAS f32x4*)(C.wsf + slot + 8 * rg + 4 * C.hi);
#pragma unroll
        for (int db = 0; db < NDB; ++db) { o[db][4 * rg + 0] *= a4.x; o[db][4 * rg + 1] *= a4.y; o[db][4 * rg + 2] *= a4.z; o[db][4 * rg + 3] *= a4.w; } }
}

__device__ __forceinline__ void dma16(const void* g, LAS unsigned char* lds_wave_base) { __builtin_amdgcn_global_load_lds((const unsigned*)g, (LAS unsigned*)lds_wave_base, 16, 0, 0); }
__device__ __forceinline__ void dma4(const void* g, LAS unsigned char* lds_wave_base) { __builtin_amdgcn_global_load_lds((const unsigned*)g, (LAS unsigned*)lds_wave_base, 4, 0, 0); }
template <int N> __device__ __forceinline__ void wait_vm() {
    if constexpr (N == 0) asm volatile("s_waitcnt vmcnt(0)" ::: "memory"); else if constexpr (N == 2) asm volatile("s_waitcnt vmcnt(2)" ::: "memory");
    else if constexpr (N == 3) asm volatile("s_waitcnt vmcnt(3)" ::: "memory"); else if constexpr (N == 4) asm volatile("s_waitcnt vmcnt(4)" ::: "memory"); else static_assert(N == 0, "wait_vm");
}
template <int DQK, int DV, bool BIAS, class Pol>
__device__ __forceinline__ void attn_core(const AttnCtx& C, const Pol& P, const bf16x8 (&qf)[DQK / 16], f32x16 (&o)[DV / 32]) {
    constexpr int NKP = DQK / 64, NVP = DV / 64, NDB = DV / 32, ND0 = DQK / 16, KROW = DQK * 2, KCH = DQK / 8, VCH = DV / 8, KBYTES = DQK * 128, SLOT = (DQK + DV) * 128, PT = NKP + NVP + (BIAS ? 1 : 0);
    int tid = C.tid; asm volatile("" : "+v"(tid));
    const int lane = tid & 63, r32 = lane & 31, hi = lane >> 5, w = C.w;
    int ksrc[NKP], vsrc[NVP];
#pragma unroll
    for (int j = 0; j < NKP; ++j) { const int id = tid + 512 * j, key = id / KCH, slot = id % KCH; const int c = slot ^ (DQK == 64 ? ((key >> 1) & 7) : (key & 15)); ksrc[j] = key * P.kpitch() + c * 8; }
#pragma unroll
    for (int j = 0; j < NVP; ++j) { const int id = tid + 512 * j, db = id >> 8, rem = id & 255, key = 8 * (rem >> 5) + ((rem & 31) >> 2), pc = 4 * db + (rem & 3); vsrc[j] = key * P.vpitch() + pc * 8; }
    int koff[ND0];
#pragma unroll
    for (int d0 = 0; d0 < ND0; ++d0) koff[d0] = r32 * KROW + (((2 * d0 + hi) ^ (DQK == 64 ? ((r32 >> 1) & 7) : (r32 & 15))) << 4);
    const int vbase = ((lane >> 4) & 1) * 32 + (lane & 3) * 8 + (4 * hi + ((lane & 15) >> 2)) * 64;
    LAS unsigned char* lds = C.lds;
    LAS float* biasw = (LAS float*)(lds + AL_BIAS) + w * 64;
#define ATT_DMA(t, s) do { const bf16* kp_ = P.kptr(t); const bf16* vp_ = P.vptr(t); LAS unsigned char* sb_ = lds + AL_RING + (s) * SLOT + w * 1024; \
        _Pragma("unroll") for (int j = 0; j < NKP; ++j) dma16(kp_ + ksrc[j], sb_ + j * 8192); \
        _Pragma("unroll") for (int j = 0; j < NVP; ++j) dma16(vp_ + vsrc[j], sb_ + KBYTES + j * 8192); \
        if (BIAS) dma4(P.biasptr(t) + lane, (LAS unsigned char*)(biasw + (s) * 512)); } while (0)
    float m_ref = 0.f, l_part = 0.f; bool seen = false;
#pragma unroll
    for (int db = 0; db < NDB; ++db) o[db] = f32x16{};
    int t = P.first(), t1 = P.next(t);
    asm volatile("s_waitcnt vmcnt(0) lgkmcnt(0)" ::: "memory"); __builtin_amdgcn_s_barrier();
    ATT_DMA(t, 0);
    if (t1 >= 0) ATT_DMA(t1, 1);
    int s0 = 0;
    while (t >= 0) {
        const int t2 = (t1 >= 0) ? P.next(t1) : -1;
        if (t1 >= 0) wait_vm<PT>(); else wait_vm<0>();
        asm volatile("s_waitcnt lgkmcnt(0)" ::: "memory"); __builtin_amdgcn_s_barrier(); asm volatile("" ::: "memory");
        const int s2 = (s0 >= 1) ? s0 - 1 : 2;
        if (t2 >= 0) ATT_DMA(t2, s2);
        if (!P.wave_skip(t)) {
            const LAS unsigned char* Kb = lds + AL_RING + s0 * SLOT; const LAS unsigned char* Vb = Kb + KBYTES;
            const float cbase = P.lane_valid(t) ? -m_ref : NEGBIG;
            f32x16 p0, p1;
            if (BIAS) {
                const float cb = cbase + P.bias_ref();
#pragma unroll
                for (int rg = 0; rg < 4; ++rg) { const f32x4 b0 = *(const LAS f32x4*)(biasw + s0 * 512 + 8 * rg + 4 * hi), b1 = *(const LAS f32x4*)(biasw + s0 * 512 + 32 + 8 * rg + 4 * hi);
                    p0[4 * rg] = cb - b0.x; p0[4 * rg + 1] = cb - b0.y; p0[4 * rg + 2] = cb - b0.z; p0[4 * rg + 3] = cb - b0.w;
                    p1[4 * rg] = cb - b1.x; p1[4 * rg + 1] = cb - b1.y; p1[4 * rg + 2] = cb - b1.z; p1[4 * rg + 3] = cb - b1.w; }
            } else {
#pragma unroll
                for (int r = 0; r < 16; ++r) { p0[r] = cbase; p1[r] = cbase; }
            }
#pragma unroll
            for (int d0 = 0; d0 < ND0; ++d0) {
                const bf16x8 k0 = *(const LAS bf16x8*)(Kb + koff[d0]); const bf16x8 k1 = *(const LAS bf16x8*)(Kb + koff[d0] + 32 * KROW);
                p0 = __builtin_amdgcn_mfma_f32_32x32x16_bf16(k0, qf[d0], p0, 0, 0, 0);
                p1 = __builtin_amdgcn_mfma_f32_32x32x16_bf16(k1, qf[d0], p1, 0, 0, 0);
            }
            asm volatile("s_nop 15\n\ts_nop 7" : "+v"(p0), "+v"(p1));
            if (P.masked(t)) {
#pragma unroll
                for (int r = 0; r < 16; ++r) { const int kvl = crow(r, hi);
                    if (!P.valid(t, kvl)) p0[r] = NEGBIG;
                    if (!P.valid(t, kvl + 32)) p1[r] = NEGBIG; }
            }
            float rm = max3f(p0[0], p1[0], p0[1]), rm2 = max3f(p1[1], p0[2], p1[2]);
#pragma unroll
            for (int r = 3; r < 15; r += 2) { rm = max3f(rm, p0[r], p1[r]); rm2 = max3f(rm2, p0[r + 1], p1[r + 1]); }
            rm = max3f(rm, p0[15], p1[15]);
            rm = max3f(rm, rm2, rm2);
            rm = max3f(rm, __shfl_xor(rm, 32), rm);
            const bool any_valid = rm > -1e29f;
            const bool trig = (rm > 8.0f) || (!seen && any_valid);
            if (__any(trig)) {
                const float dl = trig ? rm : 0.f; const float alpha = (trig && seen) ? __builtin_amdgcn_exp2f(-dl) : 1.0f;
                m_ref += dl; l_part *= alpha;
#pragma unroll
                for (int r = 0; r < 16; ++r) { p0[r] -= dl; p1[r] -= dl; }
                scale_rows<NDB>(C, o, alpha, 0);
            }
            seen = seen || any_valid;
            float ls = 0.f;
#pragma unroll
            for (int r = 0; r < 16; ++r) { const float e0 = __builtin_amdgcn_exp2f(p0[r]), e1 = __builtin_amdgcn_exp2f(p1[r]); p0[r] = e0; p1[r] = e1; ls += e0 + e1; }
            l_part += ls;
            u32x4 pw[4];
#pragma unroll
            for (int k = 0; k < 4; ++k) { pw[0][k] = cvtpk(p0[2 * k], p0[2 * k + 1]); pw[1][k] = cvtpk(p0[8 + 2 * k], p0[9 + 2 * k]); pw[2][k] = cvtpk(p1[2 * k], p1[2 * k + 1]); pw[3][k] = cvtpk(p1[8 + 2 * k], p1[9 + 2 * k]); }
#pragma unroll
            for (int db = 0; db < NDB; ++db) {
#pragma unroll
                for (int s = 0; s < 4; ++s) {
                    const s16x4 lo = vtr((const LAS char*)Vb + vbase + db * 4096 + s * 1024), hh = vtr((const LAS char*)Vb + vbase + db * 4096 + s * 1024 + 512);
                    const bf16x8 vf = {lo[0], lo[1], lo[2], lo[3], hh[0], hh[1], hh[2], hh[3]};
                    o[db] = __builtin_amdgcn_mfma_f32_32x32x16_bf16(__builtin_bit_cast(bf16x8, pw[s]), vf, o[db], 0, 0, 0);
                }
            }
        }
        s0 = (s0 == 2) ? 0 : s0 + 1; t = t1; t1 = t2;
    }
    const float l = l_part + __shfl_xor(l_part, 32);
    scale_rows<NDB>(C, o, l > 0.f ? 1.0f / l : 0.f, 32);
    asm volatile("s_waitcnt lgkmcnt(0)" ::: "memory"); __builtin_amdgcn_s_barrier(); asm volatile("" ::: "memory");
#undef ATT_DMA
}

struct FoxPol {
    const bf16 *K, *V; const float* cum; float ref; int qb, w, tq, tmin;
    __device__ __forceinline__ int first() const { return 4 * qb + 3; }
    __device__ __forceinline__ int next(int t) const { return t - 1 >= tmin ? t - 1 : -1; }
    __device__ __forceinline__ bool masked(int t) const { return t >= 4 * qb; }
    __device__ __forceinline__ bool valid(int t, int kvl) const { return 64 * t + kvl <= tq; }
    __device__ __forceinline__ bool wave_skip(int t) const { return 64 * (t - 4 * qb) > 32 * w + 31; }
    __device__ __forceinline__ bool lane_valid(int) const { return true; }
    __device__ __forceinline__ const bf16* kptr(int t) const { return K + (size_t)(64 * t) * 512; }
    __device__ __forceinline__ const bf16* vptr(int t) const { return V + (size_t)(64 * t) * 512; }
    __device__ __forceinline__ int kpitch() const { return 512; }
    __device__ __forceinline__ int vpitch() const { return 512; }
    __device__ __forceinline__ const float* biasptr(int t) const { return cum + 64 * t; }
    __device__ __forceinline__ float bias_ref() const { return ref; }
};
struct MemPol {
    const bf16 *K, *V;
    __device__ __forceinline__ int first() const { return 0; }
    __device__ __forceinline__ int next(int t) const { return t < 3 ? t + 1 : -1; }
    __device__ __forceinline__ bool masked(int) const { return false; }
    __device__ __forceinline__ bool valid(int, int) const { return true; }
    __device__ __forceinline__ bool wave_skip(int) const { return false; }
    __device__ __forceinline__ bool lane_valid(int) const { return true; }
    __device__ __forceinline__ const bf16* kptr(int t) const { return K + (size_t)(64 * t) * 512; }
    __device__ __forceinline__ const bf16* vptr(int t) const { return V + (size_t)(64 * t) * 512; }
    __device__ __forceinline__ int kpitch() const { return 512; }
    __device__ __forceinline__ int vpitch() const { return 512; }
    __device__ __forceinline__ const float* biasptr(int) const { return nullptr; }
    __device__ __forceinline__ float bias_ref() const { return 0.f; }
};
struct CmpPol {
    const bf16 *K, *V; int ntc, tq;
    __device__ __forceinline__ int first() const { return 0; }
    __device__ __forceinline__ int next(int t) const { return t + 1 < ntc ? t + 1 : -1; }
    __device__ __forceinline__ bool masked(int) const { return true; }
    __device__ __forceinline__ bool valid(int t, int kvl) const { return 16 * (64 * t + kvl) + 31 <= tq; }
    __device__ __forceinline__ bool wave_skip(int) const { return false; }
    __device__ __forceinline__ bool lane_valid(int) const { return true; }
    __device__ __forceinline__ const bf16* kptr(int t) const { return K + (size_t)(64 * t) * 64; }
    __device__ __forceinline__ const bf16* vptr(int t) const { return V + (size_t)(64 * t) * 128; }
    __device__ __forceinline__ int kpitch() const { return 64; }
    __device__ __forceinline__ int vpitch() const { return 128; }
    __device__ __forceinline__ const float* biasptr(int) const { return nullptr; }
    __device__ __forceinline__ float bias_ref() const { return 0.f; }
};
struct WinPol {
    const bf16 *K, *V; int T, tq;
    __device__ __forceinline__ int first() const { return T; }
    __device__ __forceinline__ int next(int t) const { return (t - 1 >= 0 && t - 1 >= T - 8) ? t - 1 : -1; }
    __device__ __forceinline__ bool masked(int t) const { return t == T || t == T - 8; }
    __device__ __forceinline__ bool valid(int t, int kvl) const { const int d = tq - (64 * t + kvl); return d >= 0 && d < 512; }
    __device__ __forceinline__ bool wave_skip(int) const { return false; }
    __device__ __forceinline__ bool lane_valid(int) const { return true; }
    __device__ __forceinline__ const bf16* kptr(int t) const { return K + (size_t)(64 * t) * 128; }
    __device__ __forceinline__ const bf16* vptr(int t) const { return V + (size_t)(64 * t) * 128; }
    __device__ __forceinline__ int kpitch() const { return 128; }
    __device__ __forceinline__ int vpitch() const { return 128; }
    __device__ __forceinline__ const float* biasptr(int) const { return nullptr; }
    __device__ __forceinline__ float bias_ref() const { return 0.f; }
};
struct SelPol {
    const bf16 *K, *V; unsigned long long uni, mine; int T, tq;
    __device__ __forceinline__ int first() const { return 63 - __clzll(uni); }
    __device__ __forceinline__ int next(int t) const { const unsigned long long m = uni & ((1ull << t) - 1ull); return m ? 63 - __clzll(m) : -1; }
    __device__ __forceinline__ bool masked(int t) const { return t == T; }
    __device__ __forceinline__ bool valid(int t, int kvl) const { return 64 * t + kvl <= tq; }
    __device__ __forceinline__ bool wave_skip(int) const { return false; }
    __device__ __forceinline__ bool lane_valid(int t) const { return (mine >> t) & 1ull; }
    __device__ __forceinline__ const bf16* kptr(int t) const { return K + (size_t)(64 * t) * 128; }
    __device__ __forceinline__ const bf16* vptr(int t) const { return V + (size_t)(64 * t) * 128; }
    __device__ __forceinline__ int kpitch() const { return 128; }
    __device__ __forceinline__ int vpitch() const { return 128; }
    __device__ __forceinline__ const float* biasptr(int) const { return nullptr; }
    __device__ __forceinline__ float bias_ref() const { return 0.f; }
};

template <int NDB, class RowF> __device__ __forceinline__ void store_o(const AttnCtx& C, const f32x16 (&o)[NDB], bf16* dst, RowF rowoff) {
#pragma unroll
    for (int r = 0; r < 16; ++r) { const int q = crow(r, C.hi); bf16* p = dst + rowoff(q) + C.r32;
#pragma unroll
        for (int db = 0; db < NDB; ++db) p[32 * db] = (bf16)(cvtpk(o[db][r], 0.f) & 0xffffu); }
}

__device__ __forceinline__ void fox_unit(Frame& F0, int bh, int qb) {
    const AttnCtx C = make_ctx(F0.lds);
    struct { unsigned char* ws; } F; { unsigned long long w_ = (unsigned long long)F0.ws; asm volatile("" : "+s"(w_)); F.ws = (unsigned char*)w_; }
    const int b = bh >> 3, h = bh & 7, tq = 256 * qb + 32 * C.w + C.r32;
    const bf16* Q = WSP(bf16, WS_QF) + ((size_t)(b * SEQ + tq)) * 512 + h * 64;
    bf16x8 qf[4];
#pragma unroll
    for (int d0 = 0; d0 < 4; ++d0) qf[d0] = *(const bf16x8*)(Q + 16 * d0 + 8 * C.hi);
    const float* cum = WSP(float, WS_CUM) + (size_t)bh * SEQ;
    int tmin = 0;
    { float qn = 0.f;
#pragma unroll
      for (int d0 = 0; d0 < 4; ++d0)
#pragma unroll
          for (int j = 0; j < 8; ++j) { const float v = bf2f((unsigned short)qf[d0][j]); qn += v * v; }
      qn += __shfl_xor(qn, 32);
#pragma unroll
      for (int o = 16; o >= 1; o >>= 1) qn = fmaxf(qn, __shfl_xor(qn, o));
      LAS float* qmx = (LAS float*)(C.lds + AL_SELB);
      __syncthreads();
      if (C.lane == 0) qmx[C.w] = qn;
      __syncthreads();
      float qm = qmx[0];
#pragma unroll
      for (int i = 1; i < 8; ++i) qm = fmaxf(qm, qmx[i]);
      const float B = sqrtf(qm) * WSP(float, WS_KMAX)[bh];
      const float thr = -(40.0f + 2.0f * B), c0 = cum[256 * qb];
      const bool cond = (C.lane < 4 * qb) && (c0 - cum[64 * C.lane + 63] < thr);
      const unsigned long long bal = __ballot(cond);
      tmin = bal ? 64 - __clzll(bal) : 0; }
    FoxPol P{WSP(bf16, WS_KF) + (size_t)b * SEQ * 512 + h * 64, WSP(bf16, WS_VF) + (size_t)b * SEQ * 512 + h * 64, cum, cum[256 * qb + 255], qb, C.w, tq, tmin};
    f32x16 o[2];
    attn_core<64, 64, true>(C, P, qf, o);
    bf16* dst = WSP(bf16, WS_OBR) + (size_t)1 * NTOK * 512 + h * 64;
    const size_t rb = (size_t)(b * SEQ + 256 * qb + 32 * C.w);
    store_o<2>(C, o, dst, [&](int q) { return (rb + q) * 512; });
}
__device__ __forceinline__ void mem_unit(Frame& F0, int bh, int qb) {
    const AttnCtx C = make_ctx(F0.lds);
    struct { unsigned char* ws; } F; { unsigned long long w_ = (unsigned long long)F0.ws; asm volatile("" : "+s"(w_)); F.ws = (unsigned char*)w_; }
    const int b = bh >> 2, h = bh & 3, tq = 256 * qb + 32 * C.w + C.r32;
    const bf16* Q = WSP(bf16, WS_QM) + ((size_t)(b * SEQ + tq)) * 512 + h * 128;
    bf16x8 qf[8];
#pragma unroll
    for (int d0 = 0; d0 < 8; ++d0) qf[d0] = *(const bf16x8*)(Q + 16 * d0 + 8 * C.hi);
    MemPol P{WSP(bf16, WS_KMEM) + (size_t)b * MEMLEN * 512 + h * 128, WSP(bf16, WS_VMEM) + (size_t)b * MEMLEN * 512 + h * 128};
    f32x16 o[4];
    attn_core<128, 128, false>(C, P, qf, o);
    bf16* dst = WSP(bf16, WS_OBR) + (size_t)2 * NTOK * 512 + h * 128;
    const size_t rb = (size_t)(b * SEQ + 256 * qb + 32 * C.w);
    store_o<4>(C, o, dst, [&](int q) { return (rb + q) * 512; });
}
__device__ __forceinline__ void nsa_unit(Frame& F0, int bg, int T, int parts) {
    const AttnCtx C = make_ctx(F0.lds);
    struct { unsigned char* ws; } F; { unsigned long long w_ = (unsigned long long)F0.ws; asm volatile("" : "+s"(w_)); F.ws = (unsigned char*)w_; }
    const int b = bg >> 1, g = bg & 1, q = C.r32, tokl = 8 * C.w + (q >> 2), tq = 64 * T + tokl, head = 4 * g + (q & 3);
    const bf16* Q = WSP(bf16, WS_QA) + ((size_t)(b * SEQ + tq)) * 512 + head * 64;
    bf16x8 qf[4];
#pragma unroll
    for (int d0 = 0; d0 < 4; ++d0) qf[d0] = *(const bf16x8*)(Q + 16 * d0 + 8 * C.hi);
    const float* lg = WSP(float, WS_LG) + (size_t)(b * SEQ + tq) * 32 + head * 3;
    LAS float* oacc = (LAS float*)(C.lds + AL_OACC) + C.w * 2048 + C.lane;
    LAS float* imp = (LAS float*)(C.lds + AL_IMP);
    LAS unsigned long long* selb = (LAS unsigned long long*)(C.lds + AL_SELB);
    LAS unsigned long long* unip = (LAS unsigned long long*)(C.lds + AL_UNI);
#ifndef NSA_CORES
#define NSA_CORES 7
#endif
    if (NSA_CORES & 1) {
        CmpPol P{WSP(bf16, WS_KCMP) + (size_t)bg * 256 * 64, WSP(bf16, WS_VCMP) + (size_t)bg * 256 * 128, (4 * T + 2) / 64 + 1, tq};
        f32x16 o2[2];
        attn_core<64, 64, false>(C, P, qf, o2);
        scale_rows<2>(C, o2, (parts & 1) ? fast_sigmoid(lg[0]) : 0.f, 0);
#pragma unroll
        for (int db = 0; db < 2; ++db)
#pragma unroll
            for (int r = 0; r < 16; ++r) oacc[(db * 16 + r) * 64] = o2[db][r];
        P.V += 64;
        attn_core<64, 64, false>(C, P, qf, o2);
#pragma unroll
        for (int db = 0; db < 2; ++db)
#pragma unroll
            for (int rg = 0; rg < 4; ++rg) imp[(8 * C.w + 2 * rg + C.hi) * 65 + 32 * db + C.r32] = (o2[db][4 * rg] + o2[db][4 * rg + 1]) + (o2[db][4 * rg + 2] + o2[db][4 * rg + 3]);
    }
    __syncthreads();
    {
        const int tk = C.tid >> 3, sub = C.tid & 7;
        float mine[8]; int rank[8];
#pragma unroll
        for (int i = 0; i < 8; ++i) { const int j = 8 * sub + i; const float v = imp[tk * 65 + j];
            mine[i] = (j == 0 || j == T || j == T - 1) ? 1e4f : (j > T ? -1e4f : v); rank[i] = 0; }
        for (int jj = 0; jj < 64; ++jj) { const float v0 = imp[tk * 65 + jj]; const float v = (jj == 0 || jj == T || jj == T - 1) ? 1e4f : (jj > T ? -1e4f : v0);
#pragma unroll
            for (int i = 0; i < 8; ++i) { const int j = 8 * sub + i; rank[i] += (v > mine[i] || (v == mine[i] && jj < j)) ? 1 : 0; } }
        unsigned byte = 0;
#pragma unroll
        for (int i = 0; i < 8; ++i) { const int j = 8 * sub + i; if (rank[i] < 16 && j <= T) byte |= 1u << i; }
        ((LAS unsigned char*)selb)[tk * 8 + sub] = (unsigned char)byte;
    }
    __syncthreads();
    if (C.w == 0) { unsigned long long m = selb[C.lane]; unsigned lo = (unsigned)m, hh = (unsigned)(m >> 32);
#pragma unroll
        for (int o = 1; o < 64; o <<= 1) { lo |= __shfl_xor(lo, o); hh |= __shfl_xor(hh, o); }
        if (C.lane == 0) unip[0] = ((unsigned long long)hh << 32) | lo; }
    __syncthreads();
    const unsigned long long mymask = selb[tokl]; unsigned long long uni = unip[0];
    uni = ((unsigned long long)__builtin_amdgcn_readfirstlane((unsigned)(uni >> 32)) << 32) | (unsigned)__builtin_amdgcn_readfirstlane((unsigned)uni);
    if (NSA_CORES & 2) {
        SelPol P{WSP(bf16, WS_KV6) + (size_t)2 * NTOK * 128 + (size_t)b * SEQ * 128 + g * 64, WSP(bf16, WS_KV6) + (size_t)3 * NTOK * 128 + (size_t)b * SEQ * 128 + g * 64, uni, mymask, T, tq};
        f32x16 o2[2];
        attn_core<64, 64, false>(C, P, qf, o2);
        scale_rows<2>(C, o2, (parts & 2) ? fast_sigmoid(lg[1]) : 0.f, 0);
#pragma unroll
        for (int db = 0; db < 2; ++db)
#pragma unroll
            for (int r = 0; r < 16; ++r) oacc[(db * 16 + r) * 64] += o2[db][r];
    }
    if (NSA_CORES & 4) {
        WinPol P{WSP(bf16, WS_KV6) + (size_t)4 * NTOK * 128 + (size_t)b * SEQ * 128 + g * 64, WSP(bf16, WS_KV6) + (size_t)5 * NTOK * 128 + (size_t)b * SEQ * 128 + g * 64, T, tq};
        f32x16 o2[2];
        attn_core<64, 64, false>(C, P, qf, o2);
        scale_rows<2>(C, o2, (parts & 4) ? fast_sigmoid(lg[2]) : 0.f, 0);
#pragma unroll
        for (int db = 0; db < 2; ++db)
#pragma unroll
            for (int r = 0; r < 16; ++r) o2[db][r] += oacc[(db * 16 + r) * 64];
        bf16* dst = WSP(bf16, WS_OBR) + g * 256;
        const size_t rb = (size_t)(b * SEQ + 64 * T + 8 * C.w);
        store_o<2>(C, o2, dst, [&](int qq) { return (rb + (qq >> 2)) * 512 + (qq & 3) * 64; });
    }
}

__device__ __forceinline__ void p3_phase(Frame& F, int parts, int rep) {
    LAS int* ticket = (LAS int*)(F.lds + AL_TICKET);
    unsigned* ctl = WSP(unsigned, WS_CTL);
    unsigned* qhead = ctl + CW_QATTN + 64 * rep; const unsigned* order = WSP(unsigned, WS_ORDER);
    for (;;) {
        __syncthreads();
        if (F.tid == 0) ticket[0] = (int)atomicAdd(qhead, 1u);
        __syncthreads();
        const int tk = __builtin_amdgcn_readfirstlane(ticket[0]);
        if (tk >= N_QUEUE) break;
        const unsigned d = __builtin_amdgcn_readfirstlane(order[tk]); const int type = d & 7, a = (d >> 3) & 255, bb = d >> 11;
#ifdef REP_ATTN_ONLY
        if (rep > 0 && type >= 3) continue;
#endif
#ifdef REP_CVT_ONLY
        if (rep > 0 && type != 5) continue;
#endif
        if (type == 0) { q_wait(ctl + CW_CMPDONE + 64 * a, 16u, F.tid); nsa_unit(F, a, bb, parts); }
        else if (type == 1) { q_wait(ctl + CW_CUMDONE + 64 * (a >> 3), 1u, F.tid); fox_unit(F, a, bb); }
        else if (type == 2) mem_unit(F, a, bb);
#ifndef QDIS
#define QDIS 0
#endif
        else if (type == 3) { if (!(QDIS & 1)) p2_compress_unit(F, a, bb); q_signal(ctl + CW_CMPDONE + 64 * (bb >> 3), F.tid); }
        else if (type == 4) { if (!(QDIS & 2)) p2_cumsum_unit(F, 8 * a + F.wave); q_signal(ctl + CW_CUMDONE + 64 * a, F.tid); }
        else { if (!(QDIS & 4)) convert_unit(F, bb); }
    }
}
#define XB_TMO      128
#define XB_XCNT(j)  (256  + 64 * (j))
#define XB_XSUB(j)  (1280 + 64 * (j))
#define XB_XGEN(j)  (2304 + 64 * (j))
#define XB_TOP      3328
#define XB_TOPGEN   3392
#define XCD_BAR_WORDS 3456
#define XB_SPIN_CAP (1u << 18)

__device__ __forceinline__ unsigned xb_ld(unsigned* p)              { return __hip_atomic_load(p, __ATOMIC_RELAXED, __HIP_MEMORY_SCOPE_AGENT); }
__device__ __forceinline__ unsigned xb_add(unsigned* p, unsigned v) { return __hip_atomic_fetch_add(p, v, __ATOMIC_RELAXED, __HIP_MEMORY_SCOPE_AGENT); }
__device__ __forceinline__ unsigned xb_xcc_id() { return (unsigned)__builtin_amdgcn_s_getreg((3 << 11) | 20) & 0xFu; }
#define XB_SPIN(cond, bar) do { unsigned _sp = 0; while (cond) { __builtin_amdgcn_s_sleep(1); \
    if ((++_sp & 255u) == 0u) { if (xb_ld(&(bar)[XB_TMO])) break; if (_sp > XB_SPIN_CAP) { atomicAdd(&(bar)[XB_TMO], 1u); break; } } } } while (0)

struct XcdBarrier {
    unsigned* bar; unsigned x;
    volatile LAS unsigned* st;
};

__device__ __forceinline__ XcdBarrier xcd_barrier_post(unsigned* bar, volatile LAS unsigned* st) {
    XcdBarrier b; b.bar = bar; b.x = xb_xcc_id(); b.st = st;
    if (threadIdx.x == 0) (void)xb_add(&bar[XB_XCNT(b.x)], 1u);
    return b;
}
__device__ __forceinline__ void xcd_barrier_complete(unsigned* bar, unsigned x, unsigned& nloc, unsigned& nx) {
    const unsigned G = gridDim.x * gridDim.y * gridDim.z;
    unsigned sum, cnt, mine, sp = 0u;
    for (;;) {
        sum = 0u; cnt = 0u; mine = 0u;
#pragma unroll
        for (unsigned j = 0; j < 16; ++j) { const unsigned c = xb_ld(&bar[XB_XCNT(j)]); sum += c; cnt += (c > 0u) ? 1u : 0u; mine = (j == x) ? c : mine; }
        if (sum == G) break;
        __builtin_amdgcn_s_sleep(1);
        if ((++sp & 255u) == 0u) { if (xb_ld(&bar[XB_TMO])) break; if (sp > XB_SPIN_CAP) { atomicAdd(&bar[XB_TMO], 1u); break; } }
    }
    nloc = mine > 0u ? mine : 1u; nx = cnt > 0u ? cnt : 1u;
}

__device__ __forceinline__ void xcd_barrier(const XcdBarrier& b) {
    asm volatile("s_waitcnt vmcnt(0)" ::: "memory");
    __syncthreads();
    if (threadIdx.x == 0) {
        unsigned* bar = b.bar;
        __builtin_amdgcn_s_waitcnt(0);
        unsigned nloc = b.st[0], nx = b.st[1];
        if (nloc == 0u) { xcd_barrier_complete(bar, b.x, nloc, nx); b.st[0] = nloc; b.st[1] = nx; }
        const unsigned old = xb_add(&bar[XB_XSUB(b.x)], 1u);
        const unsigned gen = old / nloc;
        if (old + 1u == (gen + 1u) * nloc) {
            __builtin_amdgcn_fence(__ATOMIC_RELEASE, "agent");
            asm volatile("s_waitcnt vmcnt(0)" ::: "memory");
            const unsigned og = xb_add(&bar[XB_TOP], 1u);
            const unsigned tg = og / nx;
            if (og + 1u == (tg + 1u) * nx) xb_add(&bar[XB_TOPGEN], 1u);
            else XB_SPIN(xb_ld(&bar[XB_TOPGEN]) == tg, bar);
            __builtin_amdgcn_fence(__ATOMIC_ACQUIRE, "agent");
            xb_add(&bar[XB_XGEN(b.x)], 1u);
            asm volatile("s_waitcnt vmcnt(0)" ::: "memory");
        } else {
            XB_SPIN(xb_ld(&bar[XB_XGEN(b.x)]) == gen, bar);
            __builtin_amdgcn_fence(__ATOMIC_ACQUIRE, "agent");
            asm volatile("s_waitcnt vmcnt(0)" ::: "memory");
        }
    }
    __syncthreads();
}
#ifndef ABL_PARTS
#define ABL_PARTS 31
#endif
#ifndef PH_MAX
#define PH_MAX 10
#endif
typedef KArgs Args;
static_assert(sizeof(Args) == 26 * 8 + 8 + 8 + 8, "Args has no padding");

__global__ void __launch_bounds__(NTHREADS, 2) fwd_megakernel(Args args) {
    extern __shared__ __attribute__((aligned(16))) unsigned char lds_raw[];
    Frame F;
    F.lds = (LAS unsigned char*)lds_raw;
    F.tid = threadIdx.x; F.lane = F.tid & 63; F.wave = __builtin_amdgcn_readfirstlane(F.tid >> 6);
    F.G = gridDim.x; F.bid = blockIdx.x; F.vcu = (F.G % 8 == 0) ? (F.bid % 8) * (F.G / 8) + F.bid / 8 : F.bid;
    F.ka = (const KArgs __attribute__((address_space(4)))*)__builtin_amdgcn_kernarg_segment_ptr();
    F.out = args.out; F.ws = args.ws;
    const int lo = args.ph_lo, hi = args.ph_hi;
    volatile LAS unsigned* xst = (volatile LAS unsigned*)(F.lds + LDS_BYTES - 64);
    if (F.tid < 2) xst[F.tid] = 0u;
    __syncthreads();
    XcdBarrier xbar = xcd_barrier_post((unsigned*)(F.ws + WS_CTL) + CW_XBAR, xst);
#ifndef PHASE_MASK
#define PHASE_MASK 0x7ff
#endif
#define IN(k) (((PHASE_MASK >> (k)) & 1) && lo <= (k) && (k) < hi)
#ifndef REP_MASK
#define REP_MASK 0
#endif
#define REPS(k) for (int rep_ = 0; rep_ < 1 + ((REP_MASK >> (k)) & 1); ++rep_)
#define SEAM(k) do { if (lo <= (k) && (k) + 1 < hi) { xcd_barrier(xbar); } } while (0)
#define FIT_GRID(n) ((F.G % 8 == 0) ? ({ const int n_ = (n), R_ = (n_ + F.G - 1) / F.G, g_ = 8 * (((n_ + R_ - 1) / R_ + 7) / 8); g_ < F.G ? g_ : F.G; }) : F.G)

    if (IN(0)) REPS(0) p0_prologue(F);
    SEAM(0);
    if (IN(1)) REPS(1) {
        const int g1 = FIT_GRID(1680);
        if (F.bid < g1) {
        SchedIn S{(const char*)(F.ws + WS_HA), (const char*)(F.ws + WS_WIN_T), g1, F.bid};
        EpiIn E{WSP(bf16, WS_QA), WSP(bf16, WS_KV6), WSP(bf16, WS_QF), WSP(bf16, WS_KF), WSP(bf16, WS_VF), WSP(bf16, WS_QM), WSP(bf16, WS_GATES), WSP(bf16, WS_KMEM), WSP(bf16, WS_VMEM), WSP(float, WS_LG),
                WSP(float, WS_ROPE_C), WSP(float, WS_ROPE_S), F.ka->in[5]};
        pg8::gemm_phase<false>(F.lds, 1024, S, E);
        }
    }
    SEAM(1);
    if (IN(3)) REPS(3) p3_phase(F, ABL_PARTS, rep_);
    SEAM(3);
    if (IN(4)) REPS(4) {
        SchedBr S{(const char*)(F.ws + WS_OBR), (const char*)(F.ws + WS_WBR_T), F.G, F.bid};
        EpiBr E{WSP(bf16, WS_GATES), WSP(bf16, WS_MERGED)};
        pg8::gemm_phase<false>(F.lds, 512, S, E);
    }
    SEAM(4);
    if (IN(5)) REPS(5) {
        SchedOut S{(const char*)(F.ws + WS_MERGED), (const char*)(F.ws + WS_WOUT_T), F.G, F.bid};
        EpiOut E{F.ka->in[0], F.out, WSP(unsigned char, WS_H2)};
        pg8::gemm_phase<false>(F.lds, 1024, S, E);
    }
    SEAM(5);
    if (IN(6)) REPS(6) p6_phase(F);
    SEAM(6);
    const bool moe_split = (F.G % 8 == 0);
    const LAS int* te = (const LAS int*)(F.lds + MT_OFF);
    if (IN(8)) REPS(8) {
        { LAS int* mt = (LAS int*)(F.lds + MT_OFF);
          if (F.tid < 64) { const int e = F.tid & 31; const int c = (int)__hip_atomic_load(WSP(unsigned, WS_CTL) + CW_GCNT + 32 * e, __ATOMIC_RELAXED, __HIP_MEMORY_SCOPE_AGENT);
              const int padc = (c + 255) & ~255; int inc = padc;
#pragma unroll
              for (int o = 1; o < 32; o <<= 1) { const int up = __shfl_up(inc, o); if (e >= o) inc += up; }
              const int start = inc - padc;
              if (F.tid < 32) { mt[320 + e] = start; mt[352 + e] = c; for (int q = 0; q < (padc >> 8); ++q) mt[(start >> 8) + q] = e | (q << 5); if (e == 31) mt[300] = inc >> 8; } }
          __syncthreads(); }
        const int nmt = __builtin_amdgcn_readfirstlane(te[300]), F8 = moe_split ? (nmt * 8) / F.G : (1 << 20);
        SchedMoE<true> S{(const char*)(F.ws + WS_H2), (const char*)(F.ws + WS_WGU_T), te, WSP(int, WS_ETOK), nmt, 8, F.G, F.vcu, (size_t)2048 * 1024, 0, F8};
        EpiGU E{F.ka->in[22], te, WSP(unsigned char, WS_ACT), WSP(float, WS_ERSTD)};
        pg8::gemm_phase<true>(F.lds, 512, S, E);
    }
    SEAM(8);
    if (IN(9)) REPS(9) {
        unsigned* done8 = WSP(unsigned, WS_CTL) + CW_DONE8;
        const int nmt = __builtin_amdgcn_readfirstlane(te[300]), n9 = nmt * 4, F8 = moe_split ? (nmt * 8) / F.G : (1 << 20), T = moe_split ? nmt * 8 - F8 * F.G : 0, v = F.vcu;
        if (v < T) {
            SchedMoE<true> S{(const char*)(F.ws + WS_H2), (const char*)(F.ws + WS_WGU_T), te, WSP(int, WS_ETOK), nmt, 8, F.G, v, (size_t)2048 * 1024, F8, F8 + 1};
            EpiGU E{F.ka->in[22], te, WSP(unsigned char, WS_ACT), WSP(float, WS_ERSTD)};
            pg8::gemm_phase<true>(F.lds, 512, S, E);
            if (F.tid == 0) { __builtin_amdgcn_fence(__ATOMIC_RELEASE, "agent"); asm volatile("s_waitcnt vmcnt(0)" ::: "memory");
                __hip_atomic_fetch_add(done8 + ((F8 * F.G + v) >> 3), 1u, __ATOMIC_RELAXED, __HIP_MEMORY_SCOPE_AGENT); }
        }
        const int vb = v - T + (v < T ? F.G : 0), pmT = moe_split ? (F8 * F.G) / 8 : (1 << 20), lim = n9 < 4 * pmT ? n9 : 4 * pmT;
        const int nseg1 = vb < lim ? (lim - 1 - vb) / F.G + 1 : 0;
        EpiDn E{F.ka->in[24], te, WSP(bf16, WS_AMOE)};
        { SchedMoE<false> S{(const char*)(F.ws + WS_ACT), (const char*)(F.ws + WS_WD_T), te, nullptr, nmt, 4, F.G, vb, (size_t)1024 * 1024, 0, nseg1};
          pg8::gemm_phase<true>(F.lds, 512, S, E); }
        if (nseg1 * F.G + vb < n9) {
            for (int L = nseg1 * F.G + vb; L < n9; L += F.G) q_wait(done8 + (L >> 2), 8u, F.tid);
            SchedMoE<false> S{(const char*)(F.ws + WS_ACT), (const char*)(F.ws + WS_WD_T), te, nullptr, nmt, 4, F.G, vb, (size_t)1024 * 1024, nseg1, 1 << 20};
            pg8::gemm_phase<true>(F.lds, 512, S, E);
        }
    }
    SEAM(9);
    if (IN(10)) { if ((REP_MASK >> 10) & 1) p10_phase(F, PH_MAX >= 9, WSP(float, WS_GATES)); p10_phase(F, PH_MAX >= 9, F.out); }
#undef IN
#undef SEAM
}

extern "C" void kernel_launch(void* const* d_in, const int* in_sizes, int n_in, void* d_out, int out_size, void* d_ws, size_t ws_size, hipStream_t stream) {
    static int grid = 0;
    if (grid == 0) {
        if (n_in != 26 || out_size != NTOK * DM || ws_size < WS_END) { fprintf(stderr, "kernel_launch: unexpected sizes n_in %d out %d ws %zu (need %zu)\n", n_in, out_size, ws_size, (size_t)WS_END); grid = -1; return; }
        int dev = 0, cus = 0, per_cu = 0;
        hipGetDevice(&dev); hipDeviceGetAttribute(&cus, hipDeviceAttributeMultiprocessorCount, dev);
        if (hipFuncSetAttribute((const void*)fwd_megakernel, hipFuncAttributeMaxDynamicSharedMemorySize, LDS_BYTES) != hipSuccess) { fprintf(stderr, "kernel_launch: hipFuncSetAttribute failed\n"); grid = -1; return; }
        if (hipOccupancyMaxActiveBlocksPerMultiprocessor(&per_cu, (const void*)fwd_megakernel, NTHREADS, LDS_BYTES) != hipSuccess || per_cu < 1) { fprintf(stderr, "kernel_launch: occupancy query says %d\n", per_cu); per_cu = 1; }
        (void)hipGetLastError();
        grid = cus * 1;
        if (grid > 256) grid = 256;
    }
    if (grid < 0) return;
    (void)hipMemsetAsync((char*)d_ws + WS_CTL, 0, CTL_BYTES, stream);
    Args a{};
    for (int i = 0; i < 26; ++i) a.in[i] = (const float*)d_in[i];
    a.out = (float*)d_out; a.ws = (unsigned char*)d_ws;
#if defined(MULTI_LAUNCH)
    for (int p = 0; p <= 10; ++p) { if (p > PH_MAX && p != 10) continue; a.ph_lo = p; a.ph_hi = p + 1; hipLaunchKernelGGL(fwd_megakernel, dim3(grid), dim3(NTHREADS), LDS_BYTES, stream, a); }
#else
    a.ph_lo = 0; a.ph_hi = 11;
    hipLaunchKernelGGL(fwd_megakernel, dim3(grid), dim3(NTHREADS), LDS_BYTES, stream, a);
#endif
}
```

```cpp
#include <hip/hip_runtime.h>
#include <hip/hip_cooperative_groups.h>
#include <cstdio>
#include <cstdint>
#include <cmath>
namespace cg = cooperative_groups;

#define LAS __attribute__((address_space(3)))
typedef unsigned short bf16;
typedef short bf16x8 __attribute__((ext_vector_type(8)));
typedef short s16x4 __attribute__((ext_vector_type(4)));
typedef float f32x4 __attribute__((ext_vector_type(4)));
typedef float f32x2 __attribute__((ext_vector_type(2)));
typedef float f32x16 __attribute__((ext_vector_type(16)));
typedef unsigned u32x4 __attribute__((ext_vector_type(4)));
typedef unsigned u32x2 __attribute__((ext_vector_type(2)));
typedef __bf16 bf16x2_t __attribute__((ext_vector_type(2)));

constexpr int NB = 4, SEQ = 4096, DM = 1024, NTOK = NB * SEQ;
constexpr int DIN = 6432, NIN = 6656;
constexpr int MEMLEN = 256, NMEMROW = NB * MEMLEN;
constexpr int NEXP = 32, TOPK = 4, FEXP = 1024;
constexpr int MAXSLOT = NTOK * TOPK + NEXP * 256;
constexpr float RMS_EPS = 1e-5f;
constexpr float LOG2E = 1.4426950408889634f;
constexpr float C2_64 = 0.125f * LOG2E;
constexpr float C2_128 = 0.08838834764831845f * LOG2E;
constexpr float NEGBIG = -1e30f;
constexpr float W8_SCALE = 32.0f, ACT8_SCALE = 4.0f;

constexpr size_t MiB = 1u << 20;
constexpr size_t WS_CTL = 0;
constexpr size_t CTL_BYTES = 64 * 1024;
constexpr size_t WS_ROPE_C = 1 * MiB, WS_ROPE_S = WS_ROPE_C + 512 * 1024;
constexpr size_t WS_W1T_K = 2 * MiB, WS_W1T_V = WS_W1T_K + 256 * 1024;
constexpr size_t WS_W2T_K = WS_W1T_V + 256 * 1024, WS_W2T_V = WS_W2T_K + 8192;
constexpr size_t WS_CPE = WS_W2T_V + 8192;
constexpr size_t WS_KCMP = 3 * MiB;
constexpr size_t WS_VCMP = WS_KCMP + 256 * 1024;
constexpr size_t WS_CUM = 4 * MiB;
constexpr size_t WS_KMAX = 4 * MiB + 512 * 1024;
constexpr size_t WS_KMEM = 5 * MiB, WS_VMEM = 6 * MiB;
constexpr size_t WS_ORDER = 7 * MiB;
constexpr size_t WS_BLKCNT = 7 * MiB + 64 * 1024;
constexpr size_t WS_TILE_E = 7 * MiB + 128 * 1024;
constexpr size_t WS_WRT = 7 * MiB + 256 * 1024;
constexpr size_t WS_RSTD = 7 * MiB + 512 * 1024;
constexpr size_t WS_RSLOT = 8 * MiB;
constexpr size_t WS_SLOTTOK = 8 * MiB + 512 * 1024;
constexpr size_t WS_WIN_T = 9 * MiB;
constexpr size_t WS_WBR_T = 24 * MiB;
constexpr size_t WS_WOUT_T = 27 * MiB;
constexpr size_t WS_WGU_T = 32 * MiB;
constexpr size_t WS_WD_T = 160 * MiB;
constexpr size_t WS_HA = 224 * MiB;
constexpr size_t WS_ETOK = 224 * MiB, WS_ERSTD = 226 * MiB;
constexpr int MT_OFF = 131072;
constexpr size_t WS_QA = 258 * MiB;
constexpr size_t WS_KV6 = 274 * MiB;
constexpr size_t WS_QM = 298 * MiB;
constexpr size_t WS_LG = 314 * MiB;
constexpr size_t WS_GATES = 316 * MiB;
constexpr size_t WS_QF = 412 * MiB, WS_KF = 428 * MiB, WS_VF = 444 * MiB;
constexpr size_t WS_ACT = 316 * MiB;
constexpr size_t WS_OBR = 460 * MiB;
constexpr size_t WS_MERGED = 508 * MiB;
constexpr size_t WS_H2 = 540 * MiB;
constexpr size_t WS_ROUTE = 572 * MiB;
constexpr size_t WS_AMOE = 576 * MiB;
constexpr size_t WS_END = 720 * MiB;
static_assert(WS_ACT + (size_t)MAXSLOT * 1024 * 2 <= WS_OBR && WS_AMOE + (size_t)MAXSLOT * 1024 * 2 <= WS_END, "ws map");
constexpr int CW_QATTN = 64;
constexpr int CW_DONE8 = 12288;
constexpr int CW_GCNT = 9216;
constexpr int CW_XBAR = 1024;

constexpr int LDS_BYTES = 155648;
constexpr int NWAVES = 8, NTHREADS = 512;

__device__ __forceinline__ unsigned cvtpk(float lo, float hi) { f32x2 v = {lo, hi}; bf16x2_t b = __builtin_convertvector(v, bf16x2_t); return __builtin_bit_cast(unsigned, b); }
__device__ __forceinline__ float bf2f(unsigned short h) { return __builtin_bit_cast(float, (unsigned)h << 16); }
__device__ __forceinline__ float bflo(unsigned u) { return __builtin_bit_cast(float, u << 16); }
__device__ __forceinline__ float bfhi(unsigned u) { return __builtin_bit_cast(float, u & 0xffff0000u); }
__device__ __forceinline__ float wave_sum(float v) {
#pragma unroll
    for (int o = 1; o < 64; o <<= 1) v += __shfl_xor(v, o);
    return v;
}
__device__ __forceinline__ float fast_sigmoid(float x) { return __builtin_amdgcn_rcpf(1.0f + __builtin_amdgcn_exp2f(-LOG2E * x)); }
__device__ __forceinline__ unsigned pk_fp8x4(float a, float b, float c, float d) {
    a = fminf(fmaxf(a, -448.f), 448.f); b = fminf(fmaxf(b, -448.f), 448.f); c = fminf(fmaxf(c, -448.f), 448.f); d = fminf(fmaxf(d, -448.f), 448.f);
    int p = __builtin_amdgcn_cvt_pk_fp8_f32(a, b, 0, false); p = __builtin_amdgcn_cvt_pk_fp8_f32(c, d, p, true); return (unsigned)p;
}
namespace pg8 {
#define PG8_LAS __attribute__((address_space(3)))
typedef unsigned short bf16_t;
typedef short bf16x8 __attribute__((ext_vector_type(8)));
typedef float f32x4 __attribute__((ext_vector_type(4)));
typedef unsigned u32x4 __attribute__((ext_vector_type(4)));
typedef unsigned u32x2 __attribute__((ext_vector_type(2)));
typedef int i32x8 __attribute__((ext_vector_type(8)));
typedef int i32x4 __attribute__((ext_vector_type(4)));
constexpr int BM = 256, BK = 64, HALF = 128, HTB = HALF * BK * 2  , STAGE_BYTES = 8 * HTB;

__host__ __device__ __forceinline__ int lds_byte(int r, int c) { const int st = (r >> 4) * 2 + (c >> 5), rr = r & 15, cc = c & 31, ob = rr * 64 + cc * 2; return st * 1024 + (ob ^ (((ob >> 9) & 1) << 5)); }
__host__ __device__ __forceinline__ void stage_rc(int b, int& R, int& C) { const int st = b / 1024, sb = b % 1024, swz = sb ^ (((sb >> 9) & 1) << 5); R = (st >> 1) * 16 + swz / 64; C = (st & 1) * 32 + (swz % 64) / 2; }
__host__ __device__ __forceinline__ int perm32(int rho) { const int n = rho >> 4, i = rho & 15; return 8 * (i >> 2) + 4 * n + (i & 3); }

struct Unit { int pm, pn; };

template <bool F8, class Epi, class Sched>
__device__ __forceinline__ void gemm_phase(PG8_LAS unsigned char* lds, const int K, const Sched& S, const Epi& E) {
    const int tid = threadIdx.x, wid = __builtin_amdgcn_readfirstlane(tid >> 6), lane = tid & 63, wr = wid >> 2, wc = wid & 3, fr = lane & 15, fq = lane >> 4;
    const int nt = K / BK;
    unsigned voffB[2]; int RA[2], CA[2];
    { int R, C; stage_rc(tid * 16, R, C); const int Rb = (R & ~31) + perm32(R & 31);
      RA[0] = R; CA[0] = C; RA[1] = R + 64; CA[1] = C; voffB[0] = (unsigned)(Rb * K + C) * 2u; voffB[1] = voffB[0] + (unsigned)(64 * K * 2); }
    constexpr bool GATHER = Sched::GATHER;
    unsigned cofA[2][2], nofA[2][2];
#define PG8_AOFF(dst, u) do { _Pragma("unroll") for (int h_ = 0; h_ < 2; ++h_) _Pragma("unroll") for (int i_ = 0; i_ < 2; ++i_) dst[h_][i_] = S.a_voff(u, h_, RA[i_], CA[i_], K); } while (0)
    const size_t kstep = (size_t)(BK * 2);
    const size_t hstep = (size_t)HALF * K * 2;
    const unsigned ldsw = (unsigned)wid * 1024u;
    const int aoff = lds_byte(wr * 64 + fr, fq * 8), boff = lds_byte(wc * 32 + fr, fq * 8);
    const int aoff8 = lds_byte(wr * 64 + fr, fq * 16), boff8 = lds_byte(wc * 32 + fr, fq * 16);
#define PG8_SA(b, h) (((b) * 2 + (h)) * HTB)
#define PG8_SB(b, h) ((4 + (b) * 2 + (h)) * HTB)
#define PG8_STAGE(bufoff, gbase, voff) do { _Pragma("unroll") for (int _i = 0; _i < 2; ++_i) \
        __builtin_amdgcn_global_load_lds((const unsigned*)((const char*)(gbase) + (voff)[_i]), (PG8_LAS unsigned*)(lds + (bufoff) + ldsw + _i * 8192), 16, 0, 0); } while (0)
#define PG8_LDA(dst, b, h) do { _Pragma("unroll") for (int m = 0; m < 4; ++m) _Pragma("unroll") for (int k = 0; k < 2; ++k) dst[m][k] = *(const PG8_LAS bf16x8*)(lds + PG8_SA(b, h) + aoff + m * 2048 + k * 1024); } while (0)
#define PG8_LDB(dst, b, h) do { _Pragma("unroll") for (int n = 0; n < 2; ++n) _Pragma("unroll") for (int k = 0; k < 2; ++k) dst[n][k] = *(const PG8_LAS bf16x8*)(lds + PG8_SB(b, h) + boff + n * 2048 + k * 1024); } while (0)
#define PG8_MMA(ai, bj, At, Bt) do { __builtin_amdgcn_s_setprio(1); _Pragma("unroll") for (int m = 0; m < 4; ++m) _Pragma("unroll") for (int n = 0; n < 2; ++n) _Pragma("unroll") for (int k = 0; k < 2; ++k) \
        acc[ai][bj][m][n] = __builtin_amdgcn_mfma_f32_16x16x32_bf16(Bt[n][k], At[m][k], acc[ai][bj][m][n], 0, 0, 0); __builtin_amdgcn_s_setprio(0); } while (0)
#define PG8_LD8(dst, base, o0, cnt) do { _Pragma("unroll") for (int q_ = 0; q_ < cnt; ++q_) { const i32x4 lo_ = *(const PG8_LAS i32x4*)(lds + (base) + (o0) + q_ * 2048), hi_ = *(const PG8_LAS i32x4*)(lds + (base) + (o0) + q_ * 2048 + 16); \
        dst[q_] = (i32x8){lo_[0], lo_[1], lo_[2], lo_[3], hi_[0], hi_[1], hi_[2], hi_[3]}; } } while (0)
#define PG8_MMA8(ai, bj, At, Bt) do { __builtin_amdgcn_s_setprio(1); _Pragma("unroll") for (int m = 0; m < 4; ++m) _Pragma("unroll") for (int n = 0; n < 2; ++n) \
        asm volatile("v_mfma_scale_f32_16x16x128_f8f6f4 %0, %1, %2, %0, %3, %3 op_sel_hi:[0,0,0]" : "+v"(acc[ai][bj][m][n]) : "v"(Bt[n]), "v"(At[m]), "v"(sc8)); asm volatile("s_nop 7" ::: "memory"); __builtin_amdgcn_s_setprio(0); } while (0)
#define PG8_WAIT_V(n) asm volatile("s_waitcnt vmcnt(" #n ")" ::: "memory")
#define PG8_WAIT_L(n) asm volatile("s_waitcnt lgkmcnt(" #n ")" ::: "memory")
#define PG8_BAR __builtin_amdgcn_s_barrier()
#define PG8_SCHED __builtin_amdgcn_sched_barrier(0)
    Unit cur, nxt; int ui = 0;
    if (!S.next(0, cur)) return;
    f32x4 acc[2][2][4][2];
#pragma unroll
    for (int a = 0; a < 2; ++a)
#pragma unroll
        for (int b = 0; b < 2; ++b)
#pragma unroll
            for (int m = 0; m < 4; ++m)
#pragma unroll
                for (int n = 0; n < 2; ++n) acc[a][b][m][n] = (f32x4){0.f, 0.f, 0.f, 0.f};
    bf16x8 At[4][2], B0[2][2], B1[2][2]; i32x8 At8[4], B08[2], B18[2]; int sc8 = 0x7f7f7f7f; asm volatile("" : "+v"(sc8));
    const char* cA = S.a_base(cur); const char* cB = S.b_base(cur);
    PG8_AOFF(cofA, cur);
    PG8_STAGE(PG8_SB(0, 0), cB, voffB); PG8_STAGE(PG8_SB(0, 1), cB + hstep, voffB); PG8_STAGE(PG8_SA(0, 0), cA, cofA[0]); PG8_STAGE(PG8_SA(0, 1), cA, cofA[1]);
    if (wr == 1) PG8_BAR;
    PG8_WAIT_V(2); PG8_BAR;
    PG8_STAGE(PG8_SB(1, 0), cB + kstep, voffB); PG8_STAGE(PG8_SA(1, 0), cA + kstep, cofA[0]); PG8_STAGE(PG8_SB(1, 1), cB + hstep + kstep, voffB);
    PG8_WAIT_V(6); PG8_BAR;
    for (;;) {
        const bool has_next = S.next(ui + 1, nxt);
        const char* nA = has_next ? S.a_base(nxt) : cA; const char* nB = has_next ? S.b_base(nxt) : cB;
        if constexpr (GATHER) { if (has_next) PG8_AOFF(nofA, nxt); else { _Pragma("unroll") for (int h_ = 0; h_ < 2; ++h_) _Pragma("unroll") for (int i_ = 0; i_ < 2; ++i_) nofA[h_][i_] = cofA[h_][i_]; } }
#pragma clang loop unroll(disable)
        for (int t = 0; t < nt; t += 2) {
            const bool last = (t == nt - 2);
            const char* a1 = cA + (size_t)(t + 1) * kstep;
            const char* a2 = last ? nA : cA + (size_t)(t + 2) * kstep; const char* b2 = last ? nB : cB + (size_t)(t + 2) * kstep;
            const char* a3 = a2 + kstep; const char* b3 = b2 + kstep;
            unsigned sofA[2][2];
            _Pragma("unroll") for (int h_ = 0; h_ < 2; ++h_) _Pragma("unroll") for (int i_ = 0; i_ < 2; ++i_) sofA[h_][i_] = (GATHER && last) ? nofA[h_][i_] : cofA[h_][i_];
            if constexpr (!F8) {
            PG8_LDB(B0, 0, 0); PG8_LDB(B1, 0, 1); PG8_SCHED; PG8_LDA(At, 0, 0); PG8_STAGE(PG8_SA(1, 1), a1, cofA[1]);
            PG8_WAIT_V(8); PG8_WAIT_L(0); PG8_BAR; PG8_MMA(0, 0, At, B0); PG8_MMA(0, 1, At, B1); PG8_BAR; PG8_SCHED;
            PG8_LDA(At, 0, 1); PG8_STAGE(PG8_SB(0, 0), b2, voffB); PG8_STAGE(PG8_SB(0, 1), b2 + hstep, voffB); PG8_STAGE(PG8_SA(0, 0), a2, sofA[0]);
            PG8_WAIT_V(8); PG8_WAIT_L(0); PG8_BAR; PG8_MMA(1, 0, At, B0); PG8_MMA(1, 1, At, B1); PG8_BAR; PG8_SCHED;
            PG8_LDB(B0, 1, 0); PG8_LDB(B1, 1, 1); PG8_SCHED; PG8_LDA(At, 1, 0); PG8_STAGE(PG8_SA(0, 1), a2, sofA[1]);
            PG8_WAIT_V(8); PG8_WAIT_L(0); PG8_BAR; PG8_MMA(0, 0, At, B0); PG8_MMA(0, 1, At, B1); PG8_BAR; PG8_SCHED;
            PG8_LDA(At, 1, 1); PG8_STAGE(PG8_SB(1, 0), b3, voffB); PG8_STAGE(PG8_SB(1, 1), b3 + hstep, voffB); PG8_STAGE(PG8_SA(1, 0), a3, sofA[0]);
            PG8_WAIT_V(8); PG8_WAIT_L(0); PG8_BAR; PG8_MMA(1, 0, At, B0); PG8_MMA(1, 1, At, B1); PG8_BAR; PG8_SCHED;
            } else {
            PG8_LD8(B08, PG8_SB(0, 0), boff8, 2); PG8_LD8(B18, PG8_SB(0, 1), boff8, 2); PG8_SCHED; PG8_LD8(At8, PG8_SA(0, 0), aoff8, 4); PG8_STAGE(PG8_SA(1, 1), a1, cofA[1]);
            PG8_WAIT_V(8); PG8_WAIT_L(0); PG8_BAR; PG8_MMA8(0, 0, At8, B08); PG8_MMA8(0, 1, At8, B18); PG8_BAR; PG8_SCHED;
            PG8_LD8(At8, PG8_SA(0, 1), aoff8, 4); PG8_STAGE(PG8_SB(0, 0), b2, voffB); PG8_STAGE(PG8_SB(0, 1), b2 + hstep, voffB); PG8_STAGE(PG8_SA(0, 0), a2, sofA[0]);
            PG8_WAIT_V(8); PG8_WAIT_L(0); PG8_BAR; PG8_MMA8(1, 0, At8, B08); PG8_MMA8(1, 1, At8, B18); PG8_BAR; PG8_SCHED;
            PG8_LD8(B08, PG8_SB(1, 0), boff8, 2); PG8_LD8(B18, PG8_SB(1, 1), boff8, 2); PG8_SCHED; PG8_LD8(At8, PG8_SA(1, 0), aoff8, 4); PG8_STAGE(PG8_SA(0, 1), a2, sofA[1]);
            PG8_WAIT_V(8); PG8_WAIT_L(0); PG8_BAR; PG8_MMA8(0, 0, At8, B08); PG8_MMA8(0, 1, At8, B18); PG8_BAR; PG8_SCHED;
            PG8_LD8(At8, PG8_SA(1, 1), aoff8, 4); PG8_STAGE(PG8_SB(1, 0), b3, voffB); PG8_STAGE(PG8_SB(1, 1), b3 + hstep, voffB); PG8_STAGE(PG8_SA(1, 0), a3, sofA[0]);
            PG8_WAIT_V(8); PG8_WAIT_L(0); PG8_BAR; PG8_MMA8(1, 0, At8, B08); PG8_MMA8(1, 1, At8, B18); PG8_BAR; PG8_SCHED;
            }
        }
        if constexpr (F8) asm volatile("s_nop 15\n\ts_nop 15" ::: "memory");
        if (wr == 0) PG8_BAR;
        E(acc, cur, wr, wc, fr, fq);
        if (!has_next) break;
        cur = nxt; cA = nA; cB = nB; ++ui;
        if constexpr (GATHER) { _Pragma("unroll") for (int h_ = 0; h_ < 2; ++h_) _Pragma("unroll") for (int i_ = 0; i_ < 2; ++i_) cofA[h_][i_] = nofA[h_][i_]; }
        if (wr == 1) PG8_BAR;
    }
    PG8_WAIT_V(0);
    PG8_BAR;
#undef PG8_AOFF
#undef PG8_SA
#undef PG8_SB
#undef PG8_STAGE
#undef PG8_LDA
#undef PG8_LDB
#undef PG8_MMA
#undef PG8_MMA8
#undef PG8_LD8
#undef PG8_WAIT_V
#undef PG8_WAIT_L
#undef PG8_BAR
#undef PG8_SCHED
}
}
typedef float acc_t[2][2][4][2] __attribute__((unused));
#define ACC_ARG pg8::f32x4 (&acc)[2][2][4][2]
#define ZERO_ACC() do { _Pragma("unroll") for (int a_ = 0; a_ < 2; ++a_) _Pragma("unroll") for (int b_ = 0; b_ < 2; ++b_) _Pragma("unroll") for (int m_ = 0; m_ < 4; ++m_) _Pragma("unroll") for (int n_ = 0; n_ < 2; ++n_) acc[a_][b_][m_][n_] = (pg8::f32x4){0.f, 0.f, 0.f, 0.f}; } while (0)

__device__ __forceinline__ bool static_unit(int L, int nM, int nN, pg8::Unit& u) {
    const int nwg = nM * nN; if (L >= nwg) return false;
    int wgid = L; { const int q = nwg / 8, r = nwg % 8, xcd = wgid % 8, off = wgid / 8; wgid = (xcd < r ? xcd * (q + 1) : r * (q + 1) + (xcd - r) * q) + off; }
    const int nig = 8 * nN, gid = wgid / nig, fm = gid * 8, gsz = (nM - fm) < 8 ? (nM - fm) : 8;
    u.pm = fm + ((wgid % nig) % gsz); u.pn = (wgid % nig) / gsz; return true;
}

struct SchedIn {
    static constexpr bool GATHER = false;
    const char* A; const char* Bt; int G, c;
    __device__ __forceinline__ bool next(int i, pg8::Unit& u) const {
        const int L = i * G + c;
        if (L < 1664) return static_unit(L, 64, 26, u);
        if (L < 1680) { const int j = L - 1664; u.pm = 64 + (j >> 2); u.pn = 26 + (j & 3); return true; }
        return false;
    }
    __device__ __forceinline__ const char* a_base(const pg8::Unit& u) const { return A + (size_t)u.pm * (256 * 1024 * 2); }
    __device__ __forceinline__ const char* b_base(const pg8::Unit& u) const { return Bt + (size_t)u.pn * (256 * 1024 * 2); }
    __device__ __forceinline__ unsigned a_voff(const pg8::Unit&, int h, int R, int C, int K) const { return (unsigned)(((h * 128 + R) * K + C) * 2); }
};
struct SchedBr {
    static constexpr bool GATHER = false;
    const char* A; const char* Bt; int G, c;
    __device__ __forceinline__ bool next(int i, pg8::Unit& u) const {
        const int rnd = i / 3, br = i - rnd * 3; pg8::Unit t;
        if (!static_unit(rnd * G + c, 64, 4, t)) return false;
        u.pm = 64 * br + t.pm; u.pn = 4 * br + t.pn; return true;
    }
    __device__ __forceinline__ const char* a_base(const pg8::Unit& u) const { return A + (size_t)u.pm * (256 * 512 * 2); }
    __device__ __forceinline__ const char* b_base(const pg8::Unit& u) const { return Bt + (size_t)u.pn * (256 * 512 * 2); }
    __device__ __forceinline__ unsigned a_voff(const pg8::Unit&, int h, int R, int C, int K) const { return (unsigned)(((h * 128 + R) * K + C) * 2); }
};
struct SchedOut {
    static constexpr bool GATHER = false;
    const char* A; const char* Bt; int G, c;
    __device__ __forceinline__ bool next(int i, pg8::Unit& u) const { return static_unit(i * G + c, 64, 4, u); }
    __device__ __forceinline__ const char* a_base(const pg8::Unit& u) const { return A + (size_t)u.pm * (256 * 1024 * 2); }
    __device__ __forceinline__ const char* b_base(const pg8::Unit& u) const { return Bt + (size_t)u.pn * (256 * 1024 * 2); }
    __device__ __forceinline__ unsigned a_voff(const pg8::Unit&, int h, int R, int C, int K) const { return (unsigned)(((h * 128 + R) * K + C) * 2); }
};
template <bool G_> struct SchedMoE {
    static constexpr bool GATHER = G_;
    const char* A; const char* Bt; const LAS int* tile_e; const int* etok; int nmt, nN, G, v; size_t estride; int i0, i1;
    __device__ __forceinline__ bool next(int i, pg8::Unit& u) const {
        if (i + i0 >= i1) return false;
        const int L = (i + i0) * G + v; if (L < 0 || L >= nmt * nN) return false;
        u.pm = L / nN; u.pn = L - u.pm * nN; return true;
    }
    __device__ __forceinline__ const char* a_base(const pg8::Unit& u) const { return G_ ? A : A + (size_t)u.pm * (256 * 1024); }
    __device__ __forceinline__ const char* b_base(const pg8::Unit& u) const { return Bt + (size_t)(__builtin_amdgcn_readfirstlane(tile_e[u.pm]) & 31) * estride + (size_t)u.pn * (256 * 1024); }
    __device__ __forceinline__ unsigned a_voff(const pg8::Unit& u, int h, int R, int C, int K) const {
        if (!G_) return (unsigned)(((h * 128 + R) * K + C) * 2);
        const int te_ = __builtin_amdgcn_readfirstlane(tile_e[u.pm]);
        unsigned t = (unsigned)etok[(te_ & 31) * NTOK + (te_ >> 5) * 256 + h * 128 + R]; t = t < (unsigned)NTOK ? t : 0u;
        return (t * (unsigned)K + (unsigned)C) * 2u;
    }
};


struct EpiIn {
    bf16 *QA, *KV6, *QF, *KF, *VF, *QM, *GATES, *KMEM, *VMEM; float* LG;
    const float *ropeC, *ropeS, *b_merge;
    __device__ __forceinline__ void operator()(ACC_ARG, const pg8::Unit& u, int wr, int wc, int fr, int fq) const {
        const int pn = u.pn, rowb = u.pm * 256 + wr * 64 + fr;
        if (pn < 13) {
#pragma unroll
            for (int bj = 0; bj < 2; ++bj) {
                const int L0 = (4 * pn + 2 * bj + (wc >> 1)) * 64, a4 = 4 * (4 * (wc & 1) + fq);
                bf16* dst; int pitch, col0; bool rope = false; float sc = 1.f;
                if (L0 < 512) { dst = QA; pitch = 512; col0 = L0; rope = true; sc = C2_64; }
                else if (L0 < 1280) { const int kk = (L0 - 512) >> 7; dst = KV6 + (size_t)kk * NTOK * 128; pitch = 128; col0 = (L0 - 512) & 127; rope = !(kk & 1); }
                else if (L0 < 1792) { dst = QF; pitch = 512; col0 = L0 - 1280; sc = C2_64; }
                else if (L0 < 2304) { dst = KF; pitch = 512; col0 = L0 - 1792; }
                else if (L0 < 2816) { dst = VF; pitch = 512; col0 = L0 - 2304; }
                else { dst = QM; pitch = 512; col0 = L0 - 2816; sc = C2_128; }
                pg8::f32x4 cv[2][4], sv[2][4];
                if (rope) {
#pragma unroll
                    for (int ai = 0; ai < 2; ++ai)
#pragma unroll
                        for (int m = 0; m < 4; ++m) { const int t = (rowb + 128 * ai + 16 * m) & (SEQ - 1); cv[ai][m] = *(const pg8::f32x4*)(ropeC + t * 32 + a4); sv[ai][m] = *(const pg8::f32x4*)(ropeS + t * 32 + a4); }
                }
                __builtin_amdgcn_sched_barrier(0);
#pragma unroll
                for (int ai = 0; ai < 2; ++ai)
#pragma unroll
                    for (int m = 0; m < 4; ++m) {
                        const int r = rowb + 128 * ai + 16 * m;
                        pg8::f32x4 x1 = acc[ai][bj][m][0], x2 = acc[ai][bj][m][1];
                        if (rope) { const pg8::f32x4 c4 = cv[ai][m], s4 = sv[ai][m];
                            const pg8::f32x4 y1 = x1 * c4 - x2 * s4, y2 = x2 * c4 + x1 * s4; x1 = y1; x2 = y2; }
                        x1 = x1 * sc; x2 = x2 * sc;
                        bf16* p = dst + (size_t)r * pitch + col0 + a4;
                        *(u32x2*)p = (u32x2){cvtpk(x1[0], x1[1]), cvtpk(x1[2], x1[3])};
                        *(u32x2*)(p + 32) = (u32x2){cvtpk(x2[0], x2[1]), cvtpk(x2[2], x2[3])};
                    }
            }
        } else if (pn < 25) {
            pg8::f32x4 bv[2][2];
#pragma unroll
            for (int bj = 0; bj < 2; ++bj) { const int cg = 256 * (pn - 13) + 128 * bj + 32 * wc + 8 * fq; bv[bj][0] = *(const pg8::f32x4*)(b_merge + cg); bv[bj][1] = *(const pg8::f32x4*)(b_merge + cg + 4); }
            __builtin_amdgcn_sched_barrier(0);
#pragma unroll
            for (int bj = 0; bj < 2; ++bj) {
                const int cg = 256 * (pn - 13) + 128 * bj + 32 * wc + 8 * fq;
                const pg8::f32x4 b0 = bv[bj][0], b1 = bv[bj][1];
#pragma unroll
                for (int ai = 0; ai < 2; ++ai)
#pragma unroll
                    for (int m = 0; m < 4; ++m) {
                        const int r = rowb + 128 * ai + 16 * m;
                        const pg8::f32x4 v0 = acc[ai][bj][m][0] + b0, v1 = acc[ai][bj][m][1] + b1;
                        u32x2 w; unsigned p = 0u;
#pragma unroll
                        for (int k = 0; k < 4; ++k) p = __builtin_amdgcn_cvt_pk_u8_f32(fmaxf(255.f * fast_sigmoid(v0[k]), 1.f), k, p);
                        w.x = p; p = 0u;
#pragma unroll
                        for (int k = 0; k < 4; ++k) p = __builtin_amdgcn_cvt_pk_u8_f32(fmaxf(255.f * fast_sigmoid(v1[k]), 1.f), k, p);
                        w.y = p;
                        *(u32x2*)((unsigned char*)GATES + (size_t)r * 3072 + cg) = w;
                    }
            }
        } else if (pn == 25) {
            if (wc == 0) {
#pragma unroll
                for (int ai = 0; ai < 2; ++ai)
#pragma unroll
                    for (int m = 0; m < 4; ++m) {
                        const int r = rowb + 128 * ai + 16 * m;
                        float* p = LG + (size_t)r * 32 + 8 * fq;
                        *(pg8::f32x4*)p = acc[ai][0][m][0]; *(pg8::f32x4*)(p + 4) = acc[ai][0][m][1];
                    }
            }
        } else {
#pragma unroll
            for (int bj = 0; bj < 2; ++bj) {
                const int cgl = 256 * (pn - 26) + 128 * bj + 32 * wc + 8 * fq;
                bf16* dst = (cgl < 512) ? KMEM : VMEM; const int col = cgl & 511;
#pragma unroll
                for (int ai = 0; ai < 2; ++ai)
#pragma unroll
                    for (int m = 0; m < 4; ++m) {
                        const int r = rowb + 128 * ai + 16 * m - NTOK;
                        const pg8::f32x4 v0 = acc[ai][bj][m][0], v1 = acc[ai][bj][m][1];
                        u32x4 w; w.x = cvtpk(v0[0], v0[1]); w.y = cvtpk(v0[2], v0[3]); w.z = cvtpk(v1[0], v1[1]); w.w = cvtpk(v1[2], v1[3]);
                        *(u32x4*)(dst + (size_t)r * 512 + col) = w;
                    }
            }
        }
        ZERO_ACC();
    }
};

struct EpiBr {
    const bf16* GATES; bf16* MERGED;
    __device__ __forceinline__ void operator()(ACC_ARG, const pg8::Unit& u, int wr, int wc, int fr, int fq) const {
        const int br = u.pn >> 2, tn = u.pn & 3, tm = u.pm & 63, rowb = tm * 256 + wr * 64 + fr;
        const unsigned char* gp = (const unsigned char*)GATES + (size_t)rowb * 3072 + 1024 * br + 256 * tn + 32 * wc + 8 * fq;
        u32x2 GA[2][4][2], GB[2][4][2];
#pragma unroll
        for (int ai = 0; ai < 2; ++ai)
#pragma unroll
            for (int m = 0; m < 4; ++m)
#pragma unroll
                for (int bj = 0; bj < 2; ++bj) { const unsigned char* p = gp + (size_t)(128 * ai + 16 * m) * 3072 + 128 * bj;
                    GA[ai][m][bj] = *(const u32x2*)p; GB[ai][m][bj] = (br < 2) ? *(const u32x2*)(p + 1024) : (u32x2){0u, 0u}; }
        __builtin_amdgcn_sched_barrier(0);
#pragma unroll
        for (int ai = 0; ai < 2; ++ai)
#pragma unroll
            for (int m = 0; m < 4; ++m) {
                const int r = rowb + 128 * ai + 16 * m;
#pragma unroll
                for (int bj = 0; bj < 2; ++bj) {
                    const int c0 = 256 * tn + 128 * bj + 32 * wc + 8 * fq;
                    const u32x2 ga = GA[ai][m][bj];
                    pg8::f32x4 g0 = {(float)(ga.x & 255u), (float)((ga.x >> 8) & 255u), (float)((ga.x >> 16) & 255u), (float)(ga.x >> 24)}, g1 = {(float)(ga.y & 255u), (float)((ga.y >> 8) & 255u), (float)((ga.y >> 16) & 255u), (float)(ga.y >> 24)};
#if defined(ABL_BR)
                    if (!((ABL_BR >> br) & 1)) { acc[ai][bj][m][0] = acc[ai][bj][m][0] * 0.f; acc[ai][bj][m][1] = acc[ai][bj][m][1] * 0.f; }
#endif
                    if (br < 2) {
                        const u32x2 gb = GB[ai][m][bj];
                        const pg8::f32x4 h0 = {(float)(gb.x & 255u), (float)((gb.x >> 8) & 255u), (float)((gb.x >> 16) & 255u), (float)(gb.x >> 24)}, h1 = {(float)(gb.y & 255u), (float)((gb.y >> 8) & 255u), (float)((gb.y >> 16) & 255u), (float)(gb.y >> 24)};
#pragma unroll
                        for (int k = 0; k < 4; ++k) { g0[k] = g0[k] * __builtin_amdgcn_rcpf(fmaxf(h0[k], 1.f)); g1[k] = g1[k] * __builtin_amdgcn_rcpf(fmaxf(h1[k], 1.f)); }
                        acc[ai][bj][m][0] = acc[ai][bj][m][0] * g0; acc[ai][bj][m][1] = acc[ai][bj][m][1] * g1;
                    } else {
                        const pg8::f32x4 v0 = acc[ai][bj][m][0] * g0 * (1.f / 255.f), v1 = acc[ai][bj][m][1] * g1 * (1.f / 255.f);
                        u32x4 w; w.x = cvtpk(v0[0], v0[1]); w.y = cvtpk(v0[2], v0[3]); w.z = cvtpk(v1[0], v1[1]); w.w = cvtpk(v1[2], v1[3]);
                        *(u32x4*)(MERGED + (size_t)r * 1024 + c0) = w;
                        acc[ai][bj][m][0] = (pg8::f32x4){0.f, 0.f, 0.f, 0.f}; acc[ai][bj][m][1] = (pg8::f32x4){0.f, 0.f, 0.f, 0.f};
                    }
                }
            }
    }
};

struct EpiOut {
    const float* X; float* X1; unsigned char* XB8;
    __device__ __forceinline__ void operator()(ACC_ARG, const pg8::Unit& u, int wr, int wc, int fr, int fq) const {
        const int rowb = u.pm * 256 + wr * 64 + fr;
        const size_t ob = (size_t)rowb * 1024 + 256 * u.pn + 32 * wc + 8 * fq;
#pragma unroll
        for (int ai = 0; ai < 2; ++ai) {
            pg8::f32x4 xs[4][2][2];
#pragma unroll
            for (int m = 0; m < 4; ++m)
#pragma unroll
                for (int bj = 0; bj < 2; ++bj) { const float* p = X + ob + (size_t)(128 * ai + 16 * m) * 1024 + 128 * bj; xs[m][bj][0] = *(const pg8::f32x4*)p; xs[m][bj][1] = *(const pg8::f32x4*)(p + 4); }
            __builtin_amdgcn_sched_barrier(0);
#pragma unroll
            for (int m = 0; m < 4; ++m)
#pragma unroll
                for (int bj = 0; bj < 2; ++bj) {
                    const size_t o = ob + (size_t)(128 * ai + 16 * m) * 1024 + 128 * bj;
                    const pg8::f32x4 y0 = xs[m][bj][0] + acc[ai][bj][m][0], y1 = xs[m][bj][1] + acc[ai][bj][m][1];
                    *(pg8::f32x4*)(X1 + o) = y0; *(pg8::f32x4*)(X1 + o + 4) = y1;
                    *(u32x2*)(XB8 + o) = (u32x2){pk_fp8x4(y0[0], y0[1], y0[2], y0[3]), pk_fp8x4(y1[0], y1[1], y1[2], y1[3])};
                }
            __builtin_amdgcn_sched_barrier(0);
        }
        ZERO_ACC();
    }
};

__device__ __forceinline__ float swiglu(float g, float uu) {
    g = fminf(g, 7.0f); uu = fminf(fmaxf(uu, -7.0f), 7.0f);
    return (uu + 1.0f) * g * __builtin_amdgcn_rcpf(1.0f + __builtin_amdgcn_exp2f(-1.702f * LOG2E * g));
}
struct EpiGU {
    const float* bias; const LAS int* tile_e; unsigned char* ACT8; const float* erstd;
    __device__ __forceinline__ void operator()(ACC_ARG, const pg8::Unit& u, int wr, int wc, int fr, int fq) const {
        const int te_ = __builtin_amdgcn_readfirstlane(tile_e[u.pm]), e = te_ & 31, rowb = u.pm * 256 + wr * 64 + fr;
        const float* rslot = erstd + (size_t)e * NTOK + (te_ >> 5) * 256 - u.pm * 256;
        float rsv[2][4]; pg8::f32x4 bv[2][2];
#pragma unroll
        for (int ai = 0; ai < 2; ++ai)
#pragma unroll
            for (int m = 0; m < 4; ++m) rsv[ai][m] = rslot[rowb + 128 * ai + 16 * m];
#pragma unroll
        for (int bj = 0; bj < 2; ++bj) { const int c0 = 256 * u.pn + 128 * bj + 32 * wc + 8 * fq; bv[bj][0] = *(const pg8::f32x4*)(bias + (size_t)e * 2048 + c0); bv[bj][1] = *(const pg8::f32x4*)(bias + (size_t)e * 2048 + c0 + 4); }
        __builtin_amdgcn_sched_barrier(0);
#pragma unroll
        for (int bj = 0; bj < 2; ++bj) {
            const int c0 = 256 * u.pn + 128 * bj + 32 * wc + 8 * fq;
            const pg8::f32x4 b0 = bv[bj][0], b1 = bv[bj][1];
#pragma unroll
            for (int ai = 0; ai < 2; ++ai)
#pragma unroll
                for (int m = 0; m < 4; ++m) {
                    const int r = rowb + 128 * ai + 16 * m; const float rs = rsv[ai][m] * (1.0f / W8_SCALE);
                    const pg8::f32x4 v0 = acc[ai][bj][m][0] * rs + b0, v1 = acc[ai][bj][m][1] * rs + b1;
                    *(unsigned*)(ACT8 + (size_t)r * 1024 + (c0 >> 1)) = pk_fp8x4(ACT8_SCALE * swiglu(v0[0], v0[1]), ACT8_SCALE * swiglu(v0[2], v0[3]), ACT8_SCALE * swiglu(v1[0], v1[1]), ACT8_SCALE * swiglu(v1[2], v1[3]));
                }
        }
        ZERO_ACC();
    }
};
struct EpiDn {
    const float* bias; const LAS int* tile_e; bf16* OS;
    __device__ __forceinline__ void operator()(ACC_ARG, const pg8::Unit& u, int wr, int wc, int fr, int fq) const {
        const int e = __builtin_amdgcn_readfirstlane(tile_e[u.pm]) & 31, rowb = u.pm * 256 + wr * 64 + fr;
        pg8::f32x4 bv[2][2];
#pragma unroll
        for (int bj = 0; bj < 2; ++bj) { const int c0 = 256 * u.pn + 128 * bj + 32 * wc + 8 * fq; bv[bj][0] = *(const pg8::f32x4*)(bias + (size_t)e * 1024 + c0); bv[bj][1] = *(const pg8::f32x4*)(bias + (size_t)e * 1024 + c0 + 4); }
        __builtin_amdgcn_sched_barrier(0);
#pragma unroll
        for (int bj = 0; bj < 2; ++bj) {
            const int c0 = 256 * u.pn + 128 * bj + 32 * wc + 8 * fq;
            const pg8::f32x4 b0 = bv[bj][0], b1 = bv[bj][1];
#pragma unroll
            for (int ai = 0; ai < 2; ++ai)
#pragma unroll
                for (int m = 0; m < 4; ++m) {
                    const int r = rowb + 128 * ai + 16 * m;
                    const pg8::f32x4 v0 = acc[ai][bj][m][0] * (1.0f / (W8_SCALE * ACT8_SCALE)) + b0, v1 = acc[ai][bj][m][1] * (1.0f / (W8_SCALE * ACT8_SCALE)) + b1;
                    u32x4 w; w.x = cvtpk(v0[0], v0[1]); w.y = cvtpk(v0[2], v0[3]); w.z = cvtpk(v1[0], v1[1]); w.w = cvtpk(v1[2], v1[3]);
                    *(u32x4*)(OS + (size_t)r * 1024 + c0) = w;
                }
        }
        ZERO_ACC();
    }
};
struct KArgs { const float* in[26]; float* out; unsigned char* ws; int ph_lo, ph_hi; };
struct Frame {
    LAS unsigned char* lds;
    int tid, lane, wave, G, bid, vcu;
    const KArgs __attribute__((address_space(4)))* ka; float* out; unsigned char* ws;
};
#define WSP(T, off) ((T*)(F.ws + (off)))

__device__ __forceinline__ int win_srccol(int n) {
    if (n < 3328) { const int p = n & 63, d = 4 * (p >> 3) + (p & 3) + 32 * ((p >> 2) & 1), L = (n & ~63) + d;
        if (L < 1280) return L; if (L < 1792) return 1304 + (L - 1280); if (L < 2304) return 1816 + (L - 1792); if (L < 2816) return 2328 + (L - 2304); return 2848 + (L - 2816); }
    if (n < 6400) return 3360 + (n - 3328);
    if (n < 6424) return 1280 + (n - 6400);
    if (n < 6432) return 2840 + (n - 6424);
    return -1;
}
__device__ __forceinline__ void transpose_item(const float* __restrict__ W, int N, bf16* __restrict__ Wt, int Kd, int n0, int k0, int sc, LAS float* scr, int lane, const float* __restrict__ kscale = nullptr) {
    const float* src = W + (size_t)k0 * N + (sc >= 0 ? sc : 0);
    float v[64];
#pragma unroll
    for (int kk = 0; kk < 64; ++kk) v[kk] = src[(size_t)kk * N];
    if (kscale) {
#pragma unroll
        for (int kk = 0; kk < 64; ++kk) v[kk] *= kscale[k0 + kk];
    }
#pragma unroll
    for (int kk = 0; kk < 64; ++kk) scr[kk * 65 + lane] = (sc >= 0) ? v[kk] : 0.f;
    asm volatile("s_waitcnt lgkmcnt(0)" ::: "memory");
    const int c = lane & 7;
#pragma unroll
    for (int j = 0; j < 8; ++j) { const int n = (lane >> 3) + 8 * j; const LAS float* s = scr + (8 * c) * 65 + n;
        u32x4 o; o.x = cvtpk(s[0], s[65]); o.y = cvtpk(s[2 * 65], s[3 * 65]); o.z = cvtpk(s[4 * 65], s[5 * 65]); o.w = cvtpk(s[6 * 65], s[7 * 65]);
        *(u32x4*)(Wt + (size_t)(n0 + n) * Kd + k0 + 8 * c) = o; }
    asm volatile("s_waitcnt lgkmcnt(0)" ::: "memory");
}
__device__ __forceinline__ void transpose_item8(const float* __restrict__ W, int N, unsigned char* __restrict__ Wt8, int Kd, int n0, int k0, LAS unsigned char* scr, int lane, const float* __restrict__ kscale, float mul) {
    const float* src = W + (size_t)k0 * N + n0 + lane;
#pragma unroll
    for (int half = 0; half < 2; ++half) {
        float v[64];
#pragma unroll
        for (int kk = 0; kk < 64; ++kk) v[kk] = src[(size_t)(64 * half + kk) * N];
#pragma unroll
        for (int kk = 0; kk < 64; ++kk) v[kk] *= kscale ? mul * kscale[k0 + 64 * half + kk] : mul;
#pragma unroll
        for (int j = 0; j < 32; ++j) { const float a = fminf(fmaxf(v[2 * j], -448.f), 448.f), b = fminf(fmaxf(v[2 * j + 1], -448.f), 448.f);
            *(LAS unsigned short*)(scr + lane * 132 + 64 * half + 2 * j) = (unsigned short)__builtin_amdgcn_cvt_pk_fp8_f32(a, b, 0, false); }
    }
    asm volatile("s_waitcnt lgkmcnt(0)" ::: "memory");
    const int c = lane & 7;
#pragma unroll
    for (int j = 0; j < 8; ++j) { const int n = (lane >> 3) + 8 * j; const LAS unsigned* s = (const LAS unsigned*)(scr + n * 132 + 16 * c);
        u32x4 o; o.x = s[0]; o.y = s[1]; o.z = s[2]; o.w = s[3];
        *(u32x4*)(Wt8 + (size_t)(n0 + n) * Kd + k0 + 16 * c) = o; }
    asm volatile("s_waitcnt lgkmcnt(0)" ::: "memory");
}
__device__ __forceinline__ void rms_row_bf16(const float* __restrict__ xrow, const float* __restrict__ g, bf16* __restrict__ orow, int lane) {
    const f32x4* xr = (const f32x4*)xrow + lane; const f32x4* gr = (const f32x4*)g + lane;
    f32x4 v[4]; float s = 0.f;
#pragma unroll
    for (int j = 0; j < 4; ++j) { v[j] = xr[64 * j]; s += (v[j].x * v[j].x + v[j].y * v[j].y) + (v[j].z * v[j].z + v[j].w * v[j].w); }
    const float rstd = 1.0f / sqrtf(wave_sum(s) * (1.f / 1024.f) + RMS_EPS);
    u32x2* o8 = (u32x2*)orow + lane;
#pragma unroll
    for (int j = 0; j < 4; ++j) { const f32x4 gg = gr[64 * j]; o8[64 * j] = (u32x2){cvtpk(v[j].x * rstd * gg.x, v[j].y * rstd * gg.y), cvtpk(v[j].z * rstd * gg.z, v[j].w * rstd * gg.w)}; }
}
__device__ __forceinline__ void sincos_big(float ang, float& s, float& c) {
    const double x = (double)ang; const double kf = __builtin_rint(x * 0.63661977236758134308); const int k = (int)kf;
    const double r = (x - kf * 1.57079632679489655800) - kf * 6.123233995736766036e-17, r2 = r * r;
    const double sp = r * (1.0 + r2 * (-1.0 / 6 + r2 * (1.0 / 120 + r2 * (-1.0 / 5040 + r2 * (1.0 / 362880 - r2 * (1.0 / 39916800))))));
    const double cp = 1.0 + r2 * (-0.5 + r2 * (1.0 / 24 + r2 * (-1.0 / 720 + r2 * (1.0 / 40320 + r2 * (-1.0 / 3628800 + r2 * (1.0 / 479001600))))));
    const double ss = (k & 1) ? cp : sp, cc = (k & 1) ? sp : cp;
    s = (float)((k & 2) ? -ss : ss); c = (float)(((k + 1) & 2) ? -cc : cc);
}
__device__ __forceinline__ void attn_unit_desc(int i, unsigned& desc, int& cost) {
    if (i < 512) { const int bg = i >> 6, T = i & 63; desc = 0u | (bg << 3) | (T << 11); cost = 8 + (T + 1) + (T < 8 ? T + 1 : 9) + 2 * (T / 4 + 1); }
    else { const int j = i - 512, bh = j >> 4, qb = j & 15; desc = 1u | (bh << 3) | (qb << 11); cost = 3 + 4 * qb + 3; }
}
constexpr int N_SORTED = 1024, MAXCOST = 128, N_CVT_UNITS = 256, CVT_CHUNK = 12;
constexpr int Q_CMP0 = 0, Q_CUM0 = 128, Q_CVT0 = 132, Q_MEM0 = Q_CVT0 + N_CVT_UNITS, Q_SRT0 = Q_MEM0 + 256, N_QUEUE = Q_SRT0 + N_SORTED;
constexpr int CW_PREDONE = 448;
constexpr int CW_CMPDONE = 8192, CW_CUMDONE = 8192 + 64 * 8;

__device__ __forceinline__ void p0_prologue(Frame& F) {
    LAS float* scr = (LAS float*)(F.lds + F.wave * 16640);
    const int gw = F.vcu * NWAVES + F.wave, NGW = F.G * NWAVES, lane = F.lane;
    bf16* HA = WSP(bf16, WS_HA);
    for (int m0 = gw; m0 < NTOK + NMEMROW; m0 += 4 * NGW) {
        f32x4 v[4][4]; float ss[4]; const float* xr[4]; bool has[4];
#pragma unroll
        for (int q = 0; q < 4; ++q) { const int m = m0 + q * NGW; has[q] = m < NTOK + NMEMROW; const int mm = has[q] ? m : m0;
            xr[q] = (mm < NTOK) ? F.ka->in[0] + (size_t)mm * DM : F.ka->in[1] + (size_t)(mm - NTOK) * DM; }
#pragma unroll
        for (int j = 0; j < 4; ++j)
#pragma unroll
            for (int q = 0; q < 4; ++q) v[q][j] = ((const f32x4*)xr[q])[64 * j + lane];
#pragma unroll
        for (int q = 0; q < 4; ++q) { float s_ = 0.f;
#pragma unroll
            for (int j = 0; j < 4; ++j) s_ += (v[q][j].x * v[q][j].x + v[q][j].y * v[q][j].y) + (v[q][j].z * v[q][j].z + v[q][j].w * v[q][j].w);
            ss[q] = s_; }
#pragma unroll
        for (int o = 1; o < 64; o <<= 1) {
#pragma unroll
            for (int q = 0; q < 4; ++q) ss[q] += __shfl_xor(ss[q], o); }
#pragma unroll
        for (int q = 0; q < 4; ++q) { const int m = m0 + q * NGW; const float r = 1.0f / sqrtf(ss[q] * (1.f / 1024.f) + RMS_EPS);
            const f32x4* g = (const f32x4*)((m < NTOK) ? F.ka->in[2] : F.ka->in[12]);
            if (has[q]) {
#pragma unroll
                for (int j = 0; j < 4; ++j) { const f32x4 a = g[64 * j + lane];
                    ((u32x2*)(HA + (size_t)m * DM))[64 * j + lane] = (u32x2){cvtpk(v[q][j].x * r * a.x, v[q][j].y * r * a.y), cvtpk(v[q][j].z * r * a.z, v[q][j].w * r * a.w)}; } } }
    }
    constexpr int I_WIN = 104 * 16, I_MKV = 16 * 16, I_BR = 16 * 8, I_OUT = 256, I_W1 = 32, I_W2 = 1;
    constexpr int NITEMS = I_WIN + I_MKV + 3 * I_BR + I_OUT + 2 * I_W1 + 2 * I_W2;
    for (int it = gw; it < NITEMS; it += NGW) {
        int r = it;
        if (r < I_WIN) { const int kt = r / 104, nt = r - kt * 104; transpose_item(F.ka->in[3], DIN, WSP(bf16, WS_WIN_T), 1024, nt * 64, kt * 64, win_srccol(nt * 64 + lane), scr, lane); continue; } r -= I_WIN;
        if (r < I_MKV) { const int kt = r >> 4, nt = r & 15; transpose_item(F.ka->in[13], 1024, WSP(bf16, WS_WIN_T) + (size_t)NIN * 1024, 1024, nt * 64, kt * 64, nt * 64 + lane, scr, lane); continue; } r -= I_MKV;
        if (r < 3 * I_BR) { const int b = r / I_BR, q = r - b * I_BR, kt = q >> 4, nt = q & 15; transpose_item(b == 0 ? F.ka->in[14] : (b == 1 ? F.ka->in[15] : F.ka->in[16]), 1024, WSP(bf16, WS_WBR_T) + (size_t)b * 1024 * 512, 512, nt * 64, kt * 64, nt * 64 + lane, scr, lane); continue; } r -= 3 * I_BR;
        if (r < I_OUT) { const int kt = r >> 4, nt = r & 15; transpose_item(F.ka->in[17], 1024, WSP(bf16, WS_WOUT_T), 1024, nt * 64, kt * 64, nt * 64 + lane, scr, lane); continue; } r -= I_OUT;
        if (r < 2 * I_W1) { const int b = r / I_W1, kt = r - b * I_W1; transpose_item(b ? F.ka->in[10] : F.ka->in[7], 64, b ? WSP(bf16, WS_W1T_V) : WSP(bf16, WS_W1T_K), 2048, 0, kt * 64, lane, scr, lane); continue; } r -= 2 * I_W1;
        { transpose_item(r ? F.ka->in[11] : F.ka->in[8], 64, r ? WSP(bf16, WS_W2T_V) : WSP(bf16, WS_W2T_K), 64, 0, 0, lane, scr, lane); }
    }
    { float* rc = WSP(float, WS_ROPE_C); float* rs = WSP(float, WS_ROPE_S);
      for (int idx = F.bid * NTHREADS + F.tid; idx < SEQ * 32; idx += F.G * NTHREADS) { const int t = idx >> 5, i = idx & 31;
          const float inv = exp2f(-(float)i * (13.287712379549449f / 32.0f)); const float ang = (float)t * inv; float s, c; sincos_big(ang, s, c); rc[idx] = c; rs[idx] = s; } }
    { bf16* wrh = WSP(bf16, WS_WRT); const float* wr = F.ka->in[19]; const float* gf = F.ka->in[18];
      for (int idx = F.bid * NTHREADS + F.tid; idx < 32 * 1024; idx += F.G * NTHREADS) { const int e = idx >> 10, k = idx & 1023; const float v = wr[k * 32 + e] * gf[k];
          const unsigned h = cvtpk(v, 0.f) & 0xffffu; const float lo = v - bflo(h); wrh[idx] = (bf16)h; wrh[32 * 1024 + idx] = (bf16)(cvtpk(lo, 0.f) & 0xffffu); } }
    if (gw >= NGW - 128) { const int j = gw - (NGW - 128), kv = j >> 6, part = j & 63; const float* pe = kv ? F.ka->in[9] : F.ka->in[6]; const float* w1 = kv ? F.ka->in[10] : F.ka->in[7]; float a = 0.f;
#pragma unroll 16
        for (int k = part * 32; k < part * 32 + 32; ++k) a += pe[k] * w1[k * 64 + lane];
        WSP(float, WS_CPE)[(kv * 64 + part) * 64 + lane] = a; }
    if (F.bid == 0) {
        __syncthreads();
        LAS int* hist = (LAS int*)F.lds;
        LAS unsigned* sorted = (LAS unsigned*)(hist + 3 * MAXCOST);
        for (int i = F.tid; i < 3 * MAXCOST; i += NTHREADS) hist[i] = 0;
        __syncthreads();
        for (int i = F.tid; i < N_SORTED; i += NTHREADS) { unsigned d; int c; attn_unit_desc(i, d, c); atomicAdd((int*)(hist + c), 1); }
        __syncthreads();
        if (F.tid < MAXCOST) { int run = 0; for (int c = F.tid + 1; c < MAXCOST; ++c) run += hist[c]; hist[MAXCOST + F.tid] = run; }
        __syncthreads();
        for (int i = F.tid; i < N_SORTED; i += NTHREADS) { unsigned d; int c; attn_unit_desc(i, d, c); const int pos = hist[MAXCOST + c] + atomicAdd((int*)(hist + 2 * MAXCOST + c), 1); sorted[pos] = d; }
        __syncthreads();
        unsigned* order = WSP(unsigned, WS_ORDER);
        for (int i = F.tid; i < N_QUEUE; i += NTHREADS) {
            unsigned d;
            if (i < Q_CUM0) d = 3u | ((unsigned)(i >> 6) << 3) | ((unsigned)(i & 63) << 11);
            else if (i < Q_CVT0) d = 4u | ((unsigned)(i - Q_CUM0) << 3);
            else if (i < Q_MEM0) d = 5u | ((unsigned)(i - Q_CVT0) << 11);
            else if (i < Q_SRT0) { const int j = i - Q_MEM0; d = 2u | ((unsigned)(j >> 4) << 3) | ((unsigned)(j & 15) << 11); }
            else d = sorted[i - Q_SRT0];
            order[i] = d;
        }
        __syncthreads();
    }
}

struct CvtItem { const float* src; unsigned char* dst; const float* ks; int N; };
__device__ __forceinline__ CvtItem cvt_item(Frame& F, int g, int wv, int lane) {
    const int e = g / 96, q = g - e * 96; CvtItem I;
    if (q < 64) { const int kt = q >> 3, ng = (q + kt + e) & 7, k0 = kt * 128 + 16 * wv, n0 = ng * 256 + 4 * lane;
        I.src = F.ka->in[21] + (size_t)e * 1024 * 2048 + (size_t)k0 * 2048 + n0; I.N = 2048; I.dst = WSP(unsigned char, WS_WGU_T) + (size_t)e * 2048 * 1024 + (size_t)n0 * 1024 + k0; I.ks = F.ka->in[18] + k0; }
    else { const int q2 = q - 64, kt = q2 >> 2, ng = (q2 + kt + e) & 3, k0 = kt * 128 + 16 * wv, n0 = ng * 256 + 4 * lane;
        I.src = F.ka->in[23] + (size_t)e * 1024 * 1024 + (size_t)k0 * 1024 + n0; I.N = 1024; I.dst = WSP(unsigned char, WS_WD_T) + (size_t)e * 1024 * 1024 + (size_t)n0 * 1024 + k0; I.ks = nullptr; }
    return I;
}
__device__ __forceinline__ void cvt_load(f32x4 (&v)[16], const CvtItem& I) {
#pragma unroll
    for (int kk = 0; kk < 16; ++kk) v[kk] = *(const f32x4*)(I.src + (size_t)kk * I.N);
}
__device__ __forceinline__ void cvt_store(const f32x4 (&v)[16], const CvtItem& I) {
    float sc[16];
#pragma unroll
    for (int kk = 0; kk < 16; ++kk) sc[kk] = I.ks ? W8_SCALE * I.ks[kk] : W8_SCALE;
#pragma unroll
    for (int j = 0; j < 4; ++j) { u32x4 o;
#pragma unroll
        for (int q = 0; q < 4; ++q) o[q] = pk_fp8x4(v[4 * q][j] * sc[4 * q], v[4 * q + 1][j] * sc[4 * q + 1], v[4 * q + 2][j] * sc[4 * q + 2], v[4 * q + 3][j] * sc[4 * q + 3]);
        *(u32x4*)(I.dst + (size_t)j * 1024) = o; }
}
__device__ __forceinline__ void convert_unit(Frame& F, int cu) {
    int tid_ = threadIdx.x; asm volatile("" : "+v"(tid_)); const int lane = tid_ & 63, wv = __builtin_amdgcn_readfirstlane(tid_ >> 6);
    f32x4 a[16], b[16];
    CvtItem Ia = cvt_item(F, cu * CVT_CHUNK, wv, lane), Ib; cvt_load(a, Ia);
#pragma clang loop unroll(disable)
    for (int bi = 0; bi < CVT_CHUNK; bi += 2) {
        Ib = cvt_item(F, cu * CVT_CHUNK + bi + 1, wv, lane); cvt_load(b, Ib);
        cvt_store(a, Ia);
        if (bi + 2 < CVT_CHUNK) { Ia = cvt_item(F, cu * CVT_CHUNK + bi + 2, wv, lane); cvt_load(a, Ia); }
        cvt_store(b, Ib);
    }
}
__device__ __forceinline__ void q_signal(unsigned* p, int tid) {
    asm volatile("s_waitcnt vmcnt(0)" ::: "memory"); __syncthreads();
    if (tid == 0) { __builtin_amdgcn_fence(__ATOMIC_RELEASE, "agent"); asm volatile("s_waitcnt vmcnt(0)" ::: "memory"); __hip_atomic_fetch_add(p, 1u, __ATOMIC_RELAXED, __HIP_MEMORY_SCOPE_AGENT); }
}
__device__ __forceinline__ void q_wait(unsigned* p, unsigned want, int tid) {
    if (tid == 0) { unsigned sp = 0; while (__hip_atomic_load(p, __ATOMIC_RELAXED, __HIP_MEMORY_SCOPE_AGENT) < want && ++sp < (1u << 24)) __builtin_amdgcn_s_sleep(2);
        __builtin_amdgcn_fence(__ATOMIC_ACQUIRE, "agent"); asm volatile("s_waitcnt vmcnt(0)" ::: "memory"); }
    __syncthreads();
}

__device__ __forceinline__ void p2_compress_unit(Frame& F, int kv, int rt) {
    int tid_ = threadIdx.x; asm volatile("" : "+v"(tid_)); const int lane = tid_ & 63, w = __builtin_amdgcn_readfirstlane(tid_ >> 6), r32 = lane & 31, hi = lane >> 5;
    const bf16* src = WSP(bf16, WS_KV6) + (size_t)kv * NTOK * 128;
    const bf16* w1t = WSP(bf16, kv ? WS_W1T_V : WS_W1T_K); const bf16* w2t = WSP(bf16, kv ? WS_W2T_V : WS_W2T_K);
    const int R = rt * 32 + r32, bg = R >> 8, n = R & 255, b = bg >> 1, g = bg & 1;
    f32x16 acc0 = {}, acc1 = {};
#pragma unroll 4
    for (int st = 0; st < 16; ++st) {
        const int step = w * 16 + st, l = step >> 2, d = 16 * (step & 3) + 8 * hi;
        int tok = 16 * n + l; tok = tok < SEQ ? tok : SEQ - 1;
        const bf16x8 a = *(const bf16x8*)(src + ((size_t)(b * SEQ + tok)) * 128 + g * 64 + d);
        const bf16x8 b0 = *(const bf16x8*)(w1t + (size_t)r32 * 2048 + 16 * step + 8 * hi);
        const bf16x8 b1 = *(const bf16x8*)(w1t + (size_t)(32 + r32) * 2048 + 16 * step + 8 * hi);
        acc0 = __builtin_amdgcn_mfma_f32_32x32x16_bf16(a, b0, acc0, 0, 0, 0);
        acc1 = __builtin_amdgcn_mfma_f32_32x32x16_bf16(a, b1, acc1, 0, 0, 0);
    }
    LAS float* red = (LAS float*)F.lds;
    LAS bf16* zs = (LAS bf16*)(F.lds + 65536);
    __syncthreads();
#pragma unroll
    for (int r = 0; r < 16; ++r) { const int row = (r & 3) + 8 * (r >> 2) + 4 * hi; red[(w * 32 + row) * 64 + r32] = acc0[r]; red[(w * 32 + row) * 64 + 32 + r32] = acc1[r]; }
    __syncthreads();
    const float* cpe = WSP(float, WS_CPE) + kv * 4096;
    for (int idx = F.tid; idx < 2048; idx += NTHREADS) { float z = 0.f;
#pragma unroll
        for (int pp = 0; pp < 64; ++pp) z += cpe[pp * 64 + (idx & 63)];
#pragma unroll
        for (int ww = 0; ww < 8; ++ww) z += red[ww * 2048 + idx];
        const float sl = z * fast_sigmoid(z); zs[idx] = (bf16)(cvtpk(sl, 0.f) & 0xffffu); }
    __syncthreads();
    if (w < 2) {
        f32x16 o = {};
#pragma unroll
        for (int st = 0; st < 4; ++st) {
            const bf16x8 a = *(const LAS bf16x8*)(zs + r32 * 64 + 16 * st + 8 * hi);
            const bf16x8 bb = *(const bf16x8*)(w2t + (size_t)(32 * w + r32) * 64 + 16 * st + 8 * hi);
            o = __builtin_amdgcn_mfma_f32_32x32x16_bf16(a, bb, o, 0, 0, 0);
        }
        const int rbase = rt * 32;
#pragma unroll
        for (int r = 0; r < 16; ++r) { const int row = (r & 3) + 8 * (r >> 2) + 4 * hi, RR = rbase + row, nn = RR & 255;
            const float v = (nn == 255) ? 0.f : o[r];
            if (kv == 0) WSP(bf16, WS_KCMP)[(size_t)RR * 64 + 32 * w + r32] = (bf16)(cvtpk(v, 0.f) & 0xffffu);
            else WSP(bf16, WS_VCMP)[(size_t)RR * 128 + 32 * w + r32] = (bf16)(cvtpk(v, 0.f) & 0xffffu); }
    } else if (kv == 1) {
        for (int idx = F.tid - 128; idx < 2048; idx += NTHREADS - 128) { const int row = idx >> 6, j = idx & 63, RR = rt * 32 + row, nn = RR & 255;
            const bool ov = (nn != 255) && (nn >= 4 * j - 1) && (nn <= 4 * j + 3);
            WSP(bf16, WS_VCMP)[(size_t)RR * 128 + 64 + j] = ov ? (bf16)0x3f80 : (bf16)0; }
    }
    __syncthreads();
}
__device__ __forceinline__ float log_sigmoid_f(float x) { return fminf(x, 0.f) - log1pf(expf(-fabsf(x))); }
__device__ __forceinline__ void p2_cumsum_unit(Frame& F, int bh) {
    const int lane = F.lane, b = bh >> 3, h = bh & 7; const float bf = F.ka->in[4][h];
    const float* lg = WSP(float, WS_LG) + (size_t)(b * SEQ + 64 * lane) * 32 + 24 + h;
    double tot = 0.0;
    for (int i = 0; i < 64; ++i) tot += (double)log_sigmoid_f(lg[(size_t)i * 32] + bf);
    double inc = tot;
#pragma unroll
    for (int o = 1; o < 64; o <<= 1) { const double v = __shfl_up(inc, o); if (lane >= o) inc += v; }
    double run = inc - tot;
    float* cum = WSP(float, WS_CUM) + (size_t)bh * SEQ + 64 * lane;
    for (int i = 0; i < 64; ++i) { run += (double)log_sigmoid_f(lg[(size_t)i * 32] + bf); cum[i] = (float)(run * 1.4426950408889634); }
    const bf16* kf = WSP(bf16, WS_KF) + (size_t)b * SEQ * 512 + h * 64; float km = 0.f;
#pragma unroll 4
    for (int i = 0; i < 64; ++i) { const u32x4* p = (const u32x4*)(kf + (size_t)(64 * i + lane) * 512); float s = 0.f;
#pragma unroll
        for (int c = 0; c < 8; ++c) { const u32x4 v = p[c]; s += (bflo(v.x) * bflo(v.x) + bfhi(v.x) * bfhi(v.x)) + (bflo(v.y) * bflo(v.y) + bfhi(v.y) * bfhi(v.y)) + (bflo(v.z) * bflo(v.z) + bfhi(v.z) * bfhi(v.z)) + (bflo(v.w) * bflo(v.w) + bfhi(v.w) * bfhi(v.w)); }
        km = fmaxf(km, s); }
#pragma unroll
    for (int o = 1; o < 64; o <<= 1) km = fmaxf(km, __shfl_xor(km, o));
    if (lane == 0) WSP(float, WS_KMAX)[bh] = sqrtf(km) * 1.001f;
}

__device__ __forceinline__ void p6_phase(Frame& F) {
    const int lane = F.lane, w = F.wave, r32 = lane & 31, hi = lane >> 5, grp = w >> 2, kq = w & 3;
    LAS float* red = (LAS float*)F.lds;
    LAS float* ssl = (LAS float*)(F.lds + 32768);
    LAS int* lcnt = (LAS int*)(F.lds + 36864);
    const float* X1 = F.out; const float* brt = F.ka->in[20];
    const bf16* whT = WSP(bf16, WS_WRT); const bf16* wlT = whT + 32 * 1024;
    int* tope = WSP(int, WS_ROUTE); float* topg = (float*)(tope + NTOK * 4); int* lrank = tope + NTOK * 8; float* rstdg = WSP(float, WS_RSTD);
    for (int tile = F.bid; tile < NTOK / 64; tile += F.G) {
        if (F.tid < 32) lcnt[F.tid] = 0;
        const float* xrow = X1 + (size_t)(tile * 64 + grp * 32 + r32) * DM + 8 * hi + 256 * kq;
        const bf16* whp = whT + (size_t)r32 * 1024 + 8 * hi + 256 * kq; const bf16* wlp = wlT + (size_t)r32 * 1024 + 8 * hi + 256 * kq;
        f32x16 acc = f32x16{}; float ss = 0.f;
        f32x4 xa[16], xb[16];
#pragma unroll
        for (int s = 0; s < 16; ++s) { xa[s] = *(const f32x4*)(xrow + 16 * s); xb[s] = *(const f32x4*)(xrow + 16 * s + 4); }
#pragma unroll
        for (int sb = 0; sb < 2; ++sb) {
            bf16x8 wh[8], wl[8];
#pragma unroll
            for (int s = 0; s < 8; ++s) { const int o = 16 * (8 * sb + s); wh[s] = *(const bf16x8*)(whp + o); wl[s] = *(const bf16x8*)(wlp + o); }
#pragma unroll
            for (int s = 0; s < 8; ++s) {
                const f32x4 a = xa[8 * sb + s], b = xb[8 * sb + s];
                ss += (a.x * a.x + a.y * a.y) + (a.z * a.z + a.w * a.w) + (b.x * b.x + b.y * b.y) + (b.z * b.z + b.w * b.w);
                u32x4 h; h.x = cvtpk(a.x, a.y); h.y = cvtpk(a.z, a.w); h.z = cvtpk(b.x, b.y); h.w = cvtpk(b.z, b.w);
                u32x4 l; l.x = cvtpk(a.x - bflo(h.x), a.y - bfhi(h.x)); l.y = cvtpk(a.z - bflo(h.y), a.w - bfhi(h.y)); l.z = cvtpk(b.x - bflo(h.z), b.y - bfhi(h.z)); l.w = cvtpk(b.z - bflo(h.w), b.w - bfhi(h.w));
                const bf16x8 hv = __builtin_bit_cast(bf16x8, h), lv = __builtin_bit_cast(bf16x8, l);
                acc = __builtin_amdgcn_mfma_f32_32x32x16_bf16(hv, wh[s], acc, 0, 0, 0);
                acc = __builtin_amdgcn_mfma_f32_32x32x16_bf16(lv, wh[s], acc, 0, 0, 0);
                acc = __builtin_amdgcn_mfma_f32_32x32x16_bf16(hv, wl[s], acc, 0, 0, 0);
            }
        }
#pragma unroll
        for (int r = 0; r < 16; ++r) red[(w * 16 + r) * 64 + lane] = acc[r];
        ssl[w * 64 + lane] = ss;
        __syncthreads();
        LAS float* lgt = (LAS float*)(F.lds + 40960);
        LAS float* rsl = (LAS float*)(F.lds + 40960 + 64 * 33 * 4);
        LAS float* topv = rsl + 64;
        LAS int* tope_l = (LAS int*)(topv + 256);
        if (kq == 0) {
#pragma unroll
            for (int r = 0; r < 16; ++r) acc[r] = (red[(w * 16 + r) * 64 + lane] + red[((w + 1) * 16 + r) * 64 + lane]) + (red[((w + 2) * 16 + r) * 64 + lane] + red[((w + 3) * 16 + r) * 64 + lane]);
            ss = (ssl[w * 64 + lane] + ssl[(w + 1) * 64 + lane]) + (ssl[(w + 2) * 64 + lane] + ssl[(w + 3) * 64 + lane]);
            ss += __shfl_xor(ss, 32);
            const float rstd = 1.0f / sqrtf(ss * (1.f / 1024.f) + RMS_EPS);
            if (hi == 0) { rstdg[tile * 64 + grp * 32 + r32] = rstd; rsl[grp * 32 + r32] = rstd; }
#pragma unroll
            for (int r = 0; r < 16; ++r) { const int rowl = (r & 3) + 8 * (r >> 2) + 4 * hi; lgt[(grp * 32 + rowl) * 33 + r32] = acc[r]; }
        }
        __syncthreads();
#pragma unroll
        for (int it = 0; it < 4; ++it) {
            const int row = it * 16 + (F.tid >> 5), e = F.tid & 31;
            const float rs = rsl[row]; const float mine = lgt[row * 33 + e] * rs + brt[e];
            int rank = 0;
#pragma unroll
            for (int j = 0; j < 32; ++j) { const float v = lgt[row * 33 + j] * rs + brt[j]; rank += (v > mine || (v == mine && j < e)) ? 1 : 0; }
            if (rank < 4) { topv[row * 4 + rank] = mine; tope_l[row * 4 + rank] = e; }
        }
        __syncthreads();
        int ee4[4], lr4[4];
        if (F.tid < 64) { const int row = F.tid, t = tile * 64 + row;
            const float v0 = topv[row * 4], e1 = expf(topv[row * 4 + 1] - v0), e2 = expf(topv[row * 4 + 2] - v0), e3 = expf(topv[row * 4 + 3] - v0); const float inv = 1.0f / (1.0f + e1 + e2 + e3);
            const float gs[4] = {inv, e1 * inv, e2 * inv, e3 * inv};
#pragma unroll
            for (int k = 0; k < 4; ++k) { const int ee = tope_l[row * 4 + k]; tope[t * 4 + k] = ee; topg[t * 4 + k] = gs[k]; ee4[k] = ee; lr4[k] = atomicAdd((int*)(lcnt + ee), 1); } }
        __syncthreads();
        if (F.tid < 32) { const int c = lcnt[F.tid]; lcnt[32 + F.tid] = c ? (int)__hip_atomic_fetch_add(WSP(unsigned, WS_CTL) + CW_GCNT + 32 * F.tid, (unsigned)c, __ATOMIC_RELAXED, __HIP_MEMORY_SCOPE_AGENT) : 0; }
        __syncthreads();
        if (F.tid < 64) { const int row = F.tid, t = tile * 64 + row; const float rs_ = rsl[row];
#pragma unroll
            for (int k = 0; k < 4; ++k) { const int rk = lcnt[32 + ee4[k]] + lr4[k]; lrank[t * 4 + k] = rk; WSP(int, WS_ETOK)[ee4[k] * NTOK + rk] = t; WSP(float, WS_ERSTD)[ee4[k] * NTOK + rk] = rs_; } }
        __syncthreads();
    }
}

__device__ __forceinline__ void p7_phase(Frame& F) {
    LAS int* part = (LAS int*)F.lds;
    LAS int* tot = part + 1024; LAS int* pre = tot + 32; LAS int* pstart = pre + 32; LAS int* slotl = pstart + 32;
    const int* blkcnt = WSP(int, WS_BLKCNT);
    int* tope = WSP(int, WS_ROUTE); int* lrank = tope + NTOK * 8; int* slot = tope + NTOK * 12;
    const float* rstdg = WSP(float, WS_RSTD); float* rslot = WSP(float, WS_RSLOT); int* slottok = WSP(int, WS_SLOTTOK);
    for (int tile = F.bid; tile < NTOK / 64; tile += F.G) {
        __syncthreads();
        { const int e = F.tid & 31, p = F.tid >> 5; int st = 0, sp = 0;
          for (int tt = p; tt < NTOK / 64; tt += 16) { const int c = blkcnt[tt * 32 + e]; st += c; if (tt < tile) sp += c; }
          part[p * 32 + e] = st; part[512 + p * 32 + e] = sp; }
        __syncthreads();
        if (F.tid < 32) { int st = 0, sp = 0;
#pragma unroll
            for (int p = 0; p < 16; ++p) { st += part[p * 32 + F.tid]; sp += part[512 + p * 32 + F.tid]; }
            tot[F.tid] = st; pre[F.tid] = sp; }
        __syncthreads();
        if (F.tid == 0) { int run = 0; for (int e = 0; e < 32; ++e) { pstart[e] = run; run += (tot[e] + 255) & ~255; }
            if (tile == 0) { int* te = WSP(int, WS_TILE_E); int j = 0; for (int e = 0; e < 32; ++e) { const int nte = (tot[e] + 255) >> 8; for (int q = 0; q < nte; ++q) te[j++] = e; } te[500] = j; } }
        __syncthreads();
        if (F.tid < 256) { const int a = tile * 256 + F.tid; const int e = tope[a]; const int s = pstart[e] + pre[e] + lrank[a]; slot[a] = s; rslot[s] = rstdg[tile * 64 + (F.tid >> 2)]; slottok[s] = tile * 64 + (F.tid >> 2); }
    }
}

__device__ __forceinline__ void p10_phase(Frame& F, bool with_moe, float* dsto) {
    const int gw = F.vcu * NWAVES + F.wave, NGW = F.G * NWAVES, lane = F.lane;
    const int* tope = WSP(int, WS_ROUTE); const float* topg = (const float*)(tope + NTOK * 4); const int* rank = tope + NTOK * 8;
    const LAS int* pstart = (const LAS int*)(F.lds + MT_OFF) + 320;
    const bf16* OS = WSP(bf16, WS_AMOE); const float* gfin = F.ka->in[25];
    for (int t = gw; t < NTOK; t += NGW) {
        const f32x4* xr = (const f32x4*)((with_moe ? F.out : F.ka->in[0]) + (size_t)t * DM) + lane;
        f32x4 v[4];
#pragma unroll
        for (int j = 0; j < 4; ++j) v[j] = xr[64 * j];
        if (with_moe) {
#pragma unroll
            for (int k = 0; k < 4; ++k) { const float gk = topg[t * 4 + k]; const u32x2* orow = (const u32x2*)(OS + (size_t)(pstart[tope[t * 4 + k]] + rank[t * 4 + k]) * DM) + lane;
#pragma unroll
                for (int j = 0; j < 4; ++j) { const u32x2 o = orow[64 * j]; v[j].x += gk * bflo(o.x); v[j].y += gk * bfhi(o.x); v[j].z += gk * bflo(o.y); v[j].w += gk * bfhi(o.y); } }
        }
        float s = 0.f;
#pragma unroll
        for (int j = 0; j < 4; ++j) s += (v[j].x * v[j].x + v[j].y * v[j].y) + (v[j].z * v[j].z + v[j].w * v[j].w);
        const float rstd = 1.0f / sqrtf(wave_sum(s) * (1.f / 1024.f) + RMS_EPS);
        f32x4* orow = (f32x4*)(dsto + (size_t)t * DM) + lane;
#pragma unroll
        for (int j = 0; j < 4; ++j) orow[64 * j] = v[j] * rstd * ((const f32x4*)gfin)[64 * j + lane];
    }
}
constexpr int AL_RING = 0, AL_OACC = 49152, AL_BIAS = 114688, AL_WSF = AL_BIAS + 3 * 8 * 64 * 4, AL_IMP = AL_WSF + 8 * 64 * 4, AL_SELB = AL_IMP + 64 * 65 * 4, AL_UNI = AL_SELB + 512, AL_TICKET = AL_UNI + 16;
static_assert(AL_TICKET + 16 <= LDS_BYTES - 64 && AL_OACC + 65536 <= AL_BIAS, "attention LDS map");
__device__ __forceinline__ int crow(int r, int hi) { return (r & 3) + 8 * (r >> 2) + 4 * hi; }
__device__ __forceinline__ s16x4 vtr(const LAS char* p) { return __builtin_bit_cast(s16x4, __builtin_amdgcn_ds_read_tr16_b64_v4i16((LAS s16x4*)p)); }

__device__ __forceinline__ float max3f(float a, float b, float c) { float r; asm("v_max3_f32 %0, %1, %2, %3" : "=v"(r) : "v"(a), "v"(b), "v"(c)); return r; }
struct AttnCtx { LAS unsigned char* lds; int tid, lane, w, r32, hi; LAS float* wsf; };
__device__ __forceinline__ AttnCtx make_ctx(LAS unsigned char* lds) {
    int tid = threadIdx.x; asm volatile("" : "+v"(tid));
    AttnCtx C; C.lds = lds; C.tid = tid; C.lane = tid & 63; C.w = __builtin_amdgcn_readfirstlane(tid >> 6); C.r32 = tid & 31; C.hi = (tid >> 5) & 1; C.wsf = (LAS float*)(lds + AL_WSF) + C.w * 64;
    return C;
}

template <int NDB> __device__ __forceinline__ void scale_rows(const AttnCtx& C, f32x16 (&o)[NDB], float vq, int slot) {
    if (C.hi == 0) C.wsf[slot + C.r32] = vq;
#pragma unroll
    for (int rg = 0; rg < 4; ++rg) { const f32x4 a4 = *(const LAS f32x4*)(C.wsf + slot + 8 * rg + 4 * C.hi);
#pragma unroll
        for (int db = 0; db < NDB; ++db) { o[db][4 * rg + 0] *= a4.x; o[db][4 * rg + 1] *= a4.y; o[db][4 * rg + 2] *= a4.z; o[db][4 * rg + 3] *= a4.w; } }
}

__device__ __forceinline__ void dma16(const void* g, LAS unsigned char* lds_wave_base) { __builtin_amdgcn_global_load_lds((const unsigned*)g, (LAS unsigned*)lds_wave_base, 16, 0, 0); }
__device__ __forceinline__ void dma4(const void* g, LAS unsigned char* lds_wave_base) { __builtin_amdgcn_global_load_lds((const unsigned*)g, (LAS unsigned*)lds_wave_base, 4, 0, 0); }
template <int N> __device__ __forceinline__ void wait_vm() {
    if constexpr (N == 0) asm volatile("s_waitcnt vmcnt(0)" ::: "memory"); else if constexpr (N == 2) asm volatile("s_waitcnt vmcnt(2)" ::: "memory");
    else if constexpr (N == 3) asm volatile("s_waitcnt vmcnt(3)" ::: "memory"); else if constexpr (N == 4) asm volatile("s_waitcnt vmcnt(4)" ::: "memory"); else static_assert(N == 0, "wait_vm");
}
template <int DQK, int DV, bool BIAS, class Pol>
__device__ __forceinline__ void attn_core(const AttnCtx& C, const Pol& P, const bf16x8 (&qf)[DQK / 16], f32x16 (&o)[DV / 32]) {
    constexpr int NKP = DQK / 64, NVP = DV / 64, NDB = DV / 32, ND0 = DQK / 16, KROW = DQK * 2, KCH = DQK / 8, VCH = DV / 8, KBYTES = DQK * 128, SLOT = (DQK + DV) * 128, PT = NKP + NVP + (BIAS ? 1 : 0);
    int tid = C.tid; asm volatile("" : "+v"(tid));
    const int lane = tid & 63, r32 = lane & 31, hi = lane >> 5, w = C.w;
    int ksrc[NKP], vsrc[NVP];
#pragma unroll
    for (int j = 0; j < NKP; ++j) { const int id = tid + 512 * j, key = id / KCH, slot = id % KCH; const int c = slot ^ (DQK == 64 ? ((key >> 1) & 7) : (key & 15)); ksrc[j] = key * P.kpitch() + c * 8; }
#pragma unroll
    for (int j = 0; j < NVP; ++j) { const int id = tid + 512 * j, db = id >> 8, rem = id & 255, key = 8 * (rem >> 5) + ((rem & 31) >> 2), pc = 4 * db + (rem & 3); vsrc[j] = key * P.vpitch() + pc * 8; }
    int koff[ND0];
#pragma unroll
    for (int d0 = 0; d0 < ND0; ++d0) koff[d0] = r32 * KROW + (((2 * d0 + hi) ^ (DQK == 64 ? ((r32 >> 1) & 7) : (r32 & 15))) << 4);
    const int vbase = ((lane >> 4) & 1) * 32 + (lane & 3) * 8 + (4 * hi + ((lane & 15) >> 2)) * 64;
    LAS unsigned char* lds = C.lds;
    LAS float* biasw = (LAS float*)(lds + AL_BIAS) + w * 64;
#define ATT_DMA(t, s) do { const bf16* kp_ = P.kptr(t); const bf16* vp_ = P.vptr(t); LAS unsigned char* sb_ = lds + AL_RING + (s) * SLOT + w * 1024; \
        _Pragma("unroll") for (int j = 0; j < NKP; ++j) dma16(kp_ + ksrc[j], sb_ + j * 8192); \
        _Pragma("unroll") for (int j = 0; j < NVP; ++j) dma16(vp_ + vsrc[j], sb_ + KBYTES + j * 8192); \
        if (BIAS) dma4(P.biasptr(t) + lane, (LAS unsigned char*)(biasw + (s) * 512)); } while (0)
    float m_ref = 0.f, l_part = 0.f; bool seen = false;
#pragma unroll
    for (int db = 0; db < NDB; ++db) o[db] = f32x16{};
    int t = P.first(), t1 = P.next(t);
    asm volatile("s_waitcnt vmcnt(0) lgkmcnt(0)" ::: "memory"); __builtin_amdgcn_s_barrier();
    ATT_DMA(t, 0);
    if (t1 >= 0) ATT_DMA(t1, 1);
    int s0 = 0;
    while (t >= 0) {
        const int t2 = (t1 >= 0) ? P.next(t1) : -1;
        if (t1 >= 0) wait_vm<PT>(); else wait_vm<0>();
        asm volatile("s_waitcnt lgkmcnt(0)" ::: "memory"); __builtin_amdgcn_s_barrier(); asm volatile("" ::: "memory");
        const int s2 = (s0 >= 1) ? s0 - 1 : 2;
        if (t2 >= 0) ATT_DMA(t2, s2);
        if (!P.wave_skip(t)) {
            const LAS unsigned char* Kb = lds + AL_RING + s0 * SLOT; const LAS unsigned char* Vb = Kb + KBYTES;
            const float cbase = P.lane_valid(t) ? -m_ref : NEGBIG;
            f32x16 p0, p1;
            if (BIAS) {
                const float cb = cbase + P.bias_ref();
#pragma unroll
                for (int rg = 0; rg < 4; ++rg) { const f32x4 b0 = *(const LAS f32x4*)(biasw + s0 * 512 + 8 * rg + 4 * hi), b1 = *(const LAS f32x4*)(biasw + s0 * 512 + 32 + 8 * rg + 4 * hi);
                    p0[4 * rg] = cb - b0.x; p0[4 * rg + 1] = cb - b0.y; p0[4 * rg + 2] = cb - b0.z; p0[4 * rg + 3] = cb - b0.w;
                    p1[4 * rg] = cb - b1.x; p1[4 * rg + 1] = cb - b1.y; p1[4 * rg + 2] = cb - b1.z; p1[4 * rg + 3] = cb - b1.w; }
            } else {
#pragma unroll
                for (int r = 0; r < 16; ++r) { p0[r] = cbase; p1[r] = cbase; }
            }
#pragma unroll
            for (int d0 = 0; d0 < ND0; ++d0) {
                const bf16x8 k0 = *(const LAS bf16x8*)(Kb + koff[d0]); const bf16x8 k1 = *(const LAS bf16x8*)(Kb + koff[d0] + 32 * KROW);
                p0 = __builtin_amdgcn_mfma_f32_32x32x16_bf16(k0, qf[d0], p0, 0, 0, 0);
                p1 = __builtin_amdgcn_mfma_f32_32x32x16_bf16(k1, qf[d0], p1, 0, 0, 0);
            }
            asm volatile("s_nop 15\n\ts_nop 7" : "+v"(p0), "+v"(p1));
            if (P.masked(t)) {
#pragma unroll
                for (int r = 0; r < 16; ++r) { const int kvl = crow(r, hi);
                    if (!P.valid(t, kvl)) p0[r] = NEGBIG;
                    if (!P.valid(t, kvl + 32)) p1[r] = NEGBIG; }
            }
            float rm = max3f(p0[0], p1[0], p0[1]), rm2 = max3f(p1[1], p0[2], p1[2]);
#pragma unroll
            for (int r = 3; r < 15; r += 2) { rm = max3f(rm, p0[r], p1[r]); rm2 = max3f(rm2, p0[r + 1], p1[r + 1]); }
            rm = max3f(rm, p0[15], p1[15]);
            rm = max3f(rm, rm2, rm2);
            rm = max3f(rm, __shfl_xor(rm, 32), rm);
            const bool any_valid = rm > -1e29f;
            const bool trig = (rm > 8.0f) || (!seen && any_valid);
            if (__any(trig)) {
                const float dl = trig ? rm : 0.f; const float alpha = (trig && seen) ? __builtin_amdgcn_exp2f(-dl) : 1.0f;
                m_ref += dl; l_part *= alpha;
#pragma unroll
                for (int r = 0; r < 16; ++r) { p0[r] -= dl; p1[r] -= dl; }
                scale_rows<NDB>(C, o, alpha, 0);
            }
            seen = seen || any_valid;
            float ls = 0.f;
#pragma unroll
            for (int r = 0; r < 16; ++r) { const float e0 = __builtin_amdgcn_exp2f(p0[r]), e1 = __builtin_amdgcn_exp2f(p1[r]); p0[r] = e0; p1[r] = e1; ls += e0 + e1; }
            l_part += ls;
            u32x4 pw[4];
#pragma unroll
            for (int k = 0; k < 4; ++k) { pw[0][k] = cvtpk(p0[2 * k], p0[2 * k + 1]); pw[1][k] = cvtpk(p0[8 + 2 * k], p0[9 + 2 * k]); pw[2][k] = cvtpk(p1[2 * k], p1[2 * k + 1]); pw[3][k] = cvtpk(p1[8 + 2 * k], p1[9 + 2 * k]); }
#pragma unroll
            for (int db = 0; db < NDB; ++db) {
#pragma unroll
                for (int s = 0; s < 4; ++s) {
                    const s16x4 lo = vtr((const LAS char*)Vb + vbase + db * 4096 + s * 1024), hh = vtr((const LAS char*)Vb + vbase + db * 4096 + s * 1024 + 512);
                    const bf16x8 vf = {lo[0], lo[1], lo[2], lo[3], hh[0], hh[1], hh[2], hh[3]};
                    o[db] = __builtin_amdgcn_mfma_f32_32x32x16_bf16(__builtin_bit_cast(bf16x8, pw[s]), vf, o[db], 0, 0, 0);
                }
            }
        }
        s0 = (s0 == 2) ? 0 : s0 + 1; t = t1; t1 = t2;
    }
    const float l = l_part + __shfl_xor(l_part, 32);
    scale_rows<NDB>(C, o, l > 0.f ? 1.0f / l : 0.f, 32);
    asm volatile("s_waitcnt lgkmcnt(0)" ::: "memory"); __builtin_amdgcn_s_barrier(); asm volatile("" ::: "memory");
#undef ATT_DMA
}

struct FoxPol {
    const bf16 *K, *V; const float* cum; float ref; int qb, w, tq, tmin;
    __device__ __forceinline__ int first() const { return 4 * qb + 3; }
    __device__ __forceinline__ int next(int t) const { return t - 1 >= tmin ? t - 1 : -1; }
    __device__ __forceinline__ bool masked(int t) const { return t >= 4 * qb; }
    __device__ __forceinline__ bool valid(int t, int kvl) const { return 64 * t + kvl <= tq; }
    __device__ __forceinline__ bool wave_skip(int t) const { return 64 * (t - 4 * qb) > 32 * w + 31; }
    __device__ __forceinline__ bool lane_valid(int) const { return true; }
    __device__ __forceinline__ const bf16* kptr(int t) const { return K + (size_t)(64 * t) * 512; }
    __device__ __forceinline__ const bf16* vptr(int t) const { return V + (size_t)(64 * t) * 512; }
    __device__ __forceinline__ int kpitch() const { return 512; }
    __device__ __forceinline__ int vpitch() const { return 512; }
    __device__ __forceinline__ const float* biasptr(int t) const { return cum + 64 * t; }
    __device__ __forceinline__ float bias_ref() const { return ref; }
};
struct MemPol {
    const bf16 *K, *V;
    __device__ __forceinline__ int first() const { return 0; }
    __device__ __forceinline__ int next(int t) const { return t < 3 ? t + 1 : -1; }
    __device__ __forceinline__ bool masked(int) const { return false; }
    __device__ __forceinline__ bool valid(int, int) const { return true; }
    __device__ __forceinline__ bool wave_skip(int) const { return false; }
    __device__ __forceinline__ bool lane_valid(int) const { return true; }
    __device__ __forceinline__ const bf16* kptr(int t) const { return K + (size_t)(64 * t) * 512; }
    __device__ __forceinline__ const bf16* vptr(int t) const { return V + (size_t)(64 * t) * 512; }
    __device__ __forceinline__ int kpitch() const { return 512; }
    __device__ __forceinline__ int vpitch() const { return 512; }
    __device__ __forceinline__ const float* biasptr(int) const { return nullptr; }
    __device__ __forceinline__ float bias_ref() const { return 0.f; }
};
struct CmpPol {
    const bf16 *K, *V; int ntc, tq;
    __device__ __forceinline__ int first() const { return 0; }
    __device__ __forceinline__ int next(int t) const { return t + 1 < ntc ? t + 1 : -1; }
    __device__ __forceinline__ bool masked(int) const { return true; }
    __device__ __forceinline__ bool valid(int t, int kvl) const { return 16 * (64 * t + kvl) + 31 <= tq; }
    __device__ __forceinline__ bool wave_skip(int) const { return false; }
    __device__ __forceinline__ bool lane_valid(int) const { return true; }
    __device__ __forceinline__ const bf16* kptr(int t) const { return K + (size_t)(64 * t) * 64; }
    __device__ __forceinline__ const bf16* vptr(int t) const { return V + (size_t)(64 * t) * 128; }
    __device__ __forceinline__ int kpitch() const { return 64; }
    __device__ __forceinline__ int vpitch() const { return 128; }
    __device__ __forceinline__ const float* biasptr(int) const { return nullptr; }
    __device__ __forceinline__ float bias_ref() const { return 0.f; }
};
struct WinPol {
    const bf16 *K, *V; int T, tq;
    __device__ __forceinline__ int first() const { return T; }
    __device__ __forceinline__ int next(int t) const { return (t - 1 >= 0 && t - 1 >= T - 8) ? t - 1 : -1; }
    __device__ __forceinline__ bool masked(int t) const { return t == T || t == T - 8; }
    __device__ __forceinline__ bool valid(int t, int kvl) const { const int d = tq - (64 * t + kvl); return d >= 0 && d < 512; }
    __device__ __forceinline__ bool wave_skip(int) const { return false; }
    __device__ __forceinline__ bool lane_valid(int) const { return true; }
    __device__ __forceinline__ const bf16* kptr(int t) const { return K + (size_t)(64 * t) * 128; }
    __device__ __forceinline__ const bf16* vptr(int t) const { return V + (size_t)(64 * t) * 128; }
    __device__ __forceinline__ int kpitch() const { return 128; }
    __device__ __forceinline__ int vpitch() const { return 128; }
    __device__ __forceinline__ const float* biasptr(int) const { return nullptr; }
    __device__ __forceinline__ float bias_ref() const { return 0.f; }
};
struct SelPol {
    const bf16 *K, *V; unsigned long long uni, mine; int T, tq;
    __device__ __forceinline__ int first() const { return 63 - __clzll(uni); }
    __device__ __forceinline__ int next(int t) const { const unsigned long long m = uni & ((1ull << t) - 1ull); return m ? 63 - __clzll(m) : -1; }
    __device__ __forceinline__ bool masked(int t) const { return t == T; }
    __device__ __forceinline__ bool valid(int t, int kvl) const { return 64 * t + kvl <= tq; }
    __device__ __forceinline__ bool wave_skip(int) const { return false; }
    __device__ __forceinline__ bool lane_valid(int t) const { return (mine >> t) & 1ull; }
    __device__ __forceinline__ const bf16* kptr(int t) const { return K + (size_t)(64 * t) * 128; }
    __device__ __forceinline__ const bf16* vptr(int t) const { return V + (size_t)(64 * t) * 128; }
    __device__ __forceinline__ int kpitch() const { return 128; }
    __device__ __forceinline__ int vpitch() const { return 128; }
    __device__ __forceinline__ const float* biasptr(int) const { return nullptr; }
    __device__ __forceinline__ float bias_ref() const { return 0.f; }
};

template <int NDB, class RowF> __device__ __forceinline__ void store_o(const AttnCtx& C, const f32x16 (&o)[NDB], bf16* dst, RowF rowoff) {
#pragma unroll
    for (int r = 0; r < 16; ++r) { const int q = crow(r, C.hi); bf16* p = dst + rowoff(q) + C.r32;
#pragma unroll
        for (int db = 0; db < NDB; ++db) p[32 * db] = (bf16)(cvtpk(o[db][r], 0.f) & 0xffffu); }
}

__device__ __forceinline__ void fox_unit(Frame& F0, int bh, int qb) {
    const AttnCtx C = make_ctx(F0.lds);
    struct { unsigned char* ws; } F; { unsigned long long w_ = (unsigned long long)F0.ws; asm volatile("" : "+s"(w_)); F.ws = (unsigned char*)w_; }
    const int b = bh >> 3, h = bh & 7, tq = 256 * qb + 32 * C.w + C.r32;
    const bf16* Q = WSP(bf16, WS_QF) + ((size_t)(b * SEQ + tq)) * 512 + h * 64;
    bf16x8 qf[4];
#pragma unroll
    for (int d0 = 0; d0 < 4; ++d0) qf[d0] = *(const bf16x8*)(Q + 16 * d0 + 8 * C.hi);
    const float* cum = WSP(float, WS_CUM) + (size_t)bh * SEQ;
    int tmin = 0;
    { float qn = 0.f;
#pragma unroll
      for (int d0 = 0; d0 < 4; ++d0)
#pragma unroll
          for (int j = 0; j < 8; ++j) { const float v = bf2f((unsigned short)qf[d0][j]); qn += v * v; }
      qn += __shfl_xor(qn, 32);
#pragma unroll
      for (int o = 16; o >= 1; o >>= 1) qn = fmaxf(qn, __shfl_xor(qn, o));
      LAS float* qmx = (LAS float*)(C.lds + AL_SELB);
      __syncthreads();
      if (C.lane == 0) qmx[C.w] = qn;
      __syncthreads();
      float qm = qmx[0];
#pragma unroll
      for (int i = 1; i < 8; ++i) qm = fmaxf(qm, qmx[i]);
      const float B = sqrtf(qm) * WSP(float, WS_KMAX)[bh];
      const float thr = -(40.0f + 2.0f * B), c0 = cum[256 * qb];
      const bool cond = (C.lane < 4 * qb) && (c0 - cum[64 * C.lane + 63] < thr);
      const unsigned long long bal = __ballot(cond);
      tmin = bal ? 64 - __clzll(bal) : 0; }
    FoxPol P{WSP(bf16, WS_KF) + (size_t)b * SEQ * 512 + h * 64, WSP(bf16, WS_VF) + (size_t)b * SEQ * 512 + h * 64, cum, cum[256 * qb + 255], qb, C.w, tq, tmin};
    f32x16 o[2];
    attn_core<64, 64, true>(C, P, qf, o);
    bf16* dst = WSP(bf16, WS_OBR) + (size_t)1 * NTOK * 512 + h * 64;
    const size_t rb = (size_t)(b * SEQ + 256 * qb + 32 * C.w);
    store_o<2>(C, o, dst, [&](int q) { return (rb + q) * 512; });
}
__device__ __forceinline__ void mem_unit(Frame& F0, int bh, int qb) {
    const AttnCtx C = make_ctx(F0.lds);
    struct { unsigned char* ws; } F; { unsigned long long w_ = (unsigned long long)F0.ws; asm volatile("" : "+s"(w_)); F.ws = (unsigned char*)w_; }
    const int b = bh >> 2, h = bh & 3, tq = 256 * qb + 32 * C.w + C.r32;
    const bf16* Q = WSP(bf16, WS_QM) + ((size_t)(b * SEQ + tq)) * 512 + h * 128;
    bf16x8 qf[8];
#pragma unroll
    for (int d0 = 0; d0 < 8; ++d0) qf[d0] = *(const bf16x8*)(Q + 16 * d0 + 8 * C.hi);
    MemPol P{WSP(bf16, WS_KMEM) + (size_t)b * MEMLEN * 512 + h * 128, WSP(bf16, WS_VMEM) + (size_t)b * MEMLEN * 512 + h * 128};
    f32x16 o[4];
    attn_core<128, 128, false>(C, P, qf, o);
    bf16* dst = WSP(bf16, WS_OBR) + (size_t)2 * NTOK * 512 + h * 128;
    const size_t rb = (size_t)(b * SEQ + 256 * qb + 32 * C.w);
    store_o<4>(C, o, dst, [&](int q) { return (rb + q) * 512; });
}
__device__ __forceinline__ void nsa_unit(Frame& F0, int bg, int T, int parts) {
    const AttnCtx C = make_ctx(F0.lds);
    struct { unsigned char* ws; } F; { unsigned long long w_ = (unsigned long long)F0.ws; asm volatile("" : "+s"(w_)); F.ws = (unsigned char*)w_; }
    const int b = bg >> 1, g = bg & 1, q = C.r32, tokl = 8 * C.w + (q >> 2), tq = 64 * T + tokl, head = 4 * g + (q & 3);
    const bf16* Q = WSP(bf16, WS_QA) + ((size_t)(b * SEQ + tq)) * 512 + head * 64;
    bf16x8 qf[4];
#pragma unroll
    for (int d0 = 0; d0 < 4; ++d0) qf[d0] = *(const bf16x8*)(Q + 16 * d0 + 8 * C.hi);
    const float* lg = WSP(float, WS_LG) + (size_t)(b * SEQ + tq) * 32 + head * 3;
    LAS float* oacc = (LAS float*)(C.lds + AL_OACC) + C.w * 2048 + C.lane;
    LAS float* imp = (LAS float*)(C.lds + AL_IMP);
    LAS unsigned long long* selb = (LAS unsigned long long*)(C.lds + AL_SELB);
    LAS unsigned long long* unip = (LAS unsigned long long*)(C.lds + AL_UNI);
#ifndef NSA_CORES
#define NSA_CORES 7
#endif
    if (NSA_CORES & 1) {
        CmpPol P{WSP(bf16, WS_KCMP) + (size_t)bg * 256 * 64, WSP(bf16, WS_VCMP) + (size_t)bg * 256 * 128, (4 * T + 2) / 64 + 1, tq};
        f32x16 o2[2];
        attn_core<64, 64, false>(C, P, qf, o2);
        scale_rows<2>(C, o2, (parts & 1) ? fast_sigmoid(lg[0]) : 0.f, 0);
#pragma unroll
        for (int db = 0; db < 2; ++db)
#pragma unroll
            for (int r = 0; r < 16; ++r) oacc[(db * 16 + r) * 64] = o2[db][r];
        P.V += 64;
        attn_core<64, 64, false>(C, P, qf, o2);
#pragma unroll
        for (int db = 0; db < 2; ++db)
#pragma unroll
            for (int rg = 0; rg < 4; ++rg) imp[(8 * C.w + 2 * rg + C.hi) * 65 + 32 * db + C.r32] = (o2[db][4 * rg] + o2[db][4 * rg + 1]) + (o2[db][4 * rg + 2] + o2[db][4 * rg + 3]);
    }
    __syncthreads();
    {
        const int tk = C.tid >> 3, sub = C.tid & 7;
        float mine[8]; int rank[8];
#pragma unroll
        for (int i = 0; i < 8; ++i) { const int j = 8 * sub + i; const float v = imp[tk * 65 + j];
            mine[i] = (j == 0 || j == T || j == T - 1) ? 1e4f : (j > T ? -1e4f : v); rank[i] = 0; }
        for (int jj = 0; jj < 64; ++jj) { const float v0 = imp[tk * 65 + jj]; const float v = (jj == 0 || jj == T || jj == T - 1) ? 1e4f : (jj > T ? -1e4f : v0);
#pragma unroll
            for (int i = 0; i < 8; ++i) { const int j = 8 * sub + i; rank[i] += (v > mine[i] || (v == mine[i] && jj < j)) ? 1 : 0; } }
        unsigned byte = 0;
#pragma unroll
        for (int i = 0; i < 8; ++i) { const int j = 8 * sub + i; if (rank[i] < 16 && j <= T) byte |= 1u << i; }
        ((LAS unsigned char*)selb)[tk * 8 + sub] = (unsigned char)byte;
    }
    __syncthreads();
    if (C.w == 0) { unsigned long long m = selb[C.lane]; unsigned lo = (unsigned)m, hh = (unsigned)(m >> 32);
#pragma unroll
        for (int o = 1; o < 64; o <<= 1) { lo |= __shfl_xor(lo, o); hh |= __shfl_xor(hh, o); }
        if (C.lane == 0) unip[0] = ((unsigned long long)hh << 32) | lo; }
    __syncthreads();
    const unsigned long long mymask = selb[tokl]; unsigned long long uni = unip[0];
    uni = ((unsigned long long)__builtin_amdgcn_readfirstlane((unsigned)(uni >> 32)) << 32) | (unsigned)__builtin_amdgcn_readfirstlane((unsigned)uni);
    if (NSA_CORES & 2) {
        SelPol P{WSP(bf16, WS_KV6) + (size_t)2 * NTOK * 128 + (size_t)b * SEQ * 128 + g * 64, WSP(bf16, WS_KV6) + (size_t)3 * NTOK * 128 + (size_t)b * SEQ * 128 + g * 64, uni, mymask, T, tq};
        f32x16 o2[2];
        attn_core<64, 64, false>(C, P, qf, o2);
        scale_rows<2>(C, o2, (parts & 2) ? fast_sigmoid(lg[1]) : 0.f, 0);
#pragma unroll
        for (int db = 0; db < 2; ++db)
#pragma unroll
            for (int r = 0; r < 16; ++r) oacc[(db * 16 + r) * 64] += o2[db][r];
    }
    if (NSA_CORES & 4) {
        WinPol P{WSP(bf16, WS_KV6) + (size_t)4 * NTOK * 128 + (size_t)b * SEQ * 128 + g * 64, WSP(bf16, WS_KV6) + (size_t)5 * NTOK * 128 + (size_t)b * SEQ * 128 + g * 64, T, tq};
        f32x16 o2[2];
        attn_core<64, 64, false>(C, P, qf, o2);
        scale_rows<2>(C, o2, (parts & 4) ? fast_sigmoid(lg[2]) : 0.f, 0);
#pragma unroll
        for (int db = 0; db < 2; ++db)
#pragma unroll
            for (int r = 0; r < 16; ++r) o2[db][r] += oacc[(db * 16 + r) * 64];
        bf16* dst = WSP(bf16, WS_OBR) + g * 256;
        const size_t rb = (size_t)(b * SEQ + 64 * T + 8 * C.w);
        store_o<2>(C, o2, dst, [&](int qq) { return (rb + (qq >> 2)) * 512 + (qq & 3) * 64; });
    }
}

__device__ __forceinline__ void p3_phase(Frame& F, int parts, int rep) {
    LAS int* ticket = (LAS int*)(F.lds + AL_TICKET);
    unsigned* ctl = WSP(unsigned, WS_CTL);
    unsigned* qhead = ctl + CW_QATTN + 64 * rep; const unsigned* order = WSP(unsigned, WS_ORDER);
    bool pre_ok = false;
    for (;;) {
        __syncthreads();
        if (F.tid == 0) ticket[0] = (int)atomicAdd(qhead, 1u);
        __syncthreads();
        const int tk = __builtin_amdgcn_readfirstlane(ticket[0]);
        if (tk >= N_QUEUE) break;
        const unsigned d = __builtin_amdgcn_readfirstlane(order[tk]); const int type = d & 7, a = (d >> 3) & 255, bb = d >> 11;
        if (type <= 1 && !pre_ok) {
            if (F.tid == 0) ticket[2] = (int)__hip_atomic_load(ctl + CW_PREDONE, __ATOMIC_RELAXED, __HIP_MEMORY_SCOPE_AGENT);
            if (type == 0) q_wait(ctl + CW_CMPDONE + 64 * a, 16u, F.tid); else q_wait(ctl + CW_CUMDONE + 64 * (a >> 3), 1u, F.tid);
            pre_ok = __builtin_amdgcn_readfirstlane(ticket[2]) >= 132;
        }
        if (type == 0) nsa_unit(F, a, bb, parts);
        else if (type == 1) fox_unit(F, a, bb);
        else if (type == 2) mem_unit(F, a, bb);
        else if (type == 3) { p2_compress_unit(F, a, bb); q_signal(ctl + CW_CMPDONE + 64 * (bb >> 3), F.tid); if (F.tid == 0) __hip_atomic_fetch_add(ctl + CW_PREDONE, 1u, __ATOMIC_RELAXED, __HIP_MEMORY_SCOPE_AGENT); }
        else if (type == 4) { p2_cumsum_unit(F, 8 * a + F.wave); q_signal(ctl + CW_CUMDONE + 64 * a, F.tid); if (F.tid == 0) __hip_atomic_fetch_add(ctl + CW_PREDONE, 1u, __ATOMIC_RELAXED, __HIP_MEMORY_SCOPE_AGENT); }
        else convert_unit(F, bb);
    }
}
#define XB_TMO      128
#define XB_XCNT(j)  (256  + 64 * (j))
#define XB_XSUB(j)  (1280 + 64 * (j))
#define XB_XGEN(j)  (2304 + 64 * (j))
#define XB_TOP      3328
#define XB_TOPGEN   3392
#define XCD_BAR_WORDS 3456
#define XB_SPIN_CAP (1u << 18)

__device__ __forceinline__ unsigned xb_ld(unsigned* p)              { return __hip_atomic_load(p, __ATOMIC_RELAXED, __HIP_MEMORY_SCOPE_AGENT); }
__device__ __forceinline__ unsigned xb_add(unsigned* p, unsigned v) { return __hip_atomic_fetch_add(p, v, __ATOMIC_RELAXED, __HIP_MEMORY_SCOPE_AGENT); }
__device__ __forceinline__ unsigned xb_xcc_id() { return (unsigned)__builtin_amdgcn_s_getreg((3 << 11) | 20) & 0xFu; }
#define XB_SPIN(cond, bar) do { unsigned _sp = 0; while (cond) { __builtin_amdgcn_s_sleep(1); \
    if ((++_sp & 255u) == 0u) { if (xb_ld(&(bar)[XB_TMO])) break; if (_sp > XB_SPIN_CAP) { atomicAdd(&(bar)[XB_TMO], 1u); break; } } } } while (0)

struct XcdBarrier {
    unsigned* bar; unsigned x;
    volatile LAS unsigned* st;
};

__device__ __forceinline__ XcdBarrier xcd_barrier_post(unsigned* bar, volatile LAS unsigned* st) {
    XcdBarrier b; b.bar = bar; b.x = xb_xcc_id(); b.st = st;
    if (threadIdx.x == 0) (void)xb_add(&bar[XB_XCNT(b.x)], 1u);
    return b;
}
__device__ __forceinline__ void xcd_barrier_complete(unsigned* bar, unsigned x, unsigned& nloc, unsigned& nx) {
    const unsigned G = gridDim.x * gridDim.y * gridDim.z;
    unsigned sum, cnt, mine, sp = 0u;
    for (;;) {
        sum = 0u; cnt = 0u; mine = 0u;
#pragma unroll
        for (unsigned j = 0; j < 16; ++j) { const unsigned c = xb_ld(&bar[XB_XCNT(j)]); sum += c; cnt += (c > 0u) ? 1u : 0u; mine = (j == x) ? c : mine; }
        if (sum == G) break;
        __builtin_amdgcn_s_sleep(1);
        if ((++sp & 255u) == 0u) { if (xb_ld(&bar[XB_TMO])) break; if (sp > XB_SPIN_CAP) { atomicAdd(&bar[XB_TMO], 1u); break; } }
    }
    nloc = mine > 0u ? mine : 1u; nx = cnt > 0u ? cnt : 1u;
}

__device__ __forceinline__ void xcd_barrier(const XcdBarrier& b) {
    asm volatile("s_waitcnt vmcnt(0)" ::: "memory");
    __syncthreads();
    if (threadIdx.x == 0) {
        unsigned* bar = b.bar;
        __builtin_amdgcn_s_waitcnt(0);
        unsigned nloc = b.st[0], nx = b.st[1];
        if (nloc == 0u) { xcd_barrier_complete(bar, b.x, nloc, nx); b.st[0] = nloc; b.st[1] = nx; }
        const unsigned old = xb_add(&bar[XB_XSUB(b.x)], 1u);
        const unsigned gen = old / nloc;
        if (old + 1u == (gen + 1u) * nloc) {
            __builtin_amdgcn_fence(__ATOMIC_RELEASE, "agent");
            asm volatile("s_waitcnt vmcnt(0)" ::: "memory");
            const unsigned og = xb_add(&bar[XB_TOP], 1u);
            const unsigned tg = og / nx;
            if (og + 1u == (tg + 1u) * nx) xb_add(&bar[XB_TOPGEN], 1u);
            else XB_SPIN(xb_ld(&bar[XB_TOPGEN]) == tg, bar);
            __builtin_amdgcn_fence(__ATOMIC_ACQUIRE, "agent");
            xb_add(&bar[XB_XGEN(b.x)], 1u);
            asm volatile("s_waitcnt vmcnt(0)" ::: "memory");
        } else {
            XB_SPIN(xb_ld(&bar[XB_XGEN(b.x)]) == gen, bar);
            __builtin_amdgcn_fence(__ATOMIC_ACQUIRE, "agent");
            asm volatile("s_waitcnt vmcnt(0)" ::: "memory");
        }
    }
    __syncthreads();
}
#ifndef ABL_PARTS
#define ABL_PARTS 31
#endif
#ifndef PH_MAX
#define PH_MAX 10
#endif
typedef KArgs Args;
static_assert(sizeof(Args) == 26 * 8 + 8 + 8 + 8, "Args has no padding");

__global__ void __launch_bounds__(NTHREADS, 2) fwd_megakernel(Args args) {
    extern __shared__ __attribute__((aligned(16))) unsigned char lds_raw[];
    Frame F;
    F.lds = (LAS unsigned char*)lds_raw;
    F.tid = threadIdx.x; F.lane = F.tid & 63; F.wave = __builtin_amdgcn_readfirstlane(F.tid >> 6);
    F.G = gridDim.x; F.bid = blockIdx.x; F.vcu = (F.G % 8 == 0) ? (F.bid % 8) * (F.G / 8) + F.bid / 8 : F.bid;
    F.ka = (const KArgs __attribute__((address_space(4)))*)__builtin_amdgcn_kernarg_segment_ptr();
    F.out = args.out; F.ws = args.ws;
    const int lo = args.ph_lo, hi = args.ph_hi;
    volatile LAS unsigned* xst = (volatile LAS unsigned*)(F.lds + LDS_BYTES - 64);
    if (F.tid < 2) xst[F.tid] = 0u;
    __syncthreads();
    XcdBarrier xbar = xcd_barrier_post((unsigned*)(F.ws + WS_CTL) + CW_XBAR, xst);
#ifndef PHASE_MASK
#define PHASE_MASK 0x7ff
#endif
#define IN(k) (((PHASE_MASK >> (k)) & 1) && lo <= (k) && (k) < hi)
#ifndef REP_MASK
#define REP_MASK 0
#endif
#define REPS(k) for (int rep_ = 0; rep_ < 1 + ((REP_MASK >> (k)) & 1); ++rep_)
#define SEAM(k) do { if (lo <= (k) && (k) + 1 < hi) { xcd_barrier(xbar); } } while (0)
#define FIT_GRID(n) ((F.G % 8 == 0) ? ({ const int n_ = (n), R_ = (n_ + F.G - 1) / F.G, g_ = 8 * (((n_ + R_ - 1) / R_ + 7) / 8); g_ < F.G ? g_ : F.G; }) : F.G)

    if (IN(0)) REPS(0) p0_prologue(F);
    SEAM(0);
    if (IN(1)) REPS(1) {
        const int g1 = FIT_GRID(1680);
        if (F.bid < g1) {
        SchedIn S{(const char*)(F.ws + WS_HA), (const char*)(F.ws + WS_WIN_T), g1, F.bid};
        EpiIn E{WSP(bf16, WS_QA), WSP(bf16, WS_KV6), WSP(bf16, WS_QF), WSP(bf16, WS_KF), WSP(bf16, WS_VF), WSP(bf16, WS_QM), WSP(bf16, WS_GATES), WSP(bf16, WS_KMEM), WSP(bf16, WS_VMEM), WSP(float, WS_LG),
                WSP(float, WS_ROPE_C), WSP(float, WS_ROPE_S), F.ka->in[5]};
        pg8::gemm_phase<false>(F.lds, 1024, S, E);
        }
    }
    SEAM(1);
    if (IN(3)) REPS(3) p3_phase(F, ABL_PARTS, rep_);
    SEAM(3);
    if (IN(4)) REPS(4) {
        SchedBr S{(const char*)(F.ws + WS_OBR), (const char*)(F.ws + WS_WBR_T), F.G, F.bid};
        EpiBr E{WSP(bf16, WS_GATES), WSP(bf16, WS_MERGED)};
        pg8::gemm_phase<false>(F.lds, 512, S, E);
    }
    SEAM(4);
    if (IN(5)) REPS(5) {
        SchedOut S{(const char*)(F.ws + WS_MERGED), (const char*)(F.ws + WS_WOUT_T), F.G, F.bid};
        EpiOut E{F.ka->in[0], F.out, WSP(unsigned char, WS_H2)};
        pg8::gemm_phase<false>(F.lds, 1024, S, E);
    }
    SEAM(5);
    if (IN(6)) REPS(6) p6_phase(F);
    SEAM(6);
    const bool moe_split = (F.G % 8 == 0);
    const LAS int* te = (const LAS int*)(F.lds + MT_OFF);
    if (IN(8)) REPS(8) {
        { LAS int* mt = (LAS int*)(F.lds + MT_OFF);
          if (F.tid < 64) { const int e = F.tid & 31; const int c = (int)__hip_atomic_load(WSP(unsigned, WS_CTL) + CW_GCNT + 32 * e, __ATOMIC_RELAXED, __HIP_MEMORY_SCOPE_AGENT);
              const int padc = (c + 255) & ~255; int inc = padc;
#pragma unroll
              for (int o = 1; o < 32; o <<= 1) { const int up = __shfl_up(inc, o); if (e >= o) inc += up; }
              const int start = inc - padc;
              if (F.tid < 32) { mt[320 + e] = start; mt[352 + e] = c; for (int q = 0; q < (padc >> 8); ++q) mt[(start >> 8) + q] = e | (q << 5); if (e == 31) mt[300] = inc >> 8; } }
          __syncthreads(); }
        const int nmt = __builtin_amdgcn_readfirstlane(te[300]), F8 = moe_split ? (nmt * 8) / F.G : (1 << 20);
        SchedMoE<true> S{(const char*)(F.ws + WS_H2), (const char*)(F.ws + WS_WGU_T), te, WSP(int, WS_ETOK), nmt, 8, F.G, F.vcu, (size_t)2048 * 1024, 0, F8};
        EpiGU E{F.ka->in[22], te, WSP(unsigned char, WS_ACT), WSP(float, WS_ERSTD)};
        pg8::gemm_phase<true>(F.lds, 512, S, E);
    }
    SEAM(8);
    if (IN(9)) REPS(9) {
        unsigned* done8 = WSP(unsigned, WS_CTL) + CW_DONE8;
        const int nmt = __builtin_amdgcn_readfirstlane(te[300]), n9 = nmt * 4, F8 = moe_split ? (nmt * 8) / F.G : (1 << 20), T = moe_split ? nmt * 8 - F8 * F.G : 0, v = F.vcu;
        if (v < T) {
            SchedMoE<true> S{(const char*)(F.ws + WS_H2), (const char*)(F.ws + WS_WGU_T), te, WSP(int, WS_ETOK), nmt, 8, F.G, v, (size_t)2048 * 1024, F8, F8 + 1};
            EpiGU E{F.ka->in[22], te, WSP(unsigned char, WS_ACT), WSP(float, WS_ERSTD)};
            pg8::gemm_phase<true>(F.lds, 512, S, E);
            if (F.tid == 0) { __builtin_amdgcn_fence(__ATOMIC_RELEASE, "agent"); asm volatile("s_waitcnt vmcnt(0)" ::: "memory");
                __hip_atomic_fetch_add(done8 + ((F8 * F.G + v) >> 3), 1u, __ATOMIC_RELAXED, __HIP_MEMORY_SCOPE_AGENT); }
        }
        const int vb = v - T + (v < T ? F.G : 0), pmT = moe_split ? (F8 * F.G) / 8 : (1 << 20), lim = n9 < 4 * pmT ? n9 : 4 * pmT;
        const int nseg1 = vb < lim ? (lim - 1 - vb) / F.G + 1 : 0;
        EpiDn E{F.ka->in[24], te, WSP(bf16, WS_AMOE)};
        { SchedMoE<false> S{(const char*)(F.ws + WS_ACT), (const char*)(F.ws + WS_WD_T), te, nullptr, nmt, 4, F.G, vb, (size_t)1024 * 1024, 0, nseg1};
          pg8::gemm_phase<true>(F.lds, 512, S, E); }
        if (nseg1 * F.G + vb < n9) {
            for (int L = nseg1 * F.G + vb; L < n9; L += F.G) q_wait(done8 + (L >> 2), 8u, F.tid);
            SchedMoE<false> S{(const char*)(F.ws + WS_ACT), (const char*)(F.ws + WS_WD_T), te, nullptr, nmt, 4, F.G, vb, (size_t)1024 * 1024, nseg1, 1 << 20};
            pg8::gemm_phase<true>(F.lds, 512, S, E);
        }
    }
    SEAM(9);
    if (IN(10)) { if ((REP_MASK >> 10) & 1) p10_phase(F, PH_MAX >= 9, WSP(float, WS_GATES)); p10_phase(F, PH_MAX >= 9, F.out); }
#undef IN
#undef SEAM
}

extern "C" void kernel_launch(void* const* d_in, const int* in_sizes, int n_in, void* d_out, int out_size, void* d_ws, size_t ws_size, hipStream_t stream) {
    static int grid = 0;
    if (grid == 0) {
        if (n_in != 26 || out_size != NTOK * DM || ws_size < WS_END) { fprintf(stderr, "kernel_launch: unexpected sizes n_in %d out %d ws %zu (need %zu)\n", n_in, out_size, ws_size, (size_t)WS_END); grid = -1; return; }
        int dev = 0, cus = 0, per_cu = 0;
        hipGetDevice(&dev); hipDeviceGetAttribute(&cus, hipDeviceAttributeMultiprocessorCount, dev);
        if (hipFuncSetAttribute((const void*)fwd_megakernel, hipFuncAttributeMaxDynamicSharedMemorySize, LDS_BYTES) != hipSuccess) { fprintf(stderr, "kernel_launch: hipFuncSetAttribute failed\n"); grid = -1; return; }
        if (hipOccupancyMaxActiveBlocksPerMultiprocessor(&per_cu, (const void*)fwd_megakernel, NTHREADS, LDS_BYTES) != hipSuccess || per_cu < 1) { fprintf(stderr, "kernel_launch: occupancy query says %d\n", per_cu); per_cu = 1; }
        (void)hipGetLastError();
        grid = cus * 1;
        if (grid > 256) grid = 256;
    }
    if (grid < 0) return;
    (void)hipMemsetAsync((char*)d_ws + WS_CTL, 0, CTL_BYTES, stream);
    Args a{};
    for (int i = 0; i < 26; ++i) a.in[i] = (const float*)d_in[i];
    a.out = (float*)d_out; a.ws = (unsigned char*)d_ws;
#if defined(MULTI_LAUNCH)
    for (int p = 0; p <= 10; ++p) { if (p > PH_MAX && p != 10) continue; a.ph_lo = p; a.ph_hi = p + 1; hipLaunchKernelGGL(fwd_megakernel, dim3(grid), dim3(NTHREADS), LDS_BYTES, stream, a); }
#else
    a.ph_lo = 0; a.ph_hi = 11;
    hipLaunchKernelGGL(fwd_megakernel, dim3(grid), dim3(NTHREADS), LDS_BYTES, stream, a);
#endif
}
```

```cpp
#include <hip/hip_runtime.h>
#include <hip/hip_cooperative_groups.h>
#include <cstdio>
#include <cstdint>
#include <cmath>
namespace cg = cooperative_groups;

#define LAS __attribute__((address_space(3)))
typedef unsigned short bf16;
typedef short bf16x8 __attribute__((ext_vector_type(8)));
typedef short s16x4 __attribute__((ext_vector_type(4)));
typedef float f32x4 __attribute__((ext_vector_type(4)));
typedef float f32x2 __attribute__((ext_vector_type(2)));
typedef float f32x16 __attribute__((ext_vector_type(16)));
typedef unsigned u32x4 __attribute__((ext_vector_type(4)));
typedef unsigned u32x2 __attribute__((ext_vector_type(2)));
typedef __bf16 bf16x2_t __attribute__((ext_vector_type(2)));

constexpr int NB = 4, SEQ = 4096, DM = 1024, NTOK = NB * SEQ;
constexpr int DIN = 6432, NIN = 6656;
constexpr int MEMLEN = 256, NMEMROW = NB * MEMLEN;
constexpr int NEXP = 32, TOPK = 4, FEXP = 1024;
constexpr int MAXSLOT = NTOK * TOPK + NEXP * 256;
constexpr float RMS_EPS = 1e-5f;
constexpr float LOG2E = 1.4426950408889634f;
constexpr float C2_64 = 0.125f * LOG2E;
constexpr float C2_128 = 0.08838834764831845f * LOG2E;
constexpr float NEGBIG = -1e30f;
constexpr float W8_SCALE = 32.0f, ACT8_SCALE = 4.0f;

constexpr size_t MiB = 1u << 20;
constexpr size_t WS_CTL = 0;
constexpr size_t CTL_BYTES = 64 * 1024;
constexpr size_t WS_ROPE_C = 1 * MiB, WS_ROPE_S = WS_ROPE_C + 512 * 1024;
constexpr size_t WS_W1T_K = 2 * MiB, WS_W1T_V = WS_W1T_K + 256 * 1024;
constexpr size_t WS_W2T_K = WS_W1T_V + 256 * 1024, WS_W2T_V = WS_W2T_K + 8192;
constexpr size_t WS_CPE = WS_W2T_V + 8192;
constexpr size_t WS_KCMP = 3 * MiB;
constexpr size_t WS_VCMP = WS_KCMP + 256 * 1024;
constexpr size_t WS_CUM = 4 * MiB;
constexpr size_t WS_KMAX = 4 * MiB + 512 * 1024;
constexpr size_t WS_KMEM = 5 * MiB, WS_VMEM = 6 * MiB;
constexpr size_t WS_ORDER = 7 * MiB;
constexpr size_t WS_BLKCNT = 7 * MiB + 64 * 1024;
constexpr size_t WS_TILE_E = 7 * MiB + 128 * 1024;
constexpr size_t WS_WRT = 7 * MiB + 256 * 1024;
constexpr size_t WS_RSTD = 7 * MiB + 512 * 1024;
constexpr size_t WS_RSLOT = 8 * MiB;
constexpr size_t WS_SLOTTOK = 8 * MiB + 512 * 1024;
constexpr size_t WS_WIN_T = 9 * MiB;
constexpr size_t WS_WBR_T = 24 * MiB;
constexpr size_t WS_WOUT_T = 27 * MiB;
constexpr size_t WS_WGU_T = 32 * MiB;
constexpr size_t WS_WD_T = 160 * MiB;
constexpr size_t WS_HA = 224 * MiB;
constexpr size_t WS_ETOK = 224 * MiB, WS_ERSTD = 226 * MiB;
constexpr int MT_OFF = 131072;
constexpr size_t WS_QA = 258 * MiB;
constexpr size_t WS_KV6 = 274 * MiB;
constexpr size_t WS_QM = 298 * MiB;
constexpr size_t WS_LG = 314 * MiB;
constexpr size_t WS_GATES = 316 * MiB;
constexpr size_t WS_QF = 412 * MiB, WS_KF = 428 * MiB, WS_VF = 444 * MiB;
constexpr size_t WS_ACT = 316 * MiB;
constexpr size_t WS_OBR = 460 * MiB;
constexpr size_t WS_MERGED = 508 * MiB;
constexpr size_t WS_H2 = 540 * MiB;
constexpr size_t WS_ROUTE = 572 * MiB;
constexpr size_t WS_AMOE = 576 * MiB;
constexpr size_t WS_END = 720 * MiB;
static_assert(WS_ACT + (size_t)MAXSLOT * 1024 * 2 <= WS_OBR && WS_AMOE + (size_t)MAXSLOT * 1024 * 2 <= WS_END, "ws map");
constexpr int CW_QATTN = 64;
constexpr int CW_DONE8 = 12288;
constexpr int CW_GCNT = 9216;
constexpr int CW_XBAR = 1024;

constexpr int LDS_BYTES = 155648;
constexpr int NWAVES = 8, NTHREADS = 512;

__device__ __forceinline__ unsigned cvtpk(float lo, float hi) { f32x2 v = {lo, hi}; bf16x2_t b = __builtin_convertvector(v, bf16x2_t); return __builtin_bit_cast(unsigned, b); }
__device__ __forceinline__ float bf2f(unsigned short h) { return __builtin_bit_cast(float, (unsigned)h << 16); }
__device__ __forceinline__ float bflo(unsigned u) { return __builtin_bit_cast(float, u << 16); }
__device__ __forceinline__ float bfhi(unsigned u) { return __builtin_bit_cast(float, u & 0xffff0000u); }
__device__ __forceinline__ float wave_sum(float v) {
#pragma unroll
    for (int o = 1; o < 64; o <<= 1) v += __shfl_xor(v, o);
    return v;
}
__device__ __forceinline__ float fast_sigmoid(float x) { return __builtin_amdgcn_rcpf(1.0f + __builtin_amdgcn_exp2f(-LOG2E * x)); }
__device__ __forceinline__ unsigned pk_fp8x4(float a, float b, float c, float d) {
    a = fminf(fmaxf(a, -448.f), 448.f); b = fminf(fmaxf(b, -448.f), 448.f); c = fminf(fmaxf(c, -448.f), 448.f); d = fminf(fmaxf(d, -448.f), 448.f);
    int p = __builtin_amdgcn_cvt_pk_fp8_f32(a, b, 0, false); p = __builtin_amdgcn_cvt_pk_fp8_f32(c, d, p, true); return (unsigned)p;
}
namespace pg8 {
#define PG8_LAS __attribute__((address_space(3)))
typedef unsigned short bf16_t;
typedef short bf16x8 __attribute__((ext_vector_type(8)));
typedef float f32x4 __attribute__((ext_vector_type(4)));
typedef unsigned u32x4 __attribute__((ext_vector_type(4)));
typedef unsigned u32x2 __attribute__((ext_vector_type(2)));
typedef int i32x8 __attribute__((ext_vector_type(8)));
typedef int i32x4 __attribute__((ext_vector_type(4)));
constexpr int BM = 256, BK = 64, HALF = 128, HTB = HALF * BK * 2  , STAGE_BYTES = 8 * HTB;

__host__ __device__ __forceinline__ int lds_byte(int r, int c) { const int st = (r >> 4) * 2 + (c >> 5), rr = r & 15, cc = c & 31, ob = rr * 64 + cc * 2; return st * 1024 + (ob ^ (((ob >> 9) & 1) << 5)); }
__host__ __device__ __forceinline__ void stage_rc(int b, int& R, int& C) { const int st = b / 1024, sb = b % 1024, swz = sb ^ (((sb >> 9) & 1) << 5); R = (st >> 1) * 16 + swz / 64; C = (st & 1) * 32 + (swz % 64) / 2; }
__host__ __device__ __forceinline__ int perm32(int rho) { const int n = rho >> 4, i = rho & 15; return 8 * (i >> 2) + 4 * n + (i & 3); }

struct Unit { int pm, pn; };

template <bool F8, class Epi, class Sched>
__device__ __forceinline__ void gemm_phase(PG8_LAS unsigned char* lds, const int K, const Sched& S, const Epi& E) {
    const int tid = threadIdx.x, wid = __builtin_amdgcn_readfirstlane(tid >> 6), lane = tid & 63, wr = wid >> 2, wc = wid & 3, fr = lane & 15, fq = lane >> 4;
    const int nt = K / BK;
    unsigned voffB[2]; int RA[2], CA[2];
    { int R, C; stage_rc(tid * 16, R, C); const int Rb = (R & ~31) + perm32(R & 31);
      RA[0] = R; CA[0] = C; RA[1] = R + 64; CA[1] = C; voffB[0] = (unsigned)(Rb * K + C) * 2u; voffB[1] = voffB[0] + (unsigned)(64 * K * 2); }
    constexpr bool GATHER = Sched::GATHER;
    unsigned cofA[2][2], nofA[2][2];
#define PG8_AOFF(dst, u) do { _Pragma("unroll") for (int h_ = 0; h_ < 2; ++h_) _Pragma("unroll") for (int i_ = 0; i_ < 2; ++i_) dst[h_][i_] = S.a_voff(u, h_, RA[i_], CA[i_], K); } while (0)
    const size_t kstep = (size_t)(BK * 2);
    const size_t hstep = (size_t)HALF * K * 2;
    const unsigned ldsw = (unsigned)wid * 1024u;
    const int aoff = lds_byte(wr * 64 + fr, fq * 8), boff = lds_byte(wc * 32 + fr, fq * 8);
    const int aoff8 = lds_byte(wr * 64 + fr, fq * 16), boff8 = lds_byte(wc * 32 + fr, fq * 16);
#define PG8_SA(b, h) (((b) * 2 + (h)) * HTB)
#define PG8_SB(b, h) ((4 + (b) * 2 + (h)) * HTB)
#define PG8_STAGE(bufoff, gbase, voff) do { _Pragma("unroll") for (int _i = 0; _i < 2; ++_i) \
        __builtin_amdgcn_global_load_lds((const unsigned*)((const char*)(gbase) + (voff)[_i]), (PG8_LAS unsigned*)(lds + (bufoff) + ldsw + _i * 8192), 16, 0, 0); } while (0)
#define PG8_LDA(dst, b, h) do { _Pragma("unroll") for (int m = 0; m < 4; ++m) _Pragma("unroll") for (int k = 0; k < 2; ++k) dst[m][k] = *(const PG8_LAS bf16x8*)(lds + PG8_SA(b, h) + aoff + m * 2048 + k * 1024); } while (0)
#define PG8_LDB(dst, b, h) do { _Pragma("unroll") for (int n = 0; n < 2; ++n) _Pragma("unroll") for (int k = 0; k < 2; ++k) dst[n][k] = *(const PG8_LAS bf16x8*)(lds + PG8_SB(b, h) + boff + n * 2048 + k * 1024); } while (0)
#define PG8_MMA(ai, bj, At, Bt) do { __builtin_amdgcn_s_setprio(1); _Pragma("unroll") for (int m = 0; m < 4; ++m) _Pragma("unroll") for (int n = 0; n < 2; ++n) _Pragma("unroll") for (int k = 0; k < 2; ++k) \
        acc[ai][bj][m][n] = __builtin_amdgcn_mfma_f32_16x16x32_bf16(Bt[n][k], At[m][k], acc[ai][bj][m][n], 0, 0, 0); __builtin_amdgcn_s_setprio(0); } while (0)
#define PG8_LD8(dst, base, o0, cnt) do { _Pragma("unroll") for (int q_ = 0; q_ < cnt; ++q_) { const i32x4 lo_ = *(const PG8_LAS i32x4*)(lds + (base) + (o0) + q_ * 2048), hi_ = *(const PG8_LAS i32x4*)(lds + (base) + (o0) + q_ * 2048 + 16); \
        dst[q_] = (i32x8){lo_[0], lo_[1], lo_[2], lo_[3], hi_[0], hi_[1], hi_[2], hi_[3]}; } } while (0)
#define PG8_MMA8(ai, bj, At, Bt) do { __builtin_amdgcn_s_setprio(1); _Pragma("unroll") for (int m = 0; m < 4; ++m) _Pragma("unroll") for (int n = 0; n < 2; ++n) \
        asm volatile("v_mfma_scale_f32_16x16x128_f8f6f4 %0, %1, %2, %0, %3, %3 op_sel_hi:[0,0,0]" : "+v"(acc[ai][bj][m][n]) : "v"(Bt[n]), "v"(At[m]), "v"(sc8)); asm volatile("s_nop 7" ::: "memory"); __builtin_amdgcn_s_setprio(0); } while (0)
#define PG8_WAIT_V(n) asm volatile("s_waitcnt vmcnt(" #n ")" ::: "memory")
#define PG8_WAIT_L(n) asm volatile("s_waitcnt lgkmcnt(" #n ")" ::: "memory")
#define PG8_BAR __builtin_amdgcn_s_barrier()
#define PG8_SCHED __builtin_amdgcn_sched_barrier(0)
    Unit cur, nxt; int ui = 0;
    if (!S.next(0, cur)) return;
    f32x4 acc[2][2][4][2];
#pragma unroll
    for (int a = 0; a < 2; ++a)
#pragma unroll
        for (int b = 0; b < 2; ++b)
#pragma unroll
            for (int m = 0; m < 4; ++m)
#pragma unroll
                for (int n = 0; n < 2; ++n) acc[a][b][m][n] = (f32x4){0.f, 0.f, 0.f, 0.f};
    if constexpr (Epi::ACC_INIT) E.init(acc, cur, wr, wc, fr, fq);
    bf16x8 At[4][2], B0[2][2], B1[2][2]; i32x8 At8[4], B08[2], B18[2]; int sc8 = 0x7f7f7f7f; asm volatile("" : "+v"(sc8));
    const char* cA = S.a_base(cur); const char* cB = S.b_base(cur);
    PG8_AOFF(cofA, cur);
    PG8_STAGE(PG8_SB(0, 0), cB, voffB); PG8_STAGE(PG8_SB(0, 1), cB + hstep, voffB); PG8_STAGE(PG8_SA(0, 0), cA, cofA[0]); PG8_STAGE(PG8_SA(0, 1), cA, cofA[1]);
    if (wr == 1) PG8_BAR;
    PG8_WAIT_V(2); PG8_BAR;
    PG8_STAGE(PG8_SB(1, 0), cB + kstep, voffB); PG8_STAGE(PG8_SA(1, 0), cA + kstep, cofA[0]); PG8_STAGE(PG8_SB(1, 1), cB + hstep + kstep, voffB);
    PG8_WAIT_V(6); PG8_BAR;
    for (;;) {
        const bool has_next = S.next(ui + 1, nxt);
        const char* nA = has_next ? S.a_base(nxt) : cA; const char* nB = has_next ? S.b_base(nxt) : cB;
        if constexpr (GATHER) { if (has_next) PG8_AOFF(nofA, nxt); else { _Pragma("unroll") for (int h_ = 0; h_ < 2; ++h_) _Pragma("unroll") for (int i_ = 0; i_ < 2; ++i_) nofA[h_][i_] = cofA[h_][i_]; } }
#pragma clang loop unroll(disable)
        for (int t = 0; t < nt; t += 2) {
            const bool last = (t == nt - 2);
            const char* a1 = cA + (size_t)(t + 1) * kstep;
            const char* a2 = last ? nA : cA + (size_t)(t + 2) * kstep; const char* b2 = last ? nB : cB + (size_t)(t + 2) * kstep;
            const char* a3 = a2 + kstep; const char* b3 = b2 + kstep;
            unsigned sofA[2][2];
            _Pragma("unroll") for (int h_ = 0; h_ < 2; ++h_) _Pragma("unroll") for (int i_ = 0; i_ < 2; ++i_) sofA[h_][i_] = (GATHER && last) ? nofA[h_][i_] : cofA[h_][i_];
            if constexpr (!F8) {
            PG8_LDB(B0, 0, 0); PG8_LDB(B1, 0, 1); PG8_SCHED; PG8_LDA(At, 0, 0); PG8_STAGE(PG8_SA(1, 1), a1, cofA[1]);
            PG8_WAIT_V(8); PG8_WAIT_L(0); PG8_BAR; PG8_MMA(0, 0, At, B0); PG8_MMA(0, 1, At, B1); PG8_BAR; PG8_SCHED;
            PG8_LDA(At, 0, 1); PG8_STAGE(PG8_SB(0, 0), b2, voffB); PG8_STAGE(PG8_SB(0, 1), b2 + hstep, voffB); PG8_STAGE(PG8_SA(0, 0), a2, sofA[0]);
            PG8_WAIT_V(8); PG8_WAIT_L(0); PG8_BAR; PG8_MMA(1, 0, At, B0); PG8_MMA(1, 1, At, B1); PG8_BAR; PG8_SCHED;
            PG8_LDB(B0, 1, 0); PG8_LDB(B1, 1, 1); PG8_SCHED; PG8_LDA(At, 1, 0); PG8_STAGE(PG8_SA(0, 1), a2, sofA[1]);
            PG8_WAIT_V(8); PG8_WAIT_L(0); PG8_BAR; PG8_MMA(0, 0, At, B0); PG8_MMA(0, 1, At, B1); PG8_BAR; PG8_SCHED;
            PG8_LDA(At, 1, 1); PG8_STAGE(PG8_SB(1, 0), b3, voffB); PG8_STAGE(PG8_SB(1, 1), b3 + hstep, voffB); PG8_STAGE(PG8_SA(1, 0), a3, sofA[0]);
            PG8_WAIT_V(8); PG8_WAIT_L(0); PG8_BAR; PG8_MMA(1, 0, At, B0); PG8_MMA(1, 1, At, B1); PG8_BAR; PG8_SCHED;
            } else {
            PG8_LD8(B08, PG8_SB(0, 0), boff8, 2); PG8_LD8(B18, PG8_SB(0, 1), boff8, 2); PG8_SCHED; PG8_LD8(At8, PG8_SA(0, 0), aoff8, 4); PG8_STAGE(PG8_SA(1, 1), a1, cofA[1]);
            PG8_WAIT_V(8); PG8_WAIT_L(0); PG8_BAR; PG8_MMA8(0, 0, At8, B08); PG8_MMA8(0, 1, At8, B18); PG8_BAR; PG8_SCHED;
            PG8_LD8(At8, PG8_SA(0, 1), aoff8, 4); PG8_STAGE(PG8_SB(0, 0), b2, voffB); PG8_STAGE(PG8_SB(0, 1), b2 + hstep, voffB); PG8_STAGE(PG8_SA(0, 0), a2, sofA[0]);
            PG8_WAIT_V(8); PG8_WAIT_L(0); PG8_BAR; PG8_MMA8(1, 0, At8, B08); PG8_MMA8(1, 1, At8, B18); PG8_BAR; PG8_SCHED;
            PG8_LD8(B08, PG8_SB(1, 0), boff8, 2); PG8_LD8(B18, PG8_SB(1, 1), boff8, 2); PG8_SCHED; PG8_LD8(At8, PG8_SA(1, 0), aoff8, 4); PG8_STAGE(PG8_SA(0, 1), a2, sofA[1]);
            PG8_WAIT_V(8); PG8_WAIT_L(0); PG8_BAR; PG8_MMA8(0, 0, At8, B08); PG8_MMA8(0, 1, At8, B18); PG8_BAR; PG8_SCHED;
            PG8_LD8(At8, PG8_SA(1, 1), aoff8, 4); PG8_STAGE(PG8_SB(1, 0), b3, voffB); PG8_STAGE(PG8_SB(1, 1), b3 + hstep, voffB); PG8_STAGE(PG8_SA(1, 0), a3, sofA[0]);
            PG8_WAIT_V(8); PG8_WAIT_L(0); PG8_BAR; PG8_MMA8(1, 0, At8, B08); PG8_MMA8(1, 1, At8, B18); PG8_BAR; PG8_SCHED;
            }
        }
        if constexpr (F8) asm volatile("s_nop 15\n\ts_nop 15" ::: "memory");
        if (wr == 0) PG8_BAR;
        E(acc, cur, wr, wc, fr, fq);
        if (!has_next) break;
        if constexpr (Epi::ACC_INIT) E.init(acc, nxt, wr, wc, fr, fq);
        cur = nxt; cA = nA; cB = nB; ++ui;
        if constexpr (GATHER) { _Pragma("unroll") for (int h_ = 0; h_ < 2; ++h_) _Pragma("unroll") for (int i_ = 0; i_ < 2; ++i_) cofA[h_][i_] = nofA[h_][i_]; }
        if (wr == 1) PG8_BAR;
    }
    PG8_WAIT_V(0);
    PG8_BAR;
#undef PG8_AOFF
#undef PG8_SA
#undef PG8_SB
#undef PG8_STAGE
#undef PG8_LDA
#undef PG8_LDB
#undef PG8_MMA
#undef PG8_MMA8
#undef PG8_LD8
#undef PG8_WAIT_V
#undef PG8_WAIT_L
#undef PG8_BAR
#undef PG8_SCHED
}
}
typedef float acc_t[2][2][4][2] __attribute__((unused));
#define ACC_ARG pg8::f32x4 (&acc)[2][2][4][2]
#define ZERO_ACC() do { _Pragma("unroll") for (int a_ = 0; a_ < 2; ++a_) _Pragma("unroll") for (int b_ = 0; b_ < 2; ++b_) _Pragma("unroll") for (int m_ = 0; m_ < 4; ++m_) _Pragma("unroll") for (int n_ = 0; n_ < 2; ++n_) acc[a_][b_][m_][n_] = (pg8::f32x4){0.f, 0.f, 0.f, 0.f}; } while (0)

__device__ __forceinline__ bool static_unit(int L, int nM, int nN, pg8::Unit& u) {
    const int nwg = nM * nN; if (L >= nwg) return false;
    int wgid = L; { const int q = nwg / 8, r = nwg % 8, xcd = wgid % 8, off = wgid / 8; wgid = (xcd < r ? xcd * (q + 1) : r * (q + 1) + (xcd - r) * q) + off; }
    const int nig = 8 * nN, gid = wgid / nig, fm = gid * 8, gsz = (nM - fm) < 8 ? (nM - fm) : 8;
    u.pm = fm + ((wgid % nig) % gsz); u.pn = (wgid % nig) / gsz; return true;
}

struct SchedIn {
    static constexpr bool GATHER = false;
    const char* A; const char* Bt; int G, c;
    __device__ __forceinline__ bool next(int i, pg8::Unit& u) const {
        const int L = i * G + c;
        if (L < 1664) return static_unit(L, 64, 26, u);
        if (L < 1680) { const int j = L - 1664; u.pm = 64 + (j >> 2); u.pn = 26 + (j & 3); return true; }
        return false;
    }
    __device__ __forceinline__ const char* a_base(const pg8::Unit& u) const { return A + (size_t)u.pm * (256 * 1024 * 2); }
    __device__ __forceinline__ const char* b_base(const pg8::Unit& u) const { return Bt + (size_t)u.pn * (256 * 1024 * 2); }
    __device__ __forceinline__ unsigned a_voff(const pg8::Unit&, int h, int R, int C, int K) const { return (unsigned)(((h * 128 + R) * K + C) * 2); }
};
struct SchedBr {
    static constexpr bool GATHER = false;
    const char* A; const char* Bt; int G, c;
    __device__ __forceinline__ bool next(int i, pg8::Unit& u) const {
        const int rnd = i / 3, br = i - rnd * 3; pg8::Unit t;
        if (!static_unit(rnd * G + c, 64, 4, t)) return false;
        u.pm = 64 * br + t.pm; u.pn = 4 * br + t.pn; return true;
    }
    __device__ __forceinline__ const char* a_base(const pg8::Unit& u) const { return A + (size_t)u.pm * (256 * 512 * 2); }
    __device__ __forceinline__ const char* b_base(const pg8::Unit& u) const { return Bt + (size_t)u.pn * (256 * 512 * 2); }
    __device__ __forceinline__ unsigned a_voff(const pg8::Unit&, int h, int R, int C, int K) const { return (unsigned)(((h * 128 + R) * K + C) * 2); }
};
struct SchedOut {
    static constexpr bool GATHER = false;
    const char* A; const char* Bt; int G, c;
    __device__ __forceinline__ bool next(int i, pg8::Unit& u) const { return static_unit(i * G + c, 64, 4, u); }
    __device__ __forceinline__ const char* a_base(const pg8::Unit& u) const { return A + (size_t)u.pm * (256 * 1024 * 2); }
    __device__ __forceinline__ const char* b_base(const pg8::Unit& u) const { return Bt + (size_t)u.pn * (256 * 1024 * 2); }
    __device__ __forceinline__ unsigned a_voff(const pg8::Unit&, int h, int R, int C, int K) const { return (unsigned)(((h * 128 + R) * K + C) * 2); }
};
template <bool G_> struct SchedMoE {
    static constexpr bool GATHER = G_;
    const char* A; const char* Bt; const LAS int* tile_e; const int* etok; int nmt, nN, G, v; size_t estride; int i0, i1;
    __device__ __forceinline__ bool next(int i, pg8::Unit& u) const {
        if (i + i0 >= i1) return false;
        const int L = (i + i0) * G + v; if (L < 0 || L >= nmt * nN) return false;
        u.pm = L / nN; u.pn = L - u.pm * nN; return true;
    }
    __device__ __forceinline__ const char* a_base(const pg8::Unit& u) const { return G_ ? A : A + (size_t)u.pm * (256 * 1024); }
    __device__ __forceinline__ const char* b_base(const pg8::Unit& u) const { return Bt + (size_t)(__builtin_amdgcn_readfirstlane(tile_e[u.pm]) & 31) * estride + (size_t)u.pn * (256 * 1024); }
    __device__ __forceinline__ unsigned a_voff(const pg8::Unit& u, int h, int R, int C, int K) const {
        if (!G_) return (unsigned)(((h * 128 + R) * K + C) * 2);
        const int te_ = __builtin_amdgcn_readfirstlane(tile_e[u.pm]);
        unsigned t = (unsigned)etok[(te_ & 31) * NTOK + (te_ >> 5) * 256 + h * 128 + R]; t = t < (unsigned)NTOK ? t : 0u;
        return (t * (unsigned)K + (unsigned)C) * 2u;
    }
};


struct EpiIn {
    static constexpr bool ACC_INIT = false;
    bf16 *QA, *KV6, *QF, *KF, *VF, *QM, *GATES, *KMEM, *VMEM; float* LG;
    const float *ropeC, *ropeS, *b_merge;
    __device__ __forceinline__ void operator()(ACC_ARG, const pg8::Unit& u, int wr, int wc, int fr, int fq) const {
        const int pn = u.pn, rowb = u.pm * 256 + wr * 64 + fr;
        if (pn < 13) {
#pragma unroll
            for (int bj = 0; bj < 2; ++bj) {
                const int L0 = (4 * pn + 2 * bj + (wc >> 1)) * 64, a4 = 4 * (4 * (wc & 1) + fq);
                bf16* dst; int pitch, col0; bool rope = false; float sc = 1.f;
                if (L0 < 512) { dst = QA; pitch = 512; col0 = L0; rope = true; sc = C2_64; }
                else if (L0 < 1280) { const int kk = (L0 - 512) >> 7; dst = KV6 + (size_t)kk * NTOK * 128; pitch = 128; col0 = (L0 - 512) & 127; rope = !(kk & 1); }
                else if (L0 < 1792) { dst = QF; pitch = 512; col0 = L0 - 1280; sc = C2_64; }
                else if (L0 < 2304) { dst = KF; pitch = 512; col0 = L0 - 1792; }
                else if (L0 < 2816) { dst = VF; pitch = 512; col0 = L0 - 2304; }
                else { dst = QM; pitch = 512; col0 = L0 - 2816; sc = C2_128; }
                pg8::f32x4 cv[2][4], sv[2][4];
                if (rope) {
#pragma unroll
                    for (int ai = 0; ai < 2; ++ai)
#pragma unroll
                        for (int m = 0; m < 4; ++m) { const int t = (rowb + 128 * ai + 16 * m) & (SEQ - 1); cv[ai][m] = *(const pg8::f32x4*)(ropeC + t * 32 + a4); sv[ai][m] = *(const pg8::f32x4*)(ropeS + t * 32 + a4); }
                }
                __builtin_amdgcn_sched_barrier(0);
#pragma unroll
                for (int ai = 0; ai < 2; ++ai)
#pragma unroll
                    for (int m = 0; m < 4; ++m) {
                        const int r = rowb + 128 * ai + 16 * m;
                        pg8::f32x4 x1 = acc[ai][bj][m][0], x2 = acc[ai][bj][m][1];
                        if (rope) { const pg8::f32x4 c4 = cv[ai][m], s4 = sv[ai][m];
                            const pg8::f32x4 y1 = x1 * c4 - x2 * s4, y2 = x2 * c4 + x1 * s4; x1 = y1; x2 = y2; }
                        x1 = x1 * sc; x2 = x2 * sc;
                        bf16* p = dst + (size_t)r * pitch + col0 + a4;
                        *(u32x2*)p = (u32x2){cvtpk(x1[0], x1[1]), cvtpk(x1[2], x1[3])};
                        *(u32x2*)(p + 32) = (u32x2){cvtpk(x2[0], x2[1]), cvtpk(x2[2], x2[3])};
                    }
            }
        } else if (pn < 25) {
            pg8::f32x4 bv[2][2];
#pragma unroll
            for (int bj = 0; bj < 2; ++bj) { const int cg = 256 * (pn - 13) + 128 * bj + 32 * wc + 8 * fq; bv[bj][0] = *(const pg8::f32x4*)(b_merge + cg); bv[bj][1] = *(const pg8::f32x4*)(b_merge + cg + 4); }
            __builtin_amdgcn_sched_barrier(0);
#pragma unroll
            for (int bj = 0; bj < 2; ++bj) {
                const int cg = 256 * (pn - 13) + 128 * bj + 32 * wc + 8 * fq;
                const pg8::f32x4 b0 = bv[bj][0], b1 = bv[bj][1];
#pragma unroll
                for (int ai = 0; ai < 2; ++ai)
#pragma unroll
                    for (int m = 0; m < 4; ++m) {
                        const int r = rowb + 128 * ai + 16 * m;
                        const pg8::f32x4 v0 = acc[ai][bj][m][0] + b0, v1 = acc[ai][bj][m][1] + b1;
                        u32x2 w; unsigned p = 0u;
#pragma unroll
                        for (int k = 0; k < 4; ++k) p = __builtin_amdgcn_cvt_pk_u8_f32(fmaxf(255.f * fast_sigmoid(v0[k]), 1.f), k, p);
                        w.x = p; p = 0u;
#pragma unroll
                        for (int k = 0; k < 4; ++k) p = __builtin_amdgcn_cvt_pk_u8_f32(fmaxf(255.f * fast_sigmoid(v1[k]), 1.f), k, p);
                        w.y = p;
                        *(u32x2*)((unsigned char*)GATES + (size_t)r * 3072 + cg) = w;
                    }
            }
        } else if (pn == 25) {
            if (wc == 0) {
#pragma unroll
                for (int ai = 0; ai < 2; ++ai)
#pragma unroll
                    for (int m = 0; m < 4; ++m) {
                        const int r = rowb + 128 * ai + 16 * m;
                        float* p = LG + (size_t)r * 32 + 8 * fq;
                        *(pg8::f32x4*)p = acc[ai][0][m][0]; *(pg8::f32x4*)(p + 4) = acc[ai][0][m][1];
                    }
            }
        } else {
#pragma unroll
            for (int bj = 0; bj < 2; ++bj) {
                const int cgl = 256 * (pn - 26) + 128 * bj + 32 * wc + 8 * fq;
                bf16* dst = (cgl < 512) ? KMEM : VMEM; const int col = cgl & 511;
#pragma unroll
                for (int ai = 0; ai < 2; ++ai)
#pragma unroll
                    for (int m = 0; m < 4; ++m) {
                        const int r = rowb + 128 * ai + 16 * m - NTOK;
                        const pg8::f32x4 v0 = acc[ai][bj][m][0], v1 = acc[ai][bj][m][1];
                        u32x4 w; w.x = cvtpk(v0[0], v0[1]); w.y = cvtpk(v0[2], v0[3]); w.z = cvtpk(v1[0], v1[1]); w.w = cvtpk(v1[2], v1[3]);
                        *(u32x4*)(dst + (size_t)r * 512 + col) = w;
                    }
            }
        }
        ZERO_ACC();
    }
};

struct EpiBr {
    static constexpr bool ACC_INIT = false;
    const bf16* GATES; bf16* MERGED;
    __device__ __forceinline__ void operator()(ACC_ARG, const pg8::Unit& u, int wr, int wc, int fr, int fq) const {
        const int br = u.pn >> 2, tn = u.pn & 3, tm = u.pm & 63, rowb = tm * 256 + wr * 64 + fr;
        const unsigned char* gp = (const unsigned char*)GATES + (size_t)rowb * 3072 + 1024 * br + 256 * tn + 32 * wc + 8 * fq;
        u32x2 GA[2][4][2], GB[2][4][2];
#pragma unroll
        for (int ai = 0; ai < 2; ++ai)
#pragma unroll
            for (int m = 0; m < 4; ++m)
#pragma unroll
                for (int bj = 0; bj < 2; ++bj) { const unsigned char* p = gp + (size_t)(128 * ai + 16 * m) * 3072 + 128 * bj;
                    GA[ai][m][bj] = *(const u32x2*)p; GB[ai][m][bj] = (br < 2) ? *(const u32x2*)(p + 1024) : (u32x2){0u, 0u}; }
        __builtin_amdgcn_sched_barrier(0);
#pragma unroll
        for (int ai = 0; ai < 2; ++ai)
#pragma unroll
            for (int m = 0; m < 4; ++m) {
                const int r = rowb + 128 * ai + 16 * m;
#pragma unroll
                for (int bj = 0; bj < 2; ++bj) {
                    const int c0 = 256 * tn + 128 * bj + 32 * wc + 8 * fq;
                    const u32x2 ga = GA[ai][m][bj];
                    pg8::f32x4 g0 = {(float)(ga.x & 255u), (float)((ga.x >> 8) & 255u), (float)((ga.x >> 16) & 255u), (float)(ga.x >> 24)}, g1 = {(float)(ga.y & 255u), (float)((ga.y >> 8) & 255u), (float)((ga.y >> 16) & 255u), (float)(ga.y >> 24)};
#if defined(ABL_BR)
                    if (!((ABL_BR >> br) & 1)) { acc[ai][bj][m][0] = acc[ai][bj][m][0] * 0.f; acc[ai][bj][m][1] = acc[ai][bj][m][1] * 0.f; }
#endif
                    if (br < 2) {
                        const u32x2 gb = GB[ai][m][bj];
                        const pg8::f32x4 h0 = {(float)(gb.x & 255u), (float)((gb.x >> 8) & 255u), (float)((gb.x >> 16) & 255u), (float)(gb.x >> 24)}, h1 = {(float)(gb.y & 255u), (float)((gb.y >> 8) & 255u), (float)((gb.y >> 16) & 255u), (float)(gb.y >> 24)};
#pragma unroll
                        for (int k = 0; k < 4; ++k) { g0[k] = g0[k] * __builtin_amdgcn_rcpf(fmaxf(h0[k], 1.f)); g1[k] = g1[k] * __builtin_amdgcn_rcpf(fmaxf(h1[k], 1.f)); }
                        acc[ai][bj][m][0] = acc[ai][bj][m][0] * g0; acc[ai][bj][m][1] = acc[ai][bj][m][1] * g1;
                    } else {
                        const pg8::f32x4 v0 = acc[ai][bj][m][0] * g0 * (1.f / 255.f), v1 = acc[ai][bj][m][1] * g1 * (1.f / 255.f);
                        u32x4 w; w.x = cvtpk(v0[0], v0[1]); w.y = cvtpk(v0[2], v0[3]); w.z = cvtpk(v1[0], v1[1]); w.w = cvtpk(v1[2], v1[3]);
                        *(u32x4*)(MERGED + (size_t)r * 1024 + c0) = w;
                        acc[ai][bj][m][0] = (pg8::f32x4){0.f, 0.f, 0.f, 0.f}; acc[ai][bj][m][1] = (pg8::f32x4){0.f, 0.f, 0.f, 0.f};
                    }
                }
            }
    }
};

struct EpiOut {
    static constexpr bool ACC_INIT = true;
    const float* X; float* X1; unsigned char* XB8;
    __device__ __forceinline__ void init(ACC_ARG, const pg8::Unit& u, int wr, int wc, int fr, int fq) const {
        const size_t ob = (size_t)(u.pm * 256 + wr * 64 + fr) * 1024 + 256 * u.pn + 32 * wc + 8 * fq;
#pragma unroll
        for (int ai = 0; ai < 2; ++ai)
#pragma unroll
            for (int m = 0; m < 4; ++m)
#pragma unroll
                for (int bj = 0; bj < 2; ++bj) { const float* p = X + ob + (size_t)(128 * ai + 16 * m) * 1024 + 128 * bj; acc[ai][bj][m][0] = *(const pg8::f32x4*)p; acc[ai][bj][m][1] = *(const pg8::f32x4*)(p + 4); }
    }
    __device__ __forceinline__ void operator()(ACC_ARG, const pg8::Unit& u, int wr, int wc, int fr, int fq) const {
        const size_t ob = (size_t)(u.pm * 256 + wr * 64 + fr) * 1024 + 256 * u.pn + 32 * wc + 8 * fq;
#pragma unroll
        for (int ai = 0; ai < 2; ++ai)
#pragma unroll
            for (int m = 0; m < 4; ++m)
#pragma unroll
                for (int bj = 0; bj < 2; ++bj) {
                    const size_t o = ob + (size_t)(128 * ai + 16 * m) * 1024 + 128 * bj;
                    const pg8::f32x4 y0 = acc[ai][bj][m][0], y1 = acc[ai][bj][m][1];
                    *(pg8::f32x4*)(X1 + o) = y0; *(pg8::f32x4*)(X1 + o + 4) = y1;
                    *(u32x2*)(XB8 + o) = (u32x2){pk_fp8x4(y0[0], y0[1], y0[2], y0[3]), pk_fp8x4(y1[0], y1[1], y1[2], y1[3])};
                }
        ZERO_ACC();
    }
};

__device__ __forceinline__ float swiglu(float g, float uu) {
    g = fminf(g, 7.0f); uu = fminf(fmaxf(uu, -7.0f), 7.0f);
    return (uu + 1.0f) * g * __builtin_amdgcn_rcpf(1.0f + __builtin_amdgcn_exp2f(-1.702f * LOG2E * g));
}
struct EpiGU {
    static constexpr bool ACC_INIT = false;
    const float* bias; const LAS int* tile_e; unsigned char* ACT8; const float* erstd;
    __device__ __forceinline__ void operator()(ACC_ARG, const pg8::Unit& u, int wr, int wc, int fr, int fq) const {
        const int te_ = __builtin_amdgcn_readfirstlane(tile_e[u.pm]), e = te_ & 31, rowb = u.pm * 256 + wr * 64 + fr;
        const float* rslot = erstd + (size_t)e * NTOK + (te_ >> 5) * 256 - u.pm * 256;
        float rsv[2][4]; pg8::f32x4 bv[2][2];
#pragma unroll
        for (int ai = 0; ai < 2; ++ai)
#pragma unroll
            for (int m = 0; m < 4; ++m) rsv[ai][m] = rslot[rowb + 128 * ai + 16 * m];
#pragma unroll
        for (int bj = 0; bj < 2; ++bj) { const int c0 = 256 * u.pn + 128 * bj + 32 * wc + 8 * fq; bv[bj][0] = *(const pg8::f32x4*)(bias + (size_t)e * 2048 + c0); bv[bj][1] = *(const pg8::f32x4*)(bias + (size_t)e * 2048 + c0 + 4); }
        __builtin_amdgcn_sched_barrier(0);
#pragma unroll
        for (int bj = 0; bj < 2; ++bj) {
            const int c0 = 256 * u.pn + 128 * bj + 32 * wc + 8 * fq;
            const pg8::f32x4 b0 = bv[bj][0], b1 = bv[bj][1];
#pragma unroll
            for (int ai = 0; ai < 2; ++ai)
#pragma unroll
                for (int m = 0; m < 4; ++m) {
                    const int r = rowb + 128 * ai + 16 * m; const float rs = rsv[ai][m] * (1.0f / W8_SCALE);
                    const pg8::f32x4 v0 = acc[ai][bj][m][0] * rs + b0, v1 = acc[ai][bj][m][1] * rs + b1;
                    *(unsigned*)(ACT8 + (size_t)r * 1024 + (c0 >> 1)) = pk_fp8x4(ACT8_SCALE * swiglu(v0[0], v0[1]), ACT8_SCALE * swiglu(v0[2], v0[3]), ACT8_SCALE * swiglu(v1[0], v1[1]), ACT8_SCALE * swiglu(v1[2], v1[3]));
                }
        }
        ZERO_ACC();
    }
};
struct EpiDn {
    static constexpr bool ACC_INIT = false;
    const float* bias; const LAS int* tile_e; bf16* OS;
    __device__ __forceinline__ void operator()(ACC_ARG, const pg8::Unit& u, int wr, int wc, int fr, int fq) const {
        const int e = __builtin_amdgcn_readfirstlane(tile_e[u.pm]) & 31, rowb = u.pm * 256 + wr * 64 + fr;
        pg8::f32x4 bv[2][2];
#pragma unroll
        for (int bj = 0; bj < 2; ++bj) { const int c0 = 256 * u.pn + 128 * bj + 32 * wc + 8 * fq; bv[bj][0] = *(const pg8::f32x4*)(bias + (size_t)e * 1024 + c0); bv[bj][1] = *(const pg8::f32x4*)(bias + (size_t)e * 1024 + c0 + 4); }
        __builtin_amdgcn_sched_barrier(0);
#pragma unroll
        for (int bj = 0; bj < 2; ++bj) {
            const int c0 = 256 * u.pn + 128 * bj + 32 * wc + 8 * fq;
            const pg8::f32x4 b0 = bv[bj][0], b1 = bv[bj][1];
#pragma unroll
            for (int ai = 0; ai < 2; ++ai)
#pragma unroll
                for (int m = 0; m < 4; ++m) {
                    const int r = rowb + 128 * ai + 16 * m;
                    const pg8::f32x4 v0 = acc[ai][bj][m][0] * (1.0f / (W8_SCALE * ACT8_SCALE)) + b0, v1 = acc[ai][bj][m][1] * (1.0f / (W8_SCALE * ACT8_SCALE)) + b1;
                    u32x4 w; w.x = cvtpk(v0[0], v0[1]); w.y = cvtpk(v0[2], v0[3]); w.z = cvtpk(v1[0], v1[1]); w.w = cvtpk(v1[2], v1[3]);
                    *(u32x4*)(OS + (size_t)r * 1024 + c0) = w;
                }
        }
        ZERO_ACC();
    }
};
struct KArgs { const float* in[26]; float* out; unsigned char* ws; int ph_lo, ph_hi; };
struct Frame {
    LAS unsigned char* lds;
    int tid, lane, wave, G, bid, vcu;
    const KArgs __attribute__((address_space(4)))* ka; float* out; unsigned char* ws;
};
#define WSP(T, off) ((T*)(F.ws + (off)))

__device__ __forceinline__ int win_srccol(int n) {
    if (n < 3328) { const int p = n & 63, d = 4 * (p >> 3) + (p & 3) + 32 * ((p >> 2) & 1), L = (n & ~63) + d;
        if (L < 1280) return L; if (L < 1792) return 1304 + (L - 1280); if (L < 2304) return 1816 + (L - 1792); if (L < 2816) return 2328 + (L - 2304); return 2848 + (L - 2816); }
    if (n < 6400) return 3360 + (n - 3328);
    if (n < 6424) return 1280 + (n - 6400);
    if (n < 6432) return 2840 + (n - 6424);
    return -1;
}
__device__ __forceinline__ void transpose_item(const float* __restrict__ W, int N, bf16* __restrict__ Wt, int Kd, int n0, int k0, int sc, LAS float* scr, int lane, const float* __restrict__ kscale = nullptr) {
    const float* src = W + (size_t)k0 * N + (sc >= 0 ? sc : 0);
    float v[64];
#pragma unroll
    for (int kk = 0; kk < 64; ++kk) v[kk] = src[(size_t)kk * N];
    if (kscale) {
#pragma unroll
        for (int kk = 0; kk < 64; ++kk) v[kk] *= kscale[k0 + kk];
    }
#pragma unroll
    for (int kk = 0; kk < 64; ++kk) scr[kk * 65 + lane] = (sc >= 0) ? v[kk] : 0.f;
    asm volatile("s_waitcnt lgkmcnt(0)" ::: "memory");
    const int c = lane & 7;
#pragma unroll
    for (int j = 0; j < 8; ++j) { const int n = (lane >> 3) + 8 * j; const LAS float* s = scr + (8 * c) * 65 + n;
        u32x4 o; o.x = cvtpk(s[0], s[65]); o.y = cvtpk(s[2 * 65], s[3 * 65]); o.z = cvtpk(s[4 * 65], s[5 * 65]); o.w = cvtpk(s[6 * 65], s[7 * 65]);
        *(u32x4*)(Wt + (size_t)(n0 + n) * Kd + k0 + 8 * c) = o; }
    asm volatile("s_waitcnt lgkmcnt(0)" ::: "memory");
}
__device__ __forceinline__ void transpose_item8(const float* __restrict__ W, int N, unsigned char* __restrict__ Wt8, int Kd, int n0, int k0, LAS unsigned char* scr, int lane, const float* __restrict__ kscale, float mul) {
    const float* src = W + (size_t)k0 * N + n0 + lane;
#pragma unroll
    for (int half = 0; half < 2; ++half) {
        float v[64];
#pragma unroll
        for (int kk = 0; kk < 64; ++kk) v[kk] = src[(size_t)(64 * half + kk) * N];
#pragma unroll
        for (int kk = 0; kk < 64; ++kk) v[kk] *= kscale ? mul * kscale[k0 + 64 * half + kk] : mul;
#pragma unroll
        for (int j = 0; j < 32; ++j) { const float a = fminf(fmaxf(v[2 * j], -448.f), 448.f), b = fminf(fmaxf(v[2 * j + 1], -448.f), 448.f);
            *(LAS unsigned short*)(scr + lane * 132 + 64 * half + 2 * j) = (unsigned short)__builtin_amdgcn_cvt_pk_fp8_f32(a, b, 0, false); }
    }
    asm volatile("s_waitcnt lgkmcnt(0)" ::: "memory");
    const int c = lane & 7;
#pragma unroll
    for (int j = 0; j < 8; ++j) { const int n = (lane >> 3) + 8 * j; const LAS unsigned* s = (const LAS unsigned*)(scr + n * 132 + 16 * c);
        u32x4 o; o.x = s[0]; o.y = s[1]; o.z = s[2]; o.w = s[3];
        *(u32x4*)(Wt8 + (size_t)(n0 + n) * Kd + k0 + 16 * c) = o; }
    asm volatile("s_waitcnt lgkmcnt(0)" ::: "memory");
}
__device__ __forceinline__ void rms_row_bf16(const float* __restrict__ xrow, const float* __restrict__ g, bf16* __restrict__ orow, int lane) {
    const f32x4* xr = (const f32x4*)xrow + lane; const f32x4* gr = (const f32x4*)g + lane;
    f32x4 v[4]; float s = 0.f;
#pragma unroll
    for (int j = 0; j < 4; ++j) { v[j] = xr[64 * j]; s += (v[j].x * v[j].x + v[j].y * v[j].y) + (v[j].z * v[j].z + v[j].w * v[j].w); }
    const float rstd = 1.0f / sqrtf(wave_sum(s) * (1.f / 1024.f) + RMS_EPS);
    u32x2* o8 = (u32x2*)orow + lane;
#pragma unroll
    for (int j = 0; j < 4; ++j) { const f32x4 gg = gr[64 * j]; o8[64 * j] = (u32x2){cvtpk(v[j].x * rstd * gg.x, v[j].y * rstd * gg.y), cvtpk(v[j].z * rstd * gg.z, v[j].w * rstd * gg.w)}; }
}
__device__ __forceinline__ void sincos_big(float ang, float& s, float& c) {
    const double x = (double)ang; const double kf = __builtin_rint(x * 0.63661977236758134308); const int k = (int)kf;
    const double r = (x - kf * 1.57079632679489655800) - kf * 6.123233995736766036e-17, r2 = r * r;
    const double sp = r * (1.0 + r2 * (-1.0 / 6 + r2 * (1.0 / 120 + r2 * (-1.0 / 5040 + r2 * (1.0 / 362880 - r2 * (1.0 / 39916800))))));
    const double cp = 1.0 + r2 * (-0.5 + r2 * (1.0 / 24 + r2 * (-1.0 / 720 + r2 * (1.0 / 40320 + r2 * (-1.0 / 3628800 + r2 * (1.0 / 479001600))))));
    const double ss = (k & 1) ? cp : sp, cc = (k & 1) ? sp : cp;
    s = (float)((k & 2) ? -ss : ss); c = (float)(((k + 1) & 2) ? -cc : cc);
}
__device__ __forceinline__ void attn_unit_desc(int i, unsigned& desc, int& cost) {
    if (i < 512) { const int bg = i >> 6, T = i & 63; desc = 0u | (bg << 3) | (T << 11); cost = 8 + (T + 1) + (T < 8 ? T + 1 : 9) + 2 * (T / 4 + 1); }
    else { const int j = i - 512, bh = j >> 4, qb = j & 15; desc = 1u | (bh << 3) | (qb << 11); cost = 3 + 4 * qb + 3; }
}
constexpr int N_SORTED = 1024, MAXCOST = 128, N_CVT_UNITS = 256, CVT_CHUNK = 12;
constexpr int Q_CMP0 = 0, Q_CUM0 = 128, Q_CVT0 = 132, Q_MEM0 = Q_CVT0 + N_CVT_UNITS, Q_SRT0 = Q_MEM0 + 256, N_QUEUE = Q_SRT0 + N_SORTED;
constexpr int CW_CMPDONE = 8192, CW_CUMDONE = 8192 + 64 * 8;

__device__ __forceinline__ void p0_prologue(Frame& F) {
    LAS float* scr = (LAS float*)(F.lds + F.wave * 16640);
    const int gw = F.vcu * NWAVES + F.wave, NGW = F.G * NWAVES, lane = F.lane;
    bf16* HA = WSP(bf16, WS_HA);
    for (int m0 = gw; m0 < NTOK + NMEMROW; m0 += 4 * NGW) {
        f32x4 v[4][4]; float ss[4]; const float* xr[4]; bool has[4];
#pragma unroll
        for (int q = 0; q < 4; ++q) { const int m = m0 + q * NGW; has[q] = m < NTOK + NMEMROW; const int mm = has[q] ? m : m0;
            xr[q] = (mm < NTOK) ? F.ka->in[0] + (size_t)mm * DM : F.ka->in[1] + (size_t)(mm - NTOK) * DM; }
#pragma unroll
        for (int j = 0; j < 4; ++j)
#pragma unroll
            for (int q = 0; q < 4; ++q) v[q][j] = ((const f32x4*)xr[q])[64 * j + lane];
#pragma unroll
        for (int q = 0; q < 4; ++q) { float s_ = 0.f;
#pragma unroll
            for (int j = 0; j < 4; ++j) s_ += (v[q][j].x * v[q][j].x + v[q][j].y * v[q][j].y) + (v[q][j].z * v[q][j].z + v[q][j].w * v[q][j].w);
            ss[q] = s_; }
#pragma unroll
        for (int o = 1; o < 64; o <<= 1) {
#pragma unroll
            for (int q = 0; q < 4; ++q) ss[q] += __shfl_xor(ss[q], o); }
#pragma unroll
        for (int q = 0; q < 4; ++q) { const int m = m0 + q * NGW; const float r = 1.0f / sqrtf(ss[q] * (1.f / 1024.f) + RMS_EPS);
            const f32x4* g = (const f32x4*)((m < NTOK) ? F.ka->in[2] : F.ka->in[12]);
            if (has[q]) {
#pragma unroll
                for (int j = 0; j < 4; ++j) { const f32x4 a = g[64 * j + lane];
                    ((u32x2*)(HA + (size_t)m * DM))[64 * j + lane] = (u32x2){cvtpk(v[q][j].x * r * a.x, v[q][j].y * r * a.y), cvtpk(v[q][j].z * r * a.z, v[q][j].w * r * a.w)}; } } }
    }
    constexpr int I_WIN = 104 * 16, I_MKV = 16 * 16, I_BR = 16 * 8, I_OUT = 256, I_W1 = 32, I_W2 = 1;
    constexpr int NITEMS = I_WIN + I_MKV + 3 * I_BR + I_OUT + 2 * I_W1 + 2 * I_W2;
    for (int it = gw; it < NITEMS; it += NGW) {
        int r = it;
        if (r < I_WIN) { const int kt = r / 104, nt = r - kt * 104; transpose_item(F.ka->in[3], DIN, WSP(bf16, WS_WIN_T), 1024, nt * 64, kt * 64, win_srccol(nt * 64 + lane), scr, lane); continue; } r -= I_WIN;
        if (r < I_MKV) { const int kt = r >> 4, nt = r & 15; transpose_item(F.ka->in[13], 1024, WSP(bf16, WS_WIN_T) + (size_t)NIN * 1024, 1024, nt * 64, kt * 64, nt * 64 + lane, scr, lane); continue; } r -= I_MKV;
        if (r < 3 * I_BR) { const int b = r / I_BR, q = r - b * I_BR, kt = q >> 4, nt = q & 15; transpose_item(b == 0 ? F.ka->in[14] : (b == 1 ? F.ka->in[15] : F.ka->in[16]), 1024, WSP(bf16, WS_WBR_T) + (size_t)b * 1024 * 512, 512, nt * 64, kt * 64, nt * 64 + lane, scr, lane); continue; } r -= 3 * I_BR;
        if (r < I_OUT) { const int kt = r >> 4, nt = r & 15; transpose_item(F.ka->in[17], 1024, WSP(bf16, WS_WOUT_T), 1024, nt * 64, kt * 64, nt * 64 + lane, scr, lane); continue; } r -= I_OUT;
        if (r < 2 * I_W1) { const int b = r / I_W1, kt = r - b * I_W1; transpose_item(b ? F.ka->in[10] : F.ka->in[7], 64, b ? WSP(bf16, WS_W1T_V) : WSP(bf16, WS_W1T_K), 2048, 0, kt * 64, lane, scr, lane); continue; } r -= 2 * I_W1;
        { transpose_item(r ? F.ka->in[11] : F.ka->in[8], 64, r ? WSP(bf16, WS_W2T_V) : WSP(bf16, WS_W2T_K), 64, 0, 0, lane, scr, lane); }
    }
    { float* rc = WSP(float, WS_ROPE_C); float* rs = WSP(float, WS_ROPE_S);
      for (int idx = F.bid * NTHREADS + F.tid; idx < SEQ * 32; idx += F.G * NTHREADS) { const int t = idx >> 5, i = idx & 31;
          const float inv = exp2f(-(float)i * (13.287712379549449f / 32.0f)); const float ang = (float)t * inv; float s, c; sincos_big(ang, s, c); rc[idx] = c; rs[idx] = s; } }
    { bf16* wrh = WSP(bf16, WS_WRT); const float* wr = F.ka->in[19]; const float* gf = F.ka->in[18];
      for (int idx = F.bid * NTHREADS + F.tid; idx < 32 * 1024; idx += F.G * NTHREADS) { const int e = idx >> 10, k = idx & 1023; const float v = wr[k * 32 + e] * gf[k];
          const unsigned h = cvtpk(v, 0.f) & 0xffffu; const float lo = v - bflo(h); wrh[idx] = (bf16)h; wrh[32 * 1024 + idx] = (bf16)(cvtpk(lo, 0.f) & 0xffffu); } }
    if (gw >= NGW - 128) { const int j = gw - (NGW - 128), kv = j >> 6, part = j & 63; const float* pe = kv ? F.ka->in[9] : F.ka->in[6]; const float* w1 = kv ? F.ka->in[10] : F.ka->in[7]; float a = 0.f;
#pragma unroll 16
        for (int k = part * 32; k < part * 32 + 32; ++k) a += pe[k] * w1[k * 64 + lane];
        WSP(float, WS_CPE)[(kv * 64 + part) * 64 + lane] = a; }
    if (F.bid == 0) {
        __syncthreads();
        LAS int* hist = (LAS int*)F.lds;
        LAS unsigned* sorted = (LAS unsigned*)(hist + 3 * MAXCOST);
        for (int i = F.tid; i < 3 * MAXCOST; i += NTHREADS) hist[i] = 0;
        __syncthreads();
        for (int i = F.tid; i < N_SORTED; i += NTHREADS) { unsigned d; int c; attn_unit_desc(i, d, c); atomicAdd((int*)(hist + c), 1); }
        __syncthreads();
        if (F.tid < MAXCOST) { int run = 0; for (int c = F.tid + 1; c < MAXCOST; ++c) run += hist[c]; hist[MAXCOST + F.tid] = run; }
        __syncthreads();
        for (int i = F.tid; i < N_SORTED; i += NTHREADS) { unsigned d; int c; attn_unit_desc(i, d, c); const int pos = hist[MAXCOST + c] + atomicAdd((int*)(hist + 2 * MAXCOST + c), 1); sorted[pos] = d; }
        __syncthreads();
        unsigned* order = WSP(unsigned, WS_ORDER);
        for (int i = F.tid; i < N_QUEUE; i += NTHREADS) {
            unsigned d;
            if (i < Q_CUM0) d = 3u | ((unsigned)(i >> 6) << 3) | ((unsigned)(i & 63) << 11);
            else if (i < Q_CVT0) d = 4u | ((unsigned)(i - Q_CUM0) << 3);
            else if (i < Q_MEM0) d = 5u | ((unsigned)(i - Q_CVT0) << 11);
            else if (i < Q_SRT0) { const int j = i - Q_MEM0; d = 2u | ((unsigned)(j >> 4) << 3) | ((unsigned)(j & 15) << 11); }
            else d = sorted[i - Q_SRT0];
            order[i] = d;
        }
        __syncthreads();
    }
}

struct CvtItem { const float* src; unsigned char* dst; const float* ks; int N; };
__device__ __forceinline__ CvtItem cvt_item(Frame& F, int g, int wv, int lane) {
    const int e = g / 96, q = g - e * 96; CvtItem I;
    if (q < 64) { const int kt = q >> 3, ng = (q + kt + e) & 7, k0 = kt * 128 + 16 * wv, n0 = ng * 256 + 4 * lane;
        I.src = F.ka->in[21] + (size_t)e * 1024 * 2048 + (size_t)k0 * 2048 + n0; I.N = 2048; I.dst = WSP(unsigned char, WS_WGU_T) + (size_t)e * 2048 * 1024 + (size_t)n0 * 1024 + k0; I.ks = F.ka->in[18] + k0; }
    else { const int q2 = q - 64, kt = q2 >> 2, ng = (q2 + kt + e) & 3, k0 = kt * 128 + 16 * wv, n0 = ng * 256 + 4 * lane;
        I.src = F.ka->in[23] + (size_t)e * 1024 * 1024 + (size_t)k0 * 1024 + n0; I.N = 1024; I.dst = WSP(unsigned char, WS_WD_T) + (size_t)e * 1024 * 1024 + (size_t)n0 * 1024 + k0; I.ks = nullptr; }
    return I;
}
__device__ __forceinline__ void cvt_load(f32x4 (&v)[16], const CvtItem& I) {
#pragma unroll
    for (int kk = 0; kk < 16; ++kk) v[kk] = *(const f32x4*)(I.src + (size_t)kk * I.N);
}
__device__ __forceinline__ void cvt_store(const f32x4 (&v)[16], const CvtItem& I) {
    float sc[16];
#pragma unroll
    for (int kk = 0; kk < 16; ++kk) sc[kk] = I.ks ? W8_SCALE * I.ks[kk] : W8_SCALE;
#pragma unroll
    for (int j = 0; j < 4; ++j) { u32x4 o;
#pragma unroll
        for (int q = 0; q < 4; ++q) o[q] = pk_fp8x4(v[4 * q][j] * sc[4 * q], v[4 * q + 1][j] * sc[4 * q + 1], v[4 * q + 2][j] * sc[4 * q + 2], v[4 * q + 3][j] * sc[4 * q + 3]);
        *(u32x4*)(I.dst + (size_t)j * 1024) = o; }
}
__device__ __forceinline__ void convert_unit(Frame& F, int cu) {
    int tid_ = threadIdx.x; asm volatile("" : "+v"(tid_)); const int lane = tid_ & 63, wv = __builtin_amdgcn_readfirstlane(tid_ >> 6);
    f32x4 a[16], b[16];
    CvtItem Ia = cvt_item(F, cu * CVT_CHUNK, wv, lane), Ib; cvt_load(a, Ia);
#pragma clang loop unroll(disable)
    for (int bi = 0; bi < CVT_CHUNK; bi += 2) {
        Ib = cvt_item(F, cu * CVT_CHUNK + bi + 1, wv, lane); cvt_load(b, Ib);
        cvt_store(a, Ia);
        if (bi + 2 < CVT_CHUNK) { Ia = cvt_item(F, cu * CVT_CHUNK + bi + 2, wv, lane); cvt_load(a, Ia); }
        cvt_store(b, Ib);
    }
}
__device__ __forceinline__ void q_signal(unsigned* p, int tid) {
    asm volatile("s_waitcnt vmcnt(0)" ::: "memory"); __syncthreads();
    if (tid == 0) { __builtin_amdgcn_fence(__ATOMIC_RELEASE, "agent"); asm volatile("s_waitcnt vmcnt(0)" ::: "memory"); __hip_atomic_fetch_add(p, 1u, __ATOMIC_RELAXED, __HIP_MEMORY_SCOPE_AGENT); }
}
__device__ __forceinline__ void q_wait(unsigned* p, unsigned want, int tid) {
    if (tid == 0) { unsigned sp = 0; while (__hip_atomic_load(p, __ATOMIC_RELAXED, __HIP_MEMORY_SCOPE_AGENT) < want && ++sp < (1u << 24)) __builtin_amdgcn_s_sleep(2);
        __builtin_amdgcn_fence(__ATOMIC_ACQUIRE, "agent"); asm volatile("s_waitcnt vmcnt(0)" ::: "memory"); }
    __syncthreads();
}

__device__ __forceinline__ void p2_compress_unit(Frame& F, int kv, int rt) {
    int tid_ = threadIdx.x; asm volatile("" : "+v"(tid_)); const int lane = tid_ & 63, w = __builtin_amdgcn_readfirstlane(tid_ >> 6), r32 = lane & 31, hi = lane >> 5;
    const bf16* src = WSP(bf16, WS_KV6) + (size_t)kv * NTOK * 128;
    const bf16* w1t = WSP(bf16, kv ? WS_W1T_V : WS_W1T_K); const bf16* w2t = WSP(bf16, kv ? WS_W2T_V : WS_W2T_K);
    const int R = rt * 32 + r32, bg = R >> 8, n = R & 255, b = bg >> 1, g = bg & 1;
    f32x16 acc0 = {}, acc1 = {};
#pragma unroll 4
    for (int st = 0; st < 16; ++st) {
        const int step = w * 16 + st, l = step >> 2, d = 16 * (step & 3) + 8 * hi;
        int tok = 16 * n + l; tok = tok < SEQ ? tok : SEQ - 1;
        const bf16x8 a = *(const bf16x8*)(src + ((size_t)(b * SEQ + tok)) * 128 + g * 64 + d);
        const bf16x8 b0 = *(const bf16x8*)(w1t + (size_t)r32 * 2048 + 16 * step + 8 * hi);
        const bf16x8 b1 = *(const bf16x8*)(w1t + (size_t)(32 + r32) * 2048 + 16 * step + 8 * hi);
        acc0 = __builtin_amdgcn_mfma_f32_32x32x16_bf16(a, b0, acc0, 0, 0, 0);
        acc1 = __builtin_amdgcn_mfma_f32_32x32x16_bf16(a, b1, acc1, 0, 0, 0);
    }
    LAS float* red = (LAS float*)F.lds;
    LAS bf16* zs = (LAS bf16*)(F.lds + 65536);
    __syncthreads();
#pragma unroll
    for (int r = 0; r < 16; ++r) { const int row = (r & 3) + 8 * (r >> 2) + 4 * hi; red[(w * 32 + row) * 64 + r32] = acc0[r]; red[(w * 32 + row) * 64 + 32 + r32] = acc1[r]; }
    __syncthreads();
    const float* cpe = WSP(float, WS_CPE) + kv * 4096;
    for (int idx = F.tid; idx < 2048; idx += NTHREADS) { float z = 0.f;
#pragma unroll
        for (int pp = 0; pp < 64; ++pp) z += cpe[pp * 64 + (idx & 63)];
#pragma unroll
        for (int ww = 0; ww < 8; ++ww) z += red[ww * 2048 + idx];
        const float sl = z * fast_sigmoid(z); zs[idx] = (bf16)(cvtpk(sl, 0.f) & 0xffffu); }
    __syncthreads();
    if (w < 2) {
        f32x16 o = {};
#pragma unroll
        for (int st = 0; st < 4; ++st) {
            const bf16x8 a = *(const LAS bf16x8*)(zs + r32 * 64 + 16 * st + 8 * hi);
            const bf16x8 bb = *(const bf16x8*)(w2t + (size_t)(32 * w + r32) * 64 + 16 * st + 8 * hi);
            o = __builtin_amdgcn_mfma_f32_32x32x16_bf16(a, bb, o, 0, 0, 0);
        }
        const int rbase = rt * 32;
#pragma unroll
        for (int r = 0; r < 16; ++r) { const int row = (r & 3) + 8 * (r >> 2) + 4 * hi, RR = rbase + row, nn = RR & 255;
            const float v = (nn == 255) ? 0.f : o[r];
            if (kv == 0) WSP(bf16, WS_KCMP)[(size_t)RR * 64 + 32 * w + r32] = (bf16)(cvtpk(v, 0.f) & 0xffffu);
            else WSP(bf16, WS_VCMP)[(size_t)RR * 128 + 32 * w + r32] = (bf16)(cvtpk(v, 0.f) & 0xffffu); }
    } else if (kv == 1) {
        for (int idx = F.tid - 128; idx < 2048; idx += NTHREADS - 128) { const int row = idx >> 6, j = idx & 63, RR = rt * 32 + row, nn = RR & 255;
            const bool ov = (nn != 255) && (nn >= 4 * j - 1) && (nn <= 4 * j + 3);
            WSP(bf16, WS_VCMP)[(size_t)RR * 128 + 64 + j] = ov ? (bf16)0x3f80 : (bf16)0; }
    }
    __syncthreads();
}
__device__ __forceinline__ float log_sigmoid_f(float x) { return fminf(x, 0.f) - log1pf(expf(-fabsf(x))); }
__device__ __forceinline__ void p2_cumsum_unit(Frame& F, int bh) {
    const int lane = F.lane, b = bh >> 3, h = bh & 7; const float bf = F.ka->in[4][h];
    const float* lg = WSP(float, WS_LG) + (size_t)(b * SEQ + 64 * lane) * 32 + 24 + h;
    double tot = 0.0;
    for (int i = 0; i < 64; ++i) tot += (double)log_sigmoid_f(lg[(size_t)i * 32] + bf);
    double inc = tot;
#pragma unroll
    for (int o = 1; o < 64; o <<= 1) { const double v = __shfl_up(inc, o); if (lane >= o) inc += v; }
    double run = inc - tot;
    float* cum = WSP(float, WS_CUM) + (size_t)bh * SEQ + 64 * lane;
    for (int i = 0; i < 64; ++i) { run += (double)log_sigmoid_f(lg[(size_t)i * 32] + bf); cum[i] = (float)(run * 1.4426950408889634); }
    const bf16* kf = WSP(bf16, WS_KF) + (size_t)b * SEQ * 512 + h * 64; float km = 0.f;
#pragma unroll 4
    for (int i = 0; i < 64; ++i) { const u32x4* p = (const u32x4*)(kf + (size_t)(64 * i + lane) * 512); float s = 0.f;
#pragma unroll
        for (int c = 0; c < 8; ++c) { const u32x4 v = p[c]; s += (bflo(v.x) * bflo(v.x) + bfhi(v.x) * bfhi(v.x)) + (bflo(v.y) * bflo(v.y) + bfhi(v.y) * bfhi(v.y)) + (bflo(v.z) * bflo(v.z) + bfhi(v.z) * bfhi(v.z)) + (bflo(v.w) * bflo(v.w) + bfhi(v.w) * bfhi(v.w)); }
        km = fmaxf(km, s); }
#pragma unroll
    for (int o = 1; o < 64; o <<= 1) km = fmaxf(km, __shfl_xor(km, o));
    if (lane == 0) WSP(float, WS_KMAX)[bh] = sqrtf(km) * 1.001f;
}

__device__ __forceinline__ void p6_phase(Frame& F) {
    const int lane = F.lane, w = F.wave, r32 = lane & 31, hi = lane >> 5, grp = w >> 2, kq = w & 3;
    LAS float* red = (LAS float*)F.lds;
    LAS float* ssl = (LAS float*)(F.lds + 32768);
    LAS int* lcnt = (LAS int*)(F.lds + 36864);
    const float* X1 = F.out; const float* brt = F.ka->in[20];
    const bf16* whT = WSP(bf16, WS_WRT); const bf16* wlT = whT + 32 * 1024;
    int* tope = WSP(int, WS_ROUTE); float* topg = (float*)(tope + NTOK * 4); int* lrank = tope + NTOK * 8; float* rstdg = WSP(float, WS_RSTD);
    for (int tile = F.bid; tile < NTOK / 64; tile += F.G) {
        if (F.tid < 32) lcnt[F.tid] = 0;
        const float* xrow = X1 + (size_t)(tile * 64 + grp * 32 + r32) * DM + 8 * hi + 256 * kq;
        const bf16* whp = whT + (size_t)r32 * 1024 + 8 * hi + 256 * kq; const bf16* wlp = wlT + (size_t)r32 * 1024 + 8 * hi + 256 * kq;
        f32x16 acc = f32x16{}; float ss = 0.f;
        f32x4 xa[16], xb[16];
#pragma unroll
        for (int s = 0; s < 16; ++s) { xa[s] = *(const f32x4*)(xrow + 16 * s); xb[s] = *(const f32x4*)(xrow + 16 * s + 4); }
#pragma unroll
        for (int sb = 0; sb < 2; ++sb) {
            bf16x8 wh[8], wl[8];
#pragma unroll
            for (int s = 0; s < 8; ++s) { const int o = 16 * (8 * sb + s); wh[s] = *(const bf16x8*)(whp + o); wl[s] = *(const bf16x8*)(wlp + o); }
#pragma unroll
            for (int s = 0; s < 8; ++s) {
                const f32x4 a = xa[8 * sb + s], b = xb[8 * sb + s];
                ss += (a.x * a.x + a.y * a.y) + (a.z * a.z + a.w * a.w) + (b.x * b.x + b.y * b.y) + (b.z * b.z + b.w * b.w);
                u32x4 h; h.x = cvtpk(a.x, a.y); h.y = cvtpk(a.z, a.w); h.z = cvtpk(b.x, b.y); h.w = cvtpk(b.z, b.w);
                u32x4 l; l.x = cvtpk(a.x - bflo(h.x), a.y - bfhi(h.x)); l.y = cvtpk(a.z - bflo(h.y), a.w - bfhi(h.y)); l.z = cvtpk(b.x - bflo(h.z), b.y - bfhi(h.z)); l.w = cvtpk(b.z - bflo(h.w), b.w - bfhi(h.w));
                const bf16x8 hv = __builtin_bit_cast(bf16x8, h), lv = __builtin_bit_cast(bf16x8, l);
                acc = __builtin_amdgcn_mfma_f32_32x32x16_bf16(hv, wh[s], acc, 0, 0, 0);
                acc = __builtin_amdgcn_mfma_f32_32x32x16_bf16(lv, wh[s], acc, 0, 0, 0);
                acc = __builtin_amdgcn_mfma_f32_32x32x16_bf16(hv, wl[s], acc, 0, 0, 0);
            }
        }
#pragma unroll
        for (int r = 0; r < 16; ++r) red[(w * 16 + r) * 64 + lane] = acc[r];
        ssl[w * 64 + lane] = ss;
        __syncthreads();
        LAS float* lgt = (LAS float*)(F.lds + 40960);
        LAS float* rsl = (LAS float*)(F.lds + 40960 + 64 * 33 * 4);
        LAS float* topv = rsl + 64;
        LAS int* tope_l = (LAS int*)(topv + 256);
        if (kq == 0) {
#pragma unroll
            for (int r = 0; r < 16; ++r) acc[r] = (red[(w * 16 + r) * 64 + lane] + red[((w + 1) * 16 + r) * 64 + lane]) + (red[((w + 2) * 16 + r) * 64 + lane] + red[((w + 3) * 16 + r) * 64 + lane]);
            ss = (ssl[w * 64 + lane] + ssl[(w + 1) * 64 + lane]) + (ssl[(w + 2) * 64 + lane] + ssl[(w + 3) * 64 + lane]);
            ss += __shfl_xor(ss, 32);
            const float rstd = 1.0f / sqrtf(ss * (1.f / 1024.f) + RMS_EPS);
            if (hi == 0) { rstdg[tile * 64 + grp * 32 + r32] = rstd; rsl[grp * 32 + r32] = rstd; }
#pragma unroll
            for (int r = 0; r < 16; ++r) { const int rowl = (r & 3) + 8 * (r >> 2) + 4 * hi; lgt[(grp * 32 + rowl) * 33 + r32] = acc[r]; }
        }
        __syncthreads();
#pragma unroll
        for (int it = 0; it < 4; ++it) {
            const int row = it * 16 + (F.tid >> 5), e = F.tid & 31;
            const float rs = rsl[row]; const float mine = lgt[row * 33 + e] * rs + brt[e];
            int rank = 0;
#pragma unroll
            for (int j = 0; j < 32; ++j) { const float v = lgt[row * 33 + j] * rs + brt[j]; rank += (v > mine || (v == mine && j < e)) ? 1 : 0; }
            if (rank < 4) { topv[row * 4 + rank] = mine; tope_l[row * 4 + rank] = e; }
        }
        __syncthreads();
        int ee4[4], lr4[4];
        if (F.tid < 64) { const int row = F.tid, t = tile * 64 + row;
            const float v0 = topv[row * 4], e1 = expf(topv[row * 4 + 1] - v0), e2 = expf(topv[row * 4 + 2] - v0), e3 = expf(topv[row * 4 + 3] - v0); const float inv = 1.0f / (1.0f + e1 + e2 + e3);
            const float gs[4] = {inv, e1 * inv, e2 * inv, e3 * inv};
#pragma unroll
            for (int k = 0; k < 4; ++k) { const int ee = tope_l[row * 4 + k]; tope[t * 4 + k] = ee; topg[t * 4 + k] = gs[k]; ee4[k] = ee; lr4[k] = atomicAdd((int*)(lcnt + ee), 1); } }
        __syncthreads();
        if (F.tid < 32) { const int c = lcnt[F.tid]; lcnt[32 + F.tid] = c ? (int)__hip_atomic_fetch_add(WSP(unsigned, WS_CTL) + CW_GCNT + 32 * F.tid, (unsigned)c, __ATOMIC_RELAXED, __HIP_MEMORY_SCOPE_AGENT) : 0; }
        __syncthreads();
        if (F.tid < 64) { const int row = F.tid, t = tile * 64 + row; const float rs_ = rsl[row];
#pragma unroll
            for (int k = 0; k < 4; ++k) { const int rk = lcnt[32 + ee4[k]] + lr4[k]; lrank[t * 4 + k] = rk; WSP(int, WS_ETOK)[ee4[k] * NTOK + rk] = t; WSP(float, WS_ERSTD)[ee4[k] * NTOK + rk] = rs_; } }
        __syncthreads();
    }
}

__device__ __forceinline__ void p7_phase(Frame& F) {
    LAS int* part = (LAS int*)F.lds;
    LAS int* tot = part + 1024; LAS int* pre = tot + 32; LAS int* pstart = pre + 32; LAS int* slotl = pstart + 32;
    const int* blkcnt = WSP(int, WS_BLKCNT);
    int* tope = WSP(int, WS_ROUTE); int* lrank = tope + NTOK * 8; int* slot = tope + NTOK * 12;
    const float* rstdg = WSP(float, WS_RSTD); float* rslot = WSP(float, WS_RSLOT); int* slottok = WSP(int, WS_SLOTTOK);
    for (int tile = F.bid; tile < NTOK / 64; tile += F.G) {
        __syncthreads();
        { const int e = F.tid & 31, p = F.tid >> 5; int st = 0, sp = 0;
          for (int tt = p; tt < NTOK / 64; tt += 16) { const int c = blkcnt[tt * 32 + e]; st += c; if (tt < tile) sp += c; }
          part[p * 32 + e] = st; part[512 + p * 32 + e] = sp; }
        __syncthreads();
        if (F.tid < 32) { int st = 0, sp = 0;
#pragma unroll
            for (int p = 0; p < 16; ++p) { st += part[p * 32 + F.tid]; sp += part[512 + p * 32 + F.tid]; }
            tot[F.tid] = st; pre[F.tid] = sp; }
        __syncthreads();
        if (F.tid == 0) { int run = 0; for (int e = 0; e < 32; ++e) { pstart[e] = run; run += (tot[e] + 255) & ~255; }
            if (tile == 0) { int* te = WSP(int, WS_TILE_E); int j = 0; for (int e = 0; e < 32; ++e) { const int nte = (tot[e] + 255) >> 8; for (int q = 0; q < nte; ++q) te[j++] = e; } te[500] = j; } }
        __syncthreads();
        if (F.tid < 256) { const int a = tile * 256 + F.tid; const int e = tope[a]; const int s = pstart[e] + pre[e] + lrank[a]; slot[a] = s; rslot[s] = rstdg[tile * 64 + (F.tid >> 2)]; slottok[s] = tile * 64 + (F.tid >> 2); }
    }
}

__device__ __forceinline__ void p10_phase(Frame& F, bool with_moe, float* dsto) {
    const int gw = F.vcu * NWAVES + F.wave, NGW = F.G * NWAVES, lane = F.lane;
    const int* tope = WSP(int, WS_ROUTE); const float* topg = (const float*)(tope + NTOK * 4); const int* rank = tope + NTOK * 8;
    const LAS int* pstart = (const LAS int*)(F.lds + MT_OFF) + 320;
    const bf16* OS = WSP(bf16, WS_AMOE); const float* gfin = F.ka->in[25];
    for (int t = gw; t < NTOK; t += NGW) {
        const f32x4* xr = (const f32x4*)((with_moe ? F.out : F.ka->in[0]) + (size_t)t * DM) + lane;
        f32x4 v[4];
#pragma unroll
        for (int j = 0; j < 4; ++j) v[j] = xr[64 * j];
        if (with_moe) {
#pragma unroll
            for (int k = 0; k < 4; ++k) { const float gk = topg[t * 4 + k]; const u32x2* orow = (const u32x2*)(OS + (size_t)(pstart[tope[t * 4 + k]] + rank[t * 4 + k]) * DM) + lane;
#pragma unroll
                for (int j = 0; j < 4; ++j) { const u32x2 o = orow[64 * j]; v[j].x += gk * bflo(o.x); v[j].y += gk * bfhi(o.x); v[j].z += gk * bflo(o.y); v[j].w += gk * bfhi(o.y); } }
        }
        float s = 0.f;
#pragma unroll
        for (int j = 0; j < 4; ++j) s += (v[j].x * v[j].x + v[j].y * v[j].y) + (v[j].z * v[j].z + v[j].w * v[j].w);
        const float rstd = 1.0f / sqrtf(wave_sum(s) * (1.f / 1024.f) + RMS_EPS);
        f32x4* orow = (f32x4*)(dsto + (size_t)t * DM) + lane;
#pragma unroll
        for (int j = 0; j < 4; ++j) orow[64 * j] = v[j] * rstd * ((const f32x4*)gfin)[64 * j + lane];
    }
}
constexpr int AL_RING = 0, AL_OACC = 49152, AL_BIAS = 114688, AL_WSF = AL_BIAS + 3 * 8 * 64 * 4, AL_IMP = AL_WSF + 8 * 64 * 4, AL_SELB = AL_IMP + 64 * 65 * 4, AL_UNI = AL_SELB + 512, AL_TICKET = AL_UNI + 16;
static_assert(AL_TICKET + 16 <= LDS_BYTES - 64 && AL_OACC + 65536 <= AL_BIAS, "attention LDS map");
__device__ __forceinline__ int crow(int r, int hi) { return (r & 3) + 8 * (r >> 2) + 4 * hi; }
__device__ __forceinline__ s16x4 vtr(const LAS char* p) { return __builtin_bit_cast(s16x4, __builtin_amdgcn_ds_read_tr16_b64_v4i16((LAS s16x4*)p)); }

__device__ __forceinline__ float max3f(float a, float b, float c) { float r; asm("v_max3_f32 %0, %1, %2, %3" : "=v"(r) : "v"(a), "v"(b), "v"(c)); return r; }
struct AttnCtx { LAS unsigned char* lds; int tid, lane, w, r32, hi; LAS float* wsf; };
__device__ __forceinline__ AttnCtx make_ctx(LAS unsigned char* lds) {
    int tid = threadIdx.x; asm volatile("" : "+v"(tid));
    AttnCtx C; C.lds = lds; C.tid = tid; C.lane = tid & 63; C.w = __builtin_amdgcn_readfirstlane(tid >> 6); C.r32 = tid & 31; C.hi = (tid >> 5) & 1; C.wsf = (LAS float*)(lds + AL_WSF) + C.w * 64;
    return C;
}

template <int NDB> __device__ __forceinline__ void scale_rows(const AttnCtx& C, f32x16 (&o)[NDB], float vq, int slot) {
    if (C.hi == 0) C.wsf[slot + C.r32] = vq;
#pragma unroll
    for (int rg = 0; rg < 4; ++rg) { const f32x4 a4 = *(const LAS f32x4*)(C.wsf + slot + 8 * rg + 4 * C.hi);
#pragma unroll
        for (int db = 0; db < NDB; ++db) { o[db][4 * rg + 0] *= a4.x; o[db][4 * rg + 1] *= a4.y; o[db][4 * rg + 2] *= a4.z; o[db][4 * rg + 3] *= a4.w; } }
}

__device__ __forceinline__ void dma16(const void* g, LAS unsigned char* lds_wave_base) { __builtin_amdgcn_global_load_lds((const unsigned*)g, (LAS unsigned*)lds_wave_base, 16, 0, 0); }
__device__ __forceinline__ void dma4(const void* g, LAS unsigned char* lds_wave_base) { __builtin_amdgcn_global_load_lds((const unsigned*)g, (LAS unsigned*)lds_wave_base, 4, 0, 0); }
template <int N> __device__ __forceinline__ void wait_vm() {
    if constexpr (N == 0) asm volatile("s_waitcnt vmcnt(0)" ::: "memory"); else if constexpr (N == 2) asm volatile("s_waitcnt vmcnt(2)" ::: "memory");
    else if constexpr (N == 3) asm volatile("s_waitcnt vmcnt(3)" ::: "memory"); else if constexpr (N == 4) asm volatile("s_waitcnt vmcnt(4)" ::: "memory"); else static_assert(N == 0, "wait_vm");
}
template <int DQK, int DV, bool BIAS, class Pol>
__device__ __forceinline__ void attn_core(const AttnCtx& C, const Pol& P, const bf16x8 (&qf)[DQK / 16], f32x16 (&o)[DV / 32]) {
    constexpr int NKP = DQK / 64, NVP = DV / 64, NDB = DV / 32, ND0 = DQK / 16, KROW = DQK * 2, KCH = DQK / 8, VCH = DV / 8, KBYTES = DQK * 128, SLOT = (DQK + DV) * 128, PT = NKP + NVP + (BIAS ? 1 : 0);
    int tid = C.tid; asm volatile("" : "+v"(tid));
    const int lane = tid & 63, r32 = lane & 31, hi = lane >> 5, w = C.w;
    int ksrc[NKP], vsrc[NVP];
#pragma unroll
    for (int j = 0; j < NKP; ++j) { const int id = tid + 512 * j, key = id / KCH, slot = id % KCH; const int c = slot ^ (DQK == 64 ? ((key >> 1) & 7) : (key & 15)); ksrc[j] = key * P.kpitch() + c * 8; }
#pragma unroll
    for (int j = 0; j < NVP; ++j) { const int id = tid + 512 * j, db = id >> 8, rem = id & 255, key = 8 * (rem >> 5) + ((rem & 31) >> 2), pc = 4 * db + (rem & 3); vsrc[j] = key * P.vpitch() + pc * 8; }
    int koff[ND0];
#pragma unroll
    for (int d0 = 0; d0 < ND0; ++d0) koff[d0] = r32 * KROW + (((2 * d0 + hi) ^ (DQK == 64 ? ((r32 >> 1) & 7) : (r32 & 15))) << 4);
    const int vbase = ((lane >> 4) & 1) * 32 + (lane & 3) * 8 + (4 * hi + ((lane & 15) >> 2)) * 64;
    LAS unsigned char* lds = C.lds;
    LAS float* biasw = (LAS float*)(lds + AL_BIAS) + w * 64;
#define ATT_DMA(t, s) do { const bf16* kp_ = P.kptr(t); const bf16* vp_ = P.vptr(t); LAS unsigned char* sb_ = lds + AL_RING + (s) * SLOT + w * 1024; \
        _Pragma("unroll") for (int j = 0; j < NKP; ++j) dma16(kp_ + ksrc[j], sb_ + j * 8192); \
        _Pragma("unroll") for (int j = 0; j < NVP; ++j) dma16(vp_ + vsrc[j], sb_ + KBYTES + j * 8192); \
        if (BIAS) dma4(P.biasptr(t) + lane, (LAS unsigned char*)(biasw + (s) * 512)); } while (0)
    float m_ref = 0.f, l_part = 0.f; bool seen = false;
#pragma unroll
    for (int db = 0; db < NDB; ++db) o[db] = f32x16{};
    int t = P.first(), t1 = P.next(t);
    asm volatile("s_waitcnt vmcnt(0) lgkmcnt(0)" ::: "memory"); __builtin_amdgcn_s_barrier();
    ATT_DMA(t, 0);
    if (t1 >= 0) ATT_DMA(t1, 1);
    int s0 = 0;
    while (t >= 0) {
        const int t2 = (t1 >= 0) ? P.next(t1) : -1;
        if (t1 >= 0) wait_vm<PT>(); else wait_vm<0>();
        asm volatile("s_waitcnt lgkmcnt(0)" ::: "memory"); __builtin_amdgcn_s_barrier(); asm volatile("" ::: "memory");
        const int s2 = (s0 >= 1) ? s0 - 1 : 2;
        if (t2 >= 0) ATT_DMA(t2, s2);
        if (!P.wave_skip(t)) {
            const LAS unsigned char* Kb = lds + AL_RING + s0 * SLOT; const LAS unsigned char* Vb = Kb + KBYTES;
            const float cbase = P.lane_valid(t) ? -m_ref : NEGBIG;
            f32x16 p0, p1;
            if (BIAS) {
                const float cb = cbase + P.bias_ref();
#pragma unroll
                for (int rg = 0; rg < 4; ++rg) { const f32x4 b0 = *(const LAS f32x4*)(biasw + s0 * 512 + 8 * rg + 4 * hi), b1 = *(const LAS f32x4*)(biasw + s0 * 512 + 32 + 8 * rg + 4 * hi);
                    p0[4 * rg] = cb - b0.x; p0[4 * rg + 1] = cb - b0.y; p0[4 * rg + 2] = cb - b0.z; p0[4 * rg + 3] = cb - b0.w;
                    p1[4 * rg] = cb - b1.x; p1[4 * rg + 1] = cb - b1.y; p1[4 * rg + 2] = cb - b1.z; p1[4 * rg + 3] = cb - b1.w; }
            } else {
#pragma unroll
                for (int r = 0; r < 16; ++r) { p0[r] = cbase; p1[r] = cbase; }
            }
#pragma unroll
            for (int d0 = 0; d0 < ND0; ++d0) {
                const bf16x8 k0 = *(const LAS bf16x8*)(Kb + koff[d0]); const bf16x8 k1 = *(const LAS bf16x8*)(Kb + koff[d0] + 32 * KROW);
                p0 = __builtin_amdgcn_mfma_f32_32x32x16_bf16(k0, qf[d0], p0, 0, 0, 0);
                p1 = __builtin_amdgcn_mfma_f32_32x32x16_bf16(k1, qf[d0], p1, 0, 0, 0);
            }
            asm volatile("s_nop 15\n\ts_nop 7" : "+v"(p0), "+v"(p1));
            if (P.masked(t)) {
#pragma unroll
                for (int r = 0; r < 16; ++r) { const int kvl = crow(r, hi);
                    if (!P.valid(t, kvl)) p0[r] = NEGBIG;
                    if (!P.valid(t, kvl + 32)) p1[r] = NEGBIG; }
            }
            float rm = max3f(p0[0], p1[0], p0[1]), rm2 = max3f(p1[1], p0[2], p1[2]);
#pragma unroll
            for (int r = 3; r < 15; r += 2) { rm = max3f(rm, p0[r], p1[r]); rm2 = max3f(rm2, p0[r + 1], p1[r + 1]); }
            rm = max3f(rm, p0[15], p1[15]);
            rm = max3f(rm, rm2, rm2);
            rm = max3f(rm, __shfl_xor(rm, 32), rm);
            const bool any_valid = rm > -1e29f;
            const bool trig = (rm > 8.0f) || (!seen && any_valid);
            if (__any(trig)) {
                const float dl = trig ? rm : 0.f; const float alpha = (trig && seen) ? __builtin_amdgcn_exp2f(-dl) : 1.0f;
                m_ref += dl; l_part *= alpha;
#pragma unroll
                for (int r = 0; r < 16; ++r) { p0[r] -= dl; p1[r] -= dl; }
                scale_rows<NDB>(C, o, alpha, 0);
            }
            seen = seen || any_valid;
            float ls = 0.f;
#pragma unroll
            for (int r = 0; r < 16; ++r) { const float e0 = __builtin_amdgcn_exp2f(p0[r]), e1 = __builtin_amdgcn_exp2f(p1[r]); p0[r] = e0; p1[r] = e1; ls += e0 + e1; }
            l_part += ls;
            u32x4 pw[4];
#pragma unroll
            for (int k = 0; k < 4; ++k) { pw[0][k] = cvtpk(p0[2 * k], p0[2 * k + 1]); pw[1][k] = cvtpk(p0[8 + 2 * k], p0[9 + 2 * k]); pw[2][k] = cvtpk(p1[2 * k], p1[2 * k + 1]); pw[3][k] = cvtpk(p1[8 + 2 * k], p1[9 + 2 * k]); }
#pragma unroll
            for (int db = 0; db < NDB; ++db) {
#pragma unroll
                for (int s = 0; s < 4; ++s) {
                    const s16x4 lo = vtr((const LAS char*)Vb + vbase + db * 4096 + s * 1024), hh = vtr((const LAS char*)Vb + vbase + db * 4096 + s * 1024 + 512);
                    const bf16x8 vf = {lo[0], lo[1], lo[2], lo[3], hh[0], hh[1], hh[2], hh[3]};
                    o[db] = __builtin_amdgcn_mfma_f32_32x32x16_bf16(__builtin_bit_cast(bf16x8, pw[s]), vf, o[db], 0, 0, 0);
                }
            }
        }
        s0 = (s0 == 2) ? 0 : s0 + 1; t = t1; t1 = t2;
    }
    const float l = l_part + __shfl_xor(l_part, 32);
    scale_rows<NDB>(C, o, l > 0.f ? 1.0f / l : 0.f, 32);
    asm volatile("s_waitcnt lgkmcnt(0)" ::: "memory"); __builtin_amdgcn_s_barrier(); asm volatile("" ::: "memory");
#undef ATT_DMA
}

struct FoxPol {
    const bf16 *K, *V; const float* cum; float ref; int qb, w, tq, tmin;
    __device__ __forceinline__ int first() const { return 4 * qb + 3; }
    __device__ __forceinline__ int next(int t) const { return t - 1 >= tmin ? t - 1 : -1; }
    __device__ __forceinline__ bool masked(int t) const { return t >= 4 * qb; }
    __device__ __forceinline__ bool valid(int t, int kvl) const { return 64 * t + kvl <= tq; }
    __device__ __forceinline__ bool wave_skip(int t) const { return 64 * (t - 4 * qb) > 32 * w + 31; }
    __device__ __forceinline__ bool lane_valid(int) const { return true; }
    __device__ __forceinline__ const bf16* kptr(int t) const { return K + (size_t)(64 * t) * 512; }
    __device__ __forceinline__ const bf16* vptr(int t) const { return V + (size_t)(64 * t) * 512; }
    __device__ __forceinline__ int kpitch() const { return 512; }
    __device__ __forceinline__ int vpitch() const { return 512; }
    __device__ __forceinline__ const float* biasptr(int t) const { return cum + 64 * t; }
    __device__ __forceinline__ float bias_ref() const { return ref; }
};
struct MemPol {
    const bf16 *K, *V;
    __device__ __forceinline__ int first() const { return 0; }
    __device__ __forceinline__ int next(int t) const { return t < 3 ? t + 1 : -1; }
    __device__ __forceinline__ bool masked(int) const { return false; }
    __device__ __forceinline__ bool valid(int, int) const { return true; }
    __device__ __forceinline__ bool wave_skip(int) const { return false; }
    __device__ __forceinline__ bool lane_valid(int) const { return true; }
    __device__ __forceinline__ const bf16* kptr(int t) const { return K + (size_t)(64 * t) * 512; }
    __device__ __forceinline__ const bf16* vptr(int t) const { return V + (size_t)(64 * t) * 512; }
    __device__ __forceinline__ int kpitch() const { return 512; }
    __device__ __forceinline__ int vpitch() const { return 512; }
    __device__ __forceinline__ const float* biasptr(int) const { return nullptr; }
    __device__ __forceinline__ float bias_ref() const { return 0.f; }
};
struct CmpPol {
    const bf16 *K, *V; int ntc, tq;
    __device__ __forceinline__ int first() const { return 0; }
    __device__ __forceinline__ int next(int t) const { return t + 1 < ntc ? t + 1 : -1; }
    __device__ __forceinline__ bool masked(int) const { return true; }
    __device__ __forceinline__ bool valid(int t, int kvl) const { return 16 * (64 * t + kvl) + 31 <= tq; }
    __device__ __forceinline__ bool wave_skip(int) const { return false; }
    __device__ __forceinline__ bool lane_valid(int) const { return true; }
    __device__ __forceinline__ const bf16* kptr(int t) const { return K + (size_t)(64 * t) * 64; }
    __device__ __forceinline__ const bf16* vptr(int t) const { return V + (size_t)(64 * t) * 128; }
    __device__ __forceinline__ int kpitch() const { return 64; }
    __device__ __forceinline__ int vpitch() const { return 128; }
    __device__ __forceinline__ const float* biasptr(int) const { return nullptr; }
    __device__ __forceinline__ float bias_ref() const { return 0.f; }
};
struct WinPol {
    const bf16 *K, *V; int T, tq;
    __device__ __forceinline__ int first() const { return T; }
    __device__ __forceinline__ int next(int t) const { return (t - 1 >= 0 && t - 1 >= T - 8) ? t - 1 : -1; }
    __device__ __forceinline__ bool masked(int t) const { return t == T || t == T - 8; }
    __device__ __forceinline__ bool valid(int t, int kvl) const { const int d = tq - (64 * t + kvl); return d >= 0 && d < 512; }
    __device__ __forceinline__ bool wave_skip(int) const { return false; }
    __device__ __forceinline__ bool lane_valid(int) const { return true; }
    __device__ __forceinline__ const bf16* kptr(int t) const { return K + (size_t)(64 * t) * 128; }
    __device__ __forceinline__ const bf16* vptr(int t) const { return V + (size_t)(64 * t) * 128; }
    __device__ __forceinline__ int kpitch() const { return 128; }
    __device__ __forceinline__ int vpitch() const { return 128; }
    __device__ __forceinline__ const float* biasptr(int) const { return nullptr; }
    __device__ __forceinline__ float bias_ref() const { return 0.f; }
};
struct SelPol {
    const bf16 *K, *V; unsigned long long uni, mine; int T, tq;
    __device__ __forceinline__ int first() const { return 63 - __clzll(uni); }
    __device__ __forceinline__ int next(int t) const { const unsigned long long m = uni & ((1ull << t) - 1ull); return m ? 63 - __clzll(m) : -1; }
    __device__ __forceinline__ bool masked(int t) const { return t == T; }
    __device__ __forceinline__ bool valid(int t, int kvl) const { return 64 * t + kvl <= tq; }
    __device__ __forceinline__ bool wave_skip(int) const { return false; }
    __device__ __forceinline__ bool lane_valid(int t) const { return (mine >> t) & 1ull; }
    __device__ __forceinline__ const bf16* kptr(int t) const { return K + (size_t)(64 * t) * 128; }
    __device__ __forceinline__ const bf16* vptr(int t) const { return V + (size_t)(64 * t) * 128; }
    __device__ __forceinline__ int kpitch() const { return 128; }
    __device__ __forceinline__ int vpitch() const { return 128; }
    __device__ __forceinline__ const float* biasptr(int) const { return nullptr; }
    __device__ __forceinline__ float bias_ref() const { return 0.f; }
};

template <int NDB, class RowF> __device__ __forceinline__ void store_o(const AttnCtx& C, const f32x16 (&o)[NDB], bf16* dst, RowF rowoff) {
#pragma unroll
    for (int r = 0; r < 16; ++r) { const int q = crow(r, C.hi); bf16* p = dst + rowoff(q) + C.r32;
#pragma unroll
        for (int db = 0; db < NDB; ++db) p[32 * db] = (bf16)(cvtpk(o[db][r], 0.f) & 0xffffu); }
}

__device__ __forceinline__ void fox_unit(Frame& F0, int bh, int qb) {
    const AttnCtx C = make_ctx(F0.lds);
    struct { unsigned char* ws; } F; { unsigned long long w_ = (unsigned long long)F0.ws; asm volatile("" : "+s"(w_)); F.ws = (unsigned char*)w_; }
    const int b = bh >> 3, h = bh & 7, tq = 256 * qb + 32 * C.w + C.r32;
    const bf16* Q = WSP(bf16, WS_QF) + ((size_t)(b * SEQ + tq)) * 512 + h * 64;
    bf16x8 qf[4];
#pragma unroll
    for (int d0 = 0; d0 < 4; ++d0) qf[d0] = *(const bf16x8*)(Q + 16 * d0 + 8 * C.hi);
    const float* cum = WSP(float, WS_CUM) + (size_t)bh * SEQ;
    int tmin = 0;
    { float qn = 0.f;
#pragma unroll
      for (int d0 = 0; d0 < 4; ++d0)
#pragma unroll
          for (int j = 0; j < 8; ++j) { const float v = bf2f((unsigned short)qf[d0][j]); qn += v * v; }
      qn += __shfl_xor(qn, 32);
#pragma unroll
      for (int o = 16; o >= 1; o >>= 1) qn = fmaxf(qn, __shfl_xor(qn, o));
      LAS float* qmx = (LAS float*)(C.lds + AL_SELB);
      __syncthreads();
      if (C.lane == 0) qmx[C.w] = qn;
      __syncthreads();
      float qm = qmx[0];
#pragma unroll
      for (int i = 1; i < 8; ++i) qm = fmaxf(qm, qmx[i]);
      const float B = sqrtf(qm) * WSP(float, WS_KMAX)[bh];
      const float thr = -(40.0f + 2.0f * B), c0 = cum[256 * qb];
      const bool cond = (C.lane < 4 * qb) && (c0 - cum[64 * C.lane + 63] < thr);
      const unsigned long long bal = __ballot(cond);
      tmin = bal ? 64 - __clzll(bal) : 0; }
    FoxPol P{WSP(bf16, WS_KF) + (size_t)b * SEQ * 512 + h * 64, WSP(bf16, WS_VF) + (size_t)b * SEQ * 512 + h * 64, cum, cum[256 * qb + 255], qb, C.w, tq, tmin};
    f32x16 o[2];
    attn_core<64, 64, true>(C, P, qf, o);
    bf16* dst = WSP(bf16, WS_OBR) + (size_t)1 * NTOK * 512 + h * 64;
    const size_t rb = (size_t)(b * SEQ + 256 * qb + 32 * C.w);
    store_o<2>(C, o, dst, [&](int q) { return (rb + q) * 512; });
}
__device__ __forceinline__ void mem_unit(Frame& F0, int bh, int qb) {
    const AttnCtx C = make_ctx(F0.lds);
    struct { unsigned char* ws; } F; { unsigned long long w_ = (unsigned long long)F0.ws; asm volatile("" : "+s"(w_)); F.ws = (unsigned char*)w_; }
    const int b = bh >> 2, h = bh & 3, tq = 256 * qb + 32 * C.w + C.r32;
    const bf16* Q = WSP(bf16, WS_QM) + ((size_t)(b * SEQ + tq)) * 512 + h * 128;
    bf16x8 qf[8];
#pragma unroll
    for (int d0 = 0; d0 < 8; ++d0) qf[d0] = *(const bf16x8*)(Q + 16 * d0 + 8 * C.hi);
    MemPol P{WSP(bf16, WS_KMEM) + (size_t)b * MEMLEN * 512 + h * 128, WSP(bf16, WS_VMEM) + (size_t)b * MEMLEN * 512 + h * 128};
    f32x16 o[4];
    attn_core<128, 128, false>(C, P, qf, o);
    bf16* dst = WSP(bf16, WS_OBR) + (size_t)2 * NTOK * 512 + h * 128;
    const size_t rb = (size_t)(b * SEQ + 256 * qb + 32 * C.w);
    store_o<4>(C, o, dst, [&](int q) { return (rb + q) * 512; });
}
__device__ __forceinline__ void nsa_unit(Frame& F0, int bg, int T, int parts) {
    const AttnCtx C = make_ctx(F0.lds);
    struct { unsigned char* ws; } F; { unsigned long long w_ = (unsigned long long)F0.ws; asm volatile("" : "+s"(w_)); F.ws = (unsigned char*)w_; }
    const int b = bg >> 1, g = bg & 1, q = C.r32, tokl = 8 * C.w + (q >> 2), tq = 64 * T + tokl, head = 4 * g + (q & 3);
    const bf16* Q = WSP(bf16, WS_QA) + ((size_t)(b * SEQ + tq)) * 512 + head * 64;
    bf16x8 qf[4];
#pragma unroll
    for (int d0 = 0; d0 < 4; ++d0) qf[d0] = *(const bf16x8*)(Q + 16 * d0 + 8 * C.hi);
    const float* lg = WSP(float, WS_LG) + (size_t)(b * SEQ + tq) * 32 + head * 3;
    LAS float* oacc = (LAS float*)(C.lds + AL_OACC) + C.w * 2048 + C.lane;
    LAS float* imp = (LAS float*)(C.lds + AL_IMP);
    LAS unsigned long long* selb = (LAS unsigned long long*)(C.lds + AL_SELB);
    LAS unsigned long long* unip = (LAS unsigned long long*)(C.lds + AL_UNI);
#ifndef NSA_CORES
#define NSA_CORES 7
#endif
    if (NSA_CORES & 1) {
        CmpPol P{WSP(bf16, WS_KCMP) + (size_t)bg * 256 * 64, WSP(bf16, WS_VCMP) + (size_t)bg * 256 * 128, (4 * T + 2) / 64 + 1, tq};
        f32x16 o2[2];
        attn_core<64, 64, false>(C, P, qf, o2);
        scale_rows<2>(C, o2, (parts & 1) ? fast_sigmoid(lg[0]) : 0.f, 0);
#pragma unroll
        for (int db = 0; db < 2; ++db)
#pragma unroll
            for (int r = 0; r < 16; ++r) oacc[(db * 16 + r) * 64] = o2[db][r];
        P.V += 64;
        attn_core<64, 64, false>(C, P, qf, o2);
#pragma unroll
        for (int db = 0; db < 2; ++db)
#pragma unroll
            for (int rg = 0; rg < 4; ++rg) imp[(8 * C.w + 2 * rg + C.hi) * 65 + 32 * db + C.r32] = (o2[db][4 * rg] + o2[db][4 * rg + 1]) + (o2[db][4 * rg + 2] + o2[db][4 * rg + 3]);
    }
    __syncthreads();
    {
        const int tk = C.tid >> 3, sub = C.tid & 7;
        float mine[8]; int rank[8];
#pragma unroll
        for (int i = 0; i < 8; ++i) { const int j = 8 * sub + i; const float v = imp[tk * 65 + j];
            mine[i] = (j == 0 || j == T || j == T - 1) ? 1e4f : (j > T ? -1e4f : v); rank[i] = 0; }
        for (int jj = 0; jj < 64; ++jj) { const float v0 = imp[tk * 65 + jj]; const float v = (jj == 0 || jj == T || jj == T - 1) ? 1e4f : (jj > T ? -1e4f : v0);
#pragma unroll
            for (int i = 0; i < 8; ++i) { const int j = 8 * sub + i; rank[i] += (v > mine[i] || (v == mine[i] && jj < j)) ? 1 : 0; } }
        unsigned byte = 0;
#pragma unroll
        for (int i = 0; i < 8; ++i) { const int j = 8 * sub + i; if (rank[i] < 16 && j <= T) byte |= 1u << i; }
        ((LAS unsigned char*)selb)[tk * 8 + sub] = (unsigned char)byte;
    }
    __syncthreads();
    if (C.w == 0) { unsigned long long m = selb[C.lane]; unsigned lo = (unsigned)m, hh = (unsigned)(m >> 32);
#pragma unroll
        for (int o = 1; o < 64; o <<= 1) { lo |= __shfl_xor(lo, o); hh |= __shfl_xor(hh, o); }
        if (C.lane == 0) unip[0] = ((unsigned long long)hh << 32) | lo; }
    __syncthreads();
    const unsigned long long mymask = selb[tokl]; unsigned long long uni = unip[0];
    uni = ((unsigned long long)__builtin_amdgcn_readfirstlane((unsigned)(uni >> 32)) << 32) | (unsigned)__builtin_amdgcn_readfirstlane((unsigned)uni);
    if (NSA_CORES & 2) {
        SelPol P{WSP(bf16, WS_KV6) + (size_t)2 * NTOK * 128 + (size_t)b * SEQ * 128 + g * 64, WSP(bf16, WS_KV6) + (size_t)3 * NTOK * 128 + (size_t)b * SEQ * 128 + g * 64, uni, mymask, T, tq};
        f32x16 o2[2];
        attn_core<64, 64, false>(C, P, qf, o2);
        scale_rows<2>(C, o2, (parts & 2) ? fast_sigmoid(lg[1]) : 0.f, 0);
#pragma unroll
        for (int db = 0; db < 2; ++db)
#pragma unroll
            for (int r = 0; r < 16; ++r) oacc[(db * 16 + r) * 64] += o2[db][r];
    }
    if (NSA_CORES & 4) {
        WinPol P{WSP(bf16, WS_KV6) + (size_t)4 * NTOK * 128 + (size_t)b * SEQ * 128 + g * 64, WSP(bf16, WS_KV6) + (size_t)5 * NTOK * 128 + (size_t)b * SEQ * 128 + g * 64, T, tq};
        f32x16 o2[2];
        attn_core<64, 64, false>(C, P, qf, o2);
        scale_rows<2>(C, o2, (parts & 4) ? fast_sigmoid(lg[2]) : 0.f, 0);
#pragma unroll
        for (int db = 0; db < 2; ++db)
#pragma unroll
            for (int r = 0; r < 16; ++r) o2[db][r] += oacc[(db * 16 + r) * 64];
        bf16* dst = WSP(bf16, WS_OBR) + g * 256;
        const size_t rb = (size_t)(b * SEQ + 64 * T + 8 * C.w);
        store_o<2>(C, o2, dst, [&](int qq) { return (rb + (qq >> 2)) * 512 + (qq & 3) * 64; });
    }
}

__device__ __forceinline__ void p3_phase(Frame& F, int parts, int rep) {
    LAS int* ticket = (LAS int*)(F.lds + AL_TICKET);
    unsigned* ctl = WSP(unsigned, WS_CTL);
    unsigned* qhead = ctl + CW_QATTN + 64 * rep; const unsigned* order = WSP(unsigned, WS_ORDER);
    for (;;) {
        __syncthreads();
        if (F.tid == 0) ticket[0] = (int)atomicAdd(qhead, 1u);
        __syncthreads();
        const int tk = __builtin_amdgcn_readfirstlane(ticket[0]);
        if (tk >= N_QUEUE) break;
        const unsigned d = __builtin_amdgcn_readfirstlane(order[tk]); const int type = d & 7, a = (d >> 3) & 255, bb = d >> 11;
#ifdef REP_ATTN_ONLY
        if (rep > 0 && type >= 3) continue;
#endif
#ifdef REP_CVT_ONLY
        if (rep > 0 && type != 5) continue;
#endif
        if (type == 0) { q_wait(ctl + CW_CMPDONE + 64 * a, 16u, F.tid); nsa_unit(F, a, bb, parts); }
        else if (type == 1) { q_wait(ctl + CW_CUMDONE + 64 * (a >> 3), 1u, F.tid); fox_unit(F, a, bb); }
        else if (type == 2) mem_unit(F, a, bb);
#ifndef QDIS
#define QDIS 0
#endif
        else if (type == 3) { if (!(QDIS & 1)) p2_compress_unit(F, a, bb); q_signal(ctl + CW_CMPDONE + 64 * (bb >> 3), F.tid); }
        else if (type == 4) { if (!(QDIS & 2)) p2_cumsum_unit(F, 8 * a + F.wave); q_signal(ctl + CW_CUMDONE + 64 * a, F.tid); }
        else { if (!(QDIS & 4)) convert_unit(F, bb); }
    }
}
#define XB_TMO      128
#define XB_XCNT(j)  (256  + 64 * (j))
#define XB_XSUB(j)  (1280 + 64 * (j))
#define XB_XGEN(j)  (2304 + 64 * (j))
#define XB_TOP      3328
#define XB_TOPGEN   3392
#define XCD_BAR_WORDS 3456
#define XB_SPIN_CAP (1u << 18)

__device__ __forceinline__ unsigned xb_ld(unsigned* p)              { return __hip_atomic_load(p, __ATOMIC_RELAXED, __HIP_MEMORY_SCOPE_AGENT); }
__device__ __forceinline__ unsigned xb_add(unsigned* p, unsigned v) { return __hip_atomic_fetch_add(p, v, __ATOMIC_RELAXED, __HIP_MEMORY_SCOPE_AGENT); }
__device__ __forceinline__ unsigned xb_xcc_id() { return (unsigned)__builtin_amdgcn_s_getreg((3 << 11) | 20) & 0xFu; }
#define XB_SPIN(cond, bar) do { unsigned _sp = 0; while (cond) { __builtin_amdgcn_s_sleep(1); \
    if ((++_sp & 255u) == 0u) { if (xb_ld(&(bar)[XB_TMO])) break; if (_sp > XB_SPIN_CAP) { atomicAdd(&(bar)[XB_TMO], 1u); break; } } } } while (0)

struct XcdBarrier {
    unsigned* bar; unsigned x;
    volatile LAS unsigned* st;
};

__device__ __forceinline__ XcdBarrier xcd_barrier_post(unsigned* bar, volatile LAS unsigned* st) {
    XcdBarrier b; b.bar = bar; b.x = xb_xcc_id(); b.st = st;
    if (threadIdx.x == 0) (void)xb_add(&bar[XB_XCNT(b.x)], 1u);
    return b;
}
__device__ __forceinline__ void xcd_barrier_complete(unsigned* bar, unsigned x, unsigned& nloc, unsigned& nx) {
    const unsigned G = gridDim.x * gridDim.y * gridDim.z;
    unsigned sum, cnt, mine, sp = 0u;
    for (;;) {
        sum = 0u; cnt = 0u; mine = 0u;
#pragma unroll
        for (unsigned j = 0; j < 16; ++j) { const unsigned c = xb_ld(&bar[XB_XCNT(j)]); sum += c; cnt += (c > 0u) ? 1u : 0u; mine = (j == x) ? c : mine; }
        if (sum == G) break;
        __builtin_amdgcn_s_sleep(1);
        if ((++sp & 255u) == 0u) { if (xb_ld(&bar[XB_TMO])) break; if (sp > XB_SPIN_CAP) { atomicAdd(&bar[XB_TMO], 1u); break; } }
    }
    nloc = mine > 0u ? mine : 1u; nx = cnt > 0u ? cnt : 1u;
}

__device__ __forceinline__ void xcd_barrier(const XcdBarrier& b) {
    asm volatile("s_waitcnt vmcnt(0)" ::: "memory");
    __syncthreads();
    if (threadIdx.x == 0) {
        unsigned* bar = b.bar;
        __builtin_amdgcn_s_waitcnt(0);
        unsigned nloc = b.st[0], nx = b.st[1];
        if (nloc == 0u) { xcd_barrier_complete(bar, b.x, nloc, nx); b.st[0] = nloc; b.st[1] = nx; }
        const unsigned old = xb_add(&bar[XB_XSUB(b.x)], 1u);
        const unsigned gen = old / nloc;
        if (old + 1u == (gen + 1u) * nloc) {
            __builtin_amdgcn_fence(__ATOMIC_RELEASE, "agent");
            asm volatile("s_waitcnt vmcnt(0)" ::: "memory");
            const unsigned og = xb_add(&bar[XB_TOP], 1u);
            const unsigned tg = og / nx;
            if (og + 1u == (tg + 1u) * nx) xb_add(&bar[XB_TOPGEN], 1u);
            else XB_SPIN(xb_ld(&bar[XB_TOPGEN]) == tg, bar);
            __builtin_amdgcn_fence(__ATOMIC_ACQUIRE, "agent");
            xb_add(&bar[XB_XGEN(b.x)], 1u);
            asm volatile("s_waitcnt vmcnt(0)" ::: "memory");
        } else {
            XB_SPIN(xb_ld(&bar[XB_XGEN(b.x)]) == gen, bar);
            __builtin_amdgcn_fence(__ATOMIC_ACQUIRE, "agent");
            asm volatile("s_waitcnt vmcnt(0)" ::: "memory");
        }
    }
    __syncthreads();
}
#ifndef ABL_PARTS
#define ABL_PARTS 31
#endif
#ifndef PH_MAX
#define PH_MAX 10
#endif
typedef KArgs Args;
static_assert(sizeof(Args) == 26 * 8 + 8 + 8 + 8, "Args has no padding");

__global__ void __launch_bounds__(NTHREADS, 2) fwd_megakernel(Args args) {
    extern __shared__ __attribute__((aligned(16))) unsigned char lds_raw[];
    Frame F;
    F.lds = (LAS unsigned char*)lds_raw;
    F.tid = threadIdx.x; F.lane = F.tid & 63; F.wave = __builtin_amdgcn_readfirstlane(F.tid >> 6);
    F.G = gridDim.x; F.bid = blockIdx.x; F.vcu = (F.G % 8 == 0) ? (F.bid % 8) * (F.G / 8) + F.bid / 8 : F.bid;
    F.ka = (const KArgs __attribute__((address_space(4)))*)__builtin_amdgcn_kernarg_segment_ptr();
    F.out = args.out; F.ws = args.ws;
    const int lo = args.ph_lo, hi = args.ph_hi;
    volatile LAS unsigned* xst = (volatile LAS unsigned*)(F.lds + LDS_BYTES - 64);
    if (F.tid < 2) xst[F.tid] = 0u;
    __syncthreads();
    XcdBarrier xbar = xcd_barrier_post((unsigned*)(F.ws + WS_CTL) + CW_XBAR, xst);
#ifndef PHASE_MASK
#define PHASE_MASK 0x7ff
#endif
#define IN(k) (((PHASE_MASK >> (k)) & 1) && lo <= (k) && (k) < hi)
#ifndef REP_MASK
#define REP_MASK 0
#endif
#define REPS(k) for (int rep_ = 0; rep_ < 1 + ((REP_MASK >> (k)) & 1); ++rep_)
#define SEAM(k) do { if (lo <= (k) && (k) + 1 < hi) { xcd_barrier(xbar); } } while (0)
#define FIT_GRID(n) ((F.G % 8 == 0) ? ({ const int n_ = (n), R_ = (n_ + F.G - 1) / F.G, g_ = 8 * (((n_ + R_ - 1) / R_ + 7) / 8); g_ < F.G ? g_ : F.G; }) : F.G)

    if (IN(0)) REPS(0) p0_prologue(F);
    SEAM(0);
    if (IN(1)) REPS(1) {
        const int g1 = FIT_GRID(1680);
        if (F.bid < g1) {
        SchedIn S{(const char*)(F.ws + WS_HA), (const char*)(F.ws + WS_WIN_T), g1, F.bid};
        EpiIn E{WSP(bf16, WS_QA), WSP(bf16, WS_KV6), WSP(bf16, WS_QF), WSP(bf16, WS_KF), WSP(bf16, WS_VF), WSP(bf16, WS_QM), WSP(bf16, WS_GATES), WSP(bf16, WS_KMEM), WSP(bf16, WS_VMEM), WSP(float, WS_LG),
                WSP(float, WS_ROPE_C), WSP(float, WS_ROPE_S), F.ka->in[5]};
        pg8::gemm_phase<false>(F.lds, 1024, S, E);
        }
    }
    SEAM(1);
    if (IN(3)) REPS(3) p3_phase(F, ABL_PARTS, rep_);
    SEAM(3);
    if (IN(4)) REPS(4) {
        SchedBr S{(const char*)(F.ws + WS_OBR), (const char*)(F.ws + WS_WBR_T), F.G, F.bid};
        EpiBr E{WSP(bf16, WS_GATES), WSP(bf16, WS_MERGED)};
        pg8::gemm_phase<false>(F.lds, 512, S, E);
    }
    SEAM(4);
    if (IN(5)) REPS(5) {
        SchedOut S{(const char*)(F.ws + WS_MERGED), (const char*)(F.ws + WS_WOUT_T), F.G, F.bid};
        EpiOut E{F.ka->in[0], F.out, WSP(unsigned char, WS_H2)};
        pg8::gemm_phase<false>(F.lds, 1024, S, E);
    }
    SEAM(5);
    if (IN(6)) REPS(6) p6_phase(F);
    SEAM(6);
    const bool moe_split = (F.G % 8 == 0);
    const LAS int* te = (const LAS int*)(F.lds + MT_OFF);
    if (IN(8)) REPS(8) {
        { LAS int* mt = (LAS int*)(F.lds + MT_OFF);
          if (F.tid < 64) { const int e = F.tid & 31; const int c = (int)__hip_atomic_load(WSP(unsigned, WS_CTL) + CW_GCNT + 32 * e, __ATOMIC_RELAXED, __HIP_MEMORY_SCOPE_AGENT);
              const int padc = (c + 255) & ~255; int inc = padc;
#pragma unroll
              for (int o = 1; o < 32; o <<= 1) { const int up = __shfl_up(inc, o); if (e >= o) inc += up; }
              const int start = inc - padc;
              if (F.tid < 32) { mt[320 + e] = start; mt[352 + e] = c; for (int q = 0; q < (padc >> 8); ++q) mt[(start >> 8) + q] = e | (q << 5); if (e == 31) mt[300] = inc >> 8; } }
          __syncthreads(); }
        const int nmt = __builtin_amdgcn_readfirstlane(te[300]), F8 = moe_split ? (nmt * 8) / F.G : (1 << 20);
        SchedMoE<true> S{(const char*)(F.ws + WS_H2), (const char*)(F.ws + WS_WGU_T), te, WSP(int, WS_ETOK), nmt, 8, F.G, F.vcu, (size_t)2048 * 1024, 0, F8};
        EpiGU E{F.ka->in[22], te, WSP(unsigned char, WS_ACT), WSP(float, WS_ERSTD)};
        pg8::gemm_phase<true>(F.lds, 512, S, E);
    }
    SEAM(8);
    if (IN(9)) REPS(9) {
        unsigned* done8 = WSP(unsigned, WS_CTL) + CW_DONE8;
        const int nmt = __builtin_amdgcn_readfirstlane(te[300]), n9 = nmt * 4, F8 = moe_split ? (nmt * 8) / F.G : (1 << 20), T = moe_split ? nmt * 8 - F8 * F.G : 0, v = F.vcu;
        if (v < T) {
            SchedMoE<true> S{(const char*)(F.ws + WS_H2), (const char*)(F.ws + WS_WGU_T), te, WSP(int, WS_ETOK), nmt, 8, F.G, v, (size_t)2048 * 1024, F8, F8 + 1};
            EpiGU E{F.ka->in[22], te, WSP(unsigned char, WS_ACT), WSP(float, WS_ERSTD)};
            pg8::gemm_phase<true>(F.lds, 512, S, E);
            if (F.tid == 0) { __builtin_amdgcn_fence(__ATOMIC_RELEASE, "agent"); asm volatile("s_waitcnt vmcnt(0)" ::: "memory");
                __hip_atomic_fetch_add(done8 + ((F8 * F.G + v) >> 3), 1u, __ATOMIC_RELAXED, __HIP_MEMORY_SCOPE_AGENT); }
        }
        const int vb = v - T + (v < T ? F.G : 0), pmT = moe_split ? (F8 * F.G) / 8 : (1 << 20), lim = n9 < 4 * pmT ? n9 : 4 * pmT;
        const int nseg1 = vb < lim ? (lim - 1 - vb) / F.G + 1 : 0;
        EpiDn E{F.ka->in[24], te, WSP(bf16, WS_AMOE)};
        { SchedMoE<false> S{(const char*)(F.ws + WS_ACT), (const char*)(F.ws + WS_WD_T), te, nullptr, nmt, 4, F.G, vb, (size_t)1024 * 1024, 0, nseg1};
          pg8::gemm_phase<true>(F.lds, 512, S, E); }
        if (nseg1 * F.G + vb < n9) {
            for (int L = nseg1 * F.G + vb; L < n9; L += F.G) q_wait(done8 + (L >> 2), 8u, F.tid);
            SchedMoE<false> S{(const char*)(F.ws + WS_ACT), (const char*)(F.ws + WS_WD_T), te, nullptr, nmt, 4, F.G, vb, (size_t)1024 * 1024, nseg1, 1 << 20};
            pg8::gemm_phase<true>(F.lds, 512, S, E);
        }
    }
    SEAM(9);
    if (IN(10)) { if ((REP_MASK >> 10) & 1) p10_phase(F, PH_MAX >= 9, WSP(float, WS_GATES)); p10_phase(F, PH_MAX >= 9, F.out); }
#undef IN
#undef SEAM
}

extern "C" void kernel_launch(void* const* d_in, const int* in_sizes, int n_in, void* d_out, int out_size, void* d_ws, size_t ws_size, hipStream_t stream) {
    static int grid = 0;
    if (grid == 0) {
        if (n_in != 26 || out_size != NTOK * DM || ws_size < WS_END) { fprintf(stderr, "kernel_launch: unexpected sizes n_in %d out %d ws %zu (need %zu)\n", n_in, out_size, ws_size, (size_t)WS_END); grid = -1; return; }
        int dev = 0, cus = 0, per_cu = 0;
        hipGetDevice(&dev); hipDeviceGetAttribute(&cus, hipDeviceAttributeMultiprocessorCount, dev);
        if (hipFuncSetAttribute((const void*)fwd_megakernel, hipFuncAttributeMaxDynamicSharedMemorySize, LDS_BYTES) != hipSuccess) { fprintf(stderr, "kernel_launch: hipFuncSetAttribute failed\n"); grid = -1; return; }
        if (hipOccupancyMaxActiveBlocksPerMultiprocessor(&per_cu, (const void*)fwd_megakernel, NTHREADS, LDS_BYTES) != hipSuccess || per_cu < 1) { fprintf(stderr, "kernel_launch: occupancy query says %d\n", per_cu); per_cu = 1; }
        (void)hipGetLastError();
        grid = cus * 1;
        if (grid > 256) grid = 256;
    }
    if (grid < 0) return;
    (void)hipMemsetAsync((char*)d_ws + WS_CTL, 0, CTL_BYTES, stream);
    Args a{};
    for (int i = 0; i < 26; ++i) a.in[i] = (const float*)d_in[i];
    a.out = (float*)d_out; a.ws = (unsigned char*)d_ws;
#if defined(MULTI_LAUNCH)
    for (int p = 0; p <= 10; ++p) { if (p > PH_MAX && p != 10) continue; a.ph_lo = p; a.ph_hi = p + 1; hipLaunchKernelGGL(fwd_megakernel, dim3(grid), dim3(NTHREADS), LDS_BYTES, stream, a); }
#else
    a.ph_lo = 0; a.ph_hi = 11;
    hipLaunchKernelGGL(fwd_megakernel, dim3(grid), dim3(NTHREADS), LDS_BYTES, stream, a);
#endif
}
```

```cpp
#include <hip/hip_runtime.h>
#include <hip/hip_cooperative_groups.h>
#include <cstdio>
#include <cstdint>
#include <cmath>
namespace cg = cooperative_groups;

#define LAS __attribute__((address_space(3)))
typedef unsigned short bf16;
typedef short bf16x8 __attribute__((ext_vector_type(8)));
typedef short s16x4 __attribute__((ext_vector_type(4)));
typedef float f32x4 __attribute__((ext_vector_type(4)));
typedef float f32x2 __attribute__((ext_vector_type(2)));
typedef float f32x16 __attribute__((ext_vector_type(16)));
typedef unsigned u32x4 __attribute__((ext_vector_type(4)));
typedef unsigned u32x2 __attribute__((ext_vector_type(2)));
typedef __bf16 bf16x2_t __attribute__((ext_vector_type(2)));

constexpr int NB = 4, SEQ = 4096, DM = 1024, NTOK = NB * SEQ;
constexpr int DIN = 6432, NIN = 6656;
constexpr int MEMLEN = 256, NMEMROW = NB * MEMLEN;
constexpr int NEXP = 32, TOPK = 4, FEXP = 1024;
constexpr int MAXSLOT = NTOK * TOPK + NEXP * 256;
constexpr float RMS_EPS = 1e-5f;
constexpr float LOG2E = 1.4426950408889634f;
constexpr float C2_64 = 0.125f * LOG2E;
constexpr float C2_128 = 0.08838834764831845f * LOG2E;
constexpr float NEGBIG = -1e30f;
constexpr float W8_SCALE = 32.0f, ACT8_SCALE = 4.0f;

constexpr size_t MiB = 1u << 20;
constexpr size_t WS_CTL = 0;
constexpr size_t CTL_BYTES = 64 * 1024;
constexpr size_t WS_ROPE_C = 1 * MiB, WS_ROPE_S = WS_ROPE_C + 512 * 1024;
constexpr size_t WS_W1T_K = 2 * MiB, WS_W1T_V = WS_W1T_K + 256 * 1024;
constexpr size_t WS_W2T_K = WS_W1T_V + 256 * 1024, WS_W2T_V = WS_W2T_K + 8192;
constexpr size_t WS_CPE = WS_W2T_V + 8192;
constexpr size_t WS_KCMP = 3 * MiB;
constexpr size_t WS_VCMP = WS_KCMP + 256 * 1024;
constexpr size_t WS_CUM = 4 * MiB;
constexpr size_t WS_KMAX = 4 * MiB + 512 * 1024;
constexpr size_t WS_KMEM = 5 * MiB, WS_VMEM = 6 * MiB;
constexpr size_t WS_ORDER = 7 * MiB;
constexpr size_t WS_BLKCNT = 7 * MiB + 64 * 1024;
constexpr size_t WS_TILE_E = 7 * MiB + 128 * 1024;
constexpr size_t WS_WRT = 7 * MiB + 256 * 1024;
constexpr size_t WS_RSTD = 7 * MiB + 512 * 1024;
constexpr size_t WS_RSLOT = 8 * MiB;
constexpr size_t WS_SLOTTOK = 8 * MiB + 512 * 1024;
constexpr size_t WS_WIN_T = 9 * MiB;
constexpr size_t WS_WBR_T = 24 * MiB;
constexpr size_t WS_WOUT_T = 27 * MiB;
constexpr size_t WS_WGU_T = 32 * MiB;
constexpr size_t WS_WD_T = 160 * MiB;
constexpr size_t WS_HA = 224 * MiB;
constexpr size_t WS_ETOK = 224 * MiB, WS_ERSTD = 226 * MiB;
constexpr int MT_OFF = 131072;
constexpr size_t WS_QA = 258 * MiB;
constexpr size_t WS_KV6 = 274 * MiB;
constexpr size_t WS_QM = 298 * MiB;
constexpr size_t WS_LG = 314 * MiB;
constexpr size_t WS_GATES = 316 * MiB;
constexpr size_t WS_QF = 412 * MiB, WS_KF = 428 * MiB, WS_VF = 444 * MiB;
constexpr size_t WS_ACT = 316 * MiB;
constexpr size_t WS_OBR = 460 * MiB;
constexpr size_t WS_MERGED = 508 * MiB;
constexpr size_t WS_H2 = 540 * MiB;
constexpr size_t WS_ROUTE = 572 * MiB;
constexpr size_t WS_AMOE = 576 * MiB;
constexpr size_t WS_END = 720 * MiB;
static_assert(WS_ACT + (size_t)MAXSLOT * 1024 * 2 <= WS_OBR && WS_AMOE + (size_t)MAXSLOT * 1024 * 2 <= WS_END, "ws map");
constexpr int CW_QATTN = 64;
constexpr int CW_DONE8 = 12288;
constexpr int CW_GCNT = 9216;
constexpr int CW_XBAR = 1024;

constexpr int LDS_BYTES = 155648;
constexpr int NWAVES = 8, NTHREADS = 512;

__device__ __forceinline__ unsigned cvtpk(float lo, float hi) { f32x2 v = {lo, hi}; bf16x2_t b = __builtin_convertvector(v, bf16x2_t); return __builtin_bit_cast(unsigned, b); }
__device__ __forceinline__ float bf2f(unsigned short h) { return __builtin_bit_cast(float, (unsigned)h << 16); }
__device__ __forceinline__ float bflo(unsigned u) { return __builtin_bit_cast(float, u << 16); }
__device__ __forceinline__ float bfhi(unsigned u) { return __builtin_bit_cast(float, u & 0xffff0000u); }
__device__ __forceinline__ float wave_sum(float v) {
#pragma unroll
    for (int o = 1; o < 64; o <<= 1) v += __shfl_xor(v, o);
    return v;
}
__device__ __forceinline__ float fast_sigmoid(float x) { return __builtin_amdgcn_rcpf(1.0f + __builtin_amdgcn_exp2f(-LOG2E * x)); }
__device__ __forceinline__ unsigned pk_fp8x4(float a, float b, float c, float d) {
    a = fminf(fmaxf(a, -448.f), 448.f); b = fminf(fmaxf(b, -448.f), 448.f); c = fminf(fmaxf(c, -448.f), 448.f); d = fminf(fmaxf(d, -448.f), 448.f);
    int p = __builtin_amdgcn_cvt_pk_fp8_f32(a, b, 0, false); p = __builtin_amdgcn_cvt_pk_fp8_f32(c, d, p, true); return (unsigned)p;
}
namespace pg8 {
#define PG8_LAS __attribute__((address_space(3)))
typedef unsigned short bf16_t;
typedef short bf16x8 __attribute__((ext_vector_type(8)));
typedef float f32x4 __attribute__((ext_vector_type(4)));
typedef unsigned u32x4 __attribute__((ext_vector_type(4)));
typedef unsigned u32x2 __attribute__((ext_vector_type(2)));
typedef int i32x8 __attribute__((ext_vector_type(8)));
typedef int i32x4 __attribute__((ext_vector_type(4)));
constexpr int BM = 256, BK = 64, HALF = 128, HTB = HALF * BK * 2  , STAGE_BYTES = 8 * HTB;

__host__ __device__ __forceinline__ int lds_byte(int r, int c) { const int st = (r >> 4) * 2 + (c >> 5), rr = r & 15, cc = c & 31, ob = rr * 64 + cc * 2; return st * 1024 + (ob ^ (((ob >> 9) & 1) << 5)); }
__host__ __device__ __forceinline__ void stage_rc(int b, int& R, int& C) { const int st = b / 1024, sb = b % 1024, swz = sb ^ (((sb >> 9) & 1) << 5); R = (st >> 1) * 16 + swz / 64; C = (st & 1) * 32 + (swz % 64) / 2; }
__host__ __device__ __forceinline__ int perm32(int rho) { const int n = rho >> 4, i = rho & 15; return 8 * (i >> 2) + 4 * n + (i & 3); }

struct Unit { int pm, pn; };

template <bool F8, class Epi, class Sched>
__device__ __forceinline__ void gemm_phase(PG8_LAS unsigned char* lds, const int K, const Sched& S, const Epi& E) {
    const int tid = threadIdx.x, wid = __builtin_amdgcn_readfirstlane(tid >> 6), lane = tid & 63, wr = wid >> 2, wc = wid & 3, fr = lane & 15, fq = lane >> 4;
    const int nt = K / BK;
    unsigned voffB[2]; int RA[2], CA[2];
    { int R, C; stage_rc(tid * 16, R, C); const int Rb = (R & ~31) + perm32(R & 31);
      RA[0] = R; CA[0] = C; RA[1] = R + 64; CA[1] = C; voffB[0] = (unsigned)(Rb * K + C) * 2u; voffB[1] = voffB[0] + (unsigned)(64 * K * 2); }
    constexpr bool GATHER = Sched::GATHER;
    unsigned cofA[2][2], nofA[2][2];
#define PG8_AOFF(dst, u) do { _Pragma("unroll") for (int h_ = 0; h_ < 2; ++h_) _Pragma("unroll") for (int i_ = 0; i_ < 2; ++i_) dst[h_][i_] = S.a_voff(u, h_, RA[i_], CA[i_], K); } while (0)
    const size_t kstep = (size_t)(BK * 2);
    const size_t hstep = (size_t)HALF * K * 2;
    const unsigned ldsw = (unsigned)wid * 1024u;
    const int aoff = lds_byte(wr * 64 + fr, fq * 8), boff = lds_byte(wc * 32 + fr, fq * 8);
    const int aoff8 = lds_byte(wr * 64 + fr, fq * 16), boff8 = lds_byte(wc * 32 + fr, fq * 16);
#define PG8_SA(b, h) (((b) * 2 + (h)) * HTB)
#define PG8_SB(b, h) ((4 + (b) * 2 + (h)) * HTB)
#define PG8_STAGE(bufoff, gbase, voff) do { _Pragma("unroll") for (int _i = 0; _i < 2; ++_i) \
        __builtin_amdgcn_global_load_lds((const unsigned*)((const char*)(gbase) + (voff)[_i]), (PG8_LAS unsigned*)(lds + (bufoff) + ldsw + _i * 8192), 16, 0, 0); } while (0)
#define PG8_LDA(dst, b, h) do { _Pragma("unroll") for (int m = 0; m < 4; ++m) _Pragma("unroll") for (int k = 0; k < 2; ++k) dst[m][k] = *(const PG8_LAS bf16x8*)(lds + PG8_SA(b, h) + aoff + m * 2048 + k * 1024); } while (0)
#define PG8_LDB(dst, b, h) do { _Pragma("unroll") for (int n = 0; n < 2; ++n) _Pragma("unroll") for (int k = 0; k < 2; ++k) dst[n][k] = *(const PG8_LAS bf16x8*)(lds + PG8_SB(b, h) + boff + n * 2048 + k * 1024); } while (0)
#define PG8_MMA(ai, bj, At, Bt) do { __builtin_amdgcn_s_setprio(1); _Pragma("unroll") for (int m = 0; m < 4; ++m) _Pragma("unroll") for (int n = 0; n < 2; ++n) _Pragma("unroll") for (int k = 0; k < 2; ++k) \
        acc[ai][bj][m][n] = __builtin_amdgcn_mfma_f32_16x16x32_bf16(Bt[n][k], At[m][k], acc[ai][bj][m][n], 0, 0, 0); __builtin_amdgcn_s_setprio(0); } while (0)
#define PG8_LD8(dst, base, o0, cnt) do { _Pragma("unroll") for (int q_ = 0; q_ < cnt; ++q_) { const i32x4 lo_ = *(const PG8_LAS i32x4*)(lds + (base) + (o0) + q_ * 2048), hi_ = *(const PG8_LAS i32x4*)(lds + (base) + (o0) + q_ * 2048 + 16); \
        dst[q_] = (i32x8){lo_[0], lo_[1], lo_[2], lo_[3], hi_[0], hi_[1], hi_[2], hi_[3]}; } } while (0)
#define PG8_MMA8(ai, bj, At, Bt) do { __builtin_amdgcn_s_setprio(1); _Pragma("unroll") for (int m = 0; m < 4; ++m) _Pragma("unroll") for (int n = 0; n < 2; ++n) \
        asm volatile("v_mfma_scale_f32_16x16x128_f8f6f4 %0, %1, %2, %0, %3, %3 op_sel_hi:[0,0,0]" : "+v"(acc[ai][bj][m][n]) : "v"(Bt[n]), "v"(At[m]), "v"(sc8)); asm volatile("s_nop 7" ::: "memory"); __builtin_amdgcn_s_setprio(0); } while (0)
#define PG8_WAIT_V(n) asm volatile("s_waitcnt vmcnt(" #n ")" ::: "memory")
#define PG8_WAIT_L(n) asm volatile("s_waitcnt lgkmcnt(" #n ")" ::: "memory")
#define PG8_BAR __builtin_amdgcn_s_barrier()
#define PG8_SCHED __builtin_amdgcn_sched_barrier(0)
    Unit cur, nxt; int ui = 0;
    if (!S.next(0, cur)) return;
    f32x4 acc[2][2][4][2];
#pragma unroll
    for (int a = 0; a < 2; ++a)
#pragma unroll
        for (int b = 0; b < 2; ++b)
#pragma unroll
            for (int m = 0; m < 4; ++m)
#pragma unroll
                for (int n = 0; n < 2; ++n) acc[a][b][m][n] = (f32x4){0.f, 0.f, 0.f, 0.f};
    bf16x8 At[4][2], B0[2][2], B1[2][2]; i32x8 At8[4], B08[2], B18[2]; int sc8 = 0x7f7f7f7f; asm volatile("" : "+v"(sc8));
    const char* cA = S.a_base(cur); const char* cB = S.b_base(cur);
    PG8_AOFF(cofA, cur);
    PG8_STAGE(PG8_SB(0, 0), cB, voffB); PG8_STAGE(PG8_SB(0, 1), cB + hstep, voffB); PG8_STAGE(PG8_SA(0, 0), cA, cofA[0]); PG8_STAGE(PG8_SA(0, 1), cA, cofA[1]);
    if (wr == 1) PG8_BAR;
    PG8_WAIT_V(2); PG8_BAR;
    PG8_STAGE(PG8_SB(1, 0), cB + kstep, voffB); PG8_STAGE(PG8_SA(1, 0), cA + kstep, cofA[0]); PG8_STAGE(PG8_SB(1, 1), cB + hstep + kstep, voffB);
    PG8_WAIT_V(6); PG8_BAR;
    for (;;) {
        const bool has_next = S.next(ui + 1, nxt);
        const char* nA = has_next ? S.a_base(nxt) : cA; const char* nB = has_next ? S.b_base(nxt) : cB;
        if constexpr (GATHER) { if (has_next) PG8_AOFF(nofA, nxt); else { _Pragma("unroll") for (int h_ = 0; h_ < 2; ++h_) _Pragma("unroll") for (int i_ = 0; i_ < 2; ++i_) nofA[h_][i_] = cofA[h_][i_]; } }
#pragma clang loop unroll(disable)
        for (int t = 0; t < nt; t += 2) {
            const bool last = (t == nt - 2);
            const char* a1 = cA + (size_t)(t + 1) * kstep;
            const char* a2 = last ? nA : cA + (size_t)(t + 2) * kstep; const char* b2 = last ? nB : cB + (size_t)(t + 2) * kstep;
            const char* a3 = a2 + kstep; const char* b3 = b2 + kstep;
            unsigned sofA[2][2];
            _Pragma("unroll") for (int h_ = 0; h_ < 2; ++h_) _Pragma("unroll") for (int i_ = 0; i_ < 2; ++i_) sofA[h_][i_] = (GATHER && last) ? nofA[h_][i_] : cofA[h_][i_];
            if constexpr (!F8) {
            PG8_LDB(B0, 0, 0); PG8_LDB(B1, 0, 1); PG8_SCHED; PG8_LDA(At, 0, 0); PG8_STAGE(PG8_SA(1, 1), a1, cofA[1]);
            PG8_WAIT_V(8); PG8_WAIT_L(0); PG8_BAR; PG8_MMA(0, 0, At, B0); PG8_MMA(0, 1, At, B1); PG8_BAR; PG8_SCHED;
            PG8_LDA(At, 0, 1); PG8_STAGE(PG8_SB(0, 0), b2, voffB); PG8_STAGE(PG8_SB(0, 1), b2 + hstep, voffB); PG8_STAGE(PG8_SA(0, 0), a2, sofA[0]);
            PG8_WAIT_V(8); PG8_WAIT_L(0); PG8_BAR; PG8_MMA(1, 0, At, B0); PG8_MMA(1, 1, At, B1); PG8_BAR; PG8_SCHED;
            PG8_LDB(B0, 1, 0); PG8_LDB(B1, 1, 1); PG8_SCHED; PG8_LDA(At, 1, 0); PG8_STAGE(PG8_SA(0, 1), a2, sofA[1]);
            PG8_WAIT_V(8); PG8_WAIT_L(0); PG8_BAR; PG8_MMA(0, 0, At, B0); PG8_MMA(0, 1, At, B1); PG8_BAR; PG8_SCHED;
            PG8_LDA(At, 1, 1); PG8_STAGE(PG8_SB(1, 0), b3, voffB); PG8_STAGE(PG8_SB(1, 1), b3 + hstep, voffB); PG8_STAGE(PG8_SA(1, 0), a3, sofA[0]);
            PG8_WAIT_V(8); PG8_WAIT_L(0); PG8_BAR; PG8_MMA(1, 0, At, B0); PG8_MMA(1, 1, At, B1); PG8_BAR; PG8_SCHED;
            } else {
            PG8_LD8(B08, PG8_SB(0, 0), boff8, 2); PG8_LD8(B18, PG8_SB(0, 1), boff8, 2); PG8_SCHED; PG8_LD8(At8, PG8_SA(0, 0), aoff8, 4); PG8_STAGE(PG8_SA(1, 1), a1, cofA[1]);
            PG8_WAIT_V(8); PG8_WAIT_L(0); PG8_BAR; PG8_MMA8(0, 0, At8, B08); PG8_MMA8(0, 1, At8, B18); PG8_BAR; PG8_SCHED;
            PG8_LD8(At8, PG8_SA(0, 1), aoff8, 4); PG8_STAGE(PG8_SB(0, 0), b2, voffB); PG8_STAGE(PG8_SB(0, 1), b2 + hstep, voffB); PG8_STAGE(PG8_SA(0, 0), a2, sofA[0]);
            PG8_WAIT_V(8); PG8_WAIT_L(0); PG8_BAR; PG8_MMA8(1, 0, At8, B08); PG8_MMA8(1, 1, At8, B18); PG8_BAR; PG8_SCHED;
            PG8_LD8(B08, PG8_SB(1, 0), boff8, 2); PG8_LD8(B18, PG8_SB(1, 1), boff8, 2); PG8_SCHED; PG8_LD8(At8, PG8_SA(1, 0), aoff8, 4); PG8_STAGE(PG8_SA(0, 1), a2, sofA[1]);
            PG8_WAIT_V(8); PG8_WAIT_L(0); PG8_BAR; PG8_MMA8(0, 0, At8, B08); PG8_MMA8(0, 1, At8, B18); PG8_BAR; PG8_SCHED;
            PG8_LD8(At8, PG8_SA(1, 1), aoff8, 4); PG8_STAGE(PG8_SB(1, 0), b3, voffB); PG8_STAGE(PG8_SB(1, 1), b3 + hstep, voffB); PG8_STAGE(PG8_SA(1, 0), a3, sofA[0]);
            PG8_WAIT_V(8); PG8_WAIT_L(0); PG8_BAR; PG8_MMA8(1, 0, At8, B08); PG8_MMA8(1, 1, At8, B18); PG8_BAR; PG8_SCHED;
            }
        }
        if constexpr (F8) asm volatile("s_nop 15\n\ts_nop 15" ::: "memory");
        if (wr == 0) PG8_BAR;
        E(acc, cur, wr, wc, fr, fq);
        if (!has_next) break;
        cur = nxt; cA = nA; cB = nB; ++ui;
        if constexpr (GATHER) { _Pragma("unroll") for (int h_ = 0; h_ < 2; ++h_) _Pragma("unroll") for (int i_ = 0; i_ < 2; ++i_) cofA[h_][i_] = nofA[h_][i_]; }
        if (wr == 1) PG8_BAR;
    }
    PG8_WAIT_V(0);
    PG8_BAR;
#undef PG8_AOFF
#undef PG8_SA
#undef PG8_SB
#undef PG8_STAGE
#undef PG8_LDA
#undef PG8_LDB
#undef PG8_MMA
#undef PG8_MMA8
#undef PG8_LD8
#undef PG8_WAIT_V
#undef PG8_WAIT_L
#undef PG8_BAR
#undef PG8_SCHED
}
}
typedef float acc_t[2][2][4][2] __attribute__((unused));
#define ACC_ARG pg8::f32x4 (&acc)[2][2][4][2]
#define ZERO_ACC() do { _Pragma("unroll") for (int a_ = 0; a_ < 2; ++a_) _Pragma("unroll") for (int b_ = 0; b_ < 2; ++b_) _Pragma("unroll") for (int m_ = 0; m_ < 4; ++m_) _Pragma("unroll") for (int n_ = 0; n_ < 2; ++n_) acc[a_][b_][m_][n_] = (pg8::f32x4){0.f, 0.f, 0.f, 0.f}; } while (0)

__device__ __forceinline__ bool static_unit(int L, int nM, int nN, pg8::Unit& u) {
    const int nwg = nM * nN; if (L >= nwg) return false;
    int wgid = L; { const int q = nwg / 8, r = nwg % 8, xcd = wgid % 8, off = wgid / 8; wgid = (xcd < r ? xcd * (q + 1) : r * (q + 1) + (xcd - r) * q) + off; }
    const int nig = 8 * nN, gid = wgid / nig, fm = gid * 8, gsz = (nM - fm) < 8 ? (nM - fm) : 8;
    u.pm = fm + ((wgid % nig) % gsz); u.pn = (wgid % nig) / gsz; return true;
}

struct SchedIn {
    static constexpr bool GATHER = false;
    const char* A; const char* Bt; int G, c;
    __device__ __forceinline__ bool next(int i, pg8::Unit& u) const {
        const int L = i * G + c;
        if (L < 1664) return static_unit(L, 64, 26, u);
        if (L < 1680) { const int j = L - 1664; u.pm = 64 + (j >> 2); u.pn = 26 + (j & 3); return true; }
        return false;
    }
    __device__ __forceinline__ const char* a_base(const pg8::Unit& u) const { return A + (size_t)u.pm * (256 * 1024 * 2); }
    __device__ __forceinline__ const char* b_base(const pg8::Unit& u) const { return Bt + (size_t)u.pn * (256 * 1024 * 2); }
    __device__ __forceinline__ unsigned a_voff(const pg8::Unit&, int h, int R, int C, int K) const { return (unsigned)(((h * 128 + R) * K + C) * 2); }
};
struct SchedBr {
    static constexpr bool GATHER = false;
    const char* A; const char* Bt; int G, c;
    __device__ __forceinline__ bool next(int i, pg8::Unit& u) const {
        const int rnd = i / 3, br = i - rnd * 3; pg8::Unit t;
        if (!static_unit(rnd * G + c, 64, 4, t)) return false;
        u.pm = 64 * br + t.pm; u.pn = 4 * br + t.pn; return true;
    }
    __device__ __forceinline__ const char* a_base(const pg8::Unit& u) const { return A + (size_t)u.pm * (256 * 512 * 2); }
    __device__ __forceinline__ const char* b_base(const pg8::Unit& u) const { return Bt + (size_t)u.pn * (256 * 512 * 2); }
    __device__ __forceinline__ unsigned a_voff(const pg8::Unit&, int h, int R, int C, int K) const { return (unsigned)(((h * 128 + R) * K + C) * 2); }
};
struct SchedOut {
    static constexpr bool GATHER = false;
    const char* A; const char* Bt; int G, c;
    __device__ __forceinline__ bool next(int i, pg8::Unit& u) const { return static_unit(i * G + c, 64, 4, u); }
    __device__ __forceinline__ const char* a_base(const pg8::Unit& u) const { return A + (size_t)u.pm * (256 * 1024 * 2); }
    __device__ __forceinline__ const char* b_base(const pg8::Unit& u) const { return Bt + (size_t)u.pn * (256 * 1024 * 2); }
    __device__ __forceinline__ unsigned a_voff(const pg8::Unit&, int h, int R, int C, int K) const { return (unsigned)(((h * 128 + R) * K + C) * 2); }
};
template <bool G_> struct SchedMoE {
    static constexpr bool GATHER = G_;
    const char* A; const char* Bt; const LAS int* tile_e; const int* etok; int nmt, nN, G, v; size_t estride; int i0, i1;
    __device__ __forceinline__ bool next(int i, pg8::Unit& u) const {
        if (i + i0 >= i1) return false;
        const int L = (i + i0) * G + v; if (L < 0 || L >= nmt * nN) return false;
        u.pm = L / nN; u.pn = L - u.pm * nN; return true;
    }
    __device__ __forceinline__ const char* a_base(const pg8::Unit& u) const { return G_ ? A : A + (size_t)u.pm * (256 * 1024); }
    __device__ __forceinline__ const char* b_base(const pg8::Unit& u) const { return Bt + (size_t)(__builtin_amdgcn_readfirstlane(tile_e[u.pm]) & 31) * estride + (size_t)u.pn * (256 * 1024); }
    __device__ __forceinline__ unsigned a_voff(const pg8::Unit& u, int h, int R, int C, int K) const {
        if (!G_) return (unsigned)(((h * 128 + R) * K + C) * 2);
        const int te_ = __builtin_amdgcn_readfirstlane(tile_e[u.pm]);
        unsigned t = (unsigned)etok[(te_ & 31) * NTOK + (te_ >> 5) * 256 + h * 128 + R]; t = t < (unsigned)NTOK ? t : 0u;
        return (t * (unsigned)K + (unsigned)C) * 2u;
    }
};


struct EpiIn {
    bf16 *QA, *KV6, *QF, *KF, *VF, *QM, *GATES, *KMEM, *VMEM; float* LG;
    const float *ropeC, *ropeS, *b_merge;
    __device__ __forceinline__ void operator()(ACC_ARG, const pg8::Unit& u, int wr, int wc, int fr, int fq) const {
        const int pn = u.pn, rowb = u.pm * 256 + wr * 64 + fr;
        if (pn < 13) {
#pragma unroll
            for (int bj = 0; bj < 2; ++bj) {
                const int L0 = (4 * pn + 2 * bj + (wc >> 1)) * 64, a4 = 4 * (4 * (wc & 1) + fq);
                bf16* dst; int pitch, col0; bool rope = false; float sc = 1.f;
                if (L0 < 512) { dst = QA; pitch = 512; col0 = L0; rope = true; sc = C2_64; }
                else if (L0 < 1280) { const int kk = (L0 - 512) >> 7; dst = KV6 + (size_t)kk * NTOK * 128; pitch = 128; col0 = (L0 - 512) & 127; rope = !(kk & 1); }
                else if (L0 < 1792) { dst = QF; pitch = 512; col0 = L0 - 1280; sc = C2_64; }
                else if (L0 < 2304) { dst = KF; pitch = 512; col0 = L0 - 1792; }
                else if (L0 < 2816) { dst = VF; pitch = 512; col0 = L0 - 2304; }
                else { dst = QM; pitch = 512; col0 = L0 - 2816; sc = C2_128; }
                pg8::f32x4 cv[2][4], sv[2][4];
                if (rope) {
#pragma unroll
                    for (int ai = 0; ai < 2; ++ai)
#pragma unroll
                        for (int m = 0; m < 4; ++m) { const int t = (rowb + 128 * ai + 16 * m) & (SEQ - 1); cv[ai][m] = *(const pg8::f32x4*)(ropeC + t * 32 + a4); sv[ai][m] = *(const pg8::f32x4*)(ropeS + t * 32 + a4); }
                }
                __builtin_amdgcn_sched_barrier(0);
#pragma unroll
                for (int ai = 0; ai < 2; ++ai)
#pragma unroll
                    for (int m = 0; m < 4; ++m) {
                        const int r = rowb + 128 * ai + 16 * m;
                        pg8::f32x4 x1 = acc[ai][bj][m][0], x2 = acc[ai][bj][m][1];
                        if (rope) { const pg8::f32x4 c4 = cv[ai][m], s4 = sv[ai][m];
                            const pg8::f32x4 y1 = x1 * c4 - x2 * s4, y2 = x2 * c4 + x1 * s4; x1 = y1; x2 = y2; }
                        x1 = x1 * sc; x2 = x2 * sc;
                        bf16* p = dst + (size_t)r * pitch + col0 + a4;
                        *(u32x2*)p = (u32x2){cvtpk(x1[0], x1[1]), cvtpk(x1[2], x1[3])};
                        *(u32x2*)(p + 32) = (u32x2){cvtpk(x2[0], x2[1]), cvtpk(x2[2], x2[3])};
                    }
            }
        } else if (pn < 25) {
            pg8::f32x4 bv[2][2];
#pragma unroll
            for (int bj = 0; bj < 2; ++bj) { const int cg = 256 * (pn - 13) + 128 * bj + 32 * wc + 8 * fq; bv[bj][0] = *(const pg8::f32x4*)(b_merge + cg); bv[bj][1] = *(const pg8::f32x4*)(b_merge + cg + 4); }
            __builtin_amdgcn_sched_barrier(0);
#pragma unroll
            for (int bj = 0; bj < 2; ++bj) {
                const int cg = 256 * (pn - 13) + 128 * bj + 32 * wc + 8 * fq;
                const pg8::f32x4 b0 = bv[bj][0], b1 = bv[bj][1];
#pragma unroll
                for (int ai = 0; ai < 2; ++ai)
#pragma unroll
                    for (int m = 0; m < 4; ++m) {
                        const int r = rowb + 128 * ai + 16 * m;
                        const pg8::f32x4 v0 = acc[ai][bj][m][0] + b0, v1 = acc[ai][bj][m][1] + b1;
                        u32x2 w; unsigned p = 0u;
#pragma unroll
                        for (int k = 0; k < 4; ++k) p = __builtin_amdgcn_cvt_pk_u8_f32(fmaxf(255.f * fast_sigmoid(v0[k]), 1.f), k, p);
                        w.x = p; p = 0u;
#pragma unroll
                        for (int k = 0; k < 4; ++k) p = __builtin_amdgcn_cvt_pk_u8_f32(fmaxf(255.f * fast_sigmoid(v1[k]), 1.f), k, p);
                        w.y = p;
                        *(u32x2*)((unsigned char*)GATES + (size_t)r * 3072 + cg) = w;
                    }
            }
        } else if (pn == 25) {
            if (wc == 0) {
#pragma unroll
                for (int ai = 0; ai < 2; ++ai)
#pragma unroll
                    for (int m = 0; m < 4; ++m) {
                        const int r = rowb + 128 * ai + 16 * m;
                        float* p = LG + (size_t)r * 32 + 8 * fq;
                        *(pg8::f32x4*)p = acc[ai][0][m][0]; *(pg8::f32x4*)(p + 4) = acc[ai][0][m][1];
                    }
            }
        } else {
#pragma unroll
            for (int bj = 0; bj < 2; ++bj) {
                const int cgl = 256 * (pn - 26) + 128 * bj + 32 * wc + 8 * fq;
                bf16* dst = (cgl < 512) ? KMEM : VMEM; const int col = cgl & 511;
#pragma unroll
                for (int ai = 0; ai < 2; ++ai)
#pragma unroll
                    for (int m = 0; m < 4; ++m) {
                        const int r = rowb + 128 * ai + 16 * m - NTOK;
                        const pg8::f32x4 v0 = acc[ai][bj][m][0], v1 = acc[ai][bj][m][1];
                        u32x4 w; w.x = cvtpk(v0[0], v0[1]); w.y = cvtpk(v0[2], v0[3]); w.z = cvtpk(v1[0], v1[1]); w.w = cvtpk(v1[2], v1[3]);
                        *(u32x4*)(dst + (size_t)r * 512 + col) = w;
                    }
            }
        }
        ZERO_ACC();
    }
};

struct EpiBr {
    const bf16* GATES; bf16* MERGED;
    __device__ __forceinline__ void operator()(ACC_ARG, const pg8::Unit& u, int wr, int wc, int fr, int fq) const {
        const int br = u.pn >> 2, tn = u.pn & 3, tm = u.pm & 63, rowb = tm * 256 + wr * 64 + fr;
        const unsigned char* gp = (const unsigned char*)GATES + (size_t)rowb * 3072 + 1024 * br + 256 * tn + 32 * wc + 8 * fq;
        u32x2 GA[2][4][2], GB[2][4][2];
#pragma unroll
        for (int ai = 0; ai < 2; ++ai)
#pragma unroll
            for (int m = 0; m < 4; ++m)
#pragma unroll
                for (int bj = 0; bj < 2; ++bj) { const unsigned char* p = gp + (size_t)(128 * ai + 16 * m) * 3072 + 128 * bj;
                    GA[ai][m][bj] = *(const u32x2*)p; GB[ai][m][bj] = (br < 2) ? *(const u32x2*)(p + 1024) : (u32x2){0u, 0u}; }
        __builtin_amdgcn_sched_barrier(0);
#pragma unroll
        for (int ai = 0; ai < 2; ++ai)
#pragma unroll
            for (int m = 0; m < 4; ++m) {
                const int r = rowb + 128 * ai + 16 * m;
#pragma unroll
                for (int bj = 0; bj < 2; ++bj) {
                    const int c0 = 256 * tn + 128 * bj + 32 * wc + 8 * fq;
                    const u32x2 ga = GA[ai][m][bj];
                    pg8::f32x4 g0 = {(float)(ga.x & 255u), (float)((ga.x >> 8) & 255u), (float)((ga.x >> 16) & 255u), (float)(ga.x >> 24)}, g1 = {(float)(ga.y & 255u), (float)((ga.y >> 8) & 255u), (float)((ga.y >> 16) & 255u), (float)(ga.y >> 24)};
#if defined(ABL_BR)
                    if (!((ABL_BR >> br) & 1)) { acc[ai][bj][m][0] = acc[ai][bj][m][0] * 0.f; acc[ai][bj][m][1] = acc[ai][bj][m][1] * 0.f; }
#endif
                    if (br < 2) {
                        const u32x2 gb = GB[ai][m][bj];
                        const pg8::f32x4 h0 = {(float)(gb.x & 255u), (float)((gb.x >> 8) & 255u), (float)((gb.x >> 16) & 255u), (float)(gb.x >> 24)}, h1 = {(float)(gb.y & 255u), (float)((gb.y >> 8) & 255u), (float)((gb.y >> 16) & 255u), (float)(gb.y >> 24)};
#pragma unroll
                        for (int k = 0; k < 4; ++k) { g0[k] = g0[k] * __builtin_amdgcn_rcpf(fmaxf(h0[k], 1.f)); g1[k] = g1[k] * __builtin_amdgcn_rcpf(fmaxf(h1[k], 1.f)); }
                        acc[ai][bj][m][0] = acc[ai][bj][m][0] * g0; acc[ai][bj][m][1] = acc[ai][bj][m][1] * g1;
                    } else {
                        const pg8::f32x4 v0 = acc[ai][bj][m][0] * g0 * (1.f / 255.f), v1 = acc[ai][bj][m][1] * g1 * (1.f / 255.f);
                        u32x4 w; w.x = cvtpk(v0[0], v0[1]); w.y = cvtpk(v0[2], v0[3]); w.z = cvtpk(v1[0], v1[1]); w.w = cvtpk(v1[2], v1[3]);
                        *(u32x4*)(MERGED + (size_t)r * 1024 + c0) = w;
                        acc[ai][bj][m][0] = (pg8::f32x4){0.f, 0.f, 0.f, 0.f}; acc[ai][bj][m][1] = (pg8::f32x4){0.f, 0.f, 0.f, 0.f};
                    }
                }
            }
    }
};

struct EpiOut {
    const float* X; float* X1; unsigned char* XB8;
    __device__ __forceinline__ void operator()(ACC_ARG, const pg8::Unit& u, int wr, int wc, int fr, int fq) const {
        const int rowb = u.pm * 256 + wr * 64 + fr;
        const size_t ob = (size_t)rowb * 1024 + 256 * u.pn + 32 * wc + 8 * fq;
#pragma unroll
        for (int ai = 0; ai < 2; ++ai) {
            pg8::f32x4 xs[4][2][2];
#pragma unroll
            for (int m = 0; m < 4; ++m)
#pragma unroll
                for (int bj = 0; bj < 2; ++bj) { const float* p = X + ob + (size_t)(128 * ai + 16 * m) * 1024 + 128 * bj; xs[m][bj][0] = *(const pg8::f32x4*)p; xs[m][bj][1] = *(const pg8::f32x4*)(p + 4); }
            __builtin_amdgcn_sched_barrier(0);
#pragma unroll
            for (int m = 0; m < 4; ++m)
#pragma unroll
                for (int bj = 0; bj < 2; ++bj) {
                    const size_t o = ob + (size_t)(128 * ai + 16 * m) * 1024 + 128 * bj;
                    const pg8::f32x4 y0 = xs[m][bj][0] + acc[ai][bj][m][0], y1 = xs[m][bj][1] + acc[ai][bj][m][1];
                    *(pg8::f32x4*)(X1 + o) = y0; *(pg8::f32x4*)(X1 + o + 4) = y1;
                    *(u32x2*)(XB8 + o) = (u32x2){pk_fp8x4(y0[0], y0[1], y0[2], y0[3]), pk_fp8x4(y1[0], y1[1], y1[2], y1[3])};
                }
            __builtin_amdgcn_sched_barrier(0);
        }
        ZERO_ACC();
    }
};

__device__ __forceinline__ float swiglu(float g, float uu) {
    g = fminf(g, 7.0f); uu = fminf(fmaxf(uu, -7.0f), 7.0f);
    return (uu + 1.0f) * g * __builtin_amdgcn_rcpf(1.0f + __builtin_amdgcn_exp2f(-1.702f * LOG2E * g));
}
struct EpiGU {
    const float* bias; const LAS int* tile_e; unsigned char* ACT8; const float* erstd;
    __device__ __forceinline__ void operator()(ACC_ARG, const pg8::Unit& u, int wr, int wc, int fr, int fq) const {
        const int te_ = __builtin_amdgcn_readfirstlane(tile_e[u.pm]), e = te_ & 31, rowb = u.pm * 256 + wr * 64 + fr;
        const float* rslot = erstd + (size_t)e * NTOK + (te_ >> 5) * 256 - u.pm * 256;
        float rsv[2][4]; pg8::f32x4 bv[2][2];
#pragma unroll
        for (int ai = 0; ai < 2; ++ai)
#pragma unroll
            for (int m = 0; m < 4; ++m) rsv[ai][m] = rslot[rowb + 128 * ai + 16 * m];
#pragma unroll
        for (int bj = 0; bj < 2; ++bj) { const int c0 = 256 * u.pn + 128 * bj + 32 * wc + 8 * fq; bv[bj][0] = *(const pg8::f32x4*)(bias + (size_t)e * 2048 + c0); bv[bj][1] = *(const pg8::f32x4*)(bias + (size_t)e * 2048 + c0 + 4); }
        __builtin_amdgcn_sched_barrier(0);
#pragma unroll
        for (int bj = 0; bj < 2; ++bj) {
            const int c0 = 256 * u.pn + 128 * bj + 32 * wc + 8 * fq;
            const pg8::f32x4 b0 = bv[bj][0], b1 = bv[bj][1];
#pragma unroll
            for (int ai = 0; ai < 2; ++ai)
#pragma unroll
                for (int m = 0; m < 4; ++m) {
                    const int r = rowb + 128 * ai + 16 * m; const float rs = rsv[ai][m] * (1.0f / W8_SCALE);
                    const pg8::f32x4 v0 = acc[ai][bj][m][0] * rs + b0, v1 = acc[ai][bj][m][1] * rs + b1;
                    *(unsigned*)(ACT8 + (size_t)r * 1024 + (c0 >> 1)) = pk_fp8x4(ACT8_SCALE * swiglu(v0[0], v0[1]), ACT8_SCALE * swiglu(v0[2], v0[3]), ACT8_SCALE * swiglu(v1[0], v1[1]), ACT8_SCALE * swiglu(v1[2], v1[3]));
                }
        }
        ZERO_ACC();
    }
};
struct EpiDn {
    const float* bias; const LAS int* tile_e; bf16* OS;
    __device__ __forceinline__ void operator()(ACC_ARG, const pg8::Unit& u, int wr, int wc, int fr, int fq) const {
        const int e = __builtin_amdgcn_readfirstlane(tile_e[u.pm]) & 31, rowb = u.pm * 256 + wr * 64 + fr;
        pg8::f32x4 bv[2][2];
#pragma unroll
        for (int bj = 0; bj < 2; ++bj) { const int c0 = 256 * u.pn + 128 * bj + 32 * wc + 8 * fq; bv[bj][0] = *(const pg8::f32x4*)(bias + (size_t)e * 1024 + c0); bv[bj][1] = *(const pg8::f32x4*)(bias + (size_t)e * 1024 + c0 + 4); }
        __builtin_amdgcn_sched_barrier(0);
#pragma unroll
        for (int bj = 0; bj < 2; ++bj) {
            const int c0 = 256 * u.pn + 128 * bj + 32 * wc + 8 * fq;
            const pg8::f32x4 b0 = bv[bj][0], b1 = bv[bj][1];
#pragma unroll
            for (int ai = 0; ai < 2; ++ai)
#pragma unroll
                for (int m = 0; m < 4; ++m) {
                    const int r = rowb + 128 * ai + 16 * m;
                    const pg8::f32x4 v0 = acc[ai][bj][m][0] * (1.0f / (W8_SCALE * ACT8_SCALE)) + b0, v1 = acc[ai][bj][m][1] * (1.0f / (W8_SCALE * ACT8_SCALE)) + b1;
                    u32x4 w; w.x = cvtpk(v0[0], v0[1]); w.y = cvtpk(v0[2], v0[3]); w.z = cvtpk(v1[0], v1[1]); w.w = cvtpk(v1[2], v1[3]);
                    *(u32x4*)(OS + (size_t)r * 1024 + c0) = w;
                }
        }
        ZERO_ACC();
    }
};
struct KArgs { const float* in[26]; float* out; unsigned char* ws; int ph_lo, ph_hi; };
struct Frame {
    LAS unsigned char* lds;
    int tid, lane, wave, G, bid, vcu;
    const KArgs __attribute__((address_space(4)))* ka; float* out; unsigned char* ws;
};
#define WSP(T, off) ((T*)(F.ws + (off)))

__device__ __forceinline__ int win_srccol(int n) {
    if (n < 3328) { const int p = n & 63, d = 4 * (p >> 3) + (p & 3) + 32 * ((p >> 2) & 1), L = (n & ~63) + d;
        if (L < 1280) return L; if (L < 1792) return 1304 + (L - 1280); if (L < 2304) return 1816 + (L - 1792); if (L < 2816) return 2328 + (L - 2304); return 2848 + (L - 2816); }
    if (n < 6400) return 3360 + (n - 3328);
    if (n < 6424) return 1280 + (n - 6400);
    if (n < 6432) return 2840 + (n - 6424);
    return -1;
}
__device__ __forceinline__ void transpose_item(const float* __restrict__ W, int N, bf16* __restrict__ Wt, int Kd, int n0, int k0, int sc, LAS float* scr, int lane, const float* __restrict__ kscale = nullptr) {
    const float* src = W + (size_t)k0 * N + (sc >= 0 ? sc : 0);
    float v[64];
#pragma unroll
    for (int kk = 0; kk < 64; ++kk) v[kk] = src[(size_t)kk * N];
    if (kscale) {
#pragma unroll
        for (int kk = 0; kk < 64; ++kk) v[kk] *= kscale[k0 + kk];
    }
#pragma unroll
    for (int kk = 0; kk < 64; ++kk) scr[kk * 65 + lane] = (sc >= 0) ? v[kk] : 0.f;
    asm volatile("s_waitcnt lgkmcnt(0)" ::: "memory");
    const int c = lane & 7;
#pragma unroll
    for (int j = 0; j < 8; ++j) { const int n = (lane >> 3) + 8 * j; const LAS float* s = scr + (8 * c) * 65 + n;
        u32x4 o; o.x = cvtpk(s[0], s[65]); o.y = cvtpk(s[2 * 65], s[3 * 65]); o.z = cvtpk(s[4 * 65], s[5 * 65]); o.w = cvtpk(s[6 * 65], s[7 * 65]);
        *(u32x4*)(Wt + (size_t)(n0 + n) * Kd + k0 + 8 * c) = o; }
    asm volatile("s_waitcnt lgkmcnt(0)" ::: "memory");
}
__device__ __forceinline__ void transpose_item8(const float* __restrict__ W, int N, unsigned char* __restrict__ Wt8, int Kd, int n0, int k0, LAS unsigned char* scr, int lane, const float* __restrict__ kscale, float mul) {
    const float* src = W + (size_t)k0 * N + n0 + lane;
#pragma unroll
    for (int half = 0; half < 2; ++half) {
        float v[64];
#pragma unroll
        for (int kk = 0; kk < 64; ++kk) v[kk] = src[(size_t)(64 * half + kk) * N];
#pragma unroll
        for (int kk = 0; kk < 64; ++kk) v[kk] *= kscale ? mul * kscale[k0 + 64 * half + kk] : mul;
#pragma unroll
        for (int j = 0; j < 32; ++j) { const float a = fminf(fmaxf(v[2 * j], -448.f), 448.f), b = fminf(fmaxf(v[2 * j + 1], -448.f), 448.f);
            *(LAS unsigned short*)(scr + lane * 132 + 64 * half + 2 * j) = (unsigned short)__builtin_amdgcn_cvt_pk_fp8_f32(a, b, 0, false); }
    }
    asm volatile("s_waitcnt lgkmcnt(0)" ::: "memory");
    const int c = lane & 7;
#pragma unroll
    for (int j = 0; j < 8; ++j) { const int n = (lane >> 3) + 8 * j; const LAS unsigned* s = (const LAS unsigned*)(scr + n * 132 + 16 * c);
        u32x4 o; o.x = s[0]; o.y = s[1]; o.z = s[2]; o.w = s[3];
        *(u32x4*)(Wt8 + (size_t)(n0 + n) * Kd + k0 + 16 * c) = o; }
    asm volatile("s_waitcnt lgkmcnt(0)" ::: "memory");
}
__device__ __forceinline__ void rms_row_bf16(const float* __restrict__ xrow, const float* __restrict__ g, bf16* __restrict__ orow, int lane) {
    const f32x4* xr = (const f32x4*)xrow + lane; const f32x4* gr = (const f32x4*)g + lane;
    f32x4 v[4]; float s = 0.f;
#pragma unroll
    for (int j = 0; j < 4; ++j) { v[j] = xr[64 * j]; s += (v[j].x * v[j].x + v[j].y * v[j].y) + (v[j].z * v[j].z + v[j].w * v[j].w); }
    const float rstd = 1.0f / sqrtf(wave_sum(s) * (1.f / 1024.f) + RMS_EPS);
    u32x2* o8 = (u32x2*)orow + lane;
#pragma unroll
    for (int j = 0; j < 4; ++j) { const f32x4 gg = gr[64 * j]; o8[64 * j] = (u32x2){cvtpk(v[j].x * rstd * gg.x, v[j].y * rstd * gg.y), cvtpk(v[j].z * rstd * gg.z, v[j].w * rstd * gg.w)}; }
}
__device__ __forceinline__ void sincos_big(float ang, float& s, float& c) {
    const double x = (double)ang; const double kf = __builtin_rint(x * 0.63661977236758134308); const int k = (int)kf;
    const double r = (x - kf * 1.57079632679489655800) - kf * 6.123233995736766036e-17, r2 = r * r;
    const double sp = r * (1.0 + r2 * (-1.0 / 6 + r2 * (1.0 / 120 + r2 * (-1.0 / 5040 + r2 * (1.0 / 362880 - r2 * (1.0 / 39916800))))));
    const double cp = 1.0 + r2 * (-0.5 + r2 * (1.0 / 24 + r2 * (-1.0 / 720 + r2 * (1.0 / 40320 + r2 * (-1.0 / 3628800 + r2 * (1.0 / 479001600))))));
    const double ss = (k & 1) ? cp : sp, cc = (k & 1) ? sp : cp;
    s = (float)((k & 2) ? -ss : ss); c = (float)(((k + 1) & 2) ? -cc : cc);
}
__device__ __forceinline__ void attn_unit_desc(int i, unsigned& desc, int& cost) {
    if (i < 512) { const int bg = i >> 6, T = i & 63; desc = 0u | (bg << 3) | (T << 11); cost = 8 + (T + 1) + (T < 8 ? T + 1 : 9) + 2 * (T / 4 + 1); }
    else { const int j = i - 512, bh = j >> 4, qb = j & 15; desc = 1u | (bh << 3) | (qb << 11); cost = (7 * (3 + 4 * qb + 3)) / 10; }
}
constexpr int N_SORTED = 1024, MAXCOST = 128, N_CVT_UNITS = 256, CVT_CHUNK = 12;
constexpr int Q_CMP0 = 0, Q_CUM0 = 128, Q_CVT0 = 132, Q_MEM0 = Q_CVT0 + N_CVT_UNITS, Q_SRT0 = Q_MEM0 + 256, N_QUEUE = Q_SRT0 + N_SORTED;
constexpr int CW_CMPDONE = 8192, CW_CUMDONE = 8192 + 64 * 8;

__device__ __forceinline__ void p0_prologue(Frame& F) {
    LAS float* scr = (LAS float*)(F.lds + F.wave * 16640);
    const int gw = F.vcu * NWAVES + F.wave, NGW = F.G * NWAVES, lane = F.lane;
    bf16* HA = WSP(bf16, WS_HA);
    for (int m0 = gw; m0 < NTOK + NMEMROW; m0 += 4 * NGW) {
        f32x4 v[4][4]; float ss[4]; const float* xr[4]; bool has[4];
#pragma unroll
        for (int q = 0; q < 4; ++q) { const int m = m0 + q * NGW; has[q] = m < NTOK + NMEMROW; const int mm = has[q] ? m : m0;
            xr[q] = (mm < NTOK) ? F.ka->in[0] + (size_t)mm * DM : F.ka->in[1] + (size_t)(mm - NTOK) * DM; }
#pragma unroll
        for (int j = 0; j < 4; ++j)
#pragma unroll
            for (int q = 0; q < 4; ++q) v[q][j] = ((const f32x4*)xr[q])[64 * j + lane];
#pragma unroll
        for (int q = 0; q < 4; ++q) { float s_ = 0.f;
#pragma unroll
            for (int j = 0; j < 4; ++j) s_ += (v[q][j].x * v[q][j].x + v[q][j].y * v[q][j].y) + (v[q][j].z * v[q][j].z + v[q][j].w * v[q][j].w);
            ss[q] = s_; }
#pragma unroll
        for (int o = 1; o < 64; o <<= 1) {
#pragma unroll
            for (int q = 0; q < 4; ++q) ss[q] += __shfl_xor(ss[q], o); }
#pragma unroll
        for (int q = 0; q < 4; ++q) { const int m = m0 + q * NGW; const float r = 1.0f / sqrtf(ss[q] * (1.f / 1024.f) + RMS_EPS);
            const f32x4* g = (const f32x4*)((m < NTOK) ? F.ka->in[2] : F.ka->in[12]);
            if (has[q]) {
#pragma unroll
                for (int j = 0; j < 4; ++j) { const f32x4 a = g[64 * j + lane];
                    ((u32x2*)(HA + (size_t)m * DM))[64 * j + lane] = (u32x2){cvtpk(v[q][j].x * r * a.x, v[q][j].y * r * a.y), cvtpk(v[q][j].z * r * a.z, v[q][j].w * r * a.w)}; } } }
    }
    constexpr int I_WIN = 104 * 16, I_MKV = 16 * 16, I_BR = 16 * 8, I_OUT = 256, I_W1 = 32, I_W2 = 1;
    constexpr int NITEMS = I_WIN + I_MKV + 3 * I_BR + I_OUT + 2 * I_W1 + 2 * I_W2;
    for (int it = gw; it < NITEMS; it += NGW) {
        int r = it;
        if (r < I_WIN) { const int kt = r / 104, nt = r - kt * 104; transpose_item(F.ka->in[3], DIN, WSP(bf16, WS_WIN_T), 1024, nt * 64, kt * 64, win_srccol(nt * 64 + lane), scr, lane); continue; } r -= I_WIN;
        if (r < I_MKV) { const int kt = r >> 4, nt = r & 15; transpose_item(F.ka->in[13], 1024, WSP(bf16, WS_WIN_T) + (size_t)NIN * 1024, 1024, nt * 64, kt * 64, nt * 64 + lane, scr, lane); continue; } r -= I_MKV;
        if (r < 3 * I_BR) { const int b = r / I_BR, q = r - b * I_BR, kt = q >> 4, nt = q & 15; transpose_item(b == 0 ? F.ka->in[14] : (b == 1 ? F.ka->in[15] : F.ka->in[16]), 1024, WSP(bf16, WS_WBR_T) + (size_t)b * 1024 * 512, 512, nt * 64, kt * 64, nt * 64 + lane, scr, lane); continue; } r -= 3 * I_BR;
        if (r < I_OUT) { const int kt = r >> 4, nt = r & 15; transpose_item(F.ka->in[17], 1024, WSP(bf16, WS_WOUT_T), 1024, nt * 64, kt * 64, nt * 64 + lane, scr, lane); continue; } r -= I_OUT;
        if (r < 2 * I_W1) { const int b = r / I_W1, kt = r - b * I_W1; transpose_item(b ? F.ka->in[10] : F.ka->in[7], 64, b ? WSP(bf16, WS_W1T_V) : WSP(bf16, WS_W1T_K), 2048, 0, kt * 64, lane, scr, lane); continue; } r -= 2 * I_W1;
        { transpose_item(r ? F.ka->in[11] : F.ka->in[8], 64, r ? WSP(bf16, WS_W2T_V) : WSP(bf16, WS_W2T_K), 64, 0, 0, lane, scr, lane); }
    }
    { float* rc = WSP(float, WS_ROPE_C); float* rs = WSP(float, WS_ROPE_S);
      for (int idx = F.bid * NTHREADS + F.tid; idx < SEQ * 32; idx += F.G * NTHREADS) { const int t = idx >> 5, i = idx & 31;
          const float inv = exp2f(-(float)i * (13.287712379549449f / 32.0f)); const float ang = (float)t * inv; float s, c; sincos_big(ang, s, c); rc[idx] = c; rs[idx] = s; } }
    { bf16* wrh = WSP(bf16, WS_WRT); const float* wr = F.ka->in[19]; const float* gf = F.ka->in[18];
      for (int idx = F.bid * NTHREADS + F.tid; idx < 32 * 1024; idx += F.G * NTHREADS) { const int e = idx >> 10, k = idx & 1023; const float v = wr[k * 32 + e] * gf[k];
          const unsigned h = cvtpk(v, 0.f) & 0xffffu; const float lo = v - bflo(h); wrh[idx] = (bf16)h; wrh[32 * 1024 + idx] = (bf16)(cvtpk(lo, 0.f) & 0xffffu); } }
    if (gw >= NGW - 128) { const int j = gw - (NGW - 128), kv = j >> 6, part = j & 63; const float* pe = kv ? F.ka->in[9] : F.ka->in[6]; const float* w1 = kv ? F.ka->in[10] : F.ka->in[7]; float a = 0.f;
#pragma unroll 16
        for (int k = part * 32; k < part * 32 + 32; ++k) a += pe[k] * w1[k * 64 + lane];
        WSP(float, WS_CPE)[(kv * 64 + part) * 64 + lane] = a; }
    if (F.bid == 0) {
        __syncthreads();
        LAS int* hist = (LAS int*)F.lds;
        LAS unsigned* sorted = (LAS unsigned*)(hist + 3 * MAXCOST);
        for (int i = F.tid; i < 3 * MAXCOST; i += NTHREADS) hist[i] = 0;
        __syncthreads();
        for (int i = F.tid; i < N_SORTED; i += NTHREADS) { unsigned d; int c; attn_unit_desc(i, d, c); atomicAdd((int*)(hist + c), 1); }
        __syncthreads();
        if (F.tid < MAXCOST) { int run = 0; for (int c = F.tid + 1; c < MAXCOST; ++c) run += hist[c]; hist[MAXCOST + F.tid] = run; }
        __syncthreads();
        for (int i = F.tid; i < N_SORTED; i += NTHREADS) { unsigned d; int c; attn_unit_desc(i, d, c); const int pos = hist[MAXCOST + c] + atomicAdd((int*)(hist + 2 * MAXCOST + c), 1); sorted[pos] = d; }
        __syncthreads();
        unsigned* order = WSP(unsigned, WS_ORDER);
        for (int i = F.tid; i < N_QUEUE; i += NTHREADS) {
            unsigned d;
            if (i < Q_CUM0) d = 3u | ((unsigned)(i >> 6) << 3) | ((unsigned)(i & 63) << 11);
            else if (i < Q_CVT0) d = 4u | ((unsigned)(i - Q_CUM0) << 3);
            else if (i < Q_MEM0) d = 5u | ((unsigned)(i - Q_CVT0) << 11);
            else if (i < Q_SRT0) { const int j = i - Q_MEM0; d = 2u | ((unsigned)(j >> 4) << 3) | ((unsigned)(j & 15) << 11); }
            else d = sorted[i - Q_SRT0];
            order[i] = d;
        }
        __syncthreads();
    }
}

struct CvtItem { const float* src; unsigned char* dst; const float* ks; int N; };
__device__ __forceinline__ CvtItem cvt_item(Frame& F, int g, int wv, int lane) {
    const int e = g / 96, q = g - e * 96; CvtItem I;
    if (q < 64) { const int kt = q >> 3, ng = (q + kt + e) & 7, k0 = kt * 128 + 16 * wv, n0 = ng * 256 + 4 * lane;
        I.src = F.ka->in[21] + (size_t)e * 1024 * 2048 + (size_t)k0 * 2048 + n0; I.N = 2048; I.dst = WSP(unsigned char, WS_WGU_T) + (size_t)e * 2048 * 1024 + (size_t)n0 * 1024 + k0; I.ks = F.ka->in[18] + k0; }
    else { const int q2 = q - 64, kt = q2 >> 2, ng = (q2 + kt + e) & 3, k0 = kt * 128 + 16 * wv, n0 = ng * 256 + 4 * lane;
        I.src = F.ka->in[23] + (size_t)e * 1024 * 1024 + (size_t)k0 * 1024 + n0; I.N = 1024; I.dst = WSP(unsigned char, WS_WD_T) + (size_t)e * 1024 * 1024 + (size_t)n0 * 1024 + k0; I.ks = nullptr; }
    return I;
}
__device__ __forceinline__ void cvt_load(f32x4 (&v)[16], const CvtItem& I) {
#pragma unroll
    for (int kk = 0; kk < 16; ++kk) v[kk] = *(const f32x4*)(I.src + (size_t)kk * I.N);
}
__device__ __forceinline__ void cvt_store(const f32x4 (&v)[16], const CvtItem& I) {
    float sc[16];
#pragma unroll
    for (int kk = 0; kk < 16; ++kk) sc[kk] = I.ks ? W8_SCALE * I.ks[kk] : W8_SCALE;
#pragma unroll
    for (int j = 0; j < 4; ++j) { u32x4 o;
#pragma unroll
        for (int q = 0; q < 4; ++q) o[q] = pk_fp8x4(v[4 * q][j] * sc[4 * q], v[4 * q + 1][j] * sc[4 * q + 1], v[4 * q + 2][j] * sc[4 * q + 2], v[4 * q + 3][j] * sc[4 * q + 3]);
        *(u32x4*)(I.dst + (size_t)j * 1024) = o; }
}
__device__ __forceinline__ void convert_unit(Frame& F, int cu) {
    int tid_ = threadIdx.x; asm volatile("" : "+v"(tid_)); const int lane = tid_ & 63, wv = __builtin_amdgcn_readfirstlane(tid_ >> 6);
    f32x4 a[16], b[16];
    CvtItem Ia = cvt_item(F, cu * CVT_CHUNK, wv, lane), Ib; cvt_load(a, Ia);
#pragma clang loop unroll(disable)
    for (int bi = 0; bi < CVT_CHUNK; bi += 2) {
        Ib = cvt_item(F, cu * CVT_CHUNK + bi + 1, wv, lane); cvt_load(b, Ib);
        cvt_store(a, Ia);
        if (bi + 2 < CVT_CHUNK) { Ia = cvt_item(F, cu * CVT_CHUNK + bi + 2, wv, lane); cvt_load(a, Ia); }
        cvt_store(b, Ib);
    }
}
__device__ __forceinline__ void q_signal(unsigned* p, int tid) {
    asm volatile("s_waitcnt vmcnt(0)" ::: "memory"); __syncthreads();
    if (tid == 0) { __builtin_amdgcn_fence(__ATOMIC_RELEASE, "agent"); asm volatile("s_waitcnt vmcnt(0)" ::: "memory"); __hip_atomic_fetch_add(p, 1u, __ATOMIC_RELAXED, __HIP_MEMORY_SCOPE_AGENT); }
}
__device__ __forceinline__ void q_wait(unsigned* p, unsigned want, int tid) {
    if (tid == 0) { unsigned sp = 0; while (__hip_atomic_load(p, __ATOMIC_RELAXED, __HIP_MEMORY_SCOPE_AGENT) < want && ++sp < (1u << 24)) __builtin_amdgcn_s_sleep(2);
        __builtin_amdgcn_fence(__ATOMIC_ACQUIRE, "agent"); asm volatile("s_waitcnt vmcnt(0)" ::: "memory"); }
    __syncthreads();
}

__device__ __forceinline__ void p2_compress_unit(Frame& F, int kv, int rt) {
    int tid_ = threadIdx.x; asm volatile("" : "+v"(tid_)); const int lane = tid_ & 63, w = __builtin_amdgcn_readfirstlane(tid_ >> 6), r32 = lane & 31, hi = lane >> 5;
    const bf16* src = WSP(bf16, WS_KV6) + (size_t)kv * NTOK * 128;
    const bf16* w1t = WSP(bf16, kv ? WS_W1T_V : WS_W1T_K); const bf16* w2t = WSP(bf16, kv ? WS_W2T_V : WS_W2T_K);
    const int R = rt * 32 + r32, bg = R >> 8, n = R & 255, b = bg >> 1, g = bg & 1;
    f32x16 acc0 = {}, acc1 = {};
#pragma unroll 4
    for (int st = 0; st < 16; ++st) {
        const int step = w * 16 + st, l = step >> 2, d = 16 * (step & 3) + 8 * hi;
        int tok = 16 * n + l; tok = tok < SEQ ? tok : SEQ - 1;
        const bf16x8 a = *(const bf16x8*)(src + ((size_t)(b * SEQ + tok)) * 128 + g * 64 + d);
        const bf16x8 b0 = *(const bf16x8*)(w1t + (size_t)r32 * 2048 + 16 * step + 8 * hi);
        const bf16x8 b1 = *(const bf16x8*)(w1t + (size_t)(32 + r32) * 2048 + 16 * step + 8 * hi);
        acc0 = __builtin_amdgcn_mfma_f32_32x32x16_bf16(a, b0, acc0, 0, 0, 0);
        acc1 = __builtin_amdgcn_mfma_f32_32x32x16_bf16(a, b1, acc1, 0, 0, 0);
    }
    LAS float* red = (LAS float*)F.lds;
    LAS bf16* zs = (LAS bf16*)(F.lds + 65536);
    __syncthreads();
#pragma unroll
    for (int r = 0; r < 16; ++r) { const int row = (r & 3) + 8 * (r >> 2) + 4 * hi; red[(w * 32 + row) * 64 + r32] = acc0[r]; red[(w * 32 + row) * 64 + 32 + r32] = acc1[r]; }
    __syncthreads();
    const float* cpe = WSP(float, WS_CPE) + kv * 4096;
    for (int idx = F.tid; idx < 2048; idx += NTHREADS) { float z = 0.f;
#pragma unroll
        for (int pp = 0; pp < 64; ++pp) z += cpe[pp * 64 + (idx & 63)];
#pragma unroll
        for (int ww = 0; ww < 8; ++ww) z += red[ww * 2048 + idx];
        const float sl = z * fast_sigmoid(z); zs[idx] = (bf16)(cvtpk(sl, 0.f) & 0xffffu); }
    __syncthreads();
    if (w < 2) {
        f32x16 o = {};
#pragma unroll
        for (int st = 0; st < 4; ++st) {
            const bf16x8 a = *(const LAS bf16x8*)(zs + r32 * 64 + 16 * st + 8 * hi);
            const bf16x8 bb = *(const bf16x8*)(w2t + (size_t)(32 * w + r32) * 64 + 16 * st + 8 * hi);
            o = __builtin_amdgcn_mfma_f32_32x32x16_bf16(a, bb, o, 0, 0, 0);
        }
        const int rbase = rt * 32;
#pragma unroll
        for (int r = 0; r < 16; ++r) { const int row = (r & 3) + 8 * (r >> 2) + 4 * hi, RR = rbase + row, nn = RR & 255;
            const float v = (nn == 255) ? 0.f : o[r];
            if (kv == 0) WSP(bf16, WS_KCMP)[(size_t)RR * 64 + 32 * w + r32] = (bf16)(cvtpk(v, 0.f) & 0xffffu);
            else WSP(bf16, WS_VCMP)[(size_t)RR * 128 + 32 * w + r32] = (bf16)(cvtpk(v, 0.f) & 0xffffu); }
    } else if (kv == 1) {
        for (int idx = F.tid - 128; idx < 2048; idx += NTHREADS - 128) { const int row = idx >> 6, j = idx & 63, RR = rt * 32 + row, nn = RR & 255;
            const bool ov = (nn != 255) && (nn >= 4 * j - 1) && (nn <= 4 * j + 3);
            WSP(bf16, WS_VCMP)[(size_t)RR * 128 + 64 + j] = ov ? (bf16)0x3f80 : (bf16)0; }
    }
    __syncthreads();
}
__device__ __forceinline__ float log_sigmoid_f(float x) { return fminf(x, 0.f) - log1pf(expf(-fabsf(x))); }
__device__ __forceinline__ void p2_cumsum_unit(Frame& F, int bh) {
    const int lane = F.lane, b = bh >> 3, h = bh & 7; const float bf = F.ka->in[4][h];
    const float* lg = WSP(float, WS_LG) + (size_t)(b * SEQ + 64 * lane) * 32 + 24 + h;
    double tot = 0.0;
    for (int i = 0; i < 64; ++i) tot += (double)log_sigmoid_f(lg[(size_t)i * 32] + bf);
    double inc = tot;
#pragma unroll
    for (int o = 1; o < 64; o <<= 1) { const double v = __shfl_up(inc, o); if (lane >= o) inc += v; }
    double run = inc - tot;
    float* cum = WSP(float, WS_CUM) + (size_t)bh * SEQ + 64 * lane;
    for (int i = 0; i < 64; ++i) { run += (double)log_sigmoid_f(lg[(size_t)i * 32] + bf); cum[i] = (float)(run * 1.4426950408889634); }
    const bf16* kf = WSP(bf16, WS_KF) + (size_t)b * SEQ * 512 + h * 64; float km = 0.f;
#pragma unroll 4
    for (int i = 0; i < 64; ++i) { const u32x4* p = (const u32x4*)(kf + (size_t)(64 * i + lane) * 512); float s = 0.f;
#pragma unroll
        for (int c = 0; c < 8; ++c) { const u32x4 v = p[c]; s += (bflo(v.x) * bflo(v.x) + bfhi(v.x) * bfhi(v.x)) + (bflo(v.y) * bflo(v.y) + bfhi(v.y) * bfhi(v.y)) + (bflo(v.z) * bflo(v.z) + bfhi(v.z) * bfhi(v.z)) + (bflo(v.w) * bflo(v.w) + bfhi(v.w) * bfhi(v.w)); }
        km = fmaxf(km, s); }
#pragma unroll
    for (int o = 1; o < 64; o <<= 1) km = fmaxf(km, __shfl_xor(km, o));
    if (lane == 0) WSP(float, WS_KMAX)[bh] = sqrtf(km) * 1.001f;
}

__device__ __forceinline__ void p6_phase(Frame& F) {
    const int lane = F.lane, w = F.wave, r32 = lane & 31, hi = lane >> 5, grp = w >> 2, kq = w & 3;
    LAS float* red = (LAS float*)F.lds;
    LAS float* ssl = (LAS float*)(F.lds + 32768);
    LAS int* lcnt = (LAS int*)(F.lds + 36864);
    const float* X1 = F.out; const float* brt = F.ka->in[20];
    const bf16* whT = WSP(bf16, WS_WRT); const bf16* wlT = whT + 32 * 1024;
    int* tope = WSP(int, WS_ROUTE); float* topg = (float*)(tope + NTOK * 4); int* lrank = tope + NTOK * 8; float* rstdg = WSP(float, WS_RSTD);
    for (int tile = F.bid; tile < NTOK / 64; tile += F.G) {
        if (F.tid < 32) lcnt[F.tid] = 0;
        const float* xrow = X1 + (size_t)(tile * 64 + grp * 32 + r32) * DM + 8 * hi + 256 * kq;
        const bf16* whp = whT + (size_t)r32 * 1024 + 8 * hi + 256 * kq; const bf16* wlp = wlT + (size_t)r32 * 1024 + 8 * hi + 256 * kq;
        f32x16 acc = f32x16{}; float ss = 0.f;
        f32x4 xa[16], xb[16];
#pragma unroll
        for (int s = 0; s < 16; ++s) { xa[s] = *(const f32x4*)(xrow + 16 * s); xb[s] = *(const f32x4*)(xrow + 16 * s + 4); }
#pragma unroll
        for (int sb = 0; sb < 2; ++sb) {
            bf16x8 wh[8], wl[8];
#pragma unroll
            for (int s = 0; s < 8; ++s) { const int o = 16 * (8 * sb + s); wh[s] = *(const bf16x8*)(whp + o); wl[s] = *(const bf16x8*)(wlp + o); }
#pragma unroll
            for (int s = 0; s < 8; ++s) {
                const f32x4 a = xa[8 * sb + s], b = xb[8 * sb + s];
                ss += (a.x * a.x + a.y * a.y) + (a.z * a.z + a.w * a.w) + (b.x * b.x + b.y * b.y) + (b.z * b.z + b.w * b.w);
                u32x4 h; h.x = cvtpk(a.x, a.y); h.y = cvtpk(a.z, a.w); h.z = cvtpk(b.x, b.y); h.w = cvtpk(b.z, b.w);
                u32x4 l; l.x = cvtpk(a.x - bflo(h.x), a.y - bfhi(h.x)); l.y = cvtpk(a.z - bflo(h.y), a.w - bfhi(h.y)); l.z = cvtpk(b.x - bflo(h.z), b.y - bfhi(h.z)); l.w = cvtpk(b.z - bflo(h.w), b.w - bfhi(h.w));
                const bf16x8 hv = __builtin_bit_cast(bf16x8, h), lv = __builtin_bit_cast(bf16x8, l);
                acc = __builtin_amdgcn_mfma_f32_32x32x16_bf16(hv, wh[s], acc, 0, 0, 0);
                acc = __builtin_amdgcn_mfma_f32_32x32x16_bf16(lv, wh[s], acc, 0, 0, 0);
                acc = __builtin_amdgcn_mfma_f32_32x32x16_bf16(hv, wl[s], acc, 0, 0, 0);
            }
        }
#pragma unroll
        for (int r = 0; r < 16; ++r) red[(w * 16 + r) * 64 + lane] = acc[r];
        ssl[w * 64 + lane] = ss;
        __syncthreads();
        LAS float* lgt = (LAS float*)(F.lds + 40960);
        LAS float* rsl = (LAS float*)(F.lds + 40960 + 64 * 33 * 4);
        LAS float* topv = rsl + 64;
        LAS int* tope_l = (LAS int*)(topv + 256);
        if (kq == 0) {
#pragma unroll
            for (int r = 0; r < 16; ++r) acc[r] = (red[(w * 16 + r) * 64 + lane] + red[((w + 1) * 16 + r) * 64 + lane]) + (red[((w + 2) * 16 + r) * 64 + lane] + red[((w + 3) * 16 + r) * 64 + lane]);
            ss = (ssl[w * 64 + lane] + ssl[(w + 1) * 64 + lane]) + (ssl[(w + 2) * 64 + lane] + ssl[(w + 3) * 64 + lane]);
            ss += __shfl_xor(ss, 32);
            const float rstd = 1.0f / sqrtf(ss * (1.f / 1024.f) + RMS_EPS);
            if (hi == 0) { rstdg[tile * 64 + grp * 32 + r32] = rstd; rsl[grp * 32 + r32] = rstd; }
#pragma unroll
            for (int r = 0; r < 16; ++r) { const int rowl = (r & 3) + 8 * (r >> 2) + 4 * hi; lgt[(grp * 32 + rowl) * 33 + r32] = acc[r]; }
        }
        __syncthreads();
#pragma unroll
        for (int it = 0; it < 4; ++it) {
            const int row = it * 16 + (F.tid >> 5), e = F.tid & 31;
            const float rs = rsl[row]; const float mine = lgt[row * 33 + e] * rs + brt[e];
            int rank = 0;
#pragma unroll
            for (int j = 0; j < 32; ++j) { const float v = lgt[row * 33 + j] * rs + brt[j]; rank += (v > mine || (v == mine && j < e)) ? 1 : 0; }
            if (rank < 4) { topv[row * 4 + rank] = mine; tope_l[row * 4 + rank] = e; }
        }
        __syncthreads();
        int ee4[4], lr4[4];
        if (F.tid < 64) { const int row = F.tid, t = tile * 64 + row;
            const float v0 = topv[row * 4], e1 = expf(topv[row * 4 + 1] - v0), e2 = expf(topv[row * 4 + 2] - v0), e3 = expf(topv[row * 4 + 3] - v0); const float inv = 1.0f / (1.0f + e1 + e2 + e3);
            const float gs[4] = {inv, e1 * inv, e2 * inv, e3 * inv};
#pragma unroll
            for (int k = 0; k < 4; ++k) { const int ee = tope_l[row * 4 + k]; tope[t * 4 + k] = ee; topg[t * 4 + k] = gs[k]; ee4[k] = ee; lr4[k] = atomicAdd((int*)(lcnt + ee), 1); } }
        __syncthreads();
        if (F.tid < 32) { const int c = lcnt[F.tid]; lcnt[32 + F.tid] = c ? (int)__hip_atomic_fetch_add(WSP(unsigned, WS_CTL) + CW_GCNT + 32 * F.tid, (unsigned)c, __ATOMIC_RELAXED, __HIP_MEMORY_SCOPE_AGENT) : 0; }
        __syncthreads();
        if (F.tid < 64) { const int row = F.tid, t = tile * 64 + row; const float rs_ = rsl[row];
#pragma unroll
            for (int k = 0; k < 4; ++k) { const int rk = lcnt[32 + ee4[k]] + lr4[k]; lrank[t * 4 + k] = rk; WSP(int, WS_ETOK)[ee4[k] * NTOK + rk] = t; WSP(float, WS_ERSTD)[ee4[k] * NTOK + rk] = rs_; } }
        __syncthreads();
    }
}

__device__ __forceinline__ void p7_phase(Frame& F) {
    LAS int* part = (LAS int*)F.lds;
    LAS int* tot = part + 1024; LAS int* pre = tot + 32; LAS int* pstart = pre + 32; LAS int* slotl = pstart + 32;
    const int* blkcnt = WSP(int, WS_BLKCNT);
    int* tope = WSP(int, WS_ROUTE); int* lrank = tope + NTOK * 8; int* slot = tope + NTOK * 12;
    const float* rstdg = WSP(float, WS_RSTD); float* rslot = WSP(float, WS_RSLOT); int* slottok = WSP(int, WS_SLOTTOK);
    for (int tile = F.bid; tile < NTOK / 64; tile += F.G) {
        __syncthreads();
        { const int e = F.tid & 31, p = F.tid >> 5; int st = 0, sp = 0;
          for (int tt = p; tt < NTOK / 64; tt += 16) { const int c = blkcnt[tt * 32 + e]; st += c; if (tt < tile) sp += c; }
          part[p * 32 + e] = st; part[512 + p * 32 + e] = sp; }
        __syncthreads();
        if (F.tid < 32) { int st = 0, sp = 0;
#pragma unroll
            for (int p = 0; p < 16; ++p) { st += part[p * 32 + F.tid]; sp += part[512 + p * 32 + F.tid]; }
            tot[F.tid] = st; pre[F.tid] = sp; }
        __syncthreads();
        if (F.tid == 0) { int run = 0; for (int e = 0; e < 32; ++e) { pstart[e] = run; run += (tot[e] + 255) & ~255; }
            if (tile == 0) { int* te = WSP(int, WS_TILE_E); int j = 0; for (int e = 0; e < 32; ++e) { const int nte = (tot[e] + 255) >> 8; for (int q = 0; q < nte; ++q) te[j++] = e; } te[500] = j; } }
        __syncthreads();
        if (F.tid < 256) { const int a = tile * 256 + F.tid; const int e = tope[a]; const int s = pstart[e] + pre[e] + lrank[a]; slot[a] = s; rslot[s] = rstdg[tile * 64 + (F.tid >> 2)]; slottok[s] = tile * 64 + (F.tid >> 2); }
    }
}

__device__ __forceinline__ void p10_phase(Frame& F, bool with_moe, float* dsto) {
    const int gw = F.vcu * NWAVES + F.wave, NGW = F.G * NWAVES, lane = F.lane;
    const int* tope = WSP(int, WS_ROUTE); const float* topg = (const float*)(tope + NTOK * 4); const int* rank = tope + NTOK * 8;
    const LAS int* pstart = (const LAS int*)(F.lds + MT_OFF) + 320;
    const bf16* OS = WSP(bf16, WS_AMOE); const float* gfin = F.ka->in[25];
    for (int t = gw; t < NTOK; t += NGW) {
        const f32x4* xr = (const f32x4*)((with_moe ? F.out : F.ka->in[0]) + (size_t)t * DM) + lane;
        f32x4 v[4];
#pragma unroll
        for (int j = 0; j < 4; ++j) v[j] = xr[64 * j];
        if (with_moe) {
#pragma unroll
            for (int k = 0; k < 4; ++k) { const float gk = topg[t * 4 + k]; const u32x2* orow = (const u32x2*)(OS + (size_t)(pstart[tope[t * 4 + k]] + rank[t * 4 + k]) * DM) + lane;
#pragma unroll
                for (int j = 0; j < 4; ++j) { const u32x2 o = orow[64 * j]; v[j].x += gk * bflo(o.x); v[j].y += gk * bfhi(o.x); v[j].z += gk * bflo(o.y); v[j].w += gk * bfhi(o.y); } }
        }
        float s = 0.f;
#pragma unroll
        for (int j = 0; j < 4; ++j) s += (v[j].x * v[j].x + v[j].y * v[j].y) + (v[j].z * v[j].z + v[j].w * v[j].w);
        const float rstd = 1.0f / sqrtf(wave_sum(s) * (1.f / 1024.f) + RMS_EPS);
        f32x4* orow = (f32x4*)(dsto + (size_t)t * DM) + lane;
#pragma unroll
        for (int j = 0; j < 4; ++j) orow[64 * j] = v[j] * rstd * ((const f32x4*)gfin)[64 * j + lane];
    }
}
constexpr int AL_RING = 0, AL_OACC = 49152, AL_BIAS = 114688, AL_WSF = AL_BIAS + 3 * 8 * 64 * 4, AL_IMP = AL_WSF + 8 * 64 * 4, AL_SELB = AL_IMP + 64 * 65 * 4, AL_UNI = AL_SELB + 512, AL_TICKET = AL_UNI + 16;
static_assert(AL_TICKET + 16 <= LDS_BYTES - 64 && AL_OACC + 65536 <= AL_BIAS, "attention LDS map");
__device__ __forceinline__ int crow(int r, int hi) { return (r & 3) + 8 * (r >> 2) + 4 * hi; }
__device__ __forceinline__ s16x4 vtr(const LAS char* p) { return __builtin_bit_cast(s16x4, __builtin_amdgcn_ds_read_tr16_b64_v4i16((LAS s16x4*)p)); }

__device__ __forceinline__ float max3f(float a, float b, float c) { float r; asm("v_max3_f32 %0, %1, %2, %3" : "=v"(r) : "v"(a), "v"(b), "v"(c)); return r; }
struct AttnCtx { LAS unsigned char* lds; int tid, lane, w, r32, hi; LAS float* wsf; };
__device__ __forceinline__ AttnCtx make_ctx(LAS unsigned char* lds) {
    int tid = threadIdx.x; asm volatile("" : "+v"(tid));
    AttnCtx C; C.lds = lds; C.tid = tid; C.lane = tid & 63; C.w = __builtin_amdgcn_readfirstlane(tid >> 6); C.r32 = tid & 31; C.hi = (tid >> 5) & 1; C.wsf = (LAS float*)(lds + AL_WSF) + C.w * 64;
    return C;
}

template <int NDB> __device__ __forceinline__ void scale_rows(const AttnCtx& C, f32x16 (&o)[NDB], float vq, int slot) {
    if (C.hi == 0) C.wsf[slot + C.r32] = vq;
#pragma unroll
    for (int rg = 0; rg < 4; ++rg) { const f32x4 a4 = *(const LAS f32x4*)(C.wsf + slot + 8 * rg + 4 * C.hi);
#pragma unroll
        for (int db = 0; db < NDB; ++db) { o[db][4 * rg + 0] *= a4.x; o[db][4 * rg + 1] *= a4.y; o[db][4 * rg + 2] *= a4.z; o[db][4 * rg + 3] *= a4.w; } }
}

__device__ __forceinline__ void dma16(const void* g, LAS unsigned char* lds_wave_base) { __builtin_amdgcn_global_load_lds((const unsigned*)g, (LAS unsigned*)lds_wave_base, 16, 0, 0); }
__device__ __forceinline__ void dma4(const void* g, LAS unsigned char* lds_wave_base) { __builtin_amdgcn_global_load_lds((const unsigned*)g, (LAS unsigned*)lds_wave_base, 4, 0, 0); }
template <int N> __device__ __forceinline__ void wait_vm() {
    if constexpr (N == 0) asm volatile("s_waitcnt vmcnt(0)" ::: "memory"); else if constexpr (N == 2) asm volatile("s_waitcnt vmcnt(2)" ::: "memory");
    else if constexpr (N == 3) asm volatile("s_waitcnt vmcnt(3)" ::: "memory"); else if constexpr (N == 4) asm volatile("s_waitcnt vmcnt(4)" ::: "memory"); else static_assert(N == 0, "wait_vm");
}
template <int DQK, int DV, bool BIAS, class Pol>
__device__ __forceinline__ void attn_core(const AttnCtx& C, const Pol& P, const bf16x8 (&qf)[DQK / 16], f32x16 (&o)[DV / 32]) {
    constexpr int NKP = DQK / 64, NVP = DV / 64, NDB = DV / 32, ND0 = DQK / 16, KROW = DQK * 2, KCH = DQK / 8, VCH = DV / 8, KBYTES = DQK * 128, SLOT = (DQK + DV) * 128, PT = NKP + NVP + (BIAS ? 1 : 0);
    int tid = C.tid; asm volatile("" : "+v"(tid));
    const int lane = tid & 63, r32 = lane & 31, hi = lane >> 5, w = C.w;
    int ksrc[NKP], vsrc[NVP];
#pragma unroll
    for (int j = 0; j < NKP; ++j) { const int id = tid + 512 * j, key = id / KCH, slot = id % KCH; const int c = slot ^ (DQK == 64 ? ((key >> 1) & 7) : (key & 15)); ksrc[j] = key * P.kpitch() + c * 8; }
#pragma unroll
    for (int j = 0; j < NVP; ++j) { const int id = tid + 512 * j, db = id >> 8, rem = id & 255, key = 8 * (rem >> 5) + ((rem & 31) >> 2), pc = 4 * db + (rem & 3); vsrc[j] = key * P.vpitch() + pc * 8; }
    int koff[ND0];
#pragma unroll
    for (int d0 = 0; d0 < ND0; ++d0) koff[d0] = r32 * KROW + (((2 * d0 + hi) ^ (DQK == 64 ? ((r32 >> 1) & 7) : (r32 & 15))) << 4);
    const int vbase = ((lane >> 4) & 1) * 32 + (lane & 3) * 8 + (4 * hi + ((lane & 15) >> 2)) * 64;
    LAS unsigned char* lds = C.lds;
    LAS float* biasw = (LAS float*)(lds + AL_BIAS) + w * 64;
#define ATT_DMA(t, s) do { const bf16* kp_ = P.kptr(t); const bf16* vp_ = P.vptr(t); LAS unsigned char* sb_ = lds + AL_RING + (s) * SLOT + w * 1024; \
        _Pragma("unroll") for (int j = 0; j < NKP; ++j) dma16(kp_ + ksrc[j], sb_ + j * 8192); \
        _Pragma("unroll") for (int j = 0; j < NVP; ++j) dma16(vp_ + vsrc[j], sb_ + KBYTES + j * 8192); \
        if (BIAS) dma4(P.biasptr(t) + lane, (LAS unsigned char*)(biasw + (s) * 512)); } while (0)
    float m_ref = 0.f, l_part = 0.f; bool seen = false;
#pragma unroll
    for (int db = 0; db < NDB; ++db) o[db] = f32x16{};
    int t = P.first(), t1 = P.next(t);
    asm volatile("s_waitcnt vmcnt(0) lgkmcnt(0)" ::: "memory"); __builtin_amdgcn_s_barrier();
    ATT_DMA(t, 0);
    if (t1 >= 0) ATT_DMA(t1, 1);
    int s0 = 0;
    while (t >= 0) {
        const int t2 = (t1 >= 0) ? P.next(t1) : -1;
        if (t1 >= 0) wait_vm<PT>(); else wait_vm<0>();
        asm volatile("s_waitcnt lgkmcnt(0)" ::: "memory"); __builtin_amdgcn_s_barrier(); asm volatile("" ::: "memory");
        const int s2 = (s0 >= 1) ? s0 - 1 : 2;
        if (t2 >= 0) ATT_DMA(t2, s2);
        if (!P.wave_skip(t)) {
            const LAS unsigned char* Kb = lds + AL_RING + s0 * SLOT; const LAS unsigned char* Vb = Kb + KBYTES;
            const float cbase = P.lane_valid(t) ? -m_ref : NEGBIG;
            f32x16 p0, p1;
            if (BIAS) {
                const float cb = cbase + P.bias_ref();
#pragma unroll
                for (int rg = 0; rg < 4; ++rg) { const f32x4 b0 = *(const LAS f32x4*)(biasw + s0 * 512 + 8 * rg + 4 * hi), b1 = *(const LAS f32x4*)(biasw + s0 * 512 + 32 + 8 * rg + 4 * hi);
                    p0[4 * rg] = cb - b0.x; p0[4 * rg + 1] = cb - b0.y; p0[4 * rg + 2] = cb - b0.z; p0[4 * rg + 3] = cb - b0.w;
                    p1[4 * rg] = cb - b1.x; p1[4 * rg + 1] = cb - b1.y; p1[4 * rg + 2] = cb - b1.z; p1[4 * rg + 3] = cb - b1.w; }
            } else {
#pragma unroll
                for (int r = 0; r < 16; ++r) { p0[r] = cbase; p1[r] = cbase; }
            }
#pragma unroll
            for (int d0 = 0; d0 < ND0; ++d0) {
                const bf16x8 k0 = *(const LAS bf16x8*)(Kb + koff[d0]); const bf16x8 k1 = *(const LAS bf16x8*)(Kb + koff[d0] + 32 * KROW);
                p0 = __builtin_amdgcn_mfma_f32_32x32x16_bf16(k0, qf[d0], p0, 0, 0, 0);
                p1 = __builtin_amdgcn_mfma_f32_32x32x16_bf16(k1, qf[d0], p1, 0, 0, 0);
            }
            asm volatile("s_nop 15\n\ts_nop 7" : "+v"(p0), "+v"(p1));
            if (P.masked(t)) {
#pragma unroll
                for (int r = 0; r < 16; ++r) { const int kvl = crow(r, hi);
                    if (!P.valid(t, kvl)) p0[r] = NEGBIG;
                    if (!P.valid(t, kvl + 32)) p1[r] = NEGBIG; }
            }
            float rm = max3f(p0[0], p1[0], p0[1]), rm2 = max3f(p1[1], p0[2], p1[2]);
#pragma unroll
            for (int r = 3; r < 15; r += 2) { rm = max3f(rm, p0[r], p1[r]); rm2 = max3f(rm2, p0[r + 1], p1[r + 1]); }
            rm = max3f(rm, p0[15], p1[15]);
            rm = max3f(rm, rm2, rm2);
            rm = max3f(rm, __shfl_xor(rm, 32), rm);
            const bool any_valid = rm > -1e29f;
            const bool trig = (rm > 8.0f) || (!seen && any_valid);
            if (__any(trig)) {
                const float dl = trig ? rm : 0.f; const float alpha = (trig && seen) ? __builtin_amdgcn_exp2f(-dl) : 1.0f;
                m_ref += dl; l_part *= alpha;
#pragma unroll
                for (int r = 0; r < 16; ++r) { p0[r] -= dl; p1[r] -= dl; }
                scale_rows<NDB>(C, o, alpha, 0);
            }
            seen = seen || any_valid;
            float ls = 0.f;
#pragma unroll
            for (int r = 0; r < 16; ++r) { const float e0 = __builtin_amdgcn_exp2f(p0[r]), e1 = __builtin_amdgcn_exp2f(p1[r]); p0[r] = e0; p1[r] = e1; ls += e0 + e1; }
            l_part += ls;
            u32x4 pw[4];
#pragma unroll
            for (int k = 0; k < 4; ++k) { pw[0][k] = cvtpk(p0[2 * k], p0[2 * k + 1]); pw[1][k] = cvtpk(p0[8 + 2 * k], p0[9 + 2 * k]); pw[2][k] = cvtpk(p1[2 * k], p1[2 * k + 1]); pw[3][k] = cvtpk(p1[8 + 2 * k], p1[9 + 2 * k]); }
#pragma unroll
            for (int db = 0; db < NDB; ++db) {
#pragma unroll
                for (int s = 0; s < 4; ++s) {
                    const s16x4 lo = vtr((const LAS char*)Vb + vbase + db * 4096 + s * 1024), hh = vtr((const LAS char*)Vb + vbase + db * 4096 + s * 1024 + 512);
                    const bf16x8 vf = {lo[0], lo[1], lo[2], lo[3], hh[0], hh[1], hh[2], hh[3]};
                    o[db] = __builtin_amdgcn_mfma_f32_32x32x16_bf16(__builtin_bit_cast(bf16x8, pw[s]), vf, o[db], 0, 0, 0);
                }
            }
        }
        s0 = (s0 == 2) ? 0 : s0 + 1; t = t1; t1 = t2;
    }
    const float l = l_part + __shfl_xor(l_part, 32);
    scale_rows<NDB>(C, o, l > 0.f ? 1.0f / l : 0.f, 32);
    asm volatile("s_waitcnt lgkmcnt(0)" ::: "memory"); __builtin_amdgcn_s_barrier(); asm volatile("" ::: "memory");
#undef ATT_DMA
}

struct FoxPol {
    const bf16 *K, *V; const float* cum; float ref; int qb, w, tq, tmin;
    __device__ __forceinline__ int first() const { return 4 * qb + 3; }
    __device__ __forceinline__ int next(int t) const { return t - 1 >= tmin ? t - 1 : -1; }
    __device__ __forceinline__ bool masked(int t) const { return t >= 4 * qb; }
    __device__ __forceinline__ bool valid(int t, int kvl) const { return 64 * t + kvl <= tq; }
    __device__ __forceinline__ bool wave_skip(int t) const { return 64 * (t - 4 * qb) > 32 * w + 31; }
    __device__ __forceinline__ bool lane_valid(int) const { return true; }
    __device__ __forceinline__ const bf16* kptr(int t) const { return K + (size_t)(64 * t) * 512; }
    __device__ __forceinline__ const bf16* vptr(int t) const { return V + (size_t)(64 * t) * 512; }
    __device__ __forceinline__ int kpitch() const { return 512; }
    __device__ __forceinline__ int vpitch() const { return 512; }
    __device__ __forceinline__ const float* biasptr(int t) const { return cum + 64 * t; }
    __device__ __forceinline__ float bias_ref() const { return ref; }
};
struct MemPol {
    const bf16 *K, *V;
    __device__ __forceinline__ int first() const { return 0; }
    __device__ __forceinline__ int next(int t) const { return t < 3 ? t + 1 : -1; }
    __device__ __forceinline__ bool masked(int) const { return false; }
    __device__ __forceinline__ bool valid(int, int) const { return true; }
    __device__ __forceinline__ bool wave_skip(int) const { return false; }
    __device__ __forceinline__ bool lane_valid(int) const { return true; }
    __device__ __forceinline__ const bf16* kptr(int t) const { return K + (size_t)(64 * t) * 512; }
    __device__ __forceinline__ const bf16* vptr(int t) const { return V + (size_t)(64 * t) * 512; }
    __device__ __forceinline__ int kpitch() const { return 512; }
    __device__ __forceinline__ int vpitch() const { return 512; }
    __device__ __forceinline__ const float* biasptr(int) const { return nullptr; }
    __device__ __forceinline__ float bias_ref() const { return 0.f; }
};
struct CmpPol {
    const bf16 *K, *V; int ntc, tq;
    __device__ __forceinline__ int first() const { return 0; }
    __device__ __forceinline__ int next(int t) const { return t + 1 < ntc ? t + 1 : -1; }
    __device__ __forceinline__ bool masked(int) const { return true; }
    __device__ __forceinline__ bool valid(int t, int kvl) const { return 16 * (64 * t + kvl) + 31 <= tq; }
    __device__ __forceinline__ bool wave_skip(int) const { return false; }
    __device__ __forceinline__ bool lane_valid(int) const { return true; }
    __device__ __forceinline__ const bf16* kptr(int t) const { return K + (size_t)(64 * t) * 64; }
    __device__ __forceinline__ const bf16* vptr(int t) const { return V + (size_t)(64 * t) * 128; }
    __device__ __forceinline__ int kpitch() const { return 64; }
    __device__ __forceinline__ int vpitch() const { return 128; }
    __device__ __forceinline__ const float* biasptr(int) const { return nullptr; }
    __device__ __forceinline__ float bias_ref() const { return 0.f; }
};
struct WinPol {
    const bf16 *K, *V; int T, tq;
    __device__ __forceinline__ int first() const { return T; }
    __device__ __forceinline__ int next(int t) const { return (t - 1 >= 0 && t - 1 >= T - 8) ? t - 1 : -1; }
    __device__ __forceinline__ bool masked(int t) const { return t == T || t == T - 8; }
    __device__ __forceinline__ bool valid(int t, int kvl) const { const int d = tq - (64 * t + kvl); return d >= 0 && d < 512; }
    __device__ __forceinline__ bool wave_skip(int) const { return false; }
    __device__ __forceinline__ bool lane_valid(int) const { return true; }
    __device__ __forceinline__ const bf16* kptr(int t) const { return K + (size_t)(64 * t) * 128; }
    __device__ __forceinline__ const bf16* vptr(int t) const { return V + (size_t)(64 * t) * 128; }
    __device__ __forceinline__ int kpitch() const { return 128; }
    __device__ __forceinline__ int vpitch() const { return 128; }
    __device__ __forceinline__ const float* biasptr(int) const { return nullptr; }
    __device__ __forceinline__ float bias_ref() const { return 0.f; }
};
struct SelPol {
    const bf16 *K, *V; unsigned long long uni, mine; int T, tq;
    __device__ __forceinline__ int first() const { return 63 - __clzll(uni); }
    __device__ __forceinline__ int next(int t) const { const unsigned long long m = uni & ((1ull << t) - 1ull); return m ? 63 - __clzll(m) : -1; }
    __device__ __forceinline__ bool masked(int t) const { return t == T; }
    __device__ __forceinline__ bool valid(int t, int kvl) const { return 64 * t + kvl <= tq; }
    __device__ __forceinline__ bool wave_skip(int) const { return false; }
    __device__ __forceinline__ bool lane_valid(int t) const { return (mine >> t) & 1ull; }
    __device__ __forceinline__ const bf16* kptr(int t) const { return K + (size_t)(64 * t) * 128; }
    __device__ __forceinline__ const bf16* vptr(int t) const { return V + (size_t)(64 * t) * 128; }
    __device__ __forceinline__ int kpitch() const { return 128; }
    __device__ __forceinline__ int vpitch() const { return 128; }
    __device__ __forceinline__ const float* biasptr(int) const { return nullptr; }
    __device__ __forceinline__ float bias_ref() const { return 0.f; }
};

template <int NDB, class RowF> __device__ __forceinline__ void store_o(const AttnCtx& C, const f32x16 (&o)[NDB], bf16* dst, RowF rowoff) {
#pragma unroll
    for (int r = 0; r < 16; ++r) { const int q = crow(r, C.hi); bf16* p = dst + rowoff(q) + C.r32;
#pragma unroll
        for (int db = 0; db < NDB; ++db) p[32 * db] = (bf16)(cvtpk(o[db][r], 0.f) & 0xffffu); }
}

__device__ __forceinline__ void fox_unit(Frame& F0, int bh, int qb) {
    const AttnCtx C = make_ctx(F0.lds);
    struct { unsigned char* ws; } F; { unsigned long long w_ = (unsigned long long)F0.ws; asm volatile("" : "+s"(w_)); F.ws = (unsigned char*)w_; }
    const int b = bh >> 3, h = bh & 7, tq = 256 * qb + 32 * C.w + C.r32;
    const bf16* Q = WSP(bf16, WS_QF) + ((size_t)(b * SEQ + tq)) * 512 + h * 64;
    bf16x8 qf[4];
#pragma unroll
    for (int d0 = 0; d0 < 4; ++d0) qf[d0] = *(const bf16x8*)(Q + 16 * d0 + 8 * C.hi);
    const float* cum = WSP(float, WS_CUM) + (size_t)bh * SEQ;
    int tmin = 0;
    { float qn = 0.f;
#pragma unroll
      for (int d0 = 0; d0 < 4; ++d0)
#pragma unroll
          for (int j = 0; j < 8; ++j) { const float v = bf2f((unsigned short)qf[d0][j]); qn += v * v; }
      qn += __shfl_xor(qn, 32);
#pragma unroll
      for (int o = 16; o >= 1; o >>= 1) qn = fmaxf(qn, __shfl_xor(qn, o));
      LAS float* qmx = (LAS float*)(C.lds + AL_SELB);
      __syncthreads();
      if (C.lane == 0) qmx[C.w] = qn;
      __syncthreads();
      float qm = qmx[0];
#pragma unroll
      for (int i = 1; i < 8; ++i) qm = fmaxf(qm, qmx[i]);
      const float B = sqrtf(qm) * WSP(float, WS_KMAX)[bh];
      const float thr = -(40.0f + 2.0f * B), c0 = cum[256 * qb];
      const bool cond = (C.lane < 4 * qb) && (c0 - cum[64 * C.lane + 63] < thr);
      const unsigned long long bal = __ballot(cond);
      tmin = bal ? 64 - __clzll(bal) : 0; }
    FoxPol P{WSP(bf16, WS_KF) + (size_t)b * SEQ * 512 + h * 64, WSP(bf16, WS_VF) + (size_t)b * SEQ * 512 + h * 64, cum, cum[256 * qb + 255], qb, C.w, tq, tmin};
    f32x16 o[2];
    attn_core<64, 64, true>(C, P, qf, o);
    bf16* dst = WSP(bf16, WS_OBR) + (size_t)1 * NTOK * 512 + h * 64;
    const size_t rb = (size_t)(b * SEQ + 256 * qb + 32 * C.w);
    store_o<2>(C, o, dst, [&](int q) { return (rb + q) * 512; });
}
__device__ __forceinline__ void mem_unit(Frame& F0, int bh, int qb) {
    const AttnCtx C = make_ctx(F0.lds);
    struct { unsigned char* ws; } F; { unsigned long long w_ = (unsigned long long)F0.ws; asm volatile("" : "+s"(w_)); F.ws = (unsigned char*)w_; }
    const int b = bh >> 2, h = bh & 3, tq = 256 * qb + 32 * C.w + C.r32;
    const bf16* Q = WSP(bf16, WS_QM) + ((size_t)(b * SEQ + tq)) * 512 + h * 128;
    bf16x8 qf[8];
#pragma unroll
    for (int d0 = 0; d0 < 8; ++d0) qf[d0] = *(const bf16x8*)(Q + 16 * d0 + 8 * C.hi);
    MemPol P{WSP(bf16, WS_KMEM) + (size_t)b * MEMLEN * 512 + h * 128, WSP(bf16, WS_VMEM) + (size_t)b * MEMLEN * 512 + h * 128};
    f32x16 o[4];
    attn_core<128, 128, false>(C, P, qf, o);
    bf16* dst = WSP(bf16, WS_OBR) + (size_t)2 * NTOK * 512 + h * 128;
    const size_t rb = (size_t)(b * SEQ + 256 * qb + 32 * C.w);
    store_o<4>(C, o, dst, [&](int q) { return (rb + q) * 512; });
}
__device__ __forceinline__ void nsa_unit(Frame& F0, int bg, int T, int parts) {
    const AttnCtx C = make_ctx(F0.lds);
    struct { unsigned char* ws; } F; { unsigned long long w_ = (unsigned long long)F0.ws; asm volatile("" : "+s"(w_)); F.ws = (unsigned char*)w_; }
    const int b = bg >> 1, g = bg & 1, q = C.r32, tokl = 8 * C.w + (q >> 2), tq = 64 * T + tokl, head = 4 * g + (q & 3);
    const bf16* Q = WSP(bf16, WS_QA) + ((size_t)(b * SEQ + tq)) * 512 + head * 64;
    bf16x8 qf[4];
#pragma unroll
    for (int d0 = 0; d0 < 4; ++d0) qf[d0] = *(const bf16x8*)(Q + 16 * d0 + 8 * C.hi);
    const float* lg = WSP(float, WS_LG) + (size_t)(b * SEQ + tq) * 32 + head * 3;
    LAS float* oacc = (LAS float*)(C.lds + AL_OACC) + C.w * 2048 + C.lane;
    LAS float* imp = (LAS float*)(C.lds + AL_IMP);
    LAS unsigned long long* selb = (LAS unsigned long long*)(C.lds + AL_SELB);
    LAS unsigned long long* unip = (LAS unsigned long long*)(C.lds + AL_UNI);
#ifndef NSA_CORES
#define NSA_CORES 7
#endif
    if (NSA_CORES & 1) {
        CmpPol P{WSP(bf16, WS_KCMP) + (size_t)bg * 256 * 64, WSP(bf16, WS_VCMP) + (size_t)bg * 256 * 128, (4 * T + 2) / 64 + 1, tq};
        f32x16 o2[2];
        attn_core<64, 64, false>(C, P, qf, o2);
        scale_rows<2>(C, o2, (parts & 1) ? fast_sigmoid(lg[0]) : 0.f, 0);
#pragma unroll
        for (int db = 0; db < 2; ++db)
#pragma unroll
            for (int r = 0; r < 16; ++r) oacc[(db * 16 + r) * 64] = o2[db][r];
        P.V += 64;
        attn_core<64, 64, false>(C, P, qf, o2);
#pragma unroll
        for (int db = 0; db < 2; ++db)
#pragma unroll
            for (int rg = 0; rg < 4; ++rg) imp[(8 * C.w + 2 * rg + C.hi) * 65 + 32 * db + C.r32] = (o2[db][4 * rg] + o2[db][4 * rg + 1]) + (o2[db][4 * rg + 2] + o2[db][4 * rg + 3]);
    }
    __syncthreads();
    {
        const int tk = C.tid >> 3, sub = C.tid & 7;
        float mine[8]; int rank[8];
#pragma unroll
        for (int i = 0; i < 8; ++i) { const int j = 8 * sub + i; const float v = imp[tk * 65 + j];
            mine[i] = (j == 0 || j == T || j == T - 1) ? 1e4f : (j > T ? -1e4f : v); rank[i] = 0; }
        for (int jj = 0; jj < 64; ++jj) { const float v0 = imp[tk * 65 + jj]; const float v = (jj == 0 || jj == T || jj == T - 1) ? 1e4f : (jj > T ? -1e4f : v0);
#pragma unroll
            for (int i = 0; i < 8; ++i) { const int j = 8 * sub + i; rank[i] += (v > mine[i] || (v == mine[i] && jj < j)) ? 1 : 0; } }
        unsigned byte = 0;
#pragma unroll
        for (int i = 0; i < 8; ++i) { const int j = 8 * sub + i; if (rank[i] < 16 && j <= T) byte |= 1u << i; }
        ((LAS unsigned char*)selb)[tk * 8 + sub] = (unsigned char)byte;
    }
    __syncthreads();
    if (C.w == 0) { unsigned long long m = selb[C.lane]; unsigned lo = (unsigned)m, hh = (unsigned)(m >> 32);
#pragma unroll
        for (int o = 1; o < 64; o <<= 1) { lo |= __shfl_xor(lo, o); hh |= __shfl_xor(hh, o); }
        if (C.lane == 0) unip[0] = ((unsigned long long)hh << 32) | lo; }
    __syncthreads();
    const unsigned long long mymask = selb[tokl]; unsigned long long uni = unip[0];
    uni = ((unsigned long long)__builtin_amdgcn_readfirstlane((unsigned)(uni >> 32)) << 32) | (unsigned)__builtin_amdgcn_readfirstlane((unsigned)uni);
    if (NSA_CORES & 2) {
        SelPol P{WSP(bf16, WS_KV6) + (size_t)2 * NTOK * 128 + (size_t)b * SEQ * 128 + g * 64, WSP(bf16, WS_KV6) + (size_t)3 * NTOK * 128 + (size_t)b * SEQ * 128 + g * 64, uni, mymask, T, tq};
        f32x16 o2[2];
        attn_core<64, 64, false>(C, P, qf, o2);
        scale_rows<2>(C, o2, (parts & 2) ? fast_sigmoid(lg[1]) : 0.f, 0);
#pragma unroll
        for (int db = 0; db < 2; ++db)
#pragma unroll
            for (int r = 0; r < 16; ++r) oacc[(db * 16 + r) * 64] += o2[db][r];
    }
    if (NSA_CORES & 4) {
        WinPol P{WSP(bf16, WS_KV6) + (size_t)4 * NTOK * 128 + (size_t)b * SEQ * 128 + g * 64, WSP(bf16, WS_KV6) + (size_t)5 * NTOK * 128 + (size_t)b * SEQ * 128 + g * 64, T, tq};
        f32x16 o2[2];
        attn_core<64, 64, false>(C, P, qf, o2);
        scale_rows<2>(C, o2, (parts & 4) ? fast_sigmoid(lg[2]) : 0.f, 0);
#pragma unroll
        for (int db = 0; db < 2; ++db)
#pragma unroll
            for (int r = 0; r < 16; ++r) o2[db][r] += oacc[(db * 16 + r) * 64];
        bf16* dst = WSP(bf16, WS_OBR) + g * 256;
        const size_t rb = (size_t)(b * SEQ + 64 * T + 8 * C.w);
        store_o<2>(C, o2, dst, [&](int qq) { return (rb + (qq >> 2)) * 512 + (qq & 3) * 64; });
    }
}

__device__ __forceinline__ void p3_phase(Frame& F, int parts, int rep) {
    LAS int* ticket = (LAS int*)(F.lds + AL_TICKET);
    unsigned* ctl = WSP(unsigned, WS_CTL);
    unsigned* qhead = ctl + CW_QATTN + 64 * rep; const unsigned* order = WSP(unsigned, WS_ORDER);
    for (;;) {
        __syncthreads();
        if (F.tid == 0) ticket[0] = (int)atomicAdd(qhead, 1u);
        __syncthreads();
        const int tk = __builtin_amdgcn_readfirstlane(ticket[0]);
        if (tk >= N_QUEUE) break;
        const unsigned d = __builtin_amdgcn_readfirstlane(order[tk]); const int type = d & 7, a = (d >> 3) & 255, bb = d >> 11;
#ifdef REP_ATTN_ONLY
        if (rep > 0 && type >= 3) continue;
#endif
#ifdef REP_CVT_ONLY
        if (rep > 0 && type != 5) continue;
#endif
        if (type == 0) { q_wait(ctl + CW_CMPDONE + 64 * a, 16u, F.tid); nsa_unit(F, a, bb, parts); }
        else if (type == 1) { q_wait(ctl + CW_CUMDONE + 64 * (a >> 3), 1u, F.tid); fox_unit(F, a, bb); }
        else if (type == 2) mem_unit(F, a, bb);
#ifndef QDIS
#define QDIS 0
#endif
        else if (type == 3) { if (!(QDIS & 1)) p2_compress_unit(F, a, bb); q_signal(ctl + CW_CMPDONE + 64 * (bb >> 3), F.tid); }
        else if (type == 4) { if (!(QDIS & 2)) p2_cumsum_unit(F, 8 * a + F.wave); q_signal(ctl + CW_CUMDONE + 64 * a, F.tid); }
        else { if (!(QDIS & 4)) convert_unit(F, bb); }
    }
}
#define XB_TMO      128
#define XB_XCNT(j)  (256  + 64 * (j))
#define XB_XSUB(j)  (1280 + 64 * (j))
#define XB_XGEN(j)  (2304 + 64 * (j))
#define XB_TOP      3328
#define XB_TOPGEN   3392
#define XCD_BAR_WORDS 3456
#define XB_SPIN_CAP (1u << 18)

__device__ __forceinline__ unsigned xb_ld(unsigned* p)              { return __hip_atomic_load(p, __ATOMIC_RELAXED, __HIP_MEMORY_SCOPE_AGENT); }
__device__ __forceinline__ unsigned xb_add(unsigned* p, unsigned v) { return __hip_atomic_fetch_add(p, v, __ATOMIC_RELAXED, __HIP_MEMORY_SCOPE_AGENT); }
__device__ __forceinline__ unsigned xb_xcc_id() { return (unsigned)__builtin_amdgcn_s_getreg((3 << 11) | 20) & 0xFu; }
#define XB_SPIN(cond, bar) do { unsigned _sp = 0; while (cond) { __builtin_amdgcn_s_sleep(1); \
    if ((++_sp & 255u) == 0u) { if (xb_ld(&(bar)[XB_TMO])) break; if (_sp > XB_SPIN_CAP) { atomicAdd(&(bar)[XB_TMO], 1u); break; } } } } while (0)

struct XcdBarrier {
    unsigned* bar; unsigned x;
    volatile LAS unsigned* st;
};

__device__ __forceinline__ XcdBarrier xcd_barrier_post(unsigned* bar, volatile LAS unsigned* st) {
    XcdBarrier b; b.bar = bar; b.x = xb_xcc_id(); b.st = st;
    if (threadIdx.x == 0) (void)xb_add(&bar[XB_XCNT(b.x)], 1u);
    return b;
}
__device__ __forceinline__ void xcd_barrier_complete(unsigned* bar, unsigned x, unsigned& nloc, unsigned& nx) {
    const unsigned G = gridDim.x * gridDim.y * gridDim.z;
    unsigned sum, cnt, mine, sp = 0u;
    for (;;) {
        sum = 0u; cnt = 0u; mine = 0u;
#pragma unroll
        for (unsigned j = 0; j < 16; ++j) { const unsigned c = xb_ld(&bar[XB_XCNT(j)]); sum += c; cnt += (c > 0u) ? 1u : 0u; mine = (j == x) ? c : mine; }
        if (sum == G) break;
        __builtin_amdgcn_s_sleep(1);
        if ((++sp & 255u) == 0u) { if (xb_ld(&bar[XB_TMO])) break; if (sp > XB_SPIN_CAP) { atomicAdd(&bar[XB_TMO], 1u); break; } }
    }
    nloc = mine > 0u ? mine : 1u; nx = cnt > 0u ? cnt : 1u;
}

__device__ __forceinline__ void xcd_barrier(const XcdBarrier& b) {
    asm volatile("s_waitcnt vmcnt(0)" ::: "memory");
    __syncthreads();
    if (threadIdx.x == 0) {
        unsigned* bar = b.bar;
        __builtin_amdgcn_s_waitcnt(0);
        unsigned nloc = b.st[0], nx = b.st[1];
        if (nloc == 0u) { xcd_barrier_complete(bar, b.x, nloc, nx); b.st[0] = nloc; b.st[1] = nx; }
        const unsigned old = xb_add(&bar[XB_XSUB(b.x)], 1u);
        const unsigned gen = old / nloc;
        if (old + 1u == (gen + 1u) * nloc) {
            __builtin_amdgcn_fence(__ATOMIC_RELEASE, "agent");
            asm volatile("s_waitcnt vmcnt(0)" ::: "memory");
            const unsigned og = xb_add(&bar[XB_TOP], 1u);
            const unsigned tg = og / nx;
            if (og + 1u == (tg + 1u) * nx) xb_add(&bar[XB_TOPGEN], 1u);
            else XB_SPIN(xb_ld(&bar[XB_TOPGEN]) == tg, bar);
            __builtin_amdgcn_fence(__ATOMIC_ACQUIRE, "agent");
            xb_add(&bar[XB_XGEN(b.x)], 1u);
            asm volatile("s_waitcnt vmcnt(0)" ::: "memory");
        } else {
            XB_SPIN(xb_ld(&bar[XB_XGEN(b.x)]) == gen, bar);
            __builtin_amdgcn_fence(__ATOMIC_ACQUIRE, "agent");
            asm volatile("s_waitcnt vmcnt(0)" ::: "memory");
        }
    }
    __syncthreads();
}
#ifndef ABL_PARTS
#define ABL_PARTS 31
#endif
#ifndef PH_MAX
#define PH_MAX 10
#endif
typedef KArgs Args;
static_assert(sizeof(Args) == 26 * 8 + 8 + 8 + 8, "Args has no padding");

__global__ void __launch_bounds__(NTHREADS, 2) fwd_megakernel(Args args) {
    extern __shared__ __attribute__((aligned(16))) unsigned char lds_raw[];
    Frame F;
    F.lds = (LAS unsigned char*)lds_raw;
    F.tid = threadIdx.x; F.lane = F.tid & 63; F.wave = __builtin_amdgcn_readfirstlane(F.tid >> 6);
    F.G = gridDim.x; F.bid = blockIdx.x; F.vcu = (F.G % 8 == 0) ? (F.bid % 8) * (F.G / 8) + F.bid / 8 : F.bid;
    F.ka = (const KArgs __attribute__((address_space(4)))*)__builtin_amdgcn_kernarg_segment_ptr();
    F.out = args.out; F.ws = args.ws;
    const int lo = args.ph_lo, hi = args.ph_hi;
    volatile LAS unsigned* xst = (volatile LAS unsigned*)(F.lds + LDS_BYTES - 64);
    if (F.tid < 2) xst[F.tid] = 0u;
    __syncthreads();
    XcdBarrier xbar = xcd_barrier_post((unsigned*)(F.ws + WS_CTL) + CW_XBAR, xst);
#ifndef PHASE_MASK
#define PHASE_MASK 0x7ff
#endif
#define IN(k) (((PHASE_MASK >> (k)) & 1) && lo <= (k) && (k) < hi)
#ifndef REP_MASK
#define REP_MASK 0
#endif
#define REPS(k) for (int rep_ = 0; rep_ < 1 + ((REP_MASK >> (k)) & 1); ++rep_)
#define SEAM(k) do { if (lo <= (k) && (k) + 1 < hi) { xcd_barrier(xbar); } } while (0)
#define FIT_GRID(n) ((F.G % 8 == 0) ? ({ const int n_ = (n), R_ = (n_ + F.G - 1) / F.G, g_ = 8 * (((n_ + R_ - 1) / R_ + 7) / 8); g_ < F.G ? g_ : F.G; }) : F.G)

    if (IN(0)) REPS(0) p0_prologue(F);
    SEAM(0);
    if (IN(1)) REPS(1) {
        const int g1 = FIT_GRID(1680);
        if (F.bid < g1) {
        SchedIn S{(const char*)(F.ws + WS_HA), (const char*)(F.ws + WS_WIN_T), g1, F.bid};
        EpiIn E{WSP(bf16, WS_QA), WSP(bf16, WS_KV6), WSP(bf16, WS_QF), WSP(bf16, WS_KF), WSP(bf16, WS_VF), WSP(bf16, WS_QM), WSP(bf16, WS_GATES), WSP(bf16, WS_KMEM), WSP(bf16, WS_VMEM), WSP(float, WS_LG),
                WSP(float, WS_ROPE_C), WSP(float, WS_ROPE_S), F.ka->in[5]};
        pg8::gemm_phase<false>(F.lds, 1024, S, E);
        }
    }
    SEAM(1);
    if (IN(3)) REPS(3) p3_phase(F, ABL_PARTS, rep_);
    SEAM(3);
    if (IN(4)) REPS(4) {
        SchedBr S{(const char*)(F.ws + WS_OBR), (const char*)(F.ws + WS_WBR_T), F.G, F.bid};
        EpiBr E{WSP(bf16, WS_GATES), WSP(bf16, WS_MERGED)};
        pg8::gemm_phase<false>(F.lds, 512, S, E);
    }
    SEAM(4);
    if (IN(5)) REPS(5) {
        SchedOut S{(const char*)(F.ws + WS_MERGED), (const char*)(F.ws + WS_WOUT_T), F.G, F.bid};
        EpiOut E{F.ka->in[0], F.out, WSP(unsigned char, WS_H2)};
        pg8::gemm_phase<false>(F.lds, 1024, S, E);
    }
    SEAM(5);
    if (IN(6)) REPS(6) p6_phase(F);
    SEAM(6);
    const bool moe_split = (F.G % 8 == 0);
    const LAS int* te = (const LAS int*)(F.lds + MT_OFF);
    if (IN(8)) REPS(8) {
        { LAS int* mt = (LAS int*)(F.lds + MT_OFF);
          if (F.tid < 64) { const int e = F.tid & 31; const int c = (int)__hip_atomic_load(WSP(unsigned, WS_CTL) + CW_GCNT + 32 * e, __ATOMIC_RELAXED, __HIP_MEMORY_SCOPE_AGENT);
              const int padc = (c + 255) & ~255; int inc = padc;
#pragma unroll
              for (int o = 1; o < 32; o <<= 1) { const int up = __shfl_up(inc, o); if (e >= o) inc += up; }
              const int start = inc - padc;
              if (F.tid < 32) { mt[320 + e] = start; mt[352 + e] = c; for (int q = 0; q < (padc >> 8); ++q) mt[(start >> 8) + q] = e | (q << 5); if (e == 31) mt[300] = inc >> 8; } }
          __syncthreads(); }
        const int nmt = __builtin_amdgcn_readfirstlane(te[300]), F8 = moe_split ? (nmt * 8) / F.G : (1 << 20);
        SchedMoE<true> S{(const char*)(F.ws + WS_H2), (const char*)(F.ws + WS_WGU_T), te, WSP(int, WS_ETOK), nmt, 8, F.G, F.vcu, (size_t)2048 * 1024, 0, F8};
        EpiGU E{F.ka->in[22], te, WSP(unsigned char, WS_ACT), WSP(float, WS_ERSTD)};
        pg8::gemm_phase<true>(F.lds, 512, S, E);
    }
    SEAM(8);
    if (IN(9)) REPS(9) {
        unsigned* done8 = WSP(unsigned, WS_CTL) + CW_DONE8;
        const int nmt = __builtin_amdgcn_readfirstlane(te[300]), n9 = nmt * 4, F8 = moe_split ? (nmt * 8) / F.G : (1 << 20), T = moe_split ? nmt * 8 - F8 * F.G : 0, v = F.vcu;
        if (v < T) {
            SchedMoE<true> S{(const char*)(F.ws + WS_H2), (const char*)(F.ws + WS_WGU_T), te, WSP(int, WS_ETOK), nmt, 8, F.G, v, (size_t)2048 * 1024, F8, F8 + 1};
            EpiGU E{F.ka->in[22], te, WSP(unsigned char, WS_ACT), WSP(float, WS_ERSTD)};
            pg8::gemm_phase<true>(F.lds, 512, S, E);
            if (F.tid == 0) { __builtin_amdgcn_fence(__ATOMIC_RELEASE, "agent"); asm volatile("s_waitcnt vmcnt(0)" ::: "memory");
                __hip_atomic_fetch_add(done8 + ((F8 * F.G + v) >> 3), 1u, __ATOMIC_RELAXED, __HIP_MEMORY_SCOPE_AGENT); }
        }
        const int vb = v - T + (v < T ? F.G : 0), pmT = moe_split ? (F8 * F.G) / 8 : (1 << 20), lim = n9 < 4 * pmT ? n9 : 4 * pmT;
        const int nseg1 = vb < lim ? (lim - 1 - vb) / F.G + 1 : 0;
        EpiDn E{F.ka->in[24], te, WSP(bf16, WS_AMOE)};
        { SchedMoE<false> S{(const char*)(F.ws + WS_ACT), (const char*)(F.ws + WS_WD_T), te, nullptr, nmt, 4, F.G, vb, (size_t)1024 * 1024, 0, nseg1};
          pg8::gemm_phase<true>(F.lds, 512, S, E); }
        if (nseg1 * F.G + vb < n9) {
            for (int L = nseg1 * F.G + vb; L < n9; L += F.G) q_wait(done8 + (L >> 2), 8u, F.tid);
            SchedMoE<false> S{(const char*)(F.ws + WS_ACT), (const char*)(F.ws + WS_WD_T), te, nullptr, nmt, 4, F.G, vb, (size_t)1024 * 1024, nseg1, 1 << 20};
            pg8::gemm_phase<true>(F.lds, 512, S, E);
        }
    }
    SEAM(9);
    if (IN(10)) { if ((REP_MASK >> 10) & 1) p10_phase(F, PH_MAX >= 9, WSP(float, WS_GATES)); p10_phase(F, PH_MAX >= 9, F.out); }
#undef IN
#undef SEAM
}

extern "C" void kernel_launch(void* const* d_in, const int* in_sizes, int n_in, void* d_out, int out_size, void* d_ws, size_t ws_size, hipStream_t stream) {
    static int grid = 0;
    if (grid == 0) {
        if (n_in != 26 || out_size != NTOK * DM || ws_size < WS_END) { fprintf(stderr, "kernel_launch: unexpected sizes n_in %d out %d ws %zu (need %zu)\n", n_in, out_size, ws_size, (size_t)WS_END); grid = -1; return; }
        int dev = 0, cus = 0, per_cu = 0;
        hipGetDevice(&dev); hipDeviceGetAttribute(&cus, hipDeviceAttributeMultiprocessorCount, dev);
        if (hipFuncSetAttribute((const void*)fwd_megakernel, hipFuncAttributeMaxDynamicSharedMemorySize, LDS_BYTES) != hipSuccess) { fprintf(stderr, "kernel_launch: hipFuncSetAttribute failed\n"); grid = -1; return; }
        if (hipOccupancyMaxActiveBlocksPerMultiprocessor(&per_cu, (const void*)fwd_megakernel, NTHREADS, LDS_BYTES) != hipSuccess || per_cu < 1) { fprintf(stderr, "kernel_launch: occupancy query says %d\n", per_cu); per_cu = 1; }
        (void)hipGetLastError();
        grid = cus * 1;
        if (grid > 256) grid = 256;
    }
    if (grid < 0) return;
    (void)hipMemsetAsync((char*)d_ws + WS_CTL, 0, CTL_BYTES, stream);
    Args a{};
    for (int i = 0; i < 26; ++i) a.in[i] = (const float*)d_in[i];
    a.out = (float*)d_out; a.ws = (unsigned char*)d_ws;
#if defined(MULTI_LAUNCH)
    for (int p = 0; p <= 10; ++p) { if (p > PH_MAX && p != 10) continue; a.ph_lo = p; a.ph_hi = p + 1; hipLaunchKernelGGL(fwd_megakernel, dim3(grid), dim3(NTHREADS), LDS_BYTES, stream, a); }
#else
    a.ph_lo = 0; a.ph_hi = 11;
    hipLaunchKernelGGL(fwd_megakernel, dim3(grid), dim3(NTHREADS), LDS_BYTES, stream, a);
#endif
}
```

```cpp
#include <hip/hip_runtime.h>
#include <hip/hip_cooperative_groups.h>
#include <cstdio>
#include <cstdint>
#include <cmath>
namespace cg = cooperative_groups;

#define LAS __attribute__((address_space(3)))
typedef unsigned short bf16;
typedef short bf16x8 __attribute__((ext_vector_type(8)));
typedef short s16x4 __attribute__((ext_vector_type(4)));
typedef float f32x4 __attribute__((ext_vector_type(4)));
typedef float f32x2 __attribute__((ext_vector_type(2)));
typedef float f32x16 __attribute__((ext_vector_type(16)));
typedef unsigned u32x4 __attribute__((ext_vector_type(4)));
typedef unsigned u32x2 __attribute__((ext_vector_type(2)));
typedef __bf16 bf16x2_t __attribute__((ext_vector_type(2)));

constexpr int NB = 4, SEQ = 4096, DM = 1024, NTOK = NB * SEQ;
constexpr int DIN = 6432, NIN = 6656;
constexpr int MEMLEN = 256, NMEMROW = NB * MEMLEN;
constexpr int NEXP = 32, TOPK = 4, FEXP = 1024;
constexpr int MAXSLOT = NTOK * TOPK + NEXP * 256;
constexpr float RMS_EPS = 1e-5f;
constexpr float LOG2E = 1.4426950408889634f;
constexpr float C2_64 = 0.125f * LOG2E;
constexpr float C2_128 = 0.08838834764831845f * LOG2E;
constexpr float NEGBIG = -1e30f;
constexpr float W8_SCALE = 32.0f, ACT8_SCALE = 4.0f;

constexpr size_t MiB = 1u << 20;
constexpr size_t WS_CTL = 0;
constexpr size_t CTL_BYTES = 64 * 1024;
constexpr size_t WS_ROPE_C = 1 * MiB, WS_ROPE_S = WS_ROPE_C + 512 * 1024;
constexpr size_t WS_W1T_K = 2 * MiB, WS_W1T_V = WS_W1T_K + 256 * 1024;
constexpr size_t WS_W2T_K = WS_W1T_V + 256 * 1024, WS_W2T_V = WS_W2T_K + 8192;
constexpr size_t WS_CPE = WS_W2T_V + 8192;
constexpr size_t WS_KCMP = 3 * MiB;
constexpr size_t WS_VCMP = WS_KCMP + 256 * 1024;
constexpr size_t WS_CUM = 4 * MiB;
constexpr size_t WS_KMAX = 4 * MiB + 512 * 1024;
constexpr size_t WS_KMEM = 5 * MiB, WS_VMEM = 6 * MiB;
constexpr size_t WS_ORDER = 7 * MiB;
constexpr size_t WS_BLKCNT = 7 * MiB + 64 * 1024;
constexpr size_t WS_TILE_E = 7 * MiB + 128 * 1024;
constexpr size_t WS_WRT = 7 * MiB + 256 * 1024;
constexpr size_t WS_RSTD = 7 * MiB + 512 * 1024;
constexpr size_t WS_RSLOT = 8 * MiB;
constexpr size_t WS_SLOTTOK = 8 * MiB + 512 * 1024;
constexpr size_t WS_WIN_T = 9 * MiB;
constexpr size_t WS_WBR_T = 24 * MiB;
constexpr size_t WS_WOUT_T = 27 * MiB;
constexpr size_t WS_WGU_T = 32 * MiB;
constexpr size_t WS_WD_T = 160 * MiB;
constexpr size_t WS_HA = 224 * MiB;
constexpr size_t WS_ETOK = 224 * MiB, WS_ERSTD = 226 * MiB;
constexpr int MT_OFF = 131072;
constexpr size_t WS_QA = 258 * MiB;
constexpr size_t WS_KV6 = 274 * MiB;
constexpr size_t WS_QM = 298 * MiB;
constexpr size_t WS_LG = 314 * MiB;
constexpr size_t WS_GATES = 316 * MiB;
constexpr size_t WS_QF = 412 * MiB, WS_KF = 428 * MiB, WS_VF = 444 * MiB;
constexpr size_t WS_ACT = 316 * MiB;
constexpr size_t WS_OBR = 460 * MiB;
constexpr size_t WS_MERGED = 508 * MiB;
constexpr size_t WS_H2 = 540 * MiB;
constexpr size_t WS_ROUTE = 572 * MiB;
constexpr size_t WS_AMOE = 576 * MiB;
constexpr size_t WS_END = 720 * MiB;
static_assert(WS_ACT + (size_t)MAXSLOT * 1024 * 2 <= WS_OBR && WS_AMOE + (size_t)MAXSLOT * 1024 * 2 <= WS_END, "ws map");
constexpr int CW_QATTN = 64;
constexpr int CW_DONE8 = 12288;
constexpr int CW_GCNT = 9216;
constexpr int CW_XBAR = 1024;

constexpr int LDS_BYTES = 155648;
constexpr int NWAVES = 8, NTHREADS = 512;

__device__ __forceinline__ unsigned cvtpk(float lo, float hi) { f32x2 v = {lo, hi}; bf16x2_t b = __builtin_convertvector(v, bf16x2_t); return __builtin_bit_cast(unsigned, b); }
__device__ __forceinline__ float bf2f(unsigned short h) { return __builtin_bit_cast(float, (unsigned)h << 16); }
__device__ __forceinline__ float bflo(unsigned u) { return __builtin_bit_cast(float, u << 16); }
__device__ __forceinline__ float bfhi(unsigned u) { return __builtin_bit_cast(float, u & 0xffff0000u); }
__device__ __forceinline__ float wave_sum(float v) {
#pragma unroll
    for (int o = 1; o < 64; o <<= 1) v += __shfl_xor(v, o);
    return v;
}
__device__ __forceinline__ float fast_sigmoid(float x) { return __builtin_amdgcn_rcpf(1.0f + __builtin_amdgcn_exp2f(-LOG2E * x)); }
__device__ __forceinline__ unsigned pk_fp8x4(float a, float b, float c, float d) {
    a = fminf(fmaxf(a, -448.f), 448.f); b = fminf(fmaxf(b, -448.f), 448.f); c = fminf(fmaxf(c, -448.f), 448.f); d = fminf(fmaxf(d, -448.f), 448.f);
    int p = __builtin_amdgcn_cvt_pk_fp8_f32(a, b, 0, false); p = __builtin_amdgcn_cvt_pk_fp8_f32(c, d, p, true); return (unsigned)p;
}
namespace pg8 {
#define PG8_LAS __attribute__((address_space(3)))
typedef unsigned short bf16_t;
typedef short bf16x8 __attribute__((ext_vector_type(8)));
typedef float f32x4 __attribute__((ext_vector_type(4)));
typedef unsigned u32x4 __attribute__((ext_vector_type(4)));
typedef unsigned u32x2 __attribute__((ext_vector_type(2)));
typedef int i32x8 __attribute__((ext_vector_type(8)));
typedef int i32x4 __attribute__((ext_vector_type(4)));
constexpr int BM = 256, BK = 64, HALF = 128, HTB = HALF * BK * 2  , STAGE_BYTES = 8 * HTB;

__host__ __device__ __forceinline__ int lds_byte(int r, int c) { const int st = (r >> 4) * 2 + (c >> 5), rr = r & 15, cc = c & 31, ob = rr * 64 + cc * 2; return st * 1024 + (ob ^ (((ob >> 9) & 1) << 5)); }
__host__ __device__ __forceinline__ void stage_rc(int b, int& R, int& C) { const int st = b / 1024, sb = b % 1024, swz = sb ^ (((sb >> 9) & 1) << 5); R = (st >> 1) * 16 + swz / 64; C = (st & 1) * 32 + (swz % 64) / 2; }
__host__ __device__ __forceinline__ int perm32(int rho) { const int n = rho >> 4, i = rho & 15; return 8 * (i >> 2) + 4 * n + (i & 3); }

struct Unit { int pm, pn; };

template <bool F8, class Epi, class Sched>
__device__ __forceinline__ void gemm_phase(PG8_LAS unsigned char* lds, const int K, const Sched& S, const Epi& E) {
    const int tid = threadIdx.x, wid = __builtin_amdgcn_readfirstlane(tid >> 6), lane = tid & 63, wr = wid >> 2, wc = wid & 3, fr = lane & 15, fq = lane >> 4;
    const int nt = K / BK;
    unsigned voffB[2]; int RA[2], CA[2];
    { int R, C; stage_rc(tid * 16, R, C); const int Rb = (R & ~31) + perm32(R & 31);
      RA[0] = R; CA[0] = C; RA[1] = R + 64; CA[1] = C; voffB[0] = (unsigned)(Rb * K + C) * 2u; voffB[1] = voffB[0] + (unsigned)(64 * K * 2); }
    constexpr bool GATHER = Sched::GATHER;
    unsigned cofA[2][2], nofA[2][2];
#define PG8_AOFF(dst, u) do { _Pragma("unroll") for (int h_ = 0; h_ < 2; ++h_) _Pragma("unroll") for (int i_ = 0; i_ < 2; ++i_) dst[h_][i_] = S.a_voff(u, h_, RA[i_], CA[i_], K); } while (0)
    const size_t kstep = (size_t)(BK * 2);
    const size_t hstep = (size_t)HALF * K * 2;
    const unsigned ldsw = (unsigned)wid * 1024u;
    const int aoff = lds_byte(wr * 64 + fr, fq * 8), boff = lds_byte(wc * 32 + fr, fq * 8);
    const int aoff8 = lds_byte(wr * 64 + fr, fq * 16), boff8 = lds_byte(wc * 32 + fr, fq * 16);
#define PG8_SA(b, h) (((b) * 2 + (h)) * HTB)
#define PG8_SB(b, h) ((4 + (b) * 2 + (h)) * HTB)
#define PG8_STAGE(bufoff, gbase, voff) do { _Pragma("unroll") for (int _i = 0; _i < 2; ++_i) \
        __builtin_amdgcn_global_load_lds((const unsigned*)((const char*)(gbase) + (voff)[_i]), (PG8_LAS unsigned*)(lds + (bufoff) + ldsw + _i * 8192), 16, 0, 0); } while (0)
#define PG8_LDA(dst, b, h) do { _Pragma("unroll") for (int m = 0; m < 4; ++m) _Pragma("unroll") for (int k = 0; k < 2; ++k) dst[m][k] = *(const PG8_LAS bf16x8*)(lds + PG8_SA(b, h) + aoff + m * 2048 + k * 1024); } while (0)
#define PG8_LDB(dst, b, h) do { _Pragma("unroll") for (int n = 0; n < 2; ++n) _Pragma("unroll") for (int k = 0; k < 2; ++k) dst[n][k] = *(const PG8_LAS bf16x8*)(lds + PG8_SB(b, h) + boff + n * 2048 + k * 1024); } while (0)
#define PG8_MMA(ai, bj, At, Bt) do { __builtin_amdgcn_s_setprio(1); _Pragma("unroll") for (int m = 0; m < 4; ++m) _Pragma("unroll") for (int n = 0; n < 2; ++n) _Pragma("unroll") for (int k = 0; k < 2; ++k) \
        acc[ai][bj][m][n] = __builtin_amdgcn_mfma_f32_16x16x32_bf16(Bt[n][k], At[m][k], acc[ai][bj][m][n], 0, 0, 0); __builtin_amdgcn_s_setprio(0); } while (0)
#define PG8_LD8(dst, base, o0, cnt) do { _Pragma("unroll") for (int q_ = 0; q_ < cnt; ++q_) { const i32x4 lo_ = *(const PG8_LAS i32x4*)(lds + (base) + (o0) + q_ * 2048), hi_ = *(const PG8_LAS i32x4*)(lds + (base) + (o0) + q_ * 2048 + 16); \
        dst[q_] = (i32x8){lo_[0], lo_[1], lo_[2], lo_[3], hi_[0], hi_[1], hi_[2], hi_[3]}; } } while (0)
#define PG8_MMA8(ai, bj, At, Bt) do { __builtin_amdgcn_s_setprio(1); _Pragma("unroll") for (int m = 0; m < 4; ++m) _Pragma("unroll") for (int n = 0; n < 2; ++n) \
        asm volatile("v_mfma_scale_f32_16x16x128_f8f6f4 %0, %1, %2, %0, %3, %3 op_sel_hi:[0,0,0]" : "+v"(acc[ai][bj][m][n]) : "v"(Bt[n]), "v"(At[m]), "v"(sc8)); asm volatile("s_nop 7" ::: "memory"); __builtin_amdgcn_s_setprio(0); } while (0)
#define PG8_WAIT_V(n) asm volatile("s_waitcnt vmcnt(" #n ")" ::: "memory")
#define PG8_WAIT_L(n) asm volatile("s_waitcnt lgkmcnt(" #n ")" ::: "memory")
#define PG8_BAR __builtin_amdgcn_s_barrier()
#define PG8_SCHED __builtin_amdgcn_sched_barrier(0)
    Unit cur, nxt; int ui = 0;
    if (!S.next(0, cur)) return;
    f32x4 acc[2][2][4][2];
#pragma unroll
    for (int a = 0; a < 2; ++a)
#pragma unroll
        for (int b = 0; b < 2; ++b)
#pragma unroll
            for (int m = 0; m < 4; ++m)
#pragma unroll
                for (int n = 0; n < 2; ++n) acc[a][b][m][n] = (f32x4){0.f, 0.f, 0.f, 0.f};
    bf16x8 At[4][2], B0[2][2], B1[2][2]; i32x8 At8[4], B08[2], B18[2]; int sc8 = 0x7f7f7f7f; asm volatile("" : "+v"(sc8));
    const char* cA = S.a_base(cur); const char* cB = S.b_base(cur);
    PG8_AOFF(cofA, cur);
    PG8_STAGE(PG8_SB(0, 0), cB, voffB); PG8_STAGE(PG8_SB(0, 1), cB + hstep, voffB); PG8_STAGE(PG8_SA(0, 0), cA, cofA[0]); PG8_STAGE(PG8_SA(0, 1), cA, cofA[1]);
    if (wr == 1) PG8_BAR;
    PG8_WAIT_V(2); PG8_BAR;
    PG8_STAGE(PG8_SB(1, 0), cB + kstep, voffB); PG8_STAGE(PG8_SA(1, 0), cA + kstep, cofA[0]); PG8_STAGE(PG8_SB(1, 1), cB + hstep + kstep, voffB);
    PG8_WAIT_V(6); PG8_BAR;
    for (;;) {
        const bool has_next = S.next(ui + 1, nxt);
        const char* nA = has_next ? S.a_base(nxt) : cA; const char* nB = has_next ? S.b_base(nxt) : cB;
        if constexpr (GATHER) { if (has_next) PG8_AOFF(nofA, nxt); else { _Pragma("unroll") for (int h_ = 0; h_ < 2; ++h_) _Pragma("unroll") for (int i_ = 0; i_ < 2; ++i_) nofA[h_][i_] = cofA[h_][i_]; } }
#pragma clang loop unroll(disable)
        for (int t = 0; t < nt; t += 2) {
            const bool last = (t == nt - 2);
            const char* a1 = cA + (size_t)(t + 1) * kstep;
            const char* a2 = last ? nA : cA + (size_t)(t + 2) * kstep; const char* b2 = last ? nB : cB + (size_t)(t + 2) * kstep;
            const char* a3 = a2 + kstep; const char* b3 = b2 + kstep;
            unsigned sofA[2][2];
            _Pragma("unroll") for (int h_ = 0; h_ < 2; ++h_) _Pragma("unroll") for (int i_ = 0; i_ < 2; ++i_) sofA[h_][i_] = (GATHER && last) ? nofA[h_][i_] : cofA[h_][i_];
            if constexpr (!F8) {
            PG8_LDB(B0, 0, 0); PG8_LDB(B1, 0, 1); PG8_SCHED; PG8_LDA(At, 0, 0); PG8_STAGE(PG8_SA(1, 1), a1, cofA[1]);
            PG8_WAIT_V(8); PG8_WAIT_L(0); PG8_BAR; PG8_MMA(0, 0, At, B0); PG8_MMA(0, 1, At, B1); PG8_BAR; PG8_SCHED;
            PG8_LDA(At, 0, 1); PG8_STAGE(PG8_SB(0, 0), b2, voffB); PG8_STAGE(PG8_SB(0, 1), b2 + hstep, voffB); PG8_STAGE(PG8_SA(0, 0), a2, sofA[0]);
            PG8_WAIT_V(8); PG8_WAIT_L(0); PG8_BAR; PG8_MMA(1, 0, At, B0); PG8_MMA(1, 1, At, B1); PG8_BAR; PG8_SCHED;
            PG8_LDB(B0, 1, 0); PG8_LDB(B1, 1, 1); PG8_SCHED; PG8_LDA(At, 1, 0); PG8_STAGE(PG8_SA(0, 1), a2, sofA[1]);
            PG8_WAIT_V(8); PG8_WAIT_L(0); PG8_BAR; PG8_MMA(0, 0, At, B0); PG8_MMA(0, 1, At, B1); PG8_BAR; PG8_SCHED;
            PG8_LDA(At, 1, 1); PG8_STAGE(PG8_SB(1, 0), b3, voffB); PG8_STAGE(PG8_SB(1, 1), b3 + hstep, voffB); PG8_STAGE(PG8_SA(1, 0), a3, sofA[0]);
            PG8_WAIT_V(8); PG8_WAIT_L(0); PG8_BAR; PG8_MMA(1, 0, At, B0); PG8_MMA(1, 1, At, B1); PG8_BAR; PG8_SCHED;
            } else {
            PG8_LD8(B08, PG8_SB(0, 0), boff8, 2); PG8_LD8(B18, PG8_SB(0, 1), boff8, 2); PG8_SCHED; PG8_LD8(At8, PG8_SA(0, 0), aoff8, 4); PG8_STAGE(PG8_SA(1, 1), a1, cofA[1]);
            PG8_WAIT_V(8); PG8_WAIT_L(0); PG8_BAR; PG8_MMA8(0, 0, At8, B08); PG8_MMA8(0, 1, At8, B18); PG8_BAR; PG8_SCHED;
            PG8_LD8(At8, PG8_SA(0, 1), aoff8, 4); PG8_STAGE(PG8_SB(0, 0), b2, voffB); PG8_STAGE(PG8_SB(0, 1), b2 + hstep, voffB); PG8_STAGE(PG8_SA(0, 0), a2, sofA[0]);
            PG8_WAIT_V(8); PG8_WAIT_L(0); PG8_BAR; PG8_MMA8(1, 0, At8, B08); PG8_MMA8(1, 1, At8, B18); PG8_BAR; PG8_SCHED;
            PG8_LD8(B08, PG8_SB(1, 0), boff8, 2); PG8_LD8(B18, PG8_SB(1, 1), boff8, 2); PG8_SCHED; PG8_LD8(At8, PG8_SA(1, 0), aoff8, 4); PG8_STAGE(PG8_SA(0, 1), a2, sofA[1]);
            PG8_WAIT_V(8); PG8_WAIT_L(0); PG8_BAR; PG8_MMA8(0, 0, At8, B08); PG8_MMA8(0, 1, At8, B18); PG8_BAR; PG8_SCHED;
            PG8_LD8(At8, PG8_SA(1, 1), aoff8, 4); PG8_STAGE(PG8_SB(1, 0), b3, voffB); PG8_STAGE(PG8_SB(1, 1), b3 + hstep, voffB); PG8_STAGE(PG8_SA(1, 0), a3, sofA[0]);
            PG8_WAIT_V(8); PG8_WAIT_L(0); PG8_BAR; PG8_MMA8(1, 0, At8, B08); PG8_MMA8(1, 1, At8, B18); PG8_BAR; PG8_SCHED;
            }
        }
        if constexpr (F8) asm volatile("s_nop 15\n\ts_nop 15" ::: "memory");
        if (wr == 0) PG8_BAR;
        E(acc, cur, wr, wc, fr, fq);
        if (!has_next) break;
        cur = nxt; cA = nA; cB = nB; ++ui;
        if constexpr (GATHER) { _Pragma("unroll") for (int h_ = 0; h_ < 2; ++h_) _Pragma("unroll") for (int i_ = 0; i_ < 2; ++i_) cofA[h_][i_] = nofA[h_][i_]; }
        if (wr == 1) PG8_BAR;
    }
    PG8_WAIT_V(0);
    PG8_BAR;
#undef PG8_AOFF
#undef PG8_SA
#undef PG8_SB
#undef PG8_STAGE
#undef PG8_LDA
#undef PG8_LDB
#undef PG8_MMA
#undef PG8_MMA8
#undef PG8_LD8
#undef PG8_WAIT_V
#undef PG8_WAIT_L
#undef PG8_BAR
#undef PG8_SCHED
}
}
typedef float acc_t[2][2][4][2] __attribute__((unused));
#define ACC_ARG pg8::f32x4 (&acc)[2][2][4][2]
#define ZERO_ACC() do { _Pragma("unroll") for (int a_ = 0; a_ < 2; ++a_) _Pragma("unroll") for (int b_ = 0; b_ < 2; ++b_) _Pragma("unroll") for (int m_ = 0; m_ < 4; ++m_) _Pragma("unroll") for (int n_ = 0; n_ < 2; ++n_) acc[a_][b_][m_][n_] = (pg8::f32x4){0.f, 0.f, 0.f, 0.f}; } while (0)

__device__ __forceinline__ bool static_unit(int L, int nM, int nN, pg8::Unit& u) {
    const int nwg = nM * nN; if (L >= nwg) return false;
    int wgid = L; { const int q = nwg / 8, r = nwg % 8, xcd = wgid % 8, off = wgid / 8; wgid = (xcd < r ? xcd * (q + 1) : r * (q + 1) + (xcd - r) * q) + off; }
    const int nig = 8 * nN, gid = wgid / nig, fm = gid * 8, gsz = (nM - fm) < 8 ? (nM - fm) : 8;
    u.pm = fm + ((wgid % nig) % gsz); u.pn = (wgid % nig) / gsz; return true;
}

struct SchedIn {
    static constexpr bool GATHER = false;
    const char* A; const char* Bt; int G, c;
    __device__ __forceinline__ bool next(int i, pg8::Unit& u) const {
        const int L = i * G + c;
        if (L < 1664) return static_unit(L, 64, 26, u);
        if (L < 1680) { const int j = L - 1664; u.pm = 64 + (j >> 2); u.pn = 26 + (j & 3); return true; }
        return false;
    }
    __device__ __forceinline__ const char* a_base(const pg8::Unit& u) const { return A + (size_t)u.pm * (256 * 1024 * 2); }
    __device__ __forceinline__ const char* b_base(const pg8::Unit& u) const { return Bt + (size_t)u.pn * (256 * 1024 * 2); }
    __device__ __forceinline__ unsigned a_voff(const pg8::Unit&, int h, int R, int C, int K) const { return (unsigned)(((h * 128 + R) * K + C) * 2); }
};
struct SchedBr {
    static constexpr bool GATHER = false;
    const char* A; const char* Bt; int G, c;
    __device__ __forceinline__ bool next(int i, pg8::Unit& u) const {
        const int rnd = i / 3, br = i - rnd * 3; pg8::Unit t;
        if (!static_unit(rnd * G + c, 64, 4, t)) return false;
        u.pm = 64 * br + t.pm; u.pn = 4 * br + t.pn; return true;
    }
    __device__ __forceinline__ const char* a_base(const pg8::Unit& u) const { return A + (size_t)u.pm * (256 * 512 * 2); }
    __device__ __forceinline__ const char* b_base(const pg8::Unit& u) const { return Bt + (size_t)u.pn * (256 * 512 * 2); }
    __device__ __forceinline__ unsigned a_voff(const pg8::Unit&, int h, int R, int C, int K) const { return (unsigned)(((h * 128 + R) * K + C) * 2); }
};
struct SchedOut {
    static constexpr bool GATHER = false;
    const char* A; const char* Bt; int G, c;
    __device__ __forceinline__ bool next(int i, pg8::Unit& u) const { return static_unit(i * G + c, 64, 4, u); }
    __device__ __forceinline__ const char* a_base(const pg8::Unit& u) const { return A + (size_t)u.pm * (256 * 1024 * 2); }
    __device__ __forceinline__ const char* b_base(const pg8::Unit& u) const { return Bt + (size_t)u.pn * (256 * 1024 * 2); }
    __device__ __forceinline__ unsigned a_voff(const pg8::Unit&, int h, int R, int C, int K) const { return (unsigned)(((h * 128 + R) * K + C) * 2); }
};
template <bool G_> struct SchedMoE {
    static constexpr bool GATHER = G_;
    const char* A; const char* Bt; const LAS int* tile_e; const int* etok; int nmt, nN, G, v; size_t estride; int i0, i1;
    __device__ __forceinline__ bool next(int i, pg8::Unit& u) const {
        if (i + i0 >= i1) return false;
        const int L = (i + i0) * G + v; if (L < 0 || L >= nmt * nN) return false;
        u.pm = L / nN; u.pn = L - u.pm * nN; return true;
    }
    __device__ __forceinline__ const char* a_base(const pg8::Unit& u) const { return G_ ? A : A + (size_t)u.pm * (256 * 1024); }
    __device__ __forceinline__ const char* b_base(const pg8::Unit& u) const { return Bt + (size_t)(__builtin_amdgcn_readfirstlane(tile_e[u.pm]) & 31) * estride + (size_t)u.pn * (256 * 1024); }
    __device__ __forceinline__ unsigned a_voff(const pg8::Unit& u, int h, int R, int C, int K) const {
        if (!G_) return (unsigned)(((h * 128 + R) * K + C) * 2);
        const int te_ = __builtin_amdgcn_readfirstlane(tile_e[u.pm]);
        unsigned t = (unsigned)etok[(te_ & 31) * NTOK + (te_ >> 5) * 256 + h * 128 + R]; t = t < (unsigned)NTOK ? t : 0u;
        return (t * (unsigned)K + (unsigned)C) * 2u;
    }
};


struct EpiIn {
    bf16 *QA, *KV6, *QF, *KF, *VF, *QM, *GATES, *KMEM, *VMEM; float* LG;
    const float *ropeC, *ropeS, *b_merge;
    __device__ __forceinline__ void operator()(ACC_ARG, const pg8::Unit& u, int wr, int wc, int fr, int fq) const {
        const int pn = u.pn, rowb = u.pm * 256 + wr * 64 + fr;
        if (pn < 13) {
#pragma unroll
            for (int bj = 0; bj < 2; ++bj) {
                const int L0 = (4 * pn + 2 * bj + (wc >> 1)) * 64, a4 = 4 * (4 * (wc & 1) + fq);
                bf16* dst; int pitch, col0; bool rope = false; float sc = 1.f;
                if (L0 < 512) { dst = QA; pitch = 512; col0 = L0; rope = true; sc = C2_64; }
                else if (L0 < 1280) { const int kk = (L0 - 512) >> 7; dst = KV6 + (size_t)kk * NTOK * 128; pitch = 128; col0 = (L0 - 512) & 127; rope = !(kk & 1); }
                else if (L0 < 1792) { dst = QF; pitch = 512; col0 = L0 - 1280; sc = C2_64; }
                else if (L0 < 2304) { dst = KF; pitch = 512; col0 = L0 - 1792; }
                else if (L0 < 2816) { dst = VF; pitch = 512; col0 = L0 - 2304; }
                else { dst = QM; pitch = 512; col0 = L0 - 2816; sc = C2_128; }
                pg8::f32x4 cv[2][4], sv[2][4];
                if (rope) {
#pragma unroll
                    for (int ai = 0; ai < 2; ++ai)
#pragma unroll
                        for (int m = 0; m < 4; ++m) { const int t = (rowb + 128 * ai + 16 * m) & (SEQ - 1); cv[ai][m] = *(const pg8::f32x4*)(ropeC + t * 32 + a4); sv[ai][m] = *(const pg8::f32x4*)(ropeS + t * 32 + a4); }
                }
                __builtin_amdgcn_sched_barrier(0);
#pragma unroll
                for (int ai = 0; ai < 2; ++ai)
#pragma unroll
                    for (int m = 0; m < 4; ++m) {
                        const int r = rowb + 128 * ai + 16 * m;
                        pg8::f32x4 x1 = acc[ai][bj][m][0], x2 = acc[ai][bj][m][1];
                        if (rope) { const pg8::f32x4 c4 = cv[ai][m], s4 = sv[ai][m];
                            const pg8::f32x4 y1 = x1 * c4 - x2 * s4, y2 = x2 * c4 + x1 * s4; x1 = y1; x2 = y2; }
                        x1 = x1 * sc; x2 = x2 * sc;
                        bf16* p = dst + (size_t)r * pitch + col0 + a4;
                        *(u32x2*)p = (u32x2){cvtpk(x1[0], x1[1]), cvtpk(x1[2], x1[3])};
                        *(u32x2*)(p + 32) = (u32x2){cvtpk(x2[0], x2[1]), cvtpk(x2[2], x2[3])};
                    }
            }
        } else if (pn < 25) {
            pg8::f32x4 bv[2][2];
#pragma unroll
            for (int bj = 0; bj < 2; ++bj) { const int cg = 256 * (pn - 13) + 128 * bj + 32 * wc + 8 * fq; bv[bj][0] = *(const pg8::f32x4*)(b_merge + cg); bv[bj][1] = *(const pg8::f32x4*)(b_merge + cg + 4); }
            __builtin_amdgcn_sched_barrier(0);
#pragma unroll
            for (int bj = 0; bj < 2; ++bj) {
                const int cg = 256 * (pn - 13) + 128 * bj + 32 * wc + 8 * fq;
                const pg8::f32x4 b0 = bv[bj][0], b1 = bv[bj][1];
#pragma unroll
                for (int ai = 0; ai < 2; ++ai)
#pragma unroll
                    for (int m = 0; m < 4; ++m) {
                        const int r = rowb + 128 * ai + 16 * m;
                        const pg8::f32x4 v0 = acc[ai][bj][m][0] + b0, v1 = acc[ai][bj][m][1] + b1;
                        u32x2 w; unsigned p = 0u;
#pragma unroll
                        for (int k = 0; k < 4; ++k) p = __builtin_amdgcn_cvt_pk_u8_f32(fmaxf(255.f * fast_sigmoid(v0[k]), 1.f), k, p);
                        w.x = p; p = 0u;
#pragma unroll
                        for (int k = 0; k < 4; ++k) p = __builtin_amdgcn_cvt_pk_u8_f32(fmaxf(255.f * fast_sigmoid(v1[k]), 1.f), k, p);
                        w.y = p;
                        *(u32x2*)((unsigned char*)GATES + (size_t)r * 3072 + cg) = w;
                    }
            }
        } else if (pn == 25) {
            if (wc == 0) {
#pragma unroll
                for (int ai = 0; ai < 2; ++ai)
#pragma unroll
                    for (int m = 0; m < 4; ++m) {
                        const int r = rowb + 128 * ai + 16 * m;
                        float* p = LG + (size_t)r * 32 + 8 * fq;
                        *(pg8::f32x4*)p = acc[ai][0][m][0]; *(pg8::f32x4*)(p + 4) = acc[ai][0][m][1];
                    }
            }
        } else {
#pragma unroll
            for (int bj = 0; bj < 2; ++bj) {
                const int cgl = 256 * (pn - 26) + 128 * bj + 32 * wc + 8 * fq;
                bf16* dst = (cgl < 512) ? KMEM : VMEM; const int col = cgl & 511;
#pragma unroll
                for (int ai = 0; ai < 2; ++ai)
#pragma unroll
                    for (int m = 0; m < 4; ++m) {
                        const int r = rowb + 128 * ai + 16 * m - NTOK;
                        const pg8::f32x4 v0 = acc[ai][bj][m][0], v1 = acc[ai][bj][m][1];
                        u32x4 w; w.x = cvtpk(v0[0], v0[1]); w.y = cvtpk(v0[2], v0[3]); w.z = cvtpk(v1[0], v1[1]); w.w = cvtpk(v1[2], v1[3]);
                        *(u32x4*)(dst + (size_t)r * 512 + col) = w;
                    }
            }
        }
        ZERO_ACC();
    }
};

struct EpiBr {
    const bf16* GATES; bf16* MERGED;
    __device__ __forceinline__ void operator()(ACC_ARG, const pg8::Unit& u, int wr, int wc, int fr, int fq) const {
        const int br = u.pn >> 2, tn = u.pn & 3, tm = u.pm & 63, rowb = tm * 256 + wr * 64 + fr;
        const unsigned char* gp = (const unsigned char*)GATES + (size_t)rowb * 3072 + 1024 * br + 256 * tn + 32 * wc + 8 * fq;
        u32x2 GA[2][4][2], GB[2][4][2];
#pragma unroll
        for (int ai = 0; ai < 2; ++ai)
#pragma unroll
            for (int m = 0; m < 4; ++m)
#pragma unroll
                for (int bj = 0; bj < 2; ++bj) { const unsigned char* p = gp + (size_t)(128 * ai + 16 * m) * 3072 + 128 * bj;
                    GA[ai][m][bj] = *(const u32x2*)p; GB[ai][m][bj] = (br < 2) ? *(const u32x2*)(p + 1024) : (u32x2){0u, 0u}; }
        __builtin_amdgcn_sched_barrier(0);
#pragma unroll
        for (int ai = 0; ai < 2; ++ai)
#pragma unroll
            for (int m = 0; m < 4; ++m) {
                const int r = rowb + 128 * ai + 16 * m;
#pragma unroll
                for (int bj = 0; bj < 2; ++bj) {
                    const int c0 = 256 * tn + 128 * bj + 32 * wc + 8 * fq;
                    const u32x2 ga = GA[ai][m][bj];
                    pg8::f32x4 g0 = {(float)(ga.x & 255u), (float)((ga.x >> 8) & 255u), (float)((ga.x >> 16) & 255u), (float)(ga.x >> 24)}, g1 = {(float)(ga.y & 255u), (float)((ga.y >> 8) & 255u), (float)((ga.y >> 16) & 255u), (float)(ga.y >> 24)};
#if defined(ABL_BR)
                    if (!((ABL_BR >> br) & 1)) { acc[ai][bj][m][0] = acc[ai][bj][m][0] * 0.f; acc[ai][bj][m][1] = acc[ai][bj][m][1] * 0.f; }
#endif
                    if (br < 2) {
                        const u32x2 gb = GB[ai][m][bj];
                        const pg8::f32x4 h0 = {(float)(gb.x & 255u), (float)((gb.x >> 8) & 255u), (float)((gb.x >> 16) & 255u), (float)(gb.x >> 24)}, h1 = {(float)(gb.y & 255u), (float)((gb.y >> 8) & 255u), (float)((gb.y >> 16) & 255u), (float)(gb.y >> 24)};
#pragma unroll
                        for (int k = 0; k < 4; ++k) { g0[k] = g0[k] * __builtin_amdgcn_rcpf(fmaxf(h0[k], 1.f)); g1[k] = g1[k] * __builtin_amdgcn_rcpf(fmaxf(h1[k], 1.f)); }
                        acc[ai][bj][m][0] = acc[ai][bj][m][0] * g0; acc[ai][bj][m][1] = acc[ai][bj][m][1] * g1;
                    } else {
                        const pg8::f32x4 v0 = acc[ai][bj][m][0] * g0 * (1.f / 255.f), v1 = acc[ai][bj][m][1] * g1 * (1.f / 255.f);
                        u32x4 w; w.x = cvtpk(v0[0], v0[1]); w.y = cvtpk(v0[2], v0[3]); w.z = cvtpk(v1[0], v1[1]); w.w = cvtpk(v1[2], v1[3]);
                        *(u32x4*)(MERGED + (size_t)r * 1024 + c0) = w;
                        acc[ai][bj][m][0] = (pg8::f32x4){0.f, 0.f, 0.f, 0.f}; acc[ai][bj][m][1] = (pg8::f32x4){0.f, 0.f, 0.f, 0.f};
                    }
                }
            }
    }
};

struct EpiOut {
    const float* X; float* X1; unsigned char* XB8;
    __device__ __forceinline__ void operator()(ACC_ARG, const pg8::Unit& u, int wr, int wc, int fr, int fq) const {
        const int rowb = u.pm * 256 + wr * 64 + fr;
        const size_t ob = (size_t)rowb * 1024 + 256 * u.pn + 32 * wc + 8 * fq;
#pragma unroll
        for (int ai = 0; ai < 2; ++ai) {
            pg8::f32x4 xs[4][2][2];
#pragma unroll
            for (int m = 0; m < 4; ++m)
#pragma unroll
                for (int bj = 0; bj < 2; ++bj) { const float* p = X + ob + (size_t)(128 * ai + 16 * m) * 1024 + 128 * bj; xs[m][bj][0] = *(const pg8::f32x4*)p; xs[m][bj][1] = *(const pg8::f32x4*)(p + 4); }
            __builtin_amdgcn_sched_barrier(0);
#pragma unroll
            for (int m = 0; m < 4; ++m)
#pragma unroll
                for (int bj = 0; bj < 2; ++bj) {
                    const size_t o = ob + (size_t)(128 * ai + 16 * m) * 1024 + 128 * bj;
                    const pg8::f32x4 y0 = xs[m][bj][0] + acc[ai][bj][m][0], y1 = xs[m][bj][1] + acc[ai][bj][m][1];
                    *(pg8::f32x4*)(X1 + o) = y0; *(pg8::f32x4*)(X1 + o + 4) = y1;
                    *(u32x2*)(XB8 + o) = (u32x2){pk_fp8x4(y0[0], y0[1], y0[2], y0[3]), pk_fp8x4(y1[0], y1[1], y1[2], y1[3])};
                }
            __builtin_amdgcn_sched_barrier(0);
        }
        ZERO_ACC();
    }
};

__device__ __forceinline__ float swiglu(float g, float uu) {
    g = fminf(g, 7.0f); uu = fminf(fmaxf(uu, -7.0f), 7.0f);
    return (uu + 1.0f) * g * __builtin_amdgcn_rcpf(1.0f + __builtin_amdgcn_exp2f(-1.702f * LOG2E * g));
}
struct EpiGU {
    const float* bias; const LAS int* tile_e; unsigned char* ACT8; const float* erstd;
    __device__ __forceinline__ void operator()(ACC_ARG, const pg8::Unit& u, int wr, int wc, int fr, int fq) const {
        const int te_ = __builtin_amdgcn_readfirstlane(tile_e[u.pm]), e = te_ & 31, rowb = u.pm * 256 + wr * 64 + fr;
        const float* rslot = erstd + (size_t)e * NTOK + (te_ >> 5) * 256 - u.pm * 256;
        float rsv[2][4]; pg8::f32x4 bv[2][2];
#pragma unroll
        for (int ai = 0; ai < 2; ++ai)
#pragma unroll
            for (int m = 0; m < 4; ++m) rsv[ai][m] = rslot[rowb + 128 * ai + 16 * m];
#pragma unroll
        for (int bj = 0; bj < 2; ++bj) { const int c0 = 256 * u.pn + 128 * bj + 32 * wc + 8 * fq; bv[bj][0] = *(const pg8::f32x4*)(bias + (size_t)e * 2048 + c0); bv[bj][1] = *(const pg8::f32x4*)(bias + (size_t)e * 2048 + c0 + 4); }
        __builtin_amdgcn_sched_barrier(0);
#pragma unroll
        for (int bj = 0; bj < 2; ++bj) {
            const int c0 = 256 * u.pn + 128 * bj + 32 * wc + 8 * fq;
            const pg8::f32x4 b0 = bv[bj][0], b1 = bv[bj][1];
#pragma unroll
            for (int ai = 0; ai < 2; ++ai)
#pragma unroll
                for (int m = 0; m < 4; ++m) {
                    const int r = rowb + 128 * ai + 16 * m; const float rs = rsv[ai][m] * (1.0f / W8_SCALE);
                    const pg8::f32x4 v0 = acc[ai][bj][m][0] * rs + b0, v1 = acc[ai][bj][m][1] * rs + b1;
                    *(unsigned*)(ACT8 + (size_t)r * 1024 + (c0 >> 1)) = pk_fp8x4(ACT8_SCALE * swiglu(v0[0], v0[1]), ACT8_SCALE * swiglu(v0[2], v0[3]), ACT8_SCALE * swiglu(v1[0], v1[1]), ACT8_SCALE * swiglu(v1[2], v1[3]));
                }
        }
        ZERO_ACC();
    }
};
struct EpiDn {
    const float* bias; const LAS int* tile_e; bf16* OS;
    __device__ __forceinline__ void operator()(ACC_ARG, const pg8::Unit& u, int wr, int wc, int fr, int fq) const {
        const int e = __builtin_amdgcn_readfirstlane(tile_e[u.pm]) & 31, rowb = u.pm * 256 + wr * 64 + fr;
        pg8::f32x4 bv[2][2];
#pragma unroll
        for (int bj = 0; bj < 2; ++bj) { const int c0 = 256 * u.pn + 128 * bj + 32 * wc + 8 * fq; bv[bj][0] = *(const pg8::f32x4*)(bias + (size_t)e * 1024 + c0); bv[bj][1] = *(const pg8::f32x4*)(bias + (size_t)e * 1024 + c0 + 4); }
        __builtin_amdgcn_sched_barrier(0);
#pragma unroll
        for (int bj = 0; bj < 2; ++bj) {
            const int c0 = 256 * u.pn + 128 * bj + 32 * wc + 8 * fq;
            const pg8::f32x4 b0 = bv[bj][0], b1 = bv[bj][1];
#pragma unroll
            for (int ai = 0; ai < 2; ++ai)
#pragma unroll
                for (int m = 0; m < 4; ++m) {
                    const int r = rowb + 128 * ai + 16 * m;
                    const pg8::f32x4 v0 = acc[ai][bj][m][0] * (1.0f / (W8_SCALE * ACT8_SCALE)) + b0, v1 = acc[ai][bj][m][1] * (1.0f / (W8_SCALE * ACT8_SCALE)) + b1;
                    u32x4 w; w.x = cvtpk(v0[0], v0[1]); w.y = cvtpk(v0[2], v0[3]); w.z = cvtpk(v1[0], v1[1]); w.w = cvtpk(v1[2], v1[3]);
                    *(u32x4*)(OS + (size_t)r * 1024 + c0) = w;
                }
        }
        ZERO_ACC();
    }
};
struct KArgs { const float* in[26]; float* out; unsigned char* ws; int ph_lo, ph_hi; };
struct Frame {
    LAS unsigned char* lds;
    int tid, lane, wave, G, bid, vcu;
    const KArgs __attribute__((address_space(4)))* ka; float* out; unsigned char* ws;
};
#define WSP(T, off) ((T*)(F.ws + (off)))

__device__ __forceinline__ int win_srccol(int n) {
    if (n < 3328) { const int p = n & 63, d = 4 * (p >> 3) + (p & 3) + 32 * ((p >> 2) & 1), L = (n & ~63) + d;
        if (L < 1280) return L; if (L < 1792) return 1304 + (L - 1280); if (L < 2304) return 1816 + (L - 1792); if (L < 2816) return 2328 + (L - 2304); return 2848 + (L - 2816); }
    if (n < 6400) return 3360 + (n - 3328);
    if (n < 6424) return 1280 + (n - 6400);
    if (n < 6432) return 2840 + (n - 6424);
    return -1;
}
__device__ __forceinline__ void transpose_item(const float* __restrict__ W, int N, bf16* __restrict__ Wt, int Kd, int n0, int k0, int sc, LAS float* scr, int lane, const float* __restrict__ kscale = nullptr) {
    const float* src = W + (size_t)k0 * N + (sc >= 0 ? sc : 0);
    float v[64];
#pragma unroll
    for (int kk = 0; kk < 64; ++kk) v[kk] = src[(size_t)kk * N];
    if (kscale) {
#pragma unroll
        for (int kk = 0; kk < 64; ++kk) v[kk] *= kscale[k0 + kk];
    }
#pragma unroll
    for (int kk = 0; kk < 64; ++kk) scr[kk * 65 + lane] = (sc >= 0) ? v[kk] : 0.f;
    asm volatile("s_waitcnt lgkmcnt(0)" ::: "memory");
    const int c = lane & 7;
#pragma unroll
    for (int j = 0; j < 8; ++j) { const int n = (lane >> 3) + 8 * j; const LAS float* s = scr + (8 * c) * 65 + n;
        u32x4 o; o.x = cvtpk(s[0], s[65]); o.y = cvtpk(s[2 * 65], s[3 * 65]); o.z = cvtpk(s[4 * 65], s[5 * 65]); o.w = cvtpk(s[6 * 65], s[7 * 65]);
        *(u32x4*)(Wt + (size_t)(n0 + n) * Kd + k0 + 8 * c) = o; }
    asm volatile("s_waitcnt lgkmcnt(0)" ::: "memory");
}
__device__ __forceinline__ void transpose_item8(const float* __restrict__ W, int N, unsigned char* __restrict__ Wt8, int Kd, int n0, int k0, LAS unsigned char* scr, int lane, const float* __restrict__ kscale, float mul) {
    const float* src = W + (size_t)k0 * N + n0 + lane;
#pragma unroll
    for (int half = 0; half < 2; ++half) {
        float v[64];
#pragma unroll
        for (int kk = 0; kk < 64; ++kk) v[kk] = src[(size_t)(64 * half + kk) * N];
#pragma unroll
        for (int kk = 0; kk < 64; ++kk) v[kk] *= kscale ? mul * kscale[k0 + 64 * half + kk] : mul;
#pragma unroll
        for (int j = 0; j < 32; ++j) { const float a = fminf(fmaxf(v[2 * j], -448.f), 448.f), b = fminf(fmaxf(v[2 * j + 1], -448.f), 448.f);
            *(LAS unsigned short*)(scr + lane * 132 + 64 * half + 2 * j) = (unsigned short)__builtin_amdgcn_cvt_pk_fp8_f32(a, b, 0, false); }
    }
    asm volatile("s_waitcnt lgkmcnt(0)" ::: "memory");
    const int c = lane & 7;
#pragma unroll
    for (int j = 0; j < 8; ++j) { const int n = (lane >> 3) + 8 * j; const LAS unsigned* s = (const LAS unsigned*)(scr + n * 132 + 16 * c);
        u32x4 o; o.x = s[0]; o.y = s[1]; o.z = s[2]; o.w = s[3];
        *(u32x4*)(Wt8 + (size_t)(n0 + n) * Kd + k0 + 16 * c) = o; }
    asm volatile("s_waitcnt lgkmcnt(0)" ::: "memory");
}
__device__ __forceinline__ void rms_row_bf16(const float* __restrict__ xrow, const float* __restrict__ g, bf16* __restrict__ orow, int lane) {
    const f32x4* xr = (const f32x4*)xrow + lane; const f32x4* gr = (const f32x4*)g + lane;
    f32x4 v[4]; float s = 0.f;
#pragma unroll
    for (int j = 0; j < 4; ++j) { v[j] = xr[64 * j]; s += (v[j].x * v[j].x + v[j].y * v[j].y) + (v[j].z * v[j].z + v[j].w * v[j].w); }
    const float rstd = 1.0f / sqrtf(wave_sum(s) * (1.f / 1024.f) + RMS_EPS);
    u32x2* o8 = (u32x2*)orow + lane;
#pragma unroll
    for (int j = 0; j < 4; ++j) { const f32x4 gg = gr[64 * j]; o8[64 * j] = (u32x2){cvtpk(v[j].x * rstd * gg.x, v[j].y * rstd * gg.y), cvtpk(v[j].z * rstd * gg.z, v[j].w * rstd * gg.w)}; }
}
__device__ __forceinline__ void sincos_big(float ang, float& s, float& c) {
    const double x = (double)ang; const double kf = __builtin_rint(x * 0.63661977236758134308); const int k = (int)kf;
    const double r = (x - kf * 1.57079632679489655800) - kf * 6.123233995736766036e-17, r2 = r * r;
    const double sp = r * (1.0 + r2 * (-1.0 / 6 + r2 * (1.0 / 120 + r2 * (-1.0 / 5040 + r2 * (1.0 / 362880 - r2 * (1.0 / 39916800))))));
    const double cp = 1.0 + r2 * (-0.5 + r2 * (1.0 / 24 + r2 * (-1.0 / 720 + r2 * (1.0 / 40320 + r2 * (-1.0 / 3628800 + r2 * (1.0 / 479001600))))));
    const double ss = (k & 1) ? cp : sp, cc = (k & 1) ? sp : cp;
    s = (float)((k & 2) ? -ss : ss); c = (float)(((k + 1) & 2) ? -cc : cc);
}
__device__ __forceinline__ void attn_unit_desc(int i, unsigned& desc, int& cost) {
    if (i < 512) { const int bg = i >> 6, T = i & 63; desc = 0u | (bg << 3) | (T << 11); cost = 8 + (T + 1) + (T < 8 ? T + 1 : 9) + 2 * (T / 4 + 1); }
    else { const int j = i - 512, bh = j >> 4, qb = j & 15; desc = 1u | (bh << 3) | (qb << 11); cost = (3 + 4 * qb + 3) / 2; }
}
constexpr int N_SORTED = 1024, MAXCOST = 128, N_CVT_UNITS = 256, CVT_CHUNK = 12;
constexpr int Q_CMP0 = 0, Q_CUM0 = 128, Q_CVT0 = 132, Q_MEM0 = Q_CVT0 + N_CVT_UNITS, Q_SRT0 = Q_MEM0 + 256, N_QUEUE = Q_SRT0 + N_SORTED;
constexpr int CW_CMPDONE = 8192, CW_CUMDONE = 8192 + 64 * 8;

__device__ __forceinline__ void p0_prologue(Frame& F) {
    LAS float* scr = (LAS float*)(F.lds + F.wave * 16640);
    const int gw = F.vcu * NWAVES + F.wave, NGW = F.G * NWAVES, lane = F.lane;
    bf16* HA = WSP(bf16, WS_HA);
    for (int m0 = gw; m0 < NTOK + NMEMROW; m0 += 4 * NGW) {
        f32x4 v[4][4]; float ss[4]; const float* xr[4]; bool has[4];
#pragma unroll
        for (int q = 0; q < 4; ++q) { const int m = m0 + q * NGW; has[q] = m < NTOK + NMEMROW; const int mm = has[q] ? m : m0;
            xr[q] = (mm < NTOK) ? F.ka->in[0] + (size_t)mm * DM : F.ka->in[1] + (size_t)(mm - NTOK) * DM; }
#pragma unroll
        for (int j = 0; j < 4; ++j)
#pragma unroll
            for (int q = 0; q < 4; ++q) v[q][j] = ((const f32x4*)xr[q])[64 * j + lane];
#pragma unroll
        for (int q = 0; q < 4; ++q) { float s_ = 0.f;
#pragma unroll
            for (int j = 0; j < 4; ++j) s_ += (v[q][j].x * v[q][j].x + v[q][j].y * v[q][j].y) + (v[q][j].z * v[q][j].z + v[q][j].w * v[q][j].w);
            ss[q] = s_; }
#pragma unroll
        for (int o = 1; o < 64; o <<= 1) {
#pragma unroll
            for (int q = 0; q < 4; ++q) ss[q] += __shfl_xor(ss[q], o); }
#pragma unroll
        for (int q = 0; q < 4; ++q) { const int m = m0 + q * NGW; const float r = 1.0f / sqrtf(ss[q] * (1.f / 1024.f) + RMS_EPS);
            const f32x4* g = (const f32x4*)((m < NTOK) ? F.ka->in[2] : F.ka->in[12]);
            if (has[q]) {
#pragma unroll
                for (int j = 0; j < 4; ++j) { const f32x4 a = g[64 * j + lane];
                    ((u32x2*)(HA + (size_t)m * DM))[64 * j + lane] = (u32x2){cvtpk(v[q][j].x * r * a.x, v[q][j].y * r * a.y), cvtpk(v[q][j].z * r * a.z, v[q][j].w * r * a.w)}; } } }
    }
    constexpr int I_WIN = 104 * 16, I_MKV = 16 * 16, I_BR = 16 * 8, I_OUT = 256, I_W1 = 32, I_W2 = 1;
    constexpr int NITEMS = I_WIN + I_MKV + 3 * I_BR + I_OUT + 2 * I_W1 + 2 * I_W2;
    for (int it = gw; it < NITEMS; it += NGW) {
        int r = it;
        if (r < I_WIN) { const int kt = r / 104, nt = r - kt * 104; transpose_item(F.ka->in[3], DIN, WSP(bf16, WS_WIN_T), 1024, nt * 64, kt * 64, win_srccol(nt * 64 + lane), scr, lane); continue; } r -= I_WIN;
        if (r < I_MKV) { const int kt = r >> 4, nt = r & 15; transpose_item(F.ka->in[13], 1024, WSP(bf16, WS_WIN_T) + (size_t)NIN * 1024, 1024, nt * 64, kt * 64, nt * 64 + lane, scr, lane); continue; } r -= I_MKV;
        if (r < 3 * I_BR) { const int b = r / I_BR, q = r - b * I_BR, kt = q >> 4, nt = q & 15; transpose_item(b == 0 ? F.ka->in[14] : (b == 1 ? F.ka->in[15] : F.ka->in[16]), 1024, WSP(bf16, WS_WBR_T) + (size_t)b * 1024 * 512, 512, nt * 64, kt * 64, nt * 64 + lane, scr, lane); continue; } r -= 3 * I_BR;
        if (r < I_OUT) { const int kt = r >> 4, nt = r & 15; transpose_item(F.ka->in[17], 1024, WSP(bf16, WS_WOUT_T), 1024, nt * 64, kt * 64, nt * 64 + lane, scr, lane); continue; } r -= I_OUT;
        if (r < 2 * I_W1) { const int b = r / I_W1, kt = r - b * I_W1; transpose_item(b ? F.ka->in[10] : F.ka->in[7], 64, b ? WSP(bf16, WS_W1T_V) : WSP(bf16, WS_W1T_K), 2048, 0, kt * 64, lane, scr, lane); continue; } r -= 2 * I_W1;
        { transpose_item(r ? F.ka->in[11] : F.ka->in[8], 64, r ? WSP(bf16, WS_W2T_V) : WSP(bf16, WS_W2T_K), 64, 0, 0, lane, scr, lane); }
    }
    { float* rc = WSP(float, WS_ROPE_C); float* rs = WSP(float, WS_ROPE_S);
      for (int idx = F.bid * NTHREADS + F.tid; idx < SEQ * 32; idx += F.G * NTHREADS) { const int t = idx >> 5, i = idx & 31;
          const float inv = exp2f(-(float)i * (13.287712379549449f / 32.0f)); const float ang = (float)t * inv; float s, c; sincos_big(ang, s, c); rc[idx] = c; rs[idx] = s; } }
    { bf16* wrh = WSP(bf16, WS_WRT); const float* wr = F.ka->in[19]; const float* gf = F.ka->in[18];
      for (int idx = F.bid * NTHREADS + F.tid; idx < 32 * 1024; idx += F.G * NTHREADS) { const int e = idx >> 10, k = idx & 1023; const float v = wr[k * 32 + e] * gf[k];
          const unsigned h = cvtpk(v, 0.f) & 0xffffu; const float lo = v - bflo(h); wrh[idx] = (bf16)h; wrh[32 * 1024 + idx] = (bf16)(cvtpk(lo, 0.f) & 0xffffu); } }
    if (gw >= NGW - 128) { const int j = gw - (NGW - 128), kv = j >> 6, part = j & 63; const float* pe = kv ? F.ka->in[9] : F.ka->in[6]; const float* w1 = kv ? F.ka->in[10] : F.ka->in[7]; float a = 0.f;
#pragma unroll 16
        for (int k = part * 32; k < part * 32 + 32; ++k) a += pe[k] * w1[k * 64 + lane];
        WSP(float, WS_CPE)[(kv * 64 + part) * 64 + lane] = a; }
    if (F.bid == 0) {
        __syncthreads();
        LAS int* hist = (LAS int*)F.lds;
        LAS unsigned* sorted = (LAS unsigned*)(hist + 3 * MAXCOST);
        for (int i = F.tid; i < 3 * MAXCOST; i += NTHREADS) hist[i] = 0;
        __syncthreads();
        for (int i = F.tid; i < N_SORTED; i += NTHREADS) { unsigned d; int c; attn_unit_desc(i, d, c); atomicAdd((int*)(hist + c), 1); }
        __syncthreads();
        if (F.tid < MAXCOST) { int run = 0; for (int c = F.tid + 1; c < MAXCOST; ++c) run += hist[c]; hist[MAXCOST + F.tid] = run; }
        __syncthreads();
        for (int i = F.tid; i < N_SORTED; i += NTHREADS) { unsigned d; int c; attn_unit_desc(i, d, c); const int pos = hist[MAXCOST + c] + atomicAdd((int*)(hist + 2 * MAXCOST + c), 1); sorted[pos] = d; }
        __syncthreads();
        unsigned* order = WSP(unsigned, WS_ORDER);
        for (int i = F.tid; i < N_QUEUE; i += NTHREADS) {
            unsigned d;
            if (i < Q_CUM0) d = 3u | ((unsigned)(i >> 6) << 3) | ((unsigned)(i & 63) << 11);
            else if (i < Q_CVT0) d = 4u | ((unsigned)(i - Q_CUM0) << 3);
            else if (i < Q_MEM0) d = 5u | ((unsigned)(i - Q_CVT0) << 11);
            else if (i < Q_SRT0) { const int j = i - Q_MEM0; d = 2u | ((unsigned)(j >> 4) << 3) | ((unsigned)(j & 15) << 11); }
            else d = sorted[i - Q_SRT0];
            order[i] = d;
        }
        __syncthreads();
    }
}

struct CvtItem { const float* src; unsigned char* dst; const float* ks; int N; };
__device__ __forceinline__ CvtItem cvt_item(Frame& F, int g, int wv, int lane) {
    const int e = g / 96, q = g - e * 96; CvtItem I;
    if (q < 64) { const int kt = q >> 3, ng = (q + kt + e) & 7, k0 = kt * 128 + 16 * wv, n0 = ng * 256 + 4 * lane;
        I.src = F.ka->in[21] + (size_t)e * 1024 * 2048 + (size_t)k0 * 2048 + n0; I.N = 2048; I.dst = WSP(unsigned char, WS_WGU_T) + (size_t)e * 2048 * 1024 + (size_t)n0 * 1024 + k0; I.ks = F.ka->in[18] + k0; }
    else { const int q2 = q - 64, kt = q2 >> 2, ng = (q2 + kt + e) & 3, k0 = kt * 128 + 16 * wv, n0 = ng * 256 + 4 * lane;
        I.src = F.ka->in[23] + (size_t)e * 1024 * 1024 + (size_t)k0 * 1024 + n0; I.N = 1024; I.dst = WSP(unsigned char, WS_WD_T) + (size_t)e * 1024 * 1024 + (size_t)n0 * 1024 + k0; I.ks = nullptr; }
    return I;
}
__device__ __forceinline__ void cvt_load(f32x4 (&v)[16], const CvtItem& I) {
#pragma unroll
    for (int kk = 0; kk < 16; ++kk) v[kk] = *(const f32x4*)(I.src + (size_t)kk * I.N);
}
__device__ __forceinline__ void cvt_store(const f32x4 (&v)[16], const CvtItem& I) {
    float sc[16];
#pragma unroll
    for (int kk = 0; kk < 16; ++kk) sc[kk] = I.ks ? W8_SCALE * I.ks[kk] : W8_SCALE;
#pragma unroll
    for (int j = 0; j < 4; ++j) { u32x4 o;
#pragma unroll
        for (int q = 0; q < 4; ++q) o[q] = pk_fp8x4(v[4 * q][j] * sc[4 * q], v[4 * q + 1][j] * sc[4 * q + 1], v[4 * q + 2][j] * sc[4 * q + 2], v[4 * q + 3][j] * sc[4 * q + 3]);
        *(u32x4*)(I.dst + (size_t)j * 1024) = o; }
}
__device__ __forceinline__ void convert_unit(Frame& F, int cu) {
    int tid_ = threadIdx.x; asm volatile("" : "+v"(tid_)); const int lane = tid_ & 63, wv = __builtin_amdgcn_readfirstlane(tid_ >> 6);
    f32x4 a[16], b[16];
    CvtItem Ia = cvt_item(F, cu * CVT_CHUNK, wv, lane), Ib; cvt_load(a, Ia);
#pragma clang loop unroll(disable)
    for (int bi = 0; bi < CVT_CHUNK; bi += 2) {
        Ib = cvt_item(F, cu * CVT_CHUNK + bi + 1, wv, lane); cvt_load(b, Ib);
        cvt_store(a, Ia);
        if (bi + 2 < CVT_CHUNK) { Ia = cvt_item(F, cu * CVT_CHUNK + bi + 2, wv, lane); cvt_load(a, Ia); }
        cvt_store(b, Ib);
    }
}
__device__ __forceinline__ void q_signal(unsigned* p, int tid) {
    asm volatile("s_waitcnt vmcnt(0)" ::: "memory"); __syncthreads();
    if (tid == 0) { __builtin_amdgcn_fence(__ATOMIC_RELEASE, "agent"); asm volatile("s_waitcnt vmcnt(0)" ::: "memory"); __hip_atomic_fetch_add(p, 1u, __ATOMIC_RELAXED, __HIP_MEMORY_SCOPE_AGENT); }
}
__device__ __forceinline__ void q_wait(unsigned* p, unsigned want, int tid) {
    if (tid == 0) { unsigned sp = 0; while (__hip_atomic_load(p, __ATOMIC_RELAXED, __HIP_MEMORY_SCOPE_AGENT) < want && ++sp < (1u << 24)) __builtin_amdgcn_s_sleep(2);
        __builtin_amdgcn_fence(__ATOMIC_ACQUIRE, "agent"); asm volatile("s_waitcnt vmcnt(0)" ::: "memory"); }
    __syncthreads();
}

__device__ __forceinline__ void p2_compress_unit(Frame& F, int kv, int rt) {
    int tid_ = threadIdx.x; asm volatile("" : "+v"(tid_)); const int lane = tid_ & 63, w = __builtin_amdgcn_readfirstlane(tid_ >> 6), r32 = lane & 31, hi = lane >> 5;
    const bf16* src = WSP(bf16, WS_KV6) + (size_t)kv * NTOK * 128;
    const bf16* w1t = WSP(bf16, kv ? WS_W1T_V : WS_W1T_K); const bf16* w2t = WSP(bf16, kv ? WS_W2T_V : WS_W2T_K);
    const int R = rt * 32 + r32, bg = R >> 8, n = R & 255, b = bg >> 1, g = bg & 1;
    f32x16 acc0 = {}, acc1 = {};
#pragma unroll 4
    for (int st = 0; st < 16; ++st) {
        const int step = w * 16 + st, l = step >> 2, d = 16 * (step & 3) + 8 * hi;
        int tok = 16 * n + l; tok = tok < SEQ ? tok : SEQ - 1;
        const bf16x8 a = *(const bf16x8*)(src + ((size_t)(b * SEQ + tok)) * 128 + g * 64 + d);
        const bf16x8 b0 = *(const bf16x8*)(w1t + (size_t)r32 * 2048 + 16 * step + 8 * hi);
        const bf16x8 b1 = *(const bf16x8*)(w1t + (size_t)(32 + r32) * 2048 + 16 * step + 8 * hi);
        acc0 = __builtin_amdgcn_mfma_f32_32x32x16_bf16(a, b0, acc0, 0, 0, 0);
        acc1 = __builtin_amdgcn_mfma_f32_32x32x16_bf16(a, b1, acc1, 0, 0, 0);
    }
    LAS float* red = (LAS float*)F.lds;
    LAS bf16* zs = (LAS bf16*)(F.lds + 65536);
    __syncthreads();
#pragma unroll
    for (int r = 0; r < 16; ++r) { const int row = (r & 3) + 8 * (r >> 2) + 4 * hi; red[(w * 32 + row) * 64 + r32] = acc0[r]; red[(w * 32 + row) * 64 + 32 + r32] = acc1[r]; }
    __syncthreads();
    const float* cpe = WSP(float, WS_CPE) + kv * 4096;
    for (int idx = F.tid; idx < 2048; idx += NTHREADS) { float z = 0.f;
#pragma unroll
        for (int pp = 0; pp < 64; ++pp) z += cpe[pp * 64 + (idx & 63)];
#pragma unroll
        for (int ww = 0; ww < 8; ++ww) z += red[ww * 2048 + idx];
        const float sl = z * fast_sigmoid(z); zs[idx] = (bf16)(cvtpk(sl, 0.f) & 0xffffu); }
    __syncthreads();
    if (w < 2) {
        f32x16 o = {};
#pragma unroll
        for (int st = 0; st < 4; ++st) {
            const bf16x8 a = *(const LAS bf16x8*)(zs + r32 * 64 + 16 * st + 8 * hi);
            const bf16x8 bb = *(const bf16x8*)(w2t + (size_t)(32 * w + r32) * 64 + 16 * st + 8 * hi);
            o = __builtin_amdgcn_mfma_f32_32x32x16_bf16(a, bb, o, 0, 0, 0);
        }
        const int rbase = rt * 32;
#pragma unroll
        for (int r = 0; r < 16; ++r) { const int row = (r & 3) + 8 * (r >> 2) + 4 * hi, RR = rbase + row, nn = RR & 255;
            const float v = (nn == 255) ? 0.f : o[r];
            if (kv == 0) WSP(bf16, WS_KCMP)[(size_t)RR * 64 + 32 * w + r32] = (bf16)(cvtpk(v, 0.f) & 0xffffu);
            else WSP(bf16, WS_VCMP)[(size_t)RR * 128 + 32 * w + r32] = (bf16)(cvtpk(v, 0.f) & 0xffffu); }
    } else if (kv == 1) {
        for (int idx = F.tid - 128; idx < 2048; idx += NTHREADS - 128) { const int row = idx >> 6, j = idx & 63, RR = rt * 32 + row, nn = RR & 255;
            const bool ov = (nn != 255) && (nn >= 4 * j - 1) && (nn <= 4 * j + 3);
            WSP(bf16, WS_VCMP)[(size_t)RR * 128 + 64 + j] = ov ? (bf16)0x3f80 : (bf16)0; }
    }
    __syncthreads();
}
__device__ __forceinline__ float log_sigmoid_f(float x) { return fminf(x, 0.f) - log1pf(expf(-fabsf(x))); }
__device__ __forceinline__ void p2_cumsum_unit(Frame& F, int bh) {
    const int lane = F.lane, b = bh >> 3, h = bh & 7; const float bf = F.ka->in[4][h];
    const float* lg = WSP(float, WS_LG) + (size_t)(b * SEQ + 64 * lane) * 32 + 24 + h;
    double tot = 0.0;
    for (int i = 0; i < 64; ++i) tot += (double)log_sigmoid_f(lg[(size_t)i * 32] + bf);
    double inc = tot;
#pragma unroll
    for (int o = 1; o < 64; o <<= 1) { const double v = __shfl_up(inc, o); if (lane >= o) inc += v; }
    double run = inc - tot;
    float* cum = WSP(float, WS_CUM) + (size_t)bh * SEQ + 64 * lane;
    for (int i = 0; i < 64; ++i) { run += (double)log_sigmoid_f(lg[(size_t)i * 32] + bf); cum[i] = (float)(run * 1.4426950408889634); }
    const bf16* kf = WSP(bf16, WS_KF) + (size_t)b * SEQ * 512 + h * 64; float km = 0.f;
#pragma unroll 4
    for (int i = 0; i < 64; ++i) { const u32x4* p = (const u32x4*)(kf + (size_t)(64 * i + lane) * 512); float s = 0.f;
#pragma unroll
        for (int c = 0; c < 8; ++c) { const u32x4 v = p[c]; s += (bflo(v.x) * bflo(v.x) + bfhi(v.x) * bfhi(v.x)) + (bflo(v.y) * bflo(v.y) + bfhi(v.y) * bfhi(v.y)) + (bflo(v.z) * bflo(v.z) + bfhi(v.z) * bfhi(v.z)) + (bflo(v.w) * bflo(v.w) + bfhi(v.w) * bfhi(v.w)); }
        km = fmaxf(km, s); }
#pragma unroll
    for (int o = 1; o < 64; o <<= 1) km = fmaxf(km, __shfl_xor(km, o));
    if (lane == 0) WSP(float, WS_KMAX)[bh] = sqrtf(km) * 1.001f;
}

__device__ __forceinline__ void p6_phase(Frame& F) {
    const int lane = F.lane, w = F.wave, r32 = lane & 31, hi = lane >> 5, grp = w >> 2, kq = w & 3;
    LAS float* red = (LAS float*)F.lds;
    LAS float* ssl = (LAS float*)(F.lds + 32768);
    LAS int* lcnt = (LAS int*)(F.lds + 36864);
    const float* X1 = F.out; const float* brt = F.ka->in[20];
    const bf16* whT = WSP(bf16, WS_WRT); const bf16* wlT = whT + 32 * 1024;
    int* tope = WSP(int, WS_ROUTE); float* topg = (float*)(tope + NTOK * 4); int* lrank = tope + NTOK * 8; float* rstdg = WSP(float, WS_RSTD);
    for (int tile = F.bid; tile < NTOK / 64; tile += F.G) {
        if (F.tid < 32) lcnt[F.tid] = 0;
        const float* xrow = X1 + (size_t)(tile * 64 + grp * 32 + r32) * DM + 8 * hi + 256 * kq;
        const bf16* whp = whT + (size_t)r32 * 1024 + 8 * hi + 256 * kq; const bf16* wlp = wlT + (size_t)r32 * 1024 + 8 * hi + 256 * kq;
        f32x16 acc = f32x16{}; float ss = 0.f;
        f32x4 xa[16], xb[16];
#pragma unroll
        for (int s = 0; s < 16; ++s) { xa[s] = *(const f32x4*)(xrow + 16 * s); xb[s] = *(const f32x4*)(xrow + 16 * s + 4); }
#pragma unroll
        for (int sb = 0; sb < 2; ++sb) {
            bf16x8 wh[8], wl[8];
#pragma unroll
            for (int s = 0; s < 8; ++s) { const int o = 16 * (8 * sb + s); wh[s] = *(const bf16x8*)(whp + o); wl[s] = *(const bf16x8*)(wlp + o); }
#pragma unroll
            for (int s = 0; s < 8; ++s) {
                const f32x4 a = xa[8 * sb + s], b = xb[8 * sb + s];
                ss += (a.x * a.x + a.y * a.y) + (a.z * a.z + a.w * a.w) + (b.x * b.x + b.y * b.y) + (b.z * b.z + b.w * b.w);
                u32x4 h; h.x = cvtpk(a.x, a.y); h.y = cvtpk(a.z, a.w); h.z = cvtpk(b.x, b.y); h.w = cvtpk(b.z, b.w);
                u32x4 l; l.x = cvtpk(a.x - bflo(h.x), a.y - bfhi(h.x)); l.y = cvtpk(a.z - bflo(h.y), a.w - bfhi(h.y)); l.z = cvtpk(b.x - bflo(h.z), b.y - bfhi(h.z)); l.w = cvtpk(b.z - bflo(h.w), b.w - bfhi(h.w));
                const bf16x8 hv = __builtin_bit_cast(bf16x8, h), lv = __builtin_bit_cast(bf16x8, l);
                acc = __builtin_amdgcn_mfma_f32_32x32x16_bf16(hv, wh[s], acc, 0, 0, 0);
                acc = __builtin_amdgcn_mfma_f32_32x32x16_bf16(lv, wh[s], acc, 0, 0, 0);
                acc = __builtin_amdgcn_mfma_f32_32x32x16_bf16(hv, wl[s], acc, 0, 0, 0);
            }
        }
#pragma unroll
        for (int r = 0; r < 16; ++r) red[(w * 16 + r) * 64 + lane] = acc[r];
        ssl[w * 64 + lane] = ss;
        __syncthreads();
        LAS float* lgt = (LAS float*)(F.lds + 40960);
        LAS float* rsl = (LAS float*)(F.lds + 40960 + 64 * 33 * 4);
        LAS float* topv = rsl + 64;
        LAS int* tope_l = (LAS int*)(topv + 256);
        if (kq == 0) {
#pragma unroll
            for (int r = 0; r < 16; ++r) acc[r] = (red[(w * 16 + r) * 64 + lane] + red[((w + 1) * 16 + r) * 64 + lane]) + (red[((w + 2) * 16 + r) * 64 + lane] + red[((w + 3) * 16 + r) * 64 + lane]);
            ss = (ssl[w * 64 + lane] + ssl[(w + 1) * 64 + lane]) + (ssl[(w + 2) * 64 + lane] + ssl[(w + 3) * 64 + lane]);
            ss += __shfl_xor(ss, 32);
            const float rstd = 1.0f / sqrtf(ss * (1.f / 1024.f) + RMS_EPS);
            if (hi == 0) { rstdg[tile * 64 + grp * 32 + r32] = rstd; rsl[grp * 32 + r32] = rstd; }
#pragma unroll
            for (int r = 0; r < 16; ++r) { const int rowl = (r & 3) + 8 * (r >> 2) + 4 * hi; lgt[(grp * 32 + rowl) * 33 + r32] = acc[r]; }
        }
        __syncthreads();
#pragma unroll
        for (int it = 0; it < 4; ++it) {
            const int row = it * 16 + (F.tid >> 5), e = F.tid & 31;
            const float rs = rsl[row]; const float mine = lgt[row * 33 + e] * rs + brt[e];
            int rank = 0;
#pragma unroll
            for (int j = 0; j < 32; ++j) { const float v = lgt[row * 33 + j] * rs + brt[j]; rank += (v > mine || (v == mine && j < e)) ? 1 : 0; }
            if (rank < 4) { topv[row * 4 + rank] = mine; tope_l[row * 4 + rank] = e; }
        }
        __syncthreads();
        int ee4[4], lr4[4];
        if (F.tid < 64) { const int row = F.tid, t = tile * 64 + row;
            const float v0 = topv[row * 4], e1 = expf(topv[row * 4 + 1] - v0), e2 = expf(topv[row * 4 + 2] - v0), e3 = expf(topv[row * 4 + 3] - v0); const float inv = 1.0f / (1.0f + e1 + e2 + e3);
            const float gs[4] = {inv, e1 * inv, e2 * inv, e3 * inv};
#pragma unroll
            for (int k = 0; k < 4; ++k) { const int ee = tope_l[row * 4 + k]; tope[t * 4 + k] = ee; topg[t * 4 + k] = gs[k]; ee4[k] = ee; lr4[k] = atomicAdd((int*)(lcnt + ee), 1); } }
        __syncthreads();
        if (F.tid < 32) { const int c = lcnt[F.tid]; lcnt[32 + F.tid] = c ? (int)__hip_atomic_fetch_add(WSP(unsigned, WS_CTL) + CW_GCNT + 32 * F.tid, (unsigned)c, __ATOMIC_RELAXED, __HIP_MEMORY_SCOPE_AGENT) : 0; }
        __syncthreads();
        if (F.tid < 64) { const int row = F.tid, t = tile * 64 + row; const float rs_ = rsl[row];
#pragma unroll
            for (int k = 0; k < 4; ++k) { const int rk = lcnt[32 + ee4[k]] + lr4[k]; lrank[t * 4 + k] = rk; WSP(int, WS_ETOK)[ee4[k] * NTOK + rk] = t; WSP(float, WS_ERSTD)[ee4[k] * NTOK + rk] = rs_; } }
        __syncthreads();
    }
}

__device__ __forceinline__ void p7_phase(Frame& F) {
    LAS int* part = (LAS int*)F.lds;
    LAS int* tot = part + 1024; LAS int* pre = tot + 32; LAS int* pstart = pre + 32; LAS int* slotl = pstart + 32;
    const int* blkcnt = WSP(int, WS_BLKCNT);
    int* tope = WSP(int, WS_ROUTE); int* lrank = tope + NTOK * 8; int* slot = tope + NTOK * 12;
    const float* rstdg = WSP(float, WS_RSTD); float* rslot = WSP(float, WS_RSLOT); int* slottok = WSP(int, WS_SLOTTOK);
    for (int tile = F.bid; tile < NTOK / 64; tile += F.G) {
        __syncthreads();
        { const int e = F.tid & 31, p = F.tid >> 5; int st = 0, sp = 0;
          for (int tt = p; tt < NTOK / 64; tt += 16) { const int c = blkcnt[tt * 32 + e]; st += c; if (tt < tile) sp += c; }
          part[p * 32 + e] = st; part[512 + p * 32 + e] = sp; }
        __syncthreads();
        if (F.tid < 32) { int st = 0, sp = 0;
#pragma unroll
            for (int p = 0; p < 16; ++p) { st += part[p * 32 + F.tid]; sp += part[512 + p * 32 + F.tid]; }
            tot[F.tid] = st; pre[F.tid] = sp; }
        __syncthreads();
        if (F.tid == 0) { int run = 0; for (int e = 0; e < 32; ++e) { pstart[e] = run; run += (tot[e] + 255) & ~255; }
            if (tile == 0) { int* te = WSP(int, WS_TILE_E); int j = 0; for (int e = 0; e < 32; ++e) { const int nte = (tot[e] + 255) >> 8; for (int q = 0; q < nte; ++q) te[j++] = e; } te[500] = j; } }
        __syncthreads();
        if (F.tid < 256) { const int a = tile * 256 + F.tid; const int e = tope[a]; const int s = pstart[e] + pre[e] + lrank[a]; slot[a] = s; rslot[s] = rstdg[tile * 64 + (F.tid >> 2)]; slottok[s] = tile * 64 + (F.tid >> 2); }
    }
}

__device__ __forceinline__ void p10_phase(Frame& F, bool with_moe, float* dsto) {
    const int gw = F.vcu * NWAVES + F.wave, NGW = F.G * NWAVES, lane = F.lane;
    const int* tope = WSP(int, WS_ROUTE); const float* topg = (const float*)(tope + NTOK * 4); const int* rank = tope + NTOK * 8;
    const LAS int* pstart = (const LAS int*)(F.lds + MT_OFF) + 320;
    const bf16* OS = WSP(bf16, WS_AMOE); const float* gfin = F.ka->in[25];
    for (int t = gw; t < NTOK; t += NGW) {
        const f32x4* xr = (const f32x4*)((with_moe ? F.out : F.ka->in[0]) + (size_t)t * DM) + lane;
        f32x4 v[4];
#pragma unroll
        for (int j = 0; j < 4; ++j) v[j] = xr[64 * j];
        if (with_moe) {
#pragma unroll
            for (int k = 0; k < 4; ++k) { const float gk = topg[t * 4 + k]; const u32x2* orow = (const u32x2*)(OS + (size_t)(pstart[tope[t * 4 + k]] + rank[t * 4 + k]) * DM) + lane;
#pragma unroll
                for (int j = 0; j < 4; ++j) { const u32x2 o = orow[64 * j]; v[j].x += gk * bflo(o.x); v[j].y += gk * bfhi(o.x); v[j].z += gk * bflo(o.y); v[j].w += gk * bfhi(o.y); } }
        }
        float s = 0.f;
#pragma unroll
        for (int j = 0; j < 4; ++j) s += (v[j].x * v[j].x + v[j].y * v[j].y) + (v[j].z * v[j].z + v[j].w * v[j].w);
        const float rstd = 1.0f / sqrtf(wave_sum(s) * (1.f / 1024.f) + RMS_EPS);
        f32x4* orow = (f32x4*)(dsto + (size_t)t * DM) + lane;
#pragma unroll
        for (int j = 0; j < 4; ++j) orow[64 * j] = v[j] * rstd * ((const f32x4*)gfin)[64 * j + lane];
    }
}
constexpr int AL_RING = 0, AL_OACC = 49152, AL_BIAS = 114688, AL_WSF = AL_BIAS + 3 * 8 * 64 * 4, AL_IMP = AL_WSF + 8 * 64 * 4, AL_SELB = AL_IMP + 64 * 65 * 4, AL_UNI = AL_SELB + 512, AL_TICKET = AL_UNI + 16;
static_assert(AL_TICKET + 16 <= LDS_BYTES - 64 && AL_OACC + 65536 <= AL_BIAS, "attention LDS map");
__device__ __forceinline__ int crow(int r, int hi) { return (r & 3) + 8 * (r >> 2) + 4 * hi; }
__device__ __forceinline__ s16x4 vtr(const LAS char* p) { return __builtin_bit_cast(s16x4, __builtin_amdgcn_ds_read_tr16_b64_v4i16((LAS s16x4*)p)); }

__device__ __forceinline__ float max3f(float a, float b, float c) { float r; asm("v_max3_f32 %0, %1, %2, %3" : "=v"(r) : "v"(a), "v"(b), "v"(c)); return r; }
struct AttnCtx { LAS unsigned char* lds; int tid, lane, w, r32, hi; LAS float* wsf; };
__device__ __forceinline__ AttnCtx make_ctx(LAS unsigned char* lds) {
    int tid = threadIdx.x; asm volatile("" : "+v"(tid));
    AttnCtx C; C.lds = lds; C.tid = tid; C.lane = tid & 63; C.w = __builtin_amdgcn_readfirstlane(tid >> 6); C.r32 = tid & 31; C.hi = (tid >> 5) & 1; C.wsf = (LAS float*)(lds + AL_WSF) + C.w * 64;
    return C;
}

template <int NDB> __device__ __forceinline__ void scale_rows(const AttnCtx& C, f32x16 (&o)[NDB], float vq, int slot) {
    if (C.hi == 0) C.wsf[slot + C.r32] = vq;
#pragma unroll
    for (int rg = 0; rg < 4; ++rg) { const f32x4 a4 = *(const LAS f32x4*)(C.wsf + slot + 8 * rg + 4 * C.hi);
#pragma unroll
        for (int db = 0; db < NDB; ++db) { o[db][4 * rg + 0] *= a4.x; o[db][4 * rg + 1] *= a4.y; o[db][4 * rg + 2] *= a4.z; o[db][4 * rg + 3] *= a4.w; } }
}

__device__ __forceinline__ void dma16(const void* g, LAS unsigned char* lds_wave_base) { __builtin_amdgcn_global_load_lds((const unsigned*)g, (LAS unsigned*)lds_wave_base, 16, 0, 0); }
__device__ __forceinline__ void dma4(const void* g, LAS unsigned char* lds_wave_base) { __builtin_amdgcn_global_load_lds((const unsigned*)g, (LAS unsigned*)lds_wave_base, 4, 0, 0); }
template <int N> __device__ __forceinline__ void wait_vm() {
    if constexpr (N == 0) asm volatile("s_waitcnt vmcnt(0)" ::: "memory"); else if constexpr (N == 2) asm volatile("s_waitcnt vmcnt(2)" ::: "memory");
    else if constexpr (N == 3) asm volatile("s_waitcnt vmcnt(3)" ::: "memory"); else if constexpr (N == 4) asm volatile("s_waitcnt vmcnt(4)" ::: "memory"); else static_assert(N == 0, "wait_vm");
}
template <int DQK, int DV, bool BIAS, class Pol>
__device__ __forceinline__ void attn_core(const AttnCtx& C, const Pol& P, const bf16x8 (&qf)[DQK / 16], f32x16 (&o)[DV / 32]) {
    constexpr int NKP = DQK / 64, NVP = DV / 64, NDB = DV / 32, ND0 = DQK / 16, KROW = DQK * 2, KCH = DQK / 8, VCH = DV / 8, KBYTES = DQK * 128, SLOT = (DQK + DV) * 128, PT = NKP + NVP + (BIAS ? 1 : 0);
    int tid = C.tid; asm volatile("" : "+v"(tid));
    const int lane = tid & 63, r32 = lane & 31, hi = lane >> 5, w = C.w;
    int ksrc[NKP], vsrc[NVP];
#pragma unroll
    for (int j = 0; j < NKP; ++j) { const int id = tid + 512 * j, key = id / KCH, slot = id % KCH; const int c = slot ^ (DQK == 64 ? ((key >> 1) & 7) : (key & 15)); ksrc[j] = key * P.kpitch() + c * 8; }
#pragma unroll
    for (int j = 0; j < NVP; ++j) { const int id = tid + 512 * j, db = id >> 8, rem = id & 255, key = 8 * (rem >> 5) + ((rem & 31) >> 2), pc = 4 * db + (rem & 3); vsrc[j] = key * P.vpitch() + pc * 8; }
    int koff[ND0];
#pragma unroll
    for (int d0 = 0; d0 < ND0; ++d0) koff[d0] = r32 * KROW + (((2 * d0 + hi) ^ (DQK == 64 ? ((r32 >> 1) & 7) : (r32 & 15))) << 4);
    const int vbase = ((lane >> 4) & 1) * 32 + (lane & 3) * 8 + (4 * hi + ((lane & 15) >> 2)) * 64;
    LAS unsigned char* lds = C.lds;
    LAS float* biasw = (LAS float*)(lds + AL_BIAS) + w * 64;
#define ATT_DMA(t, s) do { const bf16* kp_ = P.kptr(t); const bf16* vp_ = P.vptr(t); LAS unsigned char* sb_ = lds + AL_RING + (s) * SLOT + w * 1024; \
        _Pragma("unroll") for (int j = 0; j < NKP; ++j) dma16(kp_ + ksrc[j], sb_ + j * 8192); \
        _Pragma("unroll") for (int j = 0; j < NVP; ++j) dma16(vp_ + vsrc[j], sb_ + KBYTES + j * 8192); \
        if (BIAS) dma4(P.biasptr(t) + lane, (LAS unsigned char*)(biasw + (s) * 512)); } while (0)
    float m_ref = 0.f, l_part = 0.f; bool seen = false;
#pragma unroll
    for (int db = 0; db < NDB; ++db) o[db] = f32x16{};
    int t = P.first(), t1 = P.next(t);
    asm volatile("s_waitcnt vmcnt(0) lgkmcnt(0)" ::: "memory"); __builtin_amdgcn_s_barrier();
    ATT_DMA(t, 0);
    if (t1 >= 0) ATT_DMA(t1, 1);
    int s0 = 0;
    while (t >= 0) {
        const int t2 = (t1 >= 0) ? P.next(t1) : -1;
        if (t1 >= 0) wait_vm<PT>(); else wait_vm<0>();
        asm volatile("s_waitcnt lgkmcnt(0)" ::: "memory"); __builtin_amdgcn_s_barrier(); asm volatile("" ::: "memory");
        const int s2 = (s0 >= 1) ? s0 - 1 : 2;
        if (t2 >= 0) ATT_DMA(t2, s2);
        if (!P.wave_skip(t)) {
            const LAS unsigned char* Kb = lds + AL_RING + s0 * SLOT; const LAS unsigned char* Vb = Kb + KBYTES;
            const float cbase = P.lane_valid(t) ? -m_ref : NEGBIG;
            f32x16 p0, p1;
            if (BIAS) {
                const float cb = cbase + P.bias_ref();
#pragma unroll
                for (int rg = 0; rg < 4; ++rg) { const f32x4 b0 = *(const LAS f32x4*)(biasw + s0 * 512 + 8 * rg + 4 * hi), b1 = *(const LAS f32x4*)(biasw + s0 * 512 + 32 + 8 * rg + 4 * hi);
                    p0[4 * rg] = cb - b0.x; p0[4 * rg + 1] = cb - b0.y; p0[4 * rg + 2] = cb - b0.z; p0[4 * rg + 3] = cb - b0.w;
                    p1[4 * rg] = cb - b1.x; p1[4 * rg + 1] = cb - b1.y; p1[4 * rg + 2] = cb - b1.z; p1[4 * rg + 3] = cb - b1.w; }
            } else {
#pragma unroll
                for (int r = 0; r < 16; ++r) { p0[r] = cbase; p1[r] = cbase; }
            }
#pragma unroll
            for (int d0 = 0; d0 < ND0; ++d0) {
                const bf16x8 k0 = *(const LAS bf16x8*)(Kb + koff[d0]); const bf16x8 k1 = *(const LAS bf16x8*)(Kb + koff[d0] + 32 * KROW);
                p0 = __builtin_amdgcn_mfma_f32_32x32x16_bf16(k0, qf[d0], p0, 0, 0, 0);
                p1 = __builtin_amdgcn_mfma_f32_32x32x16_bf16(k1, qf[d0], p1, 0, 0, 0);
            }
            asm volatile("s_nop 15\n\ts_nop 7" : "+v"(p0), "+v"(p1));
            if (P.masked(t)) {
#pragma unroll
                for (int r = 0; r < 16; ++r) { const int kvl = crow(r, hi);
                    if (!P.valid(t, kvl)) p0[r] = NEGBIG;
                    if (!P.valid(t, kvl + 32)) p1[r] = NEGBIG; }
            }
            float rm = max3f(p0[0], p1[0], p0[1]), rm2 = max3f(p1[1], p0[2], p1[2]);
#pragma unroll
            for (int r = 3; r < 15; r += 2) { rm = max3f(rm, p0[r], p1[r]); rm2 = max3f(rm2, p0[r + 1], p1[r + 1]); }
            rm = max3f(rm, p0[15], p1[15]);
            rm = max3f(rm, rm2, rm2);
            rm = max3f(rm, __shfl_xor(rm, 32), rm);
            const bool any_valid = rm > -1e29f;
            const bool trig = (rm > 8.0f) || (!seen && any_valid);
            if (__any(trig)) {
                const float dl = trig ? rm : 0.f; const float alpha = (trig && seen) ? __builtin_amdgcn_exp2f(-dl) : 1.0f;
                m_ref += dl; l_part *= alpha;
#pragma unroll
                for (int r = 0; r < 16; ++r) { p0[r] -= dl; p1[r] -= dl; }
                scale_rows<NDB>(C, o, alpha, 0);
            }
            seen = seen || any_valid;
            float ls = 0.f;
#pragma unroll
            for (int r = 0; r < 16; ++r) { const float e0 = __builtin_amdgcn_exp2f(p0[r]), e1 = __builtin_amdgcn_exp2f(p1[r]); p0[r] = e0; p1[r] = e1; ls += e0 + e1; }
            l_part += ls;
            u32x4 pw[4];
#pragma unroll
            for (int k = 0; k < 4; ++k) { pw[0][k] = cvtpk(p0[2 * k], p0[2 * k + 1]); pw[1][k] = cvtpk(p0[8 + 2 * k], p0[9 + 2 * k]); pw[2][k] = cvtpk(p1[2 * k], p1[2 * k + 1]); pw[3][k] = cvtpk(p1[8 + 2 * k], p1[9 + 2 * k]); }
#pragma unroll
            for (int db = 0; db < NDB; ++db) {
#pragma unroll
                for (int s = 0; s < 4; ++s) {
                    const s16x4 lo = vtr((const LAS char*)Vb + vbase + db * 4096 + s * 1024), hh = vtr((const LAS char*)Vb + vbase + db * 4096 + s * 1024 + 512);
                    const bf16x8 vf = {lo[0], lo[1], lo[2], lo[3], hh[0], hh[1], hh[2], hh[3]};
                    o[db] = __builtin_amdgcn_mfma_f32_32x32x16_bf16(__builtin_bit_cast(bf16x8, pw[s]), vf, o[db], 0, 0, 0);
                }
            }
        }
        s0 = (s0 == 2) ? 0 : s0 + 1; t = t1; t1 = t2;
    }
    const float l = l_part + __shfl_xor(l_part, 32);
    scale_rows<NDB>(C, o, l > 0.f ? 1.0f / l : 0.f, 32);
    asm volatile("s_waitcnt lgkmcnt(0)" ::: "memory"); __builtin_amdgcn_s_barrier(); asm volatile("" ::: "memory");
#undef ATT_DMA
}

struct FoxPol {
    const bf16 *K, *V; const float* cum; float ref; int qb, w, tq, tmin;
    __device__ __forceinline__ int first() const { return 4 * qb + 3; }
    __device__ __forceinline__ int next(int t) const { return t - 1 >= tmin ? t - 1 : -1; }
    __device__ __forceinline__ bool masked(int t) const { return t >= 4 * qb; }
    __device__ __forceinline__ bool valid(int t, int kvl) const { return 64 * t + kvl <= tq; }
    __device__ __forceinline__ bool wave_skip(int t) const { return 64 * (t - 4 * qb) > 32 * w + 31; }
    __device__ __forceinline__ bool lane_valid(int) const { return true; }
    __device__ __forceinline__ const bf16* kptr(int t) const { return K + (size_t)(64 * t) * 512; }
    __device__ __forceinline__ const bf16* vptr(int t) const { return V + (size_t)(64 * t) * 512; }
    __device__ __forceinline__ int kpitch() const { return 512; }
    __device__ __forceinline__ int vpitch() const { return 512; }
    __device__ __forceinline__ const float* biasptr(int t) const { return cum + 64 * t; }
    __device__ __forceinline__ float bias_ref() const { return ref; }
};
struct MemPol {
    const bf16 *K, *V;
    __device__ __forceinline__ int first() const { return 0; }
    __device__ __forceinline__ int next(int t) const { return t < 3 ? t + 1 : -1; }
    __device__ __forceinline__ bool masked(int) const { return false; }
    __device__ __forceinline__ bool valid(int, int) const { return true; }
    __device__ __forceinline__ bool wave_skip(int) const { return false; }
    __device__ __forceinline__ bool lane_valid(int) const { return true; }
    __device__ __forceinline__ const bf16* kptr(int t) const { return K + (size_t)(64 * t) * 512; }
    __device__ __forceinline__ const bf16* vptr(int t) const { return V + (size_t)(64 * t) * 512; }
    __device__ __forceinline__ int kpitch() const { return 512; }
    __device__ __forceinline__ int vpitch() const { return 512; }
    __device__ __forceinline__ const float* biasptr(int) const { return nullptr; }
    __device__ __forceinline__ float bias_ref() const { return 0.f; }
};
struct CmpPol {
    const bf16 *K, *V; int ntc, tq;
    __device__ __forceinline__ int first() const { return 0; }
    __device__ __forceinline__ int next(int t) const { return t + 1 < ntc ? t + 1 : -1; }
    __device__ __forceinline__ bool masked(int) const { return true; }
    __device__ __forceinline__ bool valid(int t, int kvl) const { return 16 * (64 * t + kvl) + 31 <= tq; }
    __device__ __forceinline__ bool wave_skip(int) const { return false; }
    __device__ __forceinline__ bool lane_valid(int) const { return true; }
    __device__ __forceinline__ const bf16* kptr(int t) const { return K + (size_t)(64 * t) * 64; }
    __device__ __forceinline__ const bf16* vptr(int t) const { return V + (size_t)(64 * t) * 128; }
    __device__ __forceinline__ int kpitch() const { return 64; }
    __device__ __forceinline__ int vpitch() const { return 128; }
    __device__ __forceinline__ const float* biasptr(int) const { return nullptr; }
    __device__ __forceinline__ float bias_ref() const { return 0.f; }
};
struct WinPol {
    const bf16 *K, *V; int T, tq;
    __device__ __forceinline__ int first() const { return T; }
    __device__ __forceinline__ int next(int t) const { return (t - 1 >= 0 && t - 1 >= T - 8) ? t - 1 : -1; }
    __device__ __forceinline__ bool masked(int t) const { return t == T || t == T - 8; }
    __device__ __forceinline__ bool valid(int t, int kvl) const { const int d = tq - (64 * t + kvl); return d >= 0 && d < 512; }
    __device__ __forceinline__ bool wave_skip(int) const { return false; }
    __device__ __forceinline__ bool lane_valid(int) const { return true; }
    __device__ __forceinline__ const bf16* kptr(int t) const { return K + (size_t)(64 * t) * 128; }
    __device__ __forceinline__ const bf16* vptr(int t) const { return V + (size_t)(64 * t) * 128; }
    __device__ __forceinline__ int kpitch() const { return 128; }
    __device__ __forceinline__ int vpitch() const { return 128; }
    __device__ __forceinline__ const float* biasptr(int) const { return nullptr; }
    __device__ __forceinline__ float bias_ref() const { return 0.f; }
};
struct SelPol {
    const bf16 *K, *V; unsigned long long uni, mine; int T, tq;
    __device__ __forceinline__ int first() const { return 63 - __clzll(uni); }
    __device__ __forceinline__ int next(int t) const { const unsigned long long m = uni & ((1ull << t) - 1ull); return m ? 63 - __clzll(m) : -1; }
    __device__ __forceinline__ bool masked(int t) const { return t == T; }
    __device__ __forceinline__ bool valid(int t, int kvl) const { return 64 * t + kvl <= tq; }
    __device__ __forceinline__ bool wave_skip(int) const { return false; }
    __device__ __forceinline__ bool lane_valid(int t) const { return (mine >> t) & 1ull; }
    __device__ __forceinline__ const bf16* kptr(int t) const { return K + (size_t)(64 * t) * 128; }
    __device__ __forceinline__ const bf16* vptr(int t) const { return V + (size_t)(64 * t) * 128; }
    __device__ __forceinline__ int kpitch() const { return 128; }
    __device__ __forceinline__ int vpitch() const { return 128; }
    __device__ __forceinline__ const float* biasptr(int) const { return nullptr; }
    __device__ __forceinline__ float bias_ref() const { return 0.f; }
};

template <int NDB, class RowF> __device__ __forceinline__ void store_o(const AttnCtx& C, const f32x16 (&o)[NDB], bf16* dst, RowF rowoff) {
#pragma unroll
    for (int r = 0; r < 16; ++r) { const int q = crow(r, C.hi); bf16* p = dst + rowoff(q) + C.r32;
#pragma unroll
        for (int db = 0; db < NDB; ++db) p[32 * db] = (bf16)(cvtpk(o[db][r], 0.f) & 0xffffu); }
}

__device__ __forceinline__ void fox_unit(Frame& F0, int bh, int qb) {
    const AttnCtx C = make_ctx(F0.lds);
    struct { unsigned char* ws; } F; { unsigned long long w_ = (unsigned long long)F0.ws; asm volatile("" : "+s"(w_)); F.ws = (unsigned char*)w_; }
    const int b = bh >> 3, h = bh & 7, tq = 256 * qb + 32 * C.w + C.r32;
    const bf16* Q = WSP(bf16, WS_QF) + ((size_t)(b * SEQ + tq)) * 512 + h * 64;
    bf16x8 qf[4];
#pragma unroll
    for (int d0 = 0; d0 < 4; ++d0) qf[d0] = *(const bf16x8*)(Q + 16 * d0 + 8 * C.hi);
    const float* cum = WSP(float, WS_CUM) + (size_t)bh * SEQ;
    int tmin = 0;
    { float qn = 0.f;
#pragma unroll
      for (int d0 = 0; d0 < 4; ++d0)
#pragma unroll
          for (int j = 0; j < 8; ++j) { const float v = bf2f((unsigned short)qf[d0][j]); qn += v * v; }
      qn += __shfl_xor(qn, 32);
#pragma unroll
      for (int o = 16; o >= 1; o >>= 1) qn = fmaxf(qn, __shfl_xor(qn, o));
      LAS float* qmx = (LAS float*)(C.lds + AL_SELB);
      __syncthreads();
      if (C.lane == 0) qmx[C.w] = qn;
      __syncthreads();
      float qm = qmx[0];
#pragma unroll
      for (int i = 1; i < 8; ++i) qm = fmaxf(qm, qmx[i]);
      const float B = sqrtf(qm) * WSP(float, WS_KMAX)[bh];
      const float thr = -(40.0f + 2.0f * B), c0 = cum[256 * qb];
      const bool cond = (C.lane < 4 * qb) && (c0 - cum[64 * C.lane + 63] < thr);
      const unsigned long long bal = __ballot(cond);
      tmin = bal ? 64 - __clzll(bal) : 0; }
    FoxPol P{WSP(bf16, WS_KF) + (size_t)b * SEQ * 512 + h * 64, WSP(bf16, WS_VF) + (size_t)b * SEQ * 512 + h * 64, cum, cum[256 * qb + 255], qb, C.w, tq, tmin};
    f32x16 o[2];
    attn_core<64, 64, true>(C, P, qf, o);
    bf16* dst = WSP(bf16, WS_OBR) + (size_t)1 * NTOK * 512 + h * 64;
    const size_t rb = (size_t)(b * SEQ + 256 * qb + 32 * C.w);
    store_o<2>(C, o, dst, [&](int q) { return (rb + q) * 512; });
}
__device__ __forceinline__ void mem_unit(Frame& F0, int bh, int qb) {
    const AttnCtx C = make_ctx(F0.lds);
    struct { unsigned char* ws; } F; { unsigned long long w_ = (unsigned long long)F0.ws; asm volatile("" : "+s"(w_)); F.ws = (unsigned char*)w_; }
    const int b = bh >> 2, h = bh & 3, tq = 256 * qb + 32 * C.w + C.r32;
    const bf16* Q = WSP(bf16, WS_QM) + ((size_t)(b * SEQ + tq)) * 512 + h * 128;
    bf16x8 qf[8];
#pragma unroll
    for (int d0 = 0; d0 < 8; ++d0) qf[d0] = *(const bf16x8*)(Q + 16 * d0 + 8 * C.hi);
    MemPol P{WSP(bf16, WS_KMEM) + (size_t)b * MEMLEN * 512 + h * 128, WSP(bf16, WS_VMEM) + (size_t)b * MEMLEN * 512 + h * 128};
    f32x16 o[4];
    attn_core<128, 128, false>(C, P, qf, o);
    bf16* dst = WSP(bf16, WS_OBR) + (size_t)2 * NTOK * 512 + h * 128;
    const size_t rb = (size_t)(b * SEQ + 256 * qb + 32 * C.w);
    store_o<4>(C, o, dst, [&](int q) { return (rb + q) * 512; });
}
__device__ __forceinline__ void nsa_unit(Frame& F0, int bg, int T, int parts) {
    const AttnCtx C = make_ctx(F0.lds);
    struct { unsigned char* ws; } F; { unsigned long long w_ = (unsigned long long)F0.ws; asm volatile("" : "+s"(w_)); F.ws = (unsigned char*)w_; }
    const int b = bg >> 1, g = bg & 1, q = C.r32, tokl = 8 * C.w + (q >> 2), tq = 64 * T + tokl, head = 4 * g + (q & 3);
    const bf16* Q = WSP(bf16, WS_QA) + ((size_t)(b * SEQ + tq)) * 512 + head * 64;
    bf16x8 qf[4];
#pragma unroll
    for (int d0 = 0; d0 < 4; ++d0) qf[d0] = *(const bf16x8*)(Q + 16 * d0 + 8 * C.hi);
    const float* lg = WSP(float, WS_LG) + (size_t)(b * SEQ + tq) * 32 + head * 3;
    LAS float* oacc = (LAS float*)(C.lds + AL_OACC) + C.w * 2048 + C.lane;
    LAS float* imp = (LAS float*)(C.lds + AL_IMP);
    LAS unsigned long long* selb = (LAS unsigned long long*)(C.lds + AL_SELB);
    LAS unsigned long long* unip = (LAS unsigned long long*)(C.lds + AL_UNI);
#ifndef NSA_CORES
#define NSA_CORES 7
#endif
    if (NSA_CORES & 1) {
        CmpPol P{WSP(bf16, WS_KCMP) + (size_t)bg * 256 * 64, WSP(bf16, WS_VCMP) + (size_t)bg * 256 * 128, (4 * T + 2) / 64 + 1, tq};
        f32x16 o2[2];
        attn_core<64, 64, false>(C, P, qf, o2);
        scale_rows<2>(C, o2, (parts & 1) ? fast_sigmoid(lg[0]) : 0.f, 0);
#pragma unroll
        for (int db = 0; db < 2; ++db)
#pragma unroll
            for (int r = 0; r < 16; ++r) oacc[(db * 16 + r) * 64] = o2[db][r];
        P.V += 64;
        attn_core<64, 64, false>(C, P, qf, o2);
#pragma unroll
        for (int db = 0; db < 2; ++db)
#pragma unroll
            for (int rg = 0; rg < 4; ++rg) imp[(8 * C.w + 2 * rg + C.hi) * 65 + 32 * db + C.r32] = (o2[db][4 * rg] + o2[db][4 * rg + 1]) + (o2[db][4 * rg + 2] + o2[db][4 * rg + 3]);
    }
    __syncthreads();
    {
        const int tk = C.tid >> 3, sub = C.tid & 7;
        float mine[8]; int rank[8];
#pragma unroll
        for (int i = 0; i < 8; ++i) { const int j = 8 * sub + i; const float v = imp[tk * 65 + j];
            mine[i] = (j == 0 || j == T || j == T - 1) ? 1e4f : (j > T ? -1e4f : v); rank[i] = 0; }
        for (int jj = 0; jj < 64; ++jj) { const float v0 = imp[tk * 65 + jj]; const float v = (jj == 0 || jj == T || jj == T - 1) ? 1e4f : (jj > T ? -1e4f : v0);
#pragma unroll
            for (int i = 0; i < 8; ++i) { const int j = 8 * sub + i; rank[i] += (v > mine[i] || (v == mine[i] && jj < j)) ? 1 : 0; } }
        unsigned byte = 0;
#pragma unroll
        for (int i = 0; i < 8; ++i) { const int j = 8 * sub + i; if (rank[i] < 16 && j <= T) byte |= 1u << i; }
        ((LAS unsigned char*)selb)[tk * 8 + sub] = (unsigned char)byte;
    }
    __syncthreads();
    if (C.w == 0) { unsigned long long m = selb[C.lane]; unsigned lo = (unsigned)m, hh = (unsigned)(m >> 32);
#pragma unroll
        for (int o = 1; o < 64; o <<= 1) { lo |= __shfl_xor(lo, o); hh |= __shfl_xor(hh, o); }
        if (C.lane == 0) unip[0] = ((unsigned long long)hh << 32) | lo; }
    __syncthreads();
    const unsigned long long mymask = selb[tokl]; unsigned long long uni = unip[0];
    uni = ((unsigned long long)__builtin_amdgcn_readfirstlane((unsigned)(uni >> 32)) << 32) | (unsigned)__builtin_amdgcn_readfirstlane((unsigned)uni);
    if (NSA_CORES & 2) {
        SelPol P{WSP(bf16, WS_KV6) + (size_t)2 * NTOK * 128 + (size_t)b * SEQ * 128 + g * 64, WSP(bf16, WS_KV6) + (size_t)3 * NTOK * 128 + (size_t)b * SEQ * 128 + g * 64, uni, mymask, T, tq};
        f32x16 o2[2];
        attn_core<64, 64, false>(C, P, qf, o2);
        scale_rows<2>(C, o2, (parts & 2) ? fast_sigmoid(lg[1]) : 0.f, 0);
#pragma unroll
        for (int db = 0; db < 2; ++db)
#pragma unroll
            for (int r = 0; r < 16; ++r) oacc[(db * 16 + r) * 64] += o2[db][r];
    }
    if (NSA_CORES & 4) {
        WinPol P{WSP(bf16, WS_KV6) + (size_t)4 * NTOK * 128 + (size_t)b * SEQ * 128 + g * 64, WSP(bf16, WS_KV6) + (size_t)5 * NTOK * 128 + (size_t)b * SEQ * 128 + g * 64, T, tq};
        f32x16 o2[2];
        attn_core<64, 64, false>(C, P, qf, o2);
        scale_rows<2>(C, o2, (parts & 4) ? fast_sigmoid(lg[2]) : 0.f, 0);
#pragma unroll
        for (int db = 0; db < 2; ++db)
#pragma unroll
            for (int r = 0; r < 16; ++r) o2[db][r] += oacc[(db * 16 + r) * 64];
        bf16* dst = WSP(bf16, WS_OBR) + g * 256;
        const size_t rb = (size_t)(b * SEQ + 64 * T + 8 * C.w);
        store_o<2>(C, o2, dst, [&](int qq) { return (rb + (qq >> 2)) * 512 + (qq & 3) * 64; });
    }
}

__device__ __forceinline__ void p3_phase(Frame& F, int parts, int rep) {
    LAS int* ticket = (LAS int*)(F.lds + AL_TICKET);
    unsigned* ctl = WSP(unsigned, WS_CTL);
    unsigned* qhead = ctl + CW_QATTN + 64 * rep; const unsigned* order = WSP(unsigned, WS_ORDER);
    for (;;) {
        __syncthreads();
        if (F.tid == 0) ticket[0] = (int)atomicAdd(qhead, 1u);
        __syncthreads();
        const int tk = __builtin_amdgcn_readfirstlane(ticket[0]);
        if (tk >= N_QUEUE) break;
        const unsigned d = __builtin_amdgcn_readfirstlane(order[tk]); const int type = d & 7, a = (d >> 3) & 255, bb = d >> 11;
#ifdef REP_ATTN_ONLY
        if (rep > 0 && type >= 3) continue;
#endif
#ifdef REP_CVT_ONLY
        if (rep > 0 && type != 5) continue;
#endif
        if (type == 0) { q_wait(ctl + CW_CMPDONE + 64 * a, 16u, F.tid); nsa_unit(F, a, bb, parts); }
        else if (type == 1) { q_wait(ctl + CW_CUMDONE + 64 * (a >> 3), 1u, F.tid); fox_unit(F, a, bb); }
        else if (type == 2) mem_unit(F, a, bb);
#ifndef QDIS
#define QDIS 0
#endif
        else if (type == 3) { if (!(QDIS & 1)) p2_compress_unit(F, a, bb); q_signal(ctl + CW_CMPDONE + 64 * (bb >> 3), F.tid); }
        else if (type == 4) { if (!(QDIS & 2)) p2_cumsum_unit(F, 8 * a + F.wave); q_signal(ctl + CW_CUMDONE + 64 * a, F.tid); }
        else { if (!(QDIS & 4)) convert_unit(F, bb); }
    }
}
#define XB_TMO      128
#define XB_XCNT(j)  (256  + 64 * (j))
#define XB_XSUB(j)  (1280 + 64 * (j))
#define XB_XGEN(j)  (2304 + 64 * (j))
#define XB_TOP      3328
#define XB_TOPGEN   3392
#define XCD_BAR_WORDS 3456
#define XB_SPIN_CAP (1u << 18)

__device__ __forceinline__ unsigned xb_ld(unsigned* p)              { return __hip_atomic_load(p, __ATOMIC_RELAXED, __HIP_MEMORY_SCOPE_AGENT); }
__device__ __forceinline__ unsigned xb_add(unsigned* p, unsigned v) { return __hip_atomic_fetch_add(p, v, __ATOMIC_RELAXED, __HIP_MEMORY_SCOPE_AGENT); }
__device__ __forceinline__ unsigned xb_xcc_id() { return (unsigned)__builtin_amdgcn_s_getreg((3 << 11) | 20) & 0xFu; }
#define XB_SPIN(cond, bar) do { unsigned _sp = 0; while (cond) { __builtin_amdgcn_s_sleep(1); \
    if ((++_sp & 255u) == 0u) { if (xb_ld(&(bar)[XB_TMO])) break; if (_sp > XB_SPIN_CAP) { atomicAdd(&(bar)[XB_TMO], 1u); break; } } } } while (0)

struct XcdBarrier {
    unsigned* bar; unsigned x;
    volatile LAS unsigned* st;
};

__device__ __forceinline__ XcdBarrier xcd_barrier_post(unsigned* bar, volatile LAS unsigned* st) {
    XcdBarrier b; b.bar = bar; b.x = xb_xcc_id(); b.st = st;
    if (threadIdx.x == 0) (void)xb_add(&bar[XB_XCNT(b.x)], 1u);
    return b;
}
__device__ __forceinline__ void xcd_barrier_complete(unsigned* bar, unsigned x, unsigned& nloc, unsigned& nx) {
    const unsigned G = gridDim.x * gridDim.y * gridDim.z;
    unsigned sum, cnt, mine, sp = 0u;
    for (;;) {
        sum = 0u; cnt = 0u; mine = 0u;
#pragma unroll
        for (unsigned j = 0; j < 16; ++j) { const unsigned c = xb_ld(&bar[XB_XCNT(j)]); sum += c; cnt += (c > 0u) ? 1u : 0u; mine = (j == x) ? c : mine; }
        if (sum == G) break;
        __builtin_amdgcn_s_sleep(1);
        if ((++sp & 255u) == 0u) { if (xb_ld(&bar[XB_TMO])) break; if (sp > XB_SPIN_CAP) { atomicAdd(&bar[XB_TMO], 1u); break; } }
    }
    nloc = mine > 0u ? mine : 1u; nx = cnt > 0u ? cnt : 1u;
}

__device__ __forceinline__ void xcd_barrier(const XcdBarrier& b) {
    asm volatile("s_waitcnt vmcnt(0)" ::: "memory");
    __syncthreads();
    if (threadIdx.x == 0) {
        unsigned* bar = b.bar;
        __builtin_amdgcn_s_waitcnt(0);
        unsigned nloc = b.st[0], nx = b.st[1];
        if (nloc == 0u) { xcd_barrier_complete(bar, b.x, nloc, nx); b.st[0] = nloc; b.st[1] = nx; }
        const unsigned old = xb_add(&bar[XB_XSUB(b.x)], 1u);
        const unsigned gen = old / nloc;
        if (old + 1u == (gen + 1u) * nloc) {
            __builtin_amdgcn_fence(__ATOMIC_RELEASE, "agent");
            asm volatile("s_waitcnt vmcnt(0)" ::: "memory");
            const unsigned og = xb_add(&bar[XB_TOP], 1u);
            const unsigned tg = og / nx;
            if (og + 1u == (tg + 1u) * nx) xb_add(&bar[XB_TOPGEN], 1u);
            else XB_SPIN(xb_ld(&bar[XB_TOPGEN]) == tg, bar);
            __builtin_amdgcn_fence(__ATOMIC_ACQUIRE, "agent");
            xb_add(&bar[XB_XGEN(b.x)], 1u);
            asm volatile("s_waitcnt vmcnt(0)" ::: "memory");
        } else {
            XB_SPIN(xb_ld(&bar[XB_XGEN(b.x)]) == gen, bar);
            __builtin_amdgcn_fence(__ATOMIC_ACQUIRE, "agent");
            asm volatile("s_waitcnt vmcnt(0)" ::: "memory");
        }
    }
    __syncthreads();
}
#ifndef ABL_PARTS
#define ABL_PARTS 31
#endif
#ifndef PH_MAX
#define PH_MAX 10
#endif
typedef KArgs Args;
static_assert(sizeof(Args) == 26 * 8 + 8 + 8 + 8, "Args has no padding");

__global__ void __launch_bounds__(NTHREADS, 2) fwd_megakernel(Args args) {
    extern __shared__ __attribute__((aligned(16))) unsigned char lds_raw[];
    Frame F;
    F.lds = (LAS unsigned char*)lds_raw;
    F.tid = threadIdx.x; F.lane = F.tid & 63; F.wave = __builtin_amdgcn_readfirstlane(F.tid >> 6);
    F.G = gridDim.x; F.bid = blockIdx.x; F.vcu = (F.G % 8 == 0) ? (F.bid % 8) * (F.G / 8) + F.bid / 8 : F.bid;
    F.ka = (const KArgs __attribute__((address_space(4)))*)__builtin_amdgcn_kernarg_segment_ptr();
    F.out = args.out; F.ws = args.ws;
    const int lo = args.ph_lo, hi = args.ph_hi;
    volatile LAS unsigned* xst = (volatile LAS unsigned*)(F.lds + LDS_BYTES - 64);
    if (F.tid < 2) xst[F.tid] = 0u;
    __syncthreads();
    XcdBarrier xbar = xcd_barrier_post((unsigned*)(F.ws + WS_CTL) + CW_XBAR, xst);
#ifndef PHASE_MASK
#define PHASE_MASK 0x7ff
#endif
#define IN(k) (((PHASE_MASK >> (k)) & 1) && lo <= (k) && (k) < hi)
#ifndef REP_MASK
#define REP_MASK 0
#endif
#define REPS(k) for (int rep_ = 0; rep_ < 1 + ((REP_MASK >> (k)) & 1); ++rep_)
#define SEAM(k) do { if (lo <= (k) && (k) + 1 < hi) { xcd_barrier(xbar); } } while (0)
#define FIT_GRID(n) ((F.G % 8 == 0) ? ({ const int n_ = (n), R_ = (n_ + F.G - 1) / F.G, g_ = 8 * (((n_ + R_ - 1) / R_ + 7) / 8); g_ < F.G ? g_ : F.G; }) : F.G)

    if (IN(0)) REPS(0) p0_prologue(F);
    SEAM(0);
    if (IN(1)) REPS(1) {
        const int g1 = FIT_GRID(1680);
        if (F.bid < g1) {
        SchedIn S{(const char*)(F.ws + WS_HA), (const char*)(F.ws + WS_WIN_T), g1, F.bid};
        EpiIn E{WSP(bf16, WS_QA), WSP(bf16, WS_KV6), WSP(bf16, WS_QF), WSP(bf16, WS_KF), WSP(bf16, WS_VF), WSP(bf16, WS_QM), WSP(bf16, WS_GATES), WSP(bf16, WS_KMEM), WSP(bf16, WS_VMEM), WSP(float, WS_LG),
                WSP(float, WS_ROPE_C), WSP(float, WS_ROPE_S), F.ka->in[5]};
        pg8::gemm_phase<false>(F.lds, 1024, S, E);
        }
    }
    SEAM(1);
    if (IN(3)) REPS(3) p3_phase(F, ABL_PARTS, rep_);
    SEAM(3);
    if (IN(4)) REPS(4) {
        SchedBr S{(const char*)(F.ws + WS_OBR), (const char*)(F.ws + WS_WBR_T), F.G, F.bid};
        EpiBr E{WSP(bf16, WS_GATES), WSP(bf16, WS_MERGED)};
        pg8::gemm_phase<false>(F.lds, 512, S, E);
    }
    SEAM(4);
    if (IN(5)) REPS(5) {
        SchedOut S{(const char*)(F.ws + WS_MERGED), (const char*)(F.ws + WS_WOUT_T), F.G, F.bid};
        EpiOut E{F.ka->in[0], F.out, WSP(unsigned char, WS_H2)};
        pg8::gemm_phase<false>(F.lds, 1024, S, E);
    }
    SEAM(5);
    if (IN(6)) REPS(6) p6_phase(F);
    SEAM(6);
    const bool moe_split = (F.G % 8 == 0);
    const LAS int* te = (const LAS int*)(F.lds + MT_OFF);
    if (IN(8)) REPS(8) {
        { LAS int* mt = (LAS int*)(F.lds + MT_OFF);
          if (F.tid < 64) { const int e = F.tid & 31; const int c = (int)__hip_atomic_load(WSP(unsigned, WS_CTL) + CW_GCNT + 32 * e, __ATOMIC_RELAXED, __HIP_MEMORY_SCOPE_AGENT);
              const int padc = (c + 255) & ~255; int inc = padc;
#pragma unroll
              for (int o = 1; o < 32; o <<= 1) { const int up = __shfl_up(inc, o); if (e >= o) inc += up; }
              const int start = inc - padc;
              if (F.tid < 32) { mt[320 + e] = start; mt[352 + e] = c; for (int q = 0; q < (padc >> 8); ++q) mt[(start >> 8) + q] = e | (q << 5); if (e == 31) mt[300] = inc >> 8; } }
          __syncthreads(); }
        const int nmt = __builtin_amdgcn_readfirstlane(te[300]), F8 = moe_split ? (nmt * 8) / F.G : (1 << 20);
        SchedMoE<true> S{(const char*)(F.ws + WS_H2), (const char*)(F.ws + WS_WGU_T), te, WSP(int, WS_ETOK), nmt, 8, F.G, F.vcu, (size_t)2048 * 1024, 0, F8};
        EpiGU E{F.ka->in[22], te, WSP(unsigned char, WS_ACT), WSP(float, WS_ERSTD)};
        pg8::gemm_phase<true>(F.lds, 512, S, E);
    }
    SEAM(8);
    if (IN(9)) REPS(9) {
        unsigned* done8 = WSP(unsigned, WS_CTL) + CW_DONE8;
        const int nmt = __builtin_amdgcn_readfirstlane(te[300]), n9 = nmt * 4, F8 = moe_split ? (nmt * 8) / F.G : (1 << 20), T = moe_split ? nmt * 8 - F8 * F.G : 0, v = F.vcu;
        if (v < T) {
            SchedMoE<true> S{(const char*)(F.ws + WS_H2), (const char*)(F.ws + WS_WGU_T), te, WSP(int, WS_ETOK), nmt, 8, F.G, v, (size_t)2048 * 1024, F8, F8 + 1};
            EpiGU E{F.ka->in[22], te, WSP(unsigned char, WS_ACT), WSP(float, WS_ERSTD)};
            pg8::gemm_phase<true>(F.lds, 512, S, E);
            if (F.tid == 0) { __builtin_amdgcn_fence(__ATOMIC_RELEASE, "agent"); asm volatile("s_waitcnt vmcnt(0)" ::: "memory");
                __hip_atomic_fetch_add(done8 + ((F8 * F.G + v) >> 3), 1u, __ATOMIC_RELAXED, __HIP_MEMORY_SCOPE_AGENT); }
        }
        const int vb = v - T + (v < T ? F.G : 0), pmT = moe_split ? (F8 * F.G) / 8 : (1 << 20), lim = n9 < 4 * pmT ? n9 : 4 * pmT;
        const int nseg1 = vb < lim ? (lim - 1 - vb) / F.G + 1 : 0;
        EpiDn E{F.ka->in[24], te, WSP(bf16, WS_AMOE)};
        { SchedMoE<false> S{(const char*)(F.ws + WS_ACT), (const char*)(F.ws + WS_WD_T), te, nullptr, nmt, 4, F.G, vb, (size_t)1024 * 1024, 0, nseg1};
          pg8::gemm_phase<true>(F.lds, 512, S, E); }
        if (nseg1 * F.G + vb < n9) {
            for (int L = nseg1 * F.G + vb; L < n9; L += F.G) q_wait(done8 + (L >> 2), 8u, F.tid);
            SchedMoE<false> S{(const char*)(F.ws + WS_ACT), (const char*)(F.ws + WS_WD_T), te, nullptr, nmt, 4, F.G, vb, (size_t)1024 * 1024, nseg1, 1 << 20};
            pg8::gemm_phase<true>(F.lds, 512, S, E);
        }
    }
    SEAM(9);
    if (IN(10)) { if ((REP_MASK >> 10) & 1) p10_phase(F, PH_MAX >= 9, WSP(float, WS_GATES)); p10_phase(F, PH_MAX >= 9, F.out); }
#undef IN
#undef SEAM
}

extern "C" void kernel_launch(void* const* d_in, const int* in_sizes, int n_in, void* d_out, int out_size, void* d_ws, size_t ws_size, hipStream_t stream) {
    static int grid = 0;
    if (grid == 0) {
        if (n_in != 26 || out_size != NTOK * DM || ws_size < WS_END) { fprintf(stderr, "kernel_launch: unexpected sizes n_in %d out %d ws %zu (need %zu)\n", n_in, out_size, ws_size, (size_t)WS_END); grid = -1; return; }
        int dev = 0, cus = 0, per_cu = 0;
        hipGetDevice(&dev); hipDeviceGetAttribute(&cus, hipDeviceAttributeMultiprocessorCount, dev);
        if (hipFuncSetAttribute((const void*)fwd_megakernel, hipFuncAttributeMaxDynamicSharedMemorySize, LDS_BYTES) != hipSuccess) { fprintf(stderr, "kernel_launch: hipFuncSetAttribute failed\n"); grid = -1; return; }
        if (hipOccupancyMaxActiveBlocksPerMultiprocessor(&per_cu, (const void*)fwd_megakernel, NTHREADS, LDS_BYTES) != hipSuccess || per_cu < 1) { fprintf(stderr, "kernel_launch: occupancy query says %d\n", per_cu); per_cu = 1; }
        (void)hipGetLastError();
        grid = cus * 1;
        if (grid > 256) grid = 256;
    }
    if (grid < 0) return;
    (void)hipMemsetAsync((char*)d_ws + WS_CTL, 0, CTL_BYTES, stream);
    Args a{};
    for (int i = 0; i < 26; ++i) a.in[i] = (const float*)d_in[i];
    a.out = (float*)d_out; a.ws = (unsigned char*)d_ws;
#if defined(MULTI_LAUNCH)
    for (int p = 0; p <= 10; ++p) { if (p > PH_MAX && p != 10) continue; a.ph_lo = p; a.ph_hi = p + 1; hipLaunchKernelGGL(fwd_megakernel, dim3(grid), dim3(NTHREADS), LDS_BYTES, stream, a); }
#else
    a.ph_lo = 0; a.ph_hi = 11;
    hipLaunchKernelGGL(fwd_megakernel, dim3(grid), dim3(NTHREADS), LDS_BYTES, stream, a);
#endif
}
```

```cpp
#include <hip/hip_runtime.h>
#include <hip/hip_cooperative_groups.h>
#include <cstdio>
#include <cstdint>
#include <cmath>
namespace cg = cooperative_groups;

#define LAS __attribute__((address_space(3)))
typedef unsigned short bf16;
typedef short bf16x8 __attribute__((ext_vector_type(8)));
typedef short s16x4 __attribute__((ext_vector_type(4)));
typedef float f32x4 __attribute__((ext_vector_type(4)));
typedef float f32x2 __attribute__((ext_vector_type(2)));
typedef float f32x16 __attribute__((ext_vector_type(16)));
typedef unsigned u32x4 __attribute__((ext_vector_type(4)));
typedef unsigned u32x2 __attribute__((ext_vector_type(2)));
typedef __bf16 bf16x2_t __attribute__((ext_vector_type(2)));

constexpr int NB = 4, SEQ = 4096, DM = 1024, NTOK = NB * SEQ;
constexpr int DIN = 6432, NIN = 6656;
constexpr int MEMLEN = 256, NMEMROW = NB * MEMLEN;
constexpr int NEXP = 32, TOPK = 4, FEXP = 1024;
constexpr int MAXSLOT = NTOK * TOPK + NEXP * 256;
constexpr float RMS_EPS = 1e-5f;
constexpr float LOG2E = 1.4426950408889634f;
constexpr float C2_64 = 0.125f * LOG2E;
constexpr float C2_128 = 0.08838834764831845f * LOG2E;
constexpr float NEGBIG = -1e30f;
constexpr float W8_SCALE = 32.0f, ACT8_SCALE = 4.0f;

constexpr size_t MiB = 1u << 20;
constexpr size_t WS_CTL = 0;
constexpr size_t CTL_BYTES = 64 * 1024;
constexpr size_t WS_ROPE_C = 1 * MiB, WS_ROPE_S = WS_ROPE_C + 512 * 1024;
constexpr size_t WS_W1T_K = 2 * MiB, WS_W1T_V = WS_W1T_K + 256 * 1024;
constexpr size_t WS_W2T_K = WS_W1T_V + 256 * 1024, WS_W2T_V = WS_W2T_K + 8192;
constexpr size_t WS_CPE = WS_W2T_V + 8192;
constexpr size_t WS_KCMP = 3 * MiB;
constexpr size_t WS_VCMP = WS_KCMP + 256 * 1024;
constexpr size_t WS_CUM = 4 * MiB;
constexpr size_t WS_KMAX = 4 * MiB + 512 * 1024;
constexpr size_t WS_KMEM = 5 * MiB, WS_VMEM = 6 * MiB;
constexpr size_t WS_ORDER = 7 * MiB;
constexpr size_t WS_BLKCNT = 7 * MiB + 64 * 1024;
constexpr size_t WS_TILE_E = 7 * MiB + 128 * 1024;
constexpr size_t WS_WRT = 7 * MiB + 256 * 1024;
constexpr size_t WS_RSTD = 7 * MiB + 512 * 1024;
constexpr size_t WS_RSLOT = 8 * MiB;
constexpr size_t WS_SLOTTOK = 8 * MiB + 512 * 1024;
constexpr size_t WS_WIN_T = 9 * MiB;
constexpr size_t WS_WBR_T = 24 * MiB;
constexpr size_t WS_WOUT_T = 27 * MiB;
constexpr size_t WS_WGU_T = 32 * MiB;
constexpr size_t WS_WD_T = 160 * MiB;
constexpr size_t WS_HA = 224 * MiB;
constexpr size_t WS_ETOK = 224 * MiB, WS_ERSTD = 226 * MiB;
constexpr int MT_OFF = 131072;
constexpr size_t WS_QA = 258 * MiB;
constexpr size_t WS_KV6 = 274 * MiB;
constexpr size_t WS_QM = 298 * MiB;
constexpr size_t WS_LG = 314 * MiB;
constexpr size_t WS_GATES = 316 * MiB;
constexpr size_t WS_QF = 412 * MiB, WS_KF = 428 * MiB, WS_VF = 444 * MiB;
constexpr size_t WS_ACT = 316 * MiB;
constexpr size_t WS_OBR = 460 * MiB;
constexpr size_t WS_MERGED = 508 * MiB;
constexpr size_t WS_H2 = 540 * MiB;
constexpr size_t WS_ROUTE = 572 * MiB;
constexpr size_t WS_AMOE = 576 * MiB;
constexpr size_t WS_END = 720 * MiB;
static_assert(WS_ACT + (size_t)MAXSLOT * 1024 * 2 <= WS_OBR && WS_AMOE + (size_t)MAXSLOT * 1024 * 2 <= WS_END, "ws map");
constexpr int CW_QATTN = 64;
constexpr int CW_DONE8 = 12288;
constexpr int CW_GCNT = 9216;
constexpr int CW_XBAR = 1024;

constexpr int LDS_BYTES = 155648;
constexpr int NWAVES = 8, NTHREADS = 512;

__device__ __forceinline__ unsigned cvtpk(float lo, float hi) { f32x2 v = {lo, hi}; bf16x2_t b = __builtin_convertvector(v, bf16x2_t); return __builtin_bit_cast(unsigned, b); }
__device__ __forceinline__ float bf2f(unsigned short h) { return __builtin_bit_cast(float, (unsigned)h << 16); }
__device__ __forceinline__ float bflo(unsigned u) { return __builtin_bit_cast(float, u << 16); }
__device__ __forceinline__ float bfhi(unsigned u) { return __builtin_bit_cast(float, u & 0xffff0000u); }
__device__ __forceinline__ float wave_sum(float v) {
#pragma unroll
    for (int o = 1; o < 64; o <<= 1) v += __shfl_xor(v, o);
    return v;
}
__device__ __forceinline__ float fast_sigmoid(float x) { return __builtin_amdgcn_rcpf(1.0f + __builtin_amdgcn_exp2f(-LOG2E * x)); }
__device__ __forceinline__ unsigned pk_fp8x4(float a, float b, float c, float d) {
    a = fminf(fmaxf(a, -448.f), 448.f); b = fminf(fmaxf(b, -448.f), 448.f); c = fminf(fmaxf(c, -448.f), 448.f); d = fminf(fmaxf(d, -448.f), 448.f);
    int p = __builtin_amdgcn_cvt_pk_fp8_f32(a, b, 0, false); p = __builtin_amdgcn_cvt_pk_fp8_f32(c, d, p, true); return (unsigned)p;
}
namespace pg8 {
#define PG8_LAS __attribute__((address_space(3)))
typedef unsigned short bf16_t;
typedef short bf16x8 __attribute__((ext_vector_type(8)));
typedef float f32x4 __attribute__((ext_vector_type(4)));
typedef unsigned u32x4 __attribute__((ext_vector_type(4)));
typedef unsigned u32x2 __attribute__((ext_vector_type(2)));
typedef int i32x8 __attribute__((ext_vector_type(8)));
typedef int i32x4 __attribute__((ext_vector_type(4)));
constexpr int BM = 256, BK = 64, HALF = 128, HTB = HALF * BK * 2  , STAGE_BYTES = 8 * HTB;

__host__ __device__ __forceinline__ int lds_byte(int r, int c) { const int st = (r >> 4) * 2 + (c >> 5), rr = r & 15, cc = c & 31, ob = rr * 64 + cc * 2; return st * 1024 + (ob ^ (((ob >> 9) & 1) << 5)); }
__host__ __device__ __forceinline__ void stage_rc(int b, int& R, int& C) { const int st = b / 1024, sb = b % 1024, swz = sb ^ (((sb >> 9) & 1) << 5); R = (st >> 1) * 16 + swz / 64; C = (st & 1) * 32 + (swz % 64) / 2; }
__host__ __device__ __forceinline__ int perm32(int rho) { const int n = rho >> 4, i = rho & 15; return 8 * (i >> 2) + 4 * n + (i & 3); }

struct Unit { int pm, pn; };

template <bool F8, class Epi, class Sched>
__device__ __forceinline__ void gemm_phase(PG8_LAS unsigned char* lds, const int K, const Sched& S, const Epi& E) {
    const int tid = threadIdx.x, wid = __builtin_amdgcn_readfirstlane(tid >> 6), lane = tid & 63, wr = wid >> 2, wc = wid & 3, fr = lane & 15, fq = lane >> 4;
    const int nt = K / BK;
    unsigned voffB[2]; int RA[2], CA[2];
    { int R, C; stage_rc(tid * 16, R, C); const int Rb = (R & ~31) + perm32(R & 31);
      RA[0] = R; CA[0] = C; RA[1] = R + 64; CA[1] = C; voffB[0] = (unsigned)(Rb * K + C) * 2u; voffB[1] = voffB[0] + (unsigned)(64 * K * 2); }
    constexpr bool GATHER = Sched::GATHER;
    unsigned cofA[2][2], nofA[2][2];
#define PG8_AOFF(dst, u) do { _Pragma("unroll") for (int h_ = 0; h_ < 2; ++h_) _Pragma("unroll") for (int i_ = 0; i_ < 2; ++i_) dst[h_][i_] = S.a_voff(u, h_, RA[i_], CA[i_], K); } while (0)
    const size_t kstep = (size_t)(BK * 2);
    const size_t hstep = (size_t)HALF * K * 2;
    const unsigned ldsw = (unsigned)wid * 1024u;
    const int aoff = lds_byte(wr * 64 + fr, fq * 8), boff = lds_byte(wc * 32 + fr, fq * 8);
    const int aoff8 = lds_byte(wr * 64 + fr, fq * 16), boff8 = lds_byte(wc * 32 + fr, fq * 16);
#define PG8_SA(b, h) (((b) * 2 + (h)) * HTB)
#define PG8_SB(b, h) ((4 + (b) * 2 + (h)) * HTB)
#define PG8_STAGE(bufoff, gbase, voff) do { _Pragma("unroll") for (int _i = 0; _i < 2; ++_i) \
        __builtin_amdgcn_global_load_lds((const unsigned*)((const char*)(gbase) + (voff)[_i]), (PG8_LAS unsigned*)(lds + (bufoff) + ldsw + _i * 8192), 16, 0, 0); } while (0)
#define PG8_LDA(dst, b, h) do { _Pragma("unroll") for (int m = 0; m < 4; ++m) _Pragma("unroll") for (int k = 0; k < 2; ++k) dst[m][k] = *(const PG8_LAS bf16x8*)(lds + PG8_SA(b, h) + aoff + m * 2048 + k * 1024); } while (0)
#define PG8_LDB(dst, b, h) do { _Pragma("unroll") for (int n = 0; n < 2; ++n) _Pragma("unroll") for (int k = 0; k < 2; ++k) dst[n][k] = *(const PG8_LAS bf16x8*)(lds + PG8_SB(b, h) + boff + n * 2048 + k * 1024); } while (0)
#define PG8_MMA(ai, bj, At, Bt) do { __builtin_amdgcn_s_setprio(1); _Pragma("unroll") for (int m = 0; m < 4; ++m) _Pragma("unroll") for (int n = 0; n < 2; ++n) _Pragma("unroll") for (int k = 0; k < 2; ++k) \
        acc[ai][bj][m][n] = __builtin_amdgcn_mfma_f32_16x16x32_bf16(Bt[n][k], At[m][k], acc[ai][bj][m][n], 0, 0, 0); __builtin_amdgcn_s_setprio(0); } while (0)
#define PG8_LD8(dst, base, o0, cnt) do { _Pragma("unroll") for (int q_ = 0; q_ < cnt; ++q_) { const i32x4 lo_ = *(const PG8_LAS i32x4*)(lds + (base) + (o0) + q_ * 2048), hi_ = *(const PG8_LAS i32x4*)(lds + (base) + (o0) + q_ * 2048 + 16); \
        dst[q_] = (i32x8){lo_[0], lo_[1], lo_[2], lo_[3], hi_[0], hi_[1], hi_[2], hi_[3]}; } } while (0)
#define PG8_MMA8(ai, bj, At, Bt) do { __builtin_amdgcn_s_setprio(1); _Pragma("unroll") for (int m = 0; m < 4; ++m) _Pragma("unroll") for (int n = 0; n < 2; ++n) \
        asm volatile("v_mfma_scale_f32_16x16x128_f8f6f4 %0, %1, %2, %0, %3, %3 op_sel_hi:[0,0,0]" : "+v"(acc[ai][bj][m][n]) : "v"(Bt[n]), "v"(At[m]), "v"(sc8)); asm volatile("s_nop 7" ::: "memory"); __builtin_amdgcn_s_setprio(0); } while (0)
#define PG8_WAIT_V(n) asm volatile("s_waitcnt vmcnt(" #n ")" ::: "memory")
#define PG8_WAIT_L(n) asm volatile("s_waitcnt lgkmcnt(" #n ")" ::: "memory")
#define PG8_BAR __builtin_amdgcn_s_barrier()
#define PG8_SCHED __builtin_amdgcn_sched_barrier(0)
    Unit cur, nxt; int ui = 0;
    if (!S.next(0, cur)) return;
    f32x4 acc[2][2][4][2];
#pragma unroll
    for (int a = 0; a < 2; ++a)
#pragma unroll
        for (int b = 0; b < 2; ++b)
#pragma unroll
            for (int m = 0; m < 4; ++m)
#pragma unroll
                for (int n = 0; n < 2; ++n) acc[a][b][m][n] = (f32x4){0.f, 0.f, 0.f, 0.f};
    bf16x8 At[4][2], B0[2][2], B1[2][2]; i32x8 At8[4], B08[2], B18[2]; int sc8 = 0x7f7f7f7f; asm volatile("" : "+v"(sc8));
    const char* cA = S.a_base(cur); const char* cB = S.b_base(cur);
    PG8_AOFF(cofA, cur);
    PG8_STAGE(PG8_SB(0, 0), cB, voffB); PG8_STAGE(PG8_SB(0, 1), cB + hstep, voffB); PG8_STAGE(PG8_SA(0, 0), cA, cofA[0]); PG8_STAGE(PG8_SA(0, 1), cA, cofA[1]);
    if (wr == 1) PG8_BAR;
    PG8_WAIT_V(2); PG8_BAR;
    PG8_STAGE(PG8_SB(1, 0), cB + kstep, voffB); PG8_STAGE(PG8_SA(1, 0), cA + kstep, cofA[0]); PG8_STAGE(PG8_SB(1, 1), cB + hstep + kstep, voffB);
    PG8_WAIT_V(6); PG8_BAR;
    for (;;) {
        const bool has_next = S.next(ui + 1, nxt);
        const char* nA = has_next ? S.a_base(nxt) : cA; const char* nB = has_next ? S.b_base(nxt) : cB;
        if constexpr (GATHER) { if (has_next) PG8_AOFF(nofA, nxt); else { _Pragma("unroll") for (int h_ = 0; h_ < 2; ++h_) _Pragma("unroll") for (int i_ = 0; i_ < 2; ++i_) nofA[h_][i_] = cofA[h_][i_]; } }
#pragma clang loop unroll(disable)
        for (int t = 0; t < nt; t += 2) {
            const bool last = (t == nt - 2);
            const char* a1 = cA + (size_t)(t + 1) * kstep;
            const char* a2 = last ? nA : cA + (size_t)(t + 2) * kstep; const char* b2 = last ? nB : cB + (size_t)(t + 2) * kstep;
            const char* a3 = a2 + kstep; const char* b3 = b2 + kstep;
            unsigned sofA[2][2];
            _Pragma("unroll") for (int h_ = 0; h_ < 2; ++h_) _Pragma("unroll") for (int i_ = 0; i_ < 2; ++i_) sofA[h_][i_] = (GATHER && last) ? nofA[h_][i_] : cofA[h_][i_];
            if constexpr (!F8) {
            PG8_LDB(B0, 0, 0); PG8_LDB(B1, 0, 1); PG8_SCHED; PG8_LDA(At, 0, 0); PG8_STAGE(PG8_SA(1, 1), a1, cofA[1]);
            PG8_WAIT_V(8); PG8_WAIT_L(0); PG8_BAR; PG8_MMA(0, 0, At, B0); PG8_MMA(0, 1, At, B1); PG8_BAR; PG8_SCHED;
            PG8_LDA(At, 0, 1); PG8_STAGE(PG8_SB(0, 0), b2, voffB); PG8_STAGE(PG8_SB(0, 1), b2 + hstep, voffB); PG8_STAGE(PG8_SA(0, 0), a2, sofA[0]);
            PG8_WAIT_V(8); PG8_WAIT_L(0); PG8_BAR; PG8_MMA(1, 0, At, B0); PG8_MMA(1, 1, At, B1); PG8_BAR; PG8_SCHED;
            PG8_LDB(B0, 1, 0); PG8_LDB(B1, 1, 1); PG8_SCHED; PG8_LDA(At, 1, 0); PG8_STAGE(PG8_SA(0, 1), a2, sofA[1]);
            PG8_WAIT_V(8); PG8_WAIT_L(0); PG8_BAR; PG8_MMA(0, 0, At, B0); PG8_MMA(0, 1, At, B1); PG8_BAR; PG8_SCHED;
            PG8_LDA(At, 1, 1); PG8_STAGE(PG8_SB(1, 0), b3, voffB); PG8_STAGE(PG8_SB(1, 1), b3 + hstep, voffB); PG8_STAGE(PG8_SA(1, 0), a3, sofA[0]);
            PG8_WAIT_V(8); PG8_WAIT_L(0); PG8_BAR; PG8_MMA(1, 0, At, B0); PG8_MMA(1, 1, At, B1); PG8_BAR; PG8_SCHED;
            } else {
            PG8_LD8(B08, PG8_SB(0, 0), boff8, 2); PG8_LD8(B18, PG8_SB(0, 1), boff8, 2); PG8_SCHED; PG8_LD8(At8, PG8_SA(0, 0), aoff8, 4); PG8_STAGE(PG8_SA(1, 1), a1, cofA[1]);
            PG8_WAIT_V(8); PG8_WAIT_L(0); PG8_BAR; PG8_MMA8(0, 0, At8, B08); PG8_MMA8(0, 1, At8, B18); PG8_BAR; PG8_SCHED;
            PG8_LD8(At8, PG8_SA(0, 1), aoff8, 4); PG8_STAGE(PG8_SB(0, 0), b2, voffB); PG8_STAGE(PG8_SB(0, 1), b2 + hstep, voffB); PG8_STAGE(PG8_SA(0, 0), a2, sofA[0]);
            PG8_WAIT_V(8); PG8_WAIT_L(0); PG8_BAR; PG8_MMA8(1, 0, At8, B08); PG8_MMA8(1, 1, At8, B18); PG8_BAR; PG8_SCHED;
            PG8_LD8(B08, PG8_SB(1, 0), boff8, 2); PG8_LD8(B18, PG8_SB(1, 1), boff8, 2); PG8_SCHED; PG8_LD8(At8, PG8_SA(1, 0), aoff8, 4); PG8_STAGE(PG8_SA(0, 1), a2, sofA[1]);
            PG8_WAIT_V(8); PG8_WAIT_L(0); PG8_BAR; PG8_MMA8(0, 0, At8, B08); PG8_MMA8(0, 1, At8, B18); PG8_BAR; PG8_SCHED;
            PG8_LD8(At8, PG8_SA(1, 1), aoff8, 4); PG8_STAGE(PG8_SB(1, 0), b3, voffB); PG8_STAGE(PG8_SB(1, 1), b3 + hstep, voffB); PG8_STAGE(PG8_SA(1, 0), a3, sofA[0]);
            PG8_WAIT_V(8); PG8_WAIT_L(0); PG8_BAR; PG8_MMA8(1, 0, At8, B08); PG8_MMA8(1, 1, At8, B18); PG8_BAR; PG8_SCHED;
            }
        }
        if constexpr (F8) asm volatile("s_nop 15\n\ts_nop 15" ::: "memory");
        if (wr == 0) PG8_BAR;
        E(acc, cur, wr, wc, fr, fq);
        if (!has_next) break;
        cur = nxt; cA = nA; cB = nB; ++ui;
        if constexpr (GATHER) { _Pragma("unroll") for (int h_ = 0; h_ < 2; ++h_) _Pragma("unroll") for (int i_ = 0; i_ < 2; ++i_) cofA[h_][i_] = nofA[h_][i_]; }
        if (wr == 1) PG8_BAR;
    }
    PG8_WAIT_V(0);
    PG8_BAR;
#undef PG8_AOFF
#undef PG8_SA
#undef PG8_SB
#undef PG8_STAGE
#undef PG8_LDA
#undef PG8_LDB
#undef PG8_MMA
#undef PG8_MMA8
#undef PG8_LD8
#undef PG8_WAIT_V
#undef PG8_WAIT_L
#undef PG8_BAR
#undef PG8_SCHED
}
}
typedef float acc_t[2][2][4][2] __attribute__((unused));
#define ACC_ARG pg8::f32x4 (&acc)[2][2][4][2]
#define ZERO_ACC() do { _Pragma("unroll") for (int a_ = 0; a_ < 2; ++a_) _Pragma("unroll") for (int b_ = 0; b_ < 2; ++b_) _Pragma("unroll") for (int m_ = 0; m_ < 4; ++m_) _Pragma("unroll") for (int n_ = 0; n_ < 2; ++n_) acc[a_][b_][m_][n_] = (pg8::f32x4){0.f, 0.f, 0.f, 0.f}; } while (0)

__device__ __forceinline__ bool static_unit(int L, int nM, int nN, pg8::Unit& u) {
    const int nwg = nM * nN; if (L >= nwg) return false;
    int wgid = L; { const int q = nwg / 8, r = nwg % 8, xcd = wgid % 8, off = wgid / 8; wgid = (xcd < r ? xcd * (q + 1) : r * (q + 1) + (xcd - r) * q) + off; }
    const int nig = 8 * nN, gid = wgid / nig, fm = gid * 8, gsz = (nM - fm) < 8 ? (nM - fm) : 8;
    u.pm = fm + ((wgid % nig) % gsz); u.pn = (wgid % nig) / gsz; return true;
}

struct SchedIn {
    static constexpr bool GATHER = false;
    const char* A; const char* Bt; int G, c;
    __device__ __forceinline__ bool next(int i, pg8::Unit& u) const {
        const int L = i * G + c;
        if (L < 1664) return static_unit(L, 64, 26, u);
        if (L < 1680) { const int j = L - 1664; u.pm = 64 + (j >> 2); u.pn = 26 + (j & 3); return true; }
        return false;
    }
    __device__ __forceinline__ const char* a_base(const pg8::Unit& u) const { return A + (size_t)u.pm * (256 * 1024 * 2); }
    __device__ __forceinline__ const char* b_base(const pg8::Unit& u) const { return Bt + (size_t)u.pn * (256 * 1024 * 2); }
    __device__ __forceinline__ unsigned a_voff(const pg8::Unit&, int h, int R, int C, int K) const { return (unsigned)(((h * 128 + R) * K + C) * 2); }
};
struct SchedBr {
    static constexpr bool GATHER = false;
    const char* A; const char* Bt; int G, c;
    __device__ __forceinline__ bool next(int i, pg8::Unit& u) const {
        const int rnd = i / 3, br = i - rnd * 3; pg8::Unit t;
        if (!static_unit(rnd * G + c, 64, 4, t)) return false;
        u.pm = 64 * br + t.pm; u.pn = 4 * br + t.pn; return true;
    }
    __device__ __forceinline__ const char* a_base(const pg8::Unit& u) const { return A + (size_t)u.pm * (256 * 512 * 2); }
    __device__ __forceinline__ const char* b_base(const pg8::Unit& u) const { return Bt + (size_t)u.pn * (256 * 512 * 2); }
    __device__ __forceinline__ unsigned a_voff(const pg8::Unit&, int h, int R, int C, int K) const { return (unsigned)(((h * 128 + R) * K + C) * 2); }
};
struct SchedOut {
    static constexpr bool GATHER = false;
    const char* A; const char* Bt; int G, c;
    __device__ __forceinline__ bool next(int i, pg8::Unit& u) const { return static_unit(i * G + c, 64, 4, u); }
    __device__ __forceinline__ const char* a_base(const pg8::Unit& u) const { return A + (size_t)u.pm * (256 * 1024 * 2); }
    __device__ __forceinline__ const char* b_base(const pg8::Unit& u) const { return Bt + (size_t)u.pn * (256 * 1024 * 2); }
    __device__ __forceinline__ unsigned a_voff(const pg8::Unit&, int h, int R, int C, int K) const { return (unsigned)(((h * 128 + R) * K + C) * 2); }
};
template <bool G_> struct SchedMoE {
    static constexpr bool GATHER = G_;
    const char* A; const char* Bt; const LAS int* tile_e; const int* etok; int nmt, nN, G, v; size_t estride; int i0, i1;
    __device__ __forceinline__ bool next(int i, pg8::Unit& u) const {
        if (i + i0 >= i1) return false;
        const int L = (i + i0) * G + v; if (L < 0 || L >= nmt * nN) return false;
        u.pm = L / nN; u.pn = L - u.pm * nN; return true;
    }
    __device__ __forceinline__ const char* a_base(const pg8::Unit& u) const { return G_ ? A : A + (size_t)u.pm * (256 * 1024); }
    __device__ __forceinline__ const char* b_base(const pg8::Unit& u) const { return Bt + (size_t)(__builtin_amdgcn_readfirstlane(tile_e[u.pm]) & 31) * estride + (size_t)u.pn * (256 * 1024); }
    __device__ __forceinline__ unsigned a_voff(const pg8::Unit& u, int h, int R, int C, int K) const {
        if (!G_) return (unsigned)(((h * 128 + R) * K + C) * 2);
        const int te_ = __builtin_amdgcn_readfirstlane(tile_e[u.pm]);
        unsigned t = (unsigned)etok[(te_ & 31) * NTOK + (te_ >> 5) * 256 + h * 128 + R]; t = t < (unsigned)NTOK ? t : 0u;
        return (t * (unsigned)K + (unsigned)C) * 2u;
    }
};


struct EpiIn {
    bf16 *QA, *KV6, *QF, *KF, *VF, *QM, *GATES, *KMEM, *VMEM; float* LG;
    const float *ropeC, *ropeS, *b_merge;
    __device__ __forceinline__ void operator()(ACC_ARG, const pg8::Unit& u, int wr, int wc, int fr, int fq) const {
        const int pn = u.pn, rowb = u.pm * 256 + wr * 64 + fr;
        if (pn < 13) {
#pragma unroll
            for (int bj = 0; bj < 2; ++bj) {
                const int L0 = (4 * pn + 2 * bj + (wc >> 1)) * 64, a4 = 4 * (4 * (wc & 1) + fq);
                bf16* dst; int pitch, col0; bool rope = false; float sc = 1.f;
                if (L0 < 512) { dst = QA; pitch = 512; col0 = L0; rope = true; sc = C2_64; }
                else if (L0 < 1280) { const int kk = (L0 - 512) >> 7; dst = KV6 + (size_t)kk * NTOK * 128; pitch = 128; col0 = (L0 - 512) & 127; rope = !(kk & 1); }
                else if (L0 < 1792) { dst = QF; pitch = 512; col0 = L0 - 1280; sc = C2_64; }
                else if (L0 < 2304) { dst = KF; pitch = 512; col0 = L0 - 1792; }
                else if (L0 < 2816) { dst = VF; pitch = 512; col0 = L0 - 2304; }
                else { dst = QM; pitch = 512; col0 = L0 - 2816; sc = C2_128; }
                pg8::f32x4 cv[2][4], sv[2][4];
                if (rope) {
#pragma unroll
                    for (int ai = 0; ai < 2; ++ai)
#pragma unroll
                        for (int m = 0; m < 4; ++m) { const int t = (rowb + 128 * ai + 16 * m) & (SEQ - 1); cv[ai][m] = *(const pg8::f32x4*)(ropeC + t * 32 + a4); sv[ai][m] = *(const pg8::f32x4*)(ropeS + t * 32 + a4); }
                }
                __builtin_amdgcn_sched_barrier(0);
#pragma unroll
                for (int ai = 0; ai < 2; ++ai)
#pragma unroll
                    for (int m = 0; m < 4; ++m) {
                        const int r = rowb + 128 * ai + 16 * m;
                        pg8::f32x4 x1 = acc[ai][bj][m][0], x2 = acc[ai][bj][m][1];
                        if (rope) { const pg8::f32x4 c4 = cv[ai][m], s4 = sv[ai][m];
                            const pg8::f32x4 y1 = x1 * c4 - x2 * s4, y2 = x2 * c4 + x1 * s4; x1 = y1; x2 = y2; }
                        x1 = x1 * sc; x2 = x2 * sc;
                        bf16* p = dst + (size_t)r * pitch + col0 + a4;
                        *(u32x2*)p = (u32x2){cvtpk(x1[0], x1[1]), cvtpk(x1[2], x1[3])};
                        *(u32x2*)(p + 32) = (u32x2){cvtpk(x2[0], x2[1]), cvtpk(x2[2], x2[3])};
                    }
            }
        } else if (pn < 25) {
            pg8::f32x4 bv[2][2];
#pragma unroll
            for (int bj = 0; bj < 2; ++bj) { const int cg = 256 * (pn - 13) + 128 * bj + 32 * wc + 8 * fq; bv[bj][0] = *(const pg8::f32x4*)(b_merge + cg); bv[bj][1] = *(const pg8::f32x4*)(b_merge + cg + 4); }
            __builtin_amdgcn_sched_barrier(0);
#pragma unroll
            for (int bj = 0; bj < 2; ++bj) {
                const int cg = 256 * (pn - 13) + 128 * bj + 32 * wc + 8 * fq;
                const pg8::f32x4 b0 = bv[bj][0], b1 = bv[bj][1];
#pragma unroll
                for (int ai = 0; ai < 2; ++ai)
#pragma unroll
                    for (int m = 0; m < 4; ++m) {
                        const int r = rowb + 128 * ai + 16 * m;
                        const pg8::f32x4 v0 = acc[ai][bj][m][0] + b0, v1 = acc[ai][bj][m][1] + b1;
                        u32x2 w; unsigned p = 0u;
#pragma unroll
                        for (int k = 0; k < 4; ++k) p = __builtin_amdgcn_cvt_pk_u8_f32(fmaxf(255.f * fast_sigmoid(v0[k]), 1.f), k, p);
                        w.x = p; p = 0u;
#pragma unroll
                        for (int k = 0; k < 4; ++k) p = __builtin_amdgcn_cvt_pk_u8_f32(fmaxf(255.f * fast_sigmoid(v1[k]), 1.f), k, p);
                        w.y = p;
                        *(u32x2*)((unsigned char*)GATES + (size_t)r * 3072 + cg) = w;
                    }
            }
        } else if (pn == 25) {
            if (wc == 0) {
#pragma unroll
                for (int ai = 0; ai < 2; ++ai)
#pragma unroll
                    for (int m = 0; m < 4; ++m) {
                        const int r = rowb + 128 * ai + 16 * m;
                        float* p = LG + (size_t)r * 32 + 8 * fq;
                        *(pg8::f32x4*)p = acc[ai][0][m][0]; *(pg8::f32x4*)(p + 4) = acc[ai][0][m][1];
                    }
            }
        } else {
#pragma unroll
            for (int bj = 0; bj < 2; ++bj) {
                const int cgl = 256 * (pn - 26) + 128 * bj + 32 * wc + 8 * fq;
                bf16* dst = (cgl < 512) ? KMEM : VMEM; const int col = cgl & 511;
#pragma unroll
                for (int ai = 0; ai < 2; ++ai)
#pragma unroll
                    for (int m = 0; m < 4; ++m) {
                        const int r = rowb + 128 * ai + 16 * m - NTOK;
                        const pg8::f32x4 v0 = acc[ai][bj][m][0], v1 = acc[ai][bj][m][1];
                        u32x4 w; w.x = cvtpk(v0[0], v0[1]); w.y = cvtpk(v0[2], v0[3]); w.z = cvtpk(v1[0], v1[1]); w.w = cvtpk(v1[2], v1[3]);
                        *(u32x4*)(dst + (size_t)r * 512 + col) = w;
                    }
            }
        }
        ZERO_ACC();
    }
};

struct EpiBr {
    const bf16* GATES; bf16* MERGED;
    __device__ __forceinline__ void operator()(ACC_ARG, const pg8::Unit& u, int wr, int wc, int fr, int fq) const {
        const int br = u.pn >> 2, tn = u.pn & 3, tm = u.pm & 63, rowb = tm * 256 + wr * 64 + fr;
        const unsigned char* gp = (const unsigned char*)GATES + (size_t)rowb * 3072 + 1024 * br + 256 * tn + 32 * wc + 8 * fq;
        u32x2 GA[2][4][2], GB[2][4][2];
#pragma unroll
        for (int ai = 0; ai < 2; ++ai)
#pragma unroll
            for (int m = 0; m < 4; ++m)
#pragma unroll
                for (int bj = 0; bj < 2; ++bj) { const unsigned char* p = gp + (size_t)(128 * ai + 16 * m) * 3072 + 128 * bj;
                    GA[ai][m][bj] = *(const u32x2*)p; GB[ai][m][bj] = (br < 2) ? *(const u32x2*)(p + 1024) : (u32x2){0u, 0u}; }
        __builtin_amdgcn_sched_barrier(0);
#pragma unroll
        for (int ai = 0; ai < 2; ++ai)
#pragma unroll
            for (int m = 0; m < 4; ++m) {
                const int r = rowb + 128 * ai + 16 * m;
#pragma unroll
                for (int bj = 0; bj < 2; ++bj) {
                    const int c0 = 256 * tn + 128 * bj + 32 * wc + 8 * fq;
                    const u32x2 ga = GA[ai][m][bj];
                    pg8::f32x4 g0 = {(float)(ga.x & 255u), (float)((ga.x >> 8) & 255u), (float)((ga.x >> 16) & 255u), (float)(ga.x >> 24)}, g1 = {(float)(ga.y & 255u), (float)((ga.y >> 8) & 255u), (float)((ga.y >> 16) & 255u), (float)(ga.y >> 24)};
#if defined(ABL_BR)
                    if (!((ABL_BR >> br) & 1)) { acc[ai][bj][m][0] = acc[ai][bj][m][0] * 0.f; acc[ai][bj][m][1] = acc[ai][bj][m][1] * 0.f; }
#endif
                    if (br < 2) {
                        const u32x2 gb = GB[ai][m][bj];
                        const pg8::f32x4 h0 = {(float)(gb.x & 255u), (float)((gb.x >> 8) & 255u), (float)((gb.x >> 16) & 255u), (float)(gb.x >> 24)}, h1 = {(float)(gb.y & 255u), (float)((gb.y >> 8) & 255u), (float)((gb.y >> 16) & 255u), (float)(gb.y >> 24)};
#pragma unroll
                        for (int k = 0; k < 4; ++k) { g0[k] = g0[k] * __builtin_amdgcn_rcpf(fmaxf(h0[k], 1.f)); g1[k] = g1[k] * __builtin_amdgcn_rcpf(fmaxf(h1[k], 1.f)); }
                        acc[ai][bj][m][0] = acc[ai][bj][m][0] * g0; acc[ai][bj][m][1] = acc[ai][bj][m][1] * g1;
                    } else {
                        const pg8::f32x4 v0 = acc[ai][bj][m][0] * g0 * (1.f / 255.f), v1 = acc[ai][bj][m][1] * g1 * (1.f / 255.f);
                        u32x4 w; w.x = cvtpk(v0[0], v0[1]); w.y = cvtpk(v0[2], v0[3]); w.z = cvtpk(v1[0], v1[1]); w.w = cvtpk(v1[2], v1[3]);
                        *(u32x4*)(MERGED + (size_t)r * 1024 + c0) = w;
                        acc[ai][bj][m][0] = (pg8::f32x4){0.f, 0.f, 0.f, 0.f}; acc[ai][bj][m][1] = (pg8::f32x4){0.f, 0.f, 0.f, 0.f};
                    }
                }
            }
    }
};

struct EpiOut {
    const float* X; float* X1; unsigned char* XB8;
    __device__ __forceinline__ void operator()(ACC_ARG, const pg8::Unit& u, int wr, int wc, int fr, int fq) const {
        const int rowb = u.pm * 256 + wr * 64 + fr;
        const size_t ob = (size_t)rowb * 1024 + 256 * u.pn + 32 * wc + 8 * fq;
#pragma unroll
        for (int ai = 0; ai < 2; ++ai) {
            pg8::f32x4 xs[4][2][2];
#pragma unroll
            for (int m = 0; m < 4; ++m)
#pragma unroll
                for (int bj = 0; bj < 2; ++bj) { const float* p = X + ob + (size_t)(128 * ai + 16 * m) * 1024 + 128 * bj; xs[m][bj][0] = *(const pg8::f32x4*)p; xs[m][bj][1] = *(const pg8::f32x4*)(p + 4); }
            __builtin_amdgcn_sched_barrier(0);
#pragma unroll
            for (int m = 0; m < 4; ++m)
#pragma unroll
                for (int bj = 0; bj < 2; ++bj) {
                    const size_t o = ob + (size_t)(128 * ai + 16 * m) * 1024 + 128 * bj;
                    const pg8::f32x4 y0 = xs[m][bj][0] + acc[ai][bj][m][0], y1 = xs[m][bj][1] + acc[ai][bj][m][1];
                    *(pg8::f32x4*)(X1 + o) = y0; *(pg8::f32x4*)(X1 + o + 4) = y1;
                    *(u32x2*)(XB8 + o) = (u32x2){pk_fp8x4(y0[0], y0[1], y0[2], y0[3]), pk_fp8x4(y1[0], y1[1], y1[2], y1[3])};
                }
            __builtin_amdgcn_sched_barrier(0);
        }
        ZERO_ACC();
    }
};

__device__ __forceinline__ float swiglu(float g, float uu) {
    g = fminf(g, 7.0f); uu = fminf(fmaxf(uu, -7.0f), 7.0f);
    return (uu + 1.0f) * g * __builtin_amdgcn_rcpf(1.0f + __builtin_amdgcn_exp2f(-1.702f * LOG2E * g));
}
struct EpiGU {
    const float* bias; const LAS int* tile_e; unsigned char* ACT8; const float* erstd;
    __device__ __forceinline__ void operator()(ACC_ARG, const pg8::Unit& u, int wr, int wc, int fr, int fq) const {
        const int te_ = __builtin_amdgcn_readfirstlane(tile_e[u.pm]), e = te_ & 31, rowb = u.pm * 256 + wr * 64 + fr;
        const float* rslot = erstd + (size_t)e * NTOK + (te_ >> 5) * 256 - u.pm * 256;
        float rsv[2][4]; pg8::f32x4 bv[2][2];
#pragma unroll
        for (int ai = 0; ai < 2; ++ai)
#pragma unroll
            for (int m = 0; m < 4; ++m) rsv[ai][m] = rslot[rowb + 128 * ai + 16 * m];
#pragma unroll
        for (int bj = 0; bj < 2; ++bj) { const int c0 = 256 * u.pn + 128 * bj + 32 * wc + 8 * fq; bv[bj][0] = *(const pg8::f32x4*)(bias + (size_t)e * 2048 + c0); bv[bj][1] = *(const pg8::f32x4*)(bias + (size_t)e * 2048 + c0 + 4); }
        __builtin_amdgcn_sched_barrier(0);
#pragma unroll
        for (int bj = 0; bj < 2; ++bj) {
            const int c0 = 256 * u.pn + 128 * bj + 32 * wc + 8 * fq;
            const pg8::f32x4 b0 = bv[bj][0], b1 = bv[bj][1];
#pragma unroll
            for (int ai = 0; ai < 2; ++ai)
#pragma unroll
                for (int m = 0; m < 4; ++m) {
                    const int r = rowb + 128 * ai + 16 * m; const float rs = rsv[ai][m] * (1.0f / W8_SCALE);
                    const pg8::f32x4 v0 = acc[ai][bj][m][0] * rs + b0, v1 = acc[ai][bj][m][1] * rs + b1;
                    *(unsigned*)(ACT8 + (size_t)r * 1024 + (c0 >> 1)) = pk_fp8x4(ACT8_SCALE * swiglu(v0[0], v0[1]), ACT8_SCALE * swiglu(v0[2], v0[3]), ACT8_SCALE * swiglu(v1[0], v1[1]), ACT8_SCALE * swiglu(v1[2], v1[3]));
                }
        }
        ZERO_ACC();
    }
};
struct EpiDn {
    const float* bias; const LAS int* tile_e; bf16* OS;
    __device__ __forceinline__ void operator()(ACC_ARG, const pg8::Unit& u, int wr, int wc, int fr, int fq) const {
        const int e = __builtin_amdgcn_readfirstlane(tile_e[u.pm]) & 31, rowb = u.pm * 256 + wr * 64 + fr;
        pg8::f32x4 bv[2][2];
#pragma unroll
        for (int bj = 0; bj < 2; ++bj) { const int c0 = 256 * u.pn + 128 * bj + 32 * wc + 8 * fq; bv[bj][0] = *(const pg8::f32x4*)(bias + (size_t)e * 1024 + c0); bv[bj][1] = *(const pg8::f32x4*)(bias + (size_t)e * 1024 + c0 + 4); }
        __builtin_amdgcn_sched_barrier(0);
#pragma unroll
        for (int bj = 0; bj < 2; ++bj) {
            const int c0 = 256 * u.pn + 128 * bj + 32 * wc + 8 * fq;
            const pg8::f32x4 b0 = bv[bj][0], b1 = bv[bj][1];
#pragma unroll
            for (int ai = 0; ai < 2; ++ai)
#pragma unroll
                for (int m = 0; m < 4; ++m) {
                    const int r = rowb + 128 * ai + 16 * m;
                    const pg8::f32x4 v0 = acc[ai][bj][m][0] * (1.0f / (W8_SCALE * ACT8_SCALE)) + b0, v1 = acc[ai][bj][m][1] * (1.0f / (W8_SCALE * ACT8_SCALE)) + b1;
                    u32x4 w; w.x = cvtpk(v0[0], v0[1]); w.y = cvtpk(v0[2], v0[3]); w.z = cvtpk(v1[0], v1[1]); w.w = cvtpk(v1[2], v1[3]);
                    *(u32x4*)(OS + (size_t)r * 1024 + c0) = w;
                }
        }
        ZERO_ACC();
    }
};
struct KArgs { const float* in[26]; float* out; unsigned char* ws; int ph_lo, ph_hi; };
struct Frame {
    LAS unsigned char* lds;
    int tid, lane, wave, G, bid, vcu;
    const KArgs __attribute__((address_space(4)))* ka; float* out; unsigned char* ws;
};
#define WSP(T, off) ((T*)(F.ws + (off)))

__device__ __forceinline__ int win_srccol(int n) {
    if (n < 3328) { const int p = n & 63, d = 4 * (p >> 3) + (p & 3) + 32 * ((p >> 2) & 1), L = (n & ~63) + d;
        if (L < 1280) return L; if (L < 1792) return 1304 + (L - 1280); if (L < 2304) return 1816 + (L - 1792); if (L < 2816) return 2328 + (L - 2304); return 2848 + (L - 2816); }
    if (n < 6400) return 3360 + (n - 3328);
    if (n < 6424) return 1280 + (n - 6400);
    if (n < 6432) return 2840 + (n - 6424);
    return -1;
}
__device__ __forceinline__ void transpose_item(const float* __restrict__ W, int N, bf16* __restrict__ Wt, int Kd, int n0, int k0, int sc, LAS float* scr, int lane, const float* __restrict__ kscale = nullptr) {
    const float* src = W + (size_t)k0 * N + (sc >= 0 ? sc : 0);
    float v[64];
#pragma unroll
    for (int kk = 0; kk < 64; ++kk) v[kk] = src[(size_t)kk * N];
    if (kscale) {
#pragma unroll
        for (int kk = 0; kk < 64; ++kk) v[kk] *= kscale[k0 + kk];
    }
#pragma unroll
    for (int kk = 0; kk < 64; ++kk) scr[kk * 65 + lane] = (sc >= 0) ? v[kk] : 0.f;
    asm volatile("s_waitcnt lgkmcnt(0)" ::: "memory");
    const int c = lane & 7;
#pragma unroll
    for (int j = 0; j < 8; ++j) { const int n = (lane >> 3) + 8 * j; const LAS float* s = scr + (8 * c) * 65 + n;
        u32x4 o; o.x = cvtpk(s[0], s[65]); o.y = cvtpk(s[2 * 65], s[3 * 65]); o.z = cvtpk(s[4 * 65], s[5 * 65]); o.w = cvtpk(s[6 * 65], s[7 * 65]);
        *(u32x4*)(Wt + (size_t)(n0 + n) * Kd + k0 + 8 * c) = o; }
    asm volatile("s_waitcnt lgkmcnt(0)" ::: "memory");
}
__device__ __forceinline__ void transpose_item8(const float* __restrict__ W, int N, unsigned char* __restrict__ Wt8, int Kd, int n0, int k0, LAS unsigned char* scr, int lane, const float* __restrict__ kscale, float mul) {
    const float* src = W + (size_t)k0 * N + n0 + lane;
#pragma unroll
    for (int half = 0; half < 2; ++half) {
        float v[64];
#pragma unroll
        for (int kk = 0; kk < 64; ++kk) v[kk] = src[(size_t)(64 * half + kk) * N];
#pragma unroll
        for (int kk = 0; kk < 64; ++kk) v[kk] *= kscale ? mul * kscale[k0 + 64 * half + kk] : mul;
#pragma unroll
        for (int j = 0; j < 32; ++j) { const float a = fminf(fmaxf(v[2 * j], -448.f), 448.f), b = fminf(fmaxf(v[2 * j + 1], -448.f), 448.f);
            *(LAS unsigned short*)(scr + lane * 132 + 64 * half + 2 * j) = (unsigned short)__builtin_amdgcn_cvt_pk_fp8_f32(a, b, 0, false); }
    }
    asm volatile("s_waitcnt lgkmcnt(0)" ::: "memory");
    const int c = lane & 7;
#pragma unroll
    for (int j = 0; j < 8; ++j) { const int n = (lane >> 3) + 8 * j; const LAS unsigned* s = (const LAS unsigned*)(scr + n * 132 + 16 * c);
        u32x4 o; o.x = s[0]; o.y = s[1]; o.z = s[2]; o.w = s[3];
        *(u32x4*)(Wt8 + (size_t)(n0 + n) * Kd + k0 + 16 * c) = o; }
    asm volatile("s_waitcnt lgkmcnt(0)" ::: "memory");
}
__device__ __forceinline__ void rms_row_bf16(const float* __restrict__ xrow, const float* __restrict__ g, bf16* __restrict__ orow, int lane) {
    const f32x4* xr = (const f32x4*)xrow + lane; const f32x4* gr = (const f32x4*)g + lane;
    f32x4 v[4]; float s = 0.f;
#pragma unroll
    for (int j = 0; j < 4; ++j) { v[j] = xr[64 * j]; s += (v[j].x * v[j].x + v[j].y * v[j].y) + (v[j].z * v[j].z + v[j].w * v[j].w); }
    const float rstd = 1.0f / sqrtf(wave_sum(s) * (1.f / 1024.f) + RMS_EPS);
    u32x2* o8 = (u32x2*)orow + lane;
#pragma unroll
    for (int j = 0; j < 4; ++j) { const f32x4 gg = gr[64 * j]; o8[64 * j] = (u32x2){cvtpk(v[j].x * rstd * gg.x, v[j].y * rstd * gg.y), cvtpk(v[j].z * rstd * gg.z, v[j].w * rstd * gg.w)}; }
}
__device__ __forceinline__ void sincos_big(float ang, float& s, float& c) {
    const double x = (double)ang; const double kf = __builtin_rint(x * 0.63661977236758134308); const int k = (int)kf;
    const double r = (x - kf * 1.57079632679489655800) - kf * 6.123233995736766036e-17, r2 = r * r;
    const double sp = r * (1.0 + r2 * (-1.0 / 6 + r2 * (1.0 / 120 + r2 * (-1.0 / 5040 + r2 * (1.0 / 362880 - r2 * (1.0 / 39916800))))));
    const double cp = 1.0 + r2 * (-0.5 + r2 * (1.0 / 24 + r2 * (-1.0 / 720 + r2 * (1.0 / 40320 + r2 * (-1.0 / 3628800 + r2 * (1.0 / 479001600))))));
    const double ss = (k & 1) ? cp : sp, cc = (k & 1) ? sp : cp;
    s = (float)((k & 2) ? -ss : ss); c = (float)(((k + 1) & 2) ? -cc : cc);
}
__device__ __forceinline__ void attn_unit_desc(int i, unsigned& desc, int& cost) {
    if (i < 512) { const int bg = i >> 6, T = i & 63; desc = 0u | (bg << 3) | (T << 11); cost = 8 + (T + 1) + (T < 8 ? T + 1 : 9) + 2 * (T / 4 + 1); }
    else { const int j = i - 512, bh = j >> 4, qb = j & 15; desc = 1u | (bh << 3) | (qb << 11); cost = (7 * (3 + 4 * qb + 3)) / 10; }
}
constexpr int N_SORTED = 1024, MAXCOST = 128, N_CVT_UNITS = 256, CVT_CHUNK = 12;
constexpr int Q_CMP0 = 0, Q_CUM0 = 128, Q_CVT0 = 132, Q_SRT0 = Q_CVT0 + N_CVT_UNITS, Q_MEM0 = Q_SRT0 + N_SORTED, N_QUEUE = Q_MEM0 + 256;
constexpr int CW_CMPDONE = 8192, CW_CUMDONE = 8192 + 64 * 8;

__device__ __forceinline__ void p0_prologue(Frame& F) {
    LAS float* scr = (LAS float*)(F.lds + F.wave * 16640);
    const int gw = F.vcu * NWAVES + F.wave, NGW = F.G * NWAVES, lane = F.lane;
    bf16* HA = WSP(bf16, WS_HA);
    for (int m0 = gw; m0 < NTOK + NMEMROW; m0 += 4 * NGW) {
        f32x4 v[4][4]; float ss[4]; const float* xr[4]; bool has[4];
#pragma unroll
        for (int q = 0; q < 4; ++q) { const int m = m0 + q * NGW; has[q] = m < NTOK + NMEMROW; const int mm = has[q] ? m : m0;
            xr[q] = (mm < NTOK) ? F.ka->in[0] + (size_t)mm * DM : F.ka->in[1] + (size_t)(mm - NTOK) * DM; }
#pragma unroll
        for (int j = 0; j < 4; ++j)
#pragma unroll
            for (int q = 0; q < 4; ++q) v[q][j] = ((const f32x4*)xr[q])[64 * j + lane];
#pragma unroll
        for (int q = 0; q < 4; ++q) { float s_ = 0.f;
#pragma unroll
            for (int j = 0; j < 4; ++j) s_ += (v[q][j].x * v[q][j].x + v[q][j].y * v[q][j].y) + (v[q][j].z * v[q][j].z + v[q][j].w * v[q][j].w);
            ss[q] = s_; }
#pragma unroll
        for (int o = 1; o < 64; o <<= 1) {
#pragma unroll
            for (int q = 0; q < 4; ++q) ss[q] += __shfl_xor(ss[q], o); }
#pragma unroll
        for (int q = 0; q < 4; ++q) { const int m = m0 + q * NGW; const float r = 1.0f / sqrtf(ss[q] * (1.f / 1024.f) + RMS_EPS);
            const f32x4* g = (const f32x4*)((m < NTOK) ? F.ka->in[2] : F.ka->in[12]);
            if (has[q]) {
#pragma unroll
                for (int j = 0; j < 4; ++j) { const f32x4 a = g[64 * j + lane];
                    ((u32x2*)(HA + (size_t)m * DM))[64 * j + lane] = (u32x2){cvtpk(v[q][j].x * r * a.x, v[q][j].y * r * a.y), cvtpk(v[q][j].z * r * a.z, v[q][j].w * r * a.w)}; } } }
    }
    constexpr int I_WIN = 104 * 16, I_MKV = 16 * 16, I_BR = 16 * 8, I_OUT = 256, I_W1 = 32, I_W2 = 1;
    constexpr int NITEMS = I_WIN + I_MKV + 3 * I_BR + I_OUT + 2 * I_W1 + 2 * I_W2;
    for (int it = gw; it < NITEMS; it += NGW) {
        int r = it;
        if (r < I_WIN) { const int kt = r / 104, nt = r - kt * 104; transpose_item(F.ka->in[3], DIN, WSP(bf16, WS_WIN_T), 1024, nt * 64, kt * 64, win_srccol(nt * 64 + lane), scr, lane); continue; } r -= I_WIN;
        if (r < I_MKV) { const int kt = r >> 4, nt = r & 15; transpose_item(F.ka->in[13], 1024, WSP(bf16, WS_WIN_T) + (size_t)NIN * 1024, 1024, nt * 64, kt * 64, nt * 64 + lane, scr, lane); continue; } r -= I_MKV;
        if (r < 3 * I_BR) { const int b = r / I_BR, q = r - b * I_BR, kt = q >> 4, nt = q & 15; transpose_item(b == 0 ? F.ka->in[14] : (b == 1 ? F.ka->in[15] : F.ka->in[16]), 1024, WSP(bf16, WS_WBR_T) + (size_t)b * 1024 * 512, 512, nt * 64, kt * 64, nt * 64 + lane, scr, lane); continue; } r -= 3 * I_BR;
        if (r < I_OUT) { const int kt = r >> 4, nt = r & 15; transpose_item(F.ka->in[17], 1024, WSP(bf16, WS_WOUT_T), 1024, nt * 64, kt * 64, nt * 64 + lane, scr, lane); continue; } r -= I_OUT;
        if (r < 2 * I_W1) { const int b = r / I_W1, kt = r - b * I_W1; transpose_item(b ? F.ka->in[10] : F.ka->in[7], 64, b ? WSP(bf16, WS_W1T_V) : WSP(bf16, WS_W1T_K), 2048, 0, kt * 64, lane, scr, lane); continue; } r -= 2 * I_W1;
        { transpose_item(r ? F.ka->in[11] : F.ka->in[8], 64, r ? WSP(bf16, WS_W2T_V) : WSP(bf16, WS_W2T_K), 64, 0, 0, lane, scr, lane); }
    }
    { float* rc = WSP(float, WS_ROPE_C); float* rs = WSP(float, WS_ROPE_S);
      for (int idx = F.bid * NTHREADS + F.tid; idx < SEQ * 32; idx += F.G * NTHREADS) { const int t = idx >> 5, i = idx & 31;
          const float inv = exp2f(-(float)i * (13.287712379549449f / 32.0f)); const float ang = (float)t * inv; float s, c; sincos_big(ang, s, c); rc[idx] = c; rs[idx] = s; } }
    { bf16* wrh = WSP(bf16, WS_WRT); const float* wr = F.ka->in[19]; const float* gf = F.ka->in[18];
      for (int idx = F.bid * NTHREADS + F.tid; idx < 32 * 1024; idx += F.G * NTHREADS) { const int e = idx >> 10, k = idx & 1023; const float v = wr[k * 32 + e] * gf[k];
          const unsigned h = cvtpk(v, 0.f) & 0xffffu; const float lo = v - bflo(h); wrh[idx] = (bf16)h; wrh[32 * 1024 + idx] = (bf16)(cvtpk(lo, 0.f) & 0xffffu); } }
    if (gw >= NGW - 128) { const int j = gw - (NGW - 128), kv = j >> 6, part = j & 63; const float* pe = kv ? F.ka->in[9] : F.ka->in[6]; const float* w1 = kv ? F.ka->in[10] : F.ka->in[7]; float a = 0.f;
#pragma unroll 16
        for (int k = part * 32; k < part * 32 + 32; ++k) a += pe[k] * w1[k * 64 + lane];
        WSP(float, WS_CPE)[(kv * 64 + part) * 64 + lane] = a; }
    if (F.bid == 0) {
        __syncthreads();
        LAS int* hist = (LAS int*)F.lds;
        LAS unsigned* sorted = (LAS unsigned*)(hist + 3 * MAXCOST);
        for (int i = F.tid; i < 3 * MAXCOST; i += NTHREADS) hist[i] = 0;
        __syncthreads();
        for (int i = F.tid; i < N_SORTED; i += NTHREADS) { unsigned d; int c; attn_unit_desc(i, d, c); atomicAdd((int*)(hist + c), 1); }
        __syncthreads();
        if (F.tid < MAXCOST) { int run = 0; for (int c = F.tid + 1; c < MAXCOST; ++c) run += hist[c]; hist[MAXCOST + F.tid] = run; }
        __syncthreads();
        for (int i = F.tid; i < N_SORTED; i += NTHREADS) { unsigned d; int c; attn_unit_desc(i, d, c); const int pos = hist[MAXCOST + c] + atomicAdd((int*)(hist + 2 * MAXCOST + c), 1); sorted[pos] = d; }
        __syncthreads();
        unsigned* order = WSP(unsigned, WS_ORDER);
        for (int i = F.tid; i < N_QUEUE; i += NTHREADS) {
            unsigned d;
            if (i < Q_CUM0) d = 3u | ((unsigned)(i >> 6) << 3) | ((unsigned)(i & 63) << 11);
            else if (i < Q_CVT0) d = 4u | ((unsigned)(i - Q_CUM0) << 3);
            else if (i < Q_SRT0) d = 5u | ((unsigned)(i - Q_CVT0) << 11);
            else if (i < Q_MEM0) d = sorted[i - Q_SRT0];
            else { const int j = i - Q_MEM0; d = 2u | ((unsigned)(j >> 4) << 3) | ((unsigned)(j & 15) << 11); }
            order[i] = d;
        }
        __syncthreads();
    }
}

struct CvtItem { const float* src; unsigned char* dst; const float* ks; int N; };
__device__ __forceinline__ CvtItem cvt_item(Frame& F, int g, int wv, int lane) {
    const int e = g / 96, q = g - e * 96; CvtItem I;
    if (q < 64) { const int kt = q >> 3, ng = (q + kt + e) & 7, k0 = kt * 128 + 16 * wv, n0 = ng * 256 + 4 * lane;
        I.src = F.ka->in[21] + (size_t)e * 1024 * 2048 + (size_t)k0 * 2048 + n0; I.N = 2048; I.dst = WSP(unsigned char, WS_WGU_T) + (size_t)e * 2048 * 1024 + (size_t)n0 * 1024 + k0; I.ks = F.ka->in[18] + k0; }
    else { const int q2 = q - 64, kt = q2 >> 2, ng = (q2 + kt + e) & 3, k0 = kt * 128 + 16 * wv, n0 = ng * 256 + 4 * lane;
        I.src = F.ka->in[23] + (size_t)e * 1024 * 1024 + (size_t)k0 * 1024 + n0; I.N = 1024; I.dst = WSP(unsigned char, WS_WD_T) + (size_t)e * 1024 * 1024 + (size_t)n0 * 1024 + k0; I.ks = nullptr; }
    return I;
}
__device__ __forceinline__ void cvt_load(f32x4 (&v)[16], const CvtItem& I) {
#pragma unroll
    for (int kk = 0; kk < 16; ++kk) v[kk] = *(const f32x4*)(I.src + (size_t)kk * I.N);
}
__device__ __forceinline__ void cvt_store(const f32x4 (&v)[16], const CvtItem& I) {
    float sc[16];
#pragma unroll
    for (int kk = 0; kk < 16; ++kk) sc[kk] = I.ks ? W8_SCALE * I.ks[kk] : W8_SCALE;
#pragma unroll
    for (int j = 0; j < 4; ++j) { u32x4 o;
#pragma unroll
        for (int q = 0; q < 4; ++q) o[q] = pk_fp8x4(v[4 * q][j] * sc[4 * q], v[4 * q + 1][j] * sc[4 * q + 1], v[4 * q + 2][j] * sc[4 * q + 2], v[4 * q + 3][j] * sc[4 * q + 3]);
        *(u32x4*)(I.dst + (size_t)j * 1024) = o; }
}
__device__ __forceinline__ void convert_unit(Frame& F, int cu) {
    int tid_ = threadIdx.x; asm volatile("" : "+v"(tid_)); const int lane = tid_ & 63, wv = __builtin_amdgcn_readfirstlane(tid_ >> 6);
    f32x4 a[16], b[16];
    CvtItem Ia = cvt_item(F, cu * CVT_CHUNK, wv, lane), Ib; cvt_load(a, Ia);
#pragma clang loop unroll(disable)
    for (int bi = 0; bi < CVT_CHUNK; bi += 2) {
        Ib = cvt_item(F, cu * CVT_CHUNK + bi + 1, wv, lane); cvt_load(b, Ib);
        cvt_store(a, Ia);
        if (bi + 2 < CVT_CHUNK) { Ia = cvt_item(F, cu * CVT_CHUNK + bi + 2, wv, lane); cvt_load(a, Ia); }
        cvt_store(b, Ib);
    }
}
__device__ __forceinline__ void q_signal(unsigned* p, int tid) {
    asm volatile("s_waitcnt vmcnt(0)" ::: "memory"); __syncthreads();
    if (tid == 0) { __builtin_amdgcn_fence(__ATOMIC_RELEASE, "agent"); asm volatile("s_waitcnt vmcnt(0)" ::: "memory"); __hip_atomic_fetch_add(p, 1u, __ATOMIC_RELAXED, __HIP_MEMORY_SCOPE_AGENT); }
}
__device__ __forceinline__ void q_wait(unsigned* p, unsigned want, int tid) {
    if (tid == 0) { unsigned sp = 0; while (__hip_atomic_load(p, __ATOMIC_RELAXED, __HIP_MEMORY_SCOPE_AGENT) < want && ++sp < (1u << 24)) __builtin_amdgcn_s_sleep(2);
        __builtin_amdgcn_fence(__ATOMIC_ACQUIRE, "agent"); asm volatile("s_waitcnt vmcnt(0)" ::: "memory"); }
    __syncthreads();
}

__device__ __forceinline__ void p2_compress_unit(Frame& F, int kv, int rt) {
    int tid_ = threadIdx.x; asm volatile("" : "+v"(tid_)); const int lane = tid_ & 63, w = __builtin_amdgcn_readfirstlane(tid_ >> 6), r32 = lane & 31, hi = lane >> 5;
    const bf16* src = WSP(bf16, WS_KV6) + (size_t)kv * NTOK * 128;
    const bf16* w1t = WSP(bf16, kv ? WS_W1T_V : WS_W1T_K); const bf16* w2t = WSP(bf16, kv ? WS_W2T_V : WS_W2T_K);
    const int R = rt * 32 + r32, bg = R >> 8, n = R & 255, b = bg >> 1, g = bg & 1;
    f32x16 acc0 = {}, acc1 = {};
#pragma unroll 4
    for (int st = 0; st < 16; ++st) {
        const int step = w * 16 + st, l = step >> 2, d = 16 * (step & 3) + 8 * hi;
        int tok = 16 * n + l; tok = tok < SEQ ? tok : SEQ - 1;
        const bf16x8 a = *(const bf16x8*)(src + ((size_t)(b * SEQ + tok)) * 128 + g * 64 + d);
        const bf16x8 b0 = *(const bf16x8*)(w1t + (size_t)r32 * 2048 + 16 * step + 8 * hi);
        const bf16x8 b1 = *(const bf16x8*)(w1t + (size_t)(32 + r32) * 2048 + 16 * step + 8 * hi);
        acc0 = __builtin_amdgcn_mfma_f32_32x32x16_bf16(a, b0, acc0, 0, 0, 0);
        acc1 = __builtin_amdgcn_mfma_f32_32x32x16_bf16(a, b1, acc1, 0, 0, 0);
    }
    LAS float* red = (LAS float*)F.lds;
    LAS bf16* zs = (LAS bf16*)(F.lds + 65536);
    __syncthreads();
#pragma unroll
    for (int r = 0; r < 16; ++r) { const int row = (r & 3) + 8 * (r >> 2) + 4 * hi; red[(w * 32 + row) * 64 + r32] = acc0[r]; red[(w * 32 + row) * 64 + 32 + r32] = acc1[r]; }
    __syncthreads();
    const float* cpe = WSP(float, WS_CPE) + kv * 4096;
    for (int idx = F.tid; idx < 2048; idx += NTHREADS) { float z = 0.f;
#pragma unroll
        for (int pp = 0; pp < 64; ++pp) z += cpe[pp * 64 + (idx & 63)];
#pragma unroll
        for (int ww = 0; ww < 8; ++ww) z += red[ww * 2048 + idx];
        const float sl = z * fast_sigmoid(z); zs[idx] = (bf16)(cvtpk(sl, 0.f) & 0xffffu); }
    __syncthreads();
    if (w < 2) {
        f32x16 o = {};
#pragma unroll
        for (int st = 0; st < 4; ++st) {
            const bf16x8 a = *(const LAS bf16x8*)(zs + r32 * 64 + 16 * st + 8 * hi);
            const bf16x8 bb = *(const bf16x8*)(w2t + (size_t)(32 * w + r32) * 64 + 16 * st + 8 * hi);
            o = __builtin_amdgcn_mfma_f32_32x32x16_bf16(a, bb, o, 0, 0, 0);
        }
        const int rbase = rt * 32;
#pragma unroll
        for (int r = 0; r < 16; ++r) { const int row = (r & 3) + 8 * (r >> 2) + 4 * hi, RR = rbase + row, nn = RR & 255;
            const float v = (nn == 255) ? 0.f : o[r];
            if (kv == 0) WSP(bf16, WS_KCMP)[(size_t)RR * 64 + 32 * w + r32] = (bf16)(cvtpk(v, 0.f) & 0xffffu);
            else WSP(bf16, WS_VCMP)[(size_t)RR * 128 + 32 * w + r32] = (bf16)(cvtpk(v, 0.f) & 0xffffu); }
    } else if (kv == 1) {
        for (int idx = F.tid - 128; idx < 2048; idx += NTHREADS - 128) { const int row = idx >> 6, j = idx & 63, RR = rt * 32 + row, nn = RR & 255;
            const bool ov = (nn != 255) && (nn >= 4 * j - 1) && (nn <= 4 * j + 3);
            WSP(bf16, WS_VCMP)[(size_t)RR * 128 + 64 + j] = ov ? (bf16)0x3f80 : (bf16)0; }
    }
    __syncthreads();
}
__device__ __forceinline__ float log_sigmoid_f(float x) { return fminf(x, 0.f) - log1pf(expf(-fabsf(x))); }
__device__ __forceinline__ void p2_cumsum_unit(Frame& F, int bh) {
    const int lane = F.lane, b = bh >> 3, h = bh & 7; const float bf = F.ka->in[4][h];
    const float* lg = WSP(float, WS_LG) + (size_t)(b * SEQ + 64 * lane) * 32 + 24 + h;
    double tot = 0.0;
    for (int i = 0; i < 64; ++i) tot += (double)log_sigmoid_f(lg[(size_t)i * 32] + bf);
    double inc = tot;
#pragma unroll
    for (int o = 1; o < 64; o <<= 1) { const double v = __shfl_up(inc, o); if (lane >= o) inc += v; }
    double run = inc - tot;
    float* cum = WSP(float, WS_CUM) + (size_t)bh * SEQ + 64 * lane;
    for (int i = 0; i < 64; ++i) { run += (double)log_sigmoid_f(lg[(size_t)i * 32] + bf); cum[i] = (float)(run * 1.4426950408889634); }
    const bf16* kf = WSP(bf16, WS_KF) + (size_t)b * SEQ * 512 + h * 64; float km = 0.f;
#pragma unroll 4
    for (int i = 0; i < 64; ++i) { const u32x4* p = (const u32x4*)(kf + (size_t)(64 * i + lane) * 512); float s = 0.f;
#pragma unroll
        for (int c = 0; c < 8; ++c) { const u32x4 v = p[c]; s += (bflo(v.x) * bflo(v.x) + bfhi(v.x) * bfhi(v.x)) + (bflo(v.y) * bflo(v.y) + bfhi(v.y) * bfhi(v.y)) + (bflo(v.z) * bflo(v.z) + bfhi(v.z) * bfhi(v.z)) + (bflo(v.w) * bflo(v.w) + bfhi(v.w) * bfhi(v.w)); }
        km = fmaxf(km, s); }
#pragma unroll
    for (int o = 1; o < 64; o <<= 1) km = fmaxf(km, __shfl_xor(km, o));
    if (lane == 0) WSP(float, WS_KMAX)[bh] = sqrtf(km) * 1.001f;
}

__device__ __forceinline__ void p6_phase(Frame& F) {
    const int lane = F.lane, w = F.wave, r32 = lane & 31, hi = lane >> 5, grp = w >> 2, kq = w & 3;
    LAS float* red = (LAS float*)F.lds;
    LAS float* ssl = (LAS float*)(F.lds + 32768);
    LAS int* lcnt = (LAS int*)(F.lds + 36864);
    const float* X1 = F.out; const float* brt = F.ka->in[20];
    const bf16* whT = WSP(bf16, WS_WRT); const bf16* wlT = whT + 32 * 1024;
    int* tope = WSP(int, WS_ROUTE); float* topg = (float*)(tope + NTOK * 4); int* lrank = tope + NTOK * 8; float* rstdg = WSP(float, WS_RSTD);
    for (int tile = F.bid; tile < NTOK / 64; tile += F.G) {
        if (F.tid < 32) lcnt[F.tid] = 0;
        const float* xrow = X1 + (size_t)(tile * 64 + grp * 32 + r32) * DM + 8 * hi + 256 * kq;
        const bf16* whp = whT + (size_t)r32 * 1024 + 8 * hi + 256 * kq; const bf16* wlp = wlT + (size_t)r32 * 1024 + 8 * hi + 256 * kq;
        f32x16 acc = f32x16{}; float ss = 0.f;
        f32x4 xa[16], xb[16];
#pragma unroll
        for (int s = 0; s < 16; ++s) { xa[s] = *(const f32x4*)(xrow + 16 * s); xb[s] = *(const f32x4*)(xrow + 16 * s + 4); }
#pragma unroll
        for (int sb = 0; sb < 2; ++sb) {
            bf16x8 wh[8], wl[8];
#pragma unroll
            for (int s = 0; s < 8; ++s) { const int o = 16 * (8 * sb + s); wh[s] = *(const bf16x8*)(whp + o); wl[s] = *(const bf16x8*)(wlp + o); }
#pragma unroll
            for (int s = 0; s < 8; ++s) {
                const f32x4 a = xa[8 * sb + s], b = xb[8 * sb + s];
                ss += (a.x * a.x + a.y * a.y) + (a.z * a.z + a.w * a.w) + (b.x * b.x + b.y * b.y) + (b.z * b.z + b.w * b.w);
                u32x4 h; h.x = cvtpk(a.x, a.y); h.y = cvtpk(a.z, a.w); h.z = cvtpk(b.x, b.y); h.w = cvtpk(b.z, b.w);
                u32x4 l; l.x = cvtpk(a.x - bflo(h.x), a.y - bfhi(h.x)); l.y = cvtpk(a.z - bflo(h.y), a.w - bfhi(h.y)); l.z = cvtpk(b.x - bflo(h.z), b.y - bfhi(h.z)); l.w = cvtpk(b.z - bflo(h.w), b.w - bfhi(h.w));
                const bf16x8 hv = __builtin_bit_cast(bf16x8, h), lv = __builtin_bit_cast(bf16x8, l);
                acc = __builtin_amdgcn_mfma_f32_32x32x16_bf16(hv, wh[s], acc, 0, 0, 0);
                acc = __builtin_amdgcn_mfma_f32_32x32x16_bf16(lv, wh[s], acc, 0, 0, 0);
                acc = __builtin_amdgcn_mfma_f32_32x32x16_bf16(hv, wl[s], acc, 0, 0, 0);
            }
        }
#pragma unroll
        for (int r = 0; r < 16; ++r) red[(w * 16 + r) * 64 + lane] = acc[r];
        ssl[w * 64 + lane] = ss;
        __syncthreads();
        LAS float* lgt = (LAS float*)(F.lds + 40960);
        LAS float* rsl = (LAS float*)(F.lds + 40960 + 64 * 33 * 4);
        LAS float* topv = rsl + 64;
        LAS int* tope_l = (LAS int*)(topv + 256);
        if (kq == 0) {
#pragma unroll
            for (int r = 0; r < 16; ++r) acc[r] = (red[(w * 16 + r) * 64 + lane] + red[((w + 1) * 16 + r) * 64 + lane]) + (red[((w + 2) * 16 + r) * 64 + lane] + red[((w + 3) * 16 + r) * 64 + lane]);
            ss = (ssl[w * 64 + lane] + ssl[(w + 1) * 64 + lane]) + (ssl[(w + 2) * 64 + lane] + ssl[(w + 3) * 64 + lane]);
            ss += __shfl_xor(ss, 32);
            const float rstd = 1.0f / sqrtf(ss * (1.f / 1024.f) + RMS_EPS);
            if (hi == 0) { rstdg[tile * 64 + grp * 32 + r32] = rstd; rsl[grp * 32 + r32] = rstd; }
#pragma unroll
            for (int r = 0; r < 16; ++r) { const int rowl = (r & 3) + 8 * (r >> 2) + 4 * hi; lgt[(grp * 32 + rowl) * 33 + r32] = acc[r]; }
        }
        __syncthreads();
#pragma unroll
        for (int it = 0; it < 4; ++it) {
            const int row = it * 16 + (F.tid >> 5), e = F.tid & 31;
            const float rs = rsl[row]; const float mine = lgt[row * 33 + e] * rs + brt[e];
            int rank = 0;
#pragma unroll
            for (int j = 0; j < 32; ++j) { const float v = lgt[row * 33 + j] * rs + brt[j]; rank += (v > mine || (v == mine && j < e)) ? 1 : 0; }
            if (rank < 4) { topv[row * 4 + rank] = mine; tope_l[row * 4 + rank] = e; }
        }
        __syncthreads();
        int ee4[4], lr4[4];
        if (F.tid < 64) { const int row = F.tid, t = tile * 64 + row;
            const float v0 = topv[row * 4], e1 = expf(topv[row * 4 + 1] - v0), e2 = expf(topv[row * 4 + 2] - v0), e3 = expf(topv[row * 4 + 3] - v0); const float inv = 1.0f / (1.0f + e1 + e2 + e3);
            const float gs[4] = {inv, e1 * inv, e2 * inv, e3 * inv};
#pragma unroll
            for (int k = 0; k < 4; ++k) { const int ee = tope_l[row * 4 + k]; tope[t * 4 + k] = ee; topg[t * 4 + k] = gs[k]; ee4[k] = ee; lr4[k] = atomicAdd((int*)(lcnt + ee), 1); } }
        __syncthreads();
        if (F.tid < 32) { const int c = lcnt[F.tid]; lcnt[32 + F.tid] = c ? (int)__hip_atomic_fetch_add(WSP(unsigned, WS_CTL) + CW_GCNT + 32 * F.tid, (unsigned)c, __ATOMIC_RELAXED, __HIP_MEMORY_SCOPE_AGENT) : 0; }
        __syncthreads();
        if (F.tid < 64) { const int row = F.tid, t = tile * 64 + row; const float rs_ = rsl[row];
#pragma unroll
            for (int k = 0; k < 4; ++k) { const int rk = lcnt[32 + ee4[k]] + lr4[k]; lrank[t * 4 + k] = rk; WSP(int, WS_ETOK)[ee4[k] * NTOK + rk] = t; WSP(float, WS_ERSTD)[ee4[k] * NTOK + rk] = rs_; } }
        __syncthreads();
    }
}

__device__ __forceinline__ void p7_phase(Frame& F) {
    LAS int* part = (LAS int*)F.lds;
    LAS int* tot = part + 1024; LAS int* pre = tot + 32; LAS int* pstart = pre + 32; LAS int* slotl = pstart + 32;
    const int* blkcnt = WSP(int, WS_BLKCNT);
    int* tope = WSP(int, WS_ROUTE); int* lrank = tope + NTOK * 8; int* slot = tope + NTOK * 12;
    const float* rstdg = WSP(float, WS_RSTD); float* rslot = WSP(float, WS_RSLOT); int* slottok = WSP(int, WS_SLOTTOK);
    for (int tile = F.bid; tile < NTOK / 64; tile += F.G) {
        __syncthreads();
        { const int e = F.tid & 31, p = F.tid >> 5; int st = 0, sp = 0;
          for (int tt = p; tt < NTOK / 64; tt += 16) { const int c = blkcnt[tt * 32 + e]; st += c; if (tt < tile) sp += c; }
          part[p * 32 + e] = st; part[512 + p * 32 + e] = sp; }
        __syncthreads();
        if (F.tid < 32) { int st = 0, sp = 0;
#pragma unroll
            for (int p = 0; p < 16; ++p) { st += part[p * 32 + F.tid]; sp += part[512 + p * 32 + F.tid]; }
            tot[F.tid] = st; pre[F.tid] = sp; }
        __syncthreads();
        if (F.tid == 0) { int run = 0; for (int e = 0; e < 32; ++e) { pstart[e] = run; run += (tot[e] + 255) & ~255; }
            if (tile == 0) { int* te = WSP(int, WS_TILE_E); int j = 0; for (int e = 0; e < 32; ++e) { const int nte = (tot[e] + 255) >> 8; for (int q = 0; q < nte; ++q) te[j++] = e; } te[500] = j; } }
        __syncthreads();
        if (F.tid < 256) { const int a = tile * 256 + F.tid; const int e = tope[a]; const int s = pstart[e] + pre[e] + lrank[a]; slot[a] = s; rslot[s] = rstdg[tile * 64 + (F.tid >> 2)]; slottok[s] = tile * 64 + (F.tid >> 2); }
    }
}

__device__ __forceinline__ void p10_phase(Frame& F, bool with_moe, float* dsto) {
    const int gw = F.vcu * NWAVES + F.wave, NGW = F.G * NWAVES, lane = F.lane;
    const int* tope = WSP(int, WS_ROUTE); const float* topg = (const float*)(tope + NTOK * 4); const int* rank = tope + NTOK * 8;
    const LAS int* pstart = (const LAS int*)(F.lds + MT_OFF) + 320;
    const bf16* OS = WSP(bf16, WS_AMOE); const float* gfin = F.ka->in[25];
    for (int t = gw; t < NTOK; t += NGW) {
        const f32x4* xr = (const f32x4*)((with_moe ? F.out : F.ka->in[0]) + (size_t)t * DM) + lane;
        f32x4 v[4];
#pragma unroll
        for (int j = 0; j < 4; ++j) v[j] = xr[64 * j];
        if (with_moe) {
#pragma unroll
            for (int k = 0; k < 4; ++k) { const float gk = topg[t * 4 + k]; const u32x2* orow = (const u32x2*)(OS + (size_t)(pstart[tope[t * 4 + k]] + rank[t * 4 + k]) * DM) + lane;
#pragma unroll
                for (int j = 0; j < 4; ++j) { const u32x2 o = orow[64 * j]; v[j].x += gk * bflo(o.x); v[j].y += gk * bfhi(o.x); v[j].z += gk * bflo(o.y); v[j].w += gk * bfhi(o.y); } }
        }
        float s = 0.f;
#pragma unroll
        for (int j = 0; j < 4; ++j) s += (v[j].x * v[j].x + v[j].y * v[j].y) + (v[j].z * v[j].z + v[j].w * v[j].w);
        const float rstd = 1.0f / sqrtf(wave_sum(s) * (1.f / 1024.f) + RMS_EPS);
        f32x4* orow = (f32x4*)(dsto + (size_t)t * DM) + lane;
#pragma unroll
        for (int j = 0; j < 4; ++j) orow[64 * j] = v[j] * rstd * ((const f32x4*)gfin)[64 * j + lane];
    }
}
constexpr int AL_RING = 0, AL_OACC = 49152, AL_BIAS = 114688, AL_WSF = AL_BIAS + 3 * 8 * 64 * 4, AL_IMP = AL_WSF + 8 * 64 * 4, AL_SELB = AL_IMP + 64 * 65 * 4, AL_UNI = AL_SELB + 512, AL_TICKET = AL_UNI + 16;
static_assert(AL_TICKET + 16 <= LDS_BYTES - 64 && AL_OACC + 65536 <= AL_BIAS, "attention LDS map");
__device__ __forceinline__ int crow(int r, int hi) { return (r & 3) + 8 * (r >> 2) + 4 * hi; }
__device__ __forceinline__ s16x4 vtr(const LAS char* p) { return __builtin_bit_cast(s16x4, __builtin_amdgcn_ds_read_tr16_b64_v4i16((LAS s16x4*)p)); }

__device__ __forceinline__ float max3f(float a, float b, float c) { float r; asm("v_max3_f32 %0, %1, %2, %3" : "=v"(r) : "v"(a), "v"(b), "v"(c)); return r; }
struct AttnCtx { LAS unsigned char* lds; int tid, lane, w, r32, hi; LAS float* wsf; };
__device__ __forceinline__ AttnCtx make_ctx(LAS unsigned char* lds) {
    int tid = threadIdx.x; asm volatile("" : "+v"(tid));
    AttnCtx C; C.lds = lds; C.tid = tid; C.lane = tid & 63; C.w = __builtin_amdgcn_readfirstlane(tid >> 6); C.r32 = tid & 31; C.hi = (tid >> 5) & 1; C.wsf = (LAS float*)(lds + AL_WSF) + C.w * 64;
    return C;
}

template <int NDB> __device__ __forceinline__ void scale_rows(const AttnCtx& C, f32x16 (&o)[NDB], float vq, int slot) {
    if (C.hi == 0) C.wsf[slot + C.r32] = vq;
#pragma unroll
    for (int rg = 0; rg < 4; ++rg) { const f32x4 a4 = *(const LAS f32x4*)(C.wsf + slot + 8 * rg + 4 * C.hi);
#pragma unroll
        for (int db = 0; db < NDB; ++db) { o[db][4 * rg + 0] *= a4.x; o[db][4 * rg + 1] *= a4.y; o[db][4 * rg + 2] *= a4.z; o[db][4 * rg + 3] *= a4.w; } }
}

__device__ __forceinline__ void dma16(const void* g, LAS unsigned char* lds_wave_base) { __builtin_amdgcn_global_load_lds((const unsigned*)g, (LAS unsigned*)lds_wave_base, 16, 0, 0); }
__device__ __forceinline__ void dma4(const void* g, LAS unsigned char* lds_wave_base) { __builtin_amdgcn_global_load_lds((const unsigned*)g, (LAS unsigned*)lds_wave_base, 4, 0, 0); }
template <int N> __device__ __forceinline__ void wait_vm() {
    if constexpr (N == 0) asm volatile("s_waitcnt vmcnt(0)" ::: "memory"); else if constexpr (N == 2) asm volatile("s_waitcnt vmcnt(2)" ::: "memory");
    else if constexpr (N == 3) asm volatile("s_waitcnt vmcnt(3)" ::: "memory"); else if constexpr (N == 4) asm volatile("s_waitcnt vmcnt(4)" ::: "memory"); else static_assert(N == 0, "wait_vm");
}
template <int DQK, int DV, bool BIAS, class Pol>
__device__ __forceinline__ void attn_core(const AttnCtx& C, const Pol& P, const bf16x8 (&qf)[DQK / 16], f32x16 (&o)[DV / 32]) {
    constexpr int NKP = DQK / 64, NVP = DV / 64, NDB = DV / 32, ND0 = DQK / 16, KROW = DQK * 2, KCH = DQK / 8, VCH = DV / 8, KBYTES = DQK * 128, SLOT = (DQK + DV) * 128, PT = NKP + NVP + (BIAS ? 1 : 0);
    int tid = C.tid; asm volatile("" : "+v"(tid));
    const int lane = tid & 63, r32 = lane & 31, hi = lane >> 5, w = C.w;
    int ksrc[NKP], vsrc[NVP];
#pragma unroll
    for (int j = 0; j < NKP; ++j) { const int id = tid + 512 * j, key = id / KCH, slot = id % KCH; const int c = slot ^ (DQK == 64 ? ((key >> 1) & 7) : (key & 15)); ksrc[j] = key * P.kpitch() + c * 8; }
#pragma unroll
    for (int j = 0; j < NVP; ++j) { const int id = tid + 512 * j, db = id >> 8, rem = id & 255, key = 8 * (rem >> 5) + ((rem & 31) >> 2), pc = 4 * db + (rem & 3); vsrc[j] = key * P.vpitch() + pc * 8; }
    int koff[ND0];
#pragma unroll
    for (int d0 = 0; d0 < ND0; ++d0) koff[d0] = r32 * KROW + (((2 * d0 + hi) ^ (DQK == 64 ? ((r32 >> 1) & 7) : (r32 & 15))) << 4);
    const int vbase = ((lane >> 4) & 1) * 32 + (lane & 3) * 8 + (4 * hi + ((lane & 15) >> 2)) * 64;
    LAS unsigned char* lds = C.lds;
    LAS float* biasw = (LAS float*)(lds + AL_BIAS) + w * 64;
#define ATT_DMA(t, s) do { const bf16* kp_ = P.kptr(t); const bf16* vp_ = P.vptr(t); LAS unsigned char* sb_ = lds + AL_RING + (s) * SLOT + w * 1024; \
        _Pragma("unroll") for (int j = 0; j < NKP; ++j) dma16(kp_ + ksrc[j], sb_ + j * 8192); \
        _Pragma("unroll") for (int j = 0; j < NVP; ++j) dma16(vp_ + vsrc[j], sb_ + KBYTES + j * 8192); \
        if (BIAS) dma4(P.biasptr(t) + lane, (LAS unsigned char*)(biasw + (s) * 512)); } while (0)
    float m_ref = 0.f, l_part = 0.f; bool seen = false;
#pragma unroll
    for (int db = 0; db < NDB; ++db) o[db] = f32x16{};
    int t = P.first(), t1 = P.next(t);
    asm volatile("s_waitcnt vmcnt(0) lgkmcnt(0)" ::: "memory"); __builtin_amdgcn_s_barrier();
    ATT_DMA(t, 0);
    if (t1 >= 0) ATT_DMA(t1, 1);
    int s0 = 0;
    while (t >= 0) {
        const int t2 = (t1 >= 0) ? P.next(t1) : -1;
        if (t1 >= 0) wait_vm<PT>(); else wait_vm<0>();
        asm volatile("s_waitcnt lgkmcnt(0)" ::: "memory"); __builtin_amdgcn_s_barrier(); asm volatile("" ::: "memory");
        const int s2 = (s0 >= 1) ? s0 - 1 : 2;
        if (t2 >= 0) ATT_DMA(t2, s2);
        if (!P.wave_skip(t)) {
            const LAS unsigned char* Kb = lds + AL_RING + s0 * SLOT; const LAS unsigned char* Vb = Kb + KBYTES;
            const float cbase = P.lane_valid(t) ? -m_ref : NEGBIG;
            f32x16 p0, p1;
            if (BIAS) {
                const float cb = cbase + P.bias_ref();
#pragma unroll
                for (int rg = 0; rg < 4; ++rg) { const f32x4 b0 = *(const LAS f32x4*)(biasw + s0 * 512 + 8 * rg + 4 * hi), b1 = *(const LAS f32x4*)(biasw + s0 * 512 + 32 + 8 * rg + 4 * hi);
                    p0[4 * rg] = cb - b0.x; p0[4 * rg + 1] = cb - b0.y; p0[4 * rg + 2] = cb - b0.z; p0[4 * rg + 3] = cb - b0.w;
                    p1[4 * rg] = cb - b1.x; p1[4 * rg + 1] = cb - b1.y; p1[4 * rg + 2] = cb - b1.z; p1[4 * rg + 3] = cb - b1.w; }
            } else {
#pragma unroll
                for (int r = 0; r < 16; ++r) { p0[r] = cbase; p1[r] = cbase; }
            }
#pragma unroll
            for (int d0 = 0; d0 < ND0; ++d0) {
                const bf16x8 k0 = *(const LAS bf16x8*)(Kb + koff[d0]); const bf16x8 k1 = *(const LAS bf16x8*)(Kb + koff[d0] + 32 * KROW);
                p0 = __builtin_amdgcn_mfma_f32_32x32x16_bf16(k0, qf[d0], p0, 0, 0, 0);
                p1 = __builtin_amdgcn_mfma_f32_32x32x16_bf16(k1, qf[d0], p1, 0, 0, 0);
            }
            asm volatile("s_nop 15\n\ts_nop 7" : "+v"(p0), "+v"(p1));
            if (P.masked(t)) {
#pragma unroll
                for (int r = 0; r < 16; ++r) { const int kvl = crow(r, hi);
                    if (!P.valid(t, kvl)) p0[r] = NEGBIG;
                    if (!P.valid(t, kvl + 32)) p1[r] = NEGBIG; }
            }
            float rm = max3f(p0[0], p1[0], p0[1]), rm2 = max3f(p1[1], p0[2], p1[2]);
#pragma unroll
            for (int r = 3; r < 15; r += 2) { rm = max3f(rm, p0[r], p1[r]); rm2 = max3f(rm2, p0[r + 1], p1[r + 1]); }
            rm = max3f(rm, p0[15], p1[15]);
            rm = max3f(rm, rm2, rm2);
            rm = max3f(rm, __shfl_xor(rm, 32), rm);
            const bool any_valid = rm > -1e29f;
            const bool trig = (rm > 8.0f) || (!seen && any_valid);
            if (__any(trig)) {
                const float dl = trig ? rm : 0.f; const float alpha = (trig && seen) ? __builtin_amdgcn_exp2f(-dl) : 1.0f;
                m_ref += dl; l_part *= alpha;
#pragma unroll
                for (int r = 0; r < 16; ++r) { p0[r] -= dl; p1[r] -= dl; }
                scale_rows<NDB>(C, o, alpha, 0);
            }
            seen = seen || any_valid;
            float ls = 0.f;
#pragma unroll
            for (int r = 0; r < 16; ++r) { const float e0 = __builtin_amdgcn_exp2f(p0[r]), e1 = __builtin_amdgcn_exp2f(p1[r]); p0[r] = e0; p1[r] = e1; ls += e0 + e1; }
            l_part += ls;
            u32x4 pw[4];
#pragma unroll
            for (int k = 0; k < 4; ++k) { pw[0][k] = cvtpk(p0[2 * k], p0[2 * k + 1]); pw[1][k] = cvtpk(p0[8 + 2 * k], p0[9 + 2 * k]); pw[2][k] = cvtpk(p1[2 * k], p1[2 * k + 1]); pw[3][k] = cvtpk(p1[8 + 2 * k], p1[9 + 2 * k]); }
#pragma unroll
            for (int db = 0; db < NDB; ++db) {
#pragma unroll
                for (int s = 0; s < 4; ++s) {
                    const s16x4 lo = vtr((const LAS char*)Vb + vbase + db * 4096 + s * 1024), hh = vtr((const LAS char*)Vb + vbase + db * 4096 + s * 1024 + 512);
                    const bf16x8 vf = {lo[0], lo[1], lo[2], lo[3], hh[0], hh[1], hh[2], hh[3]};
                    o[db] = __builtin_amdgcn_mfma_f32_32x32x16_bf16(__builtin_bit_cast(bf16x8, pw[s]), vf, o[db], 0, 0, 0);
                }
            }
        }
        s0 = (s0 == 2) ? 0 : s0 + 1; t = t1; t1 = t2;
    }
    const float l = l_part + __shfl_xor(l_part, 32);
    scale_rows<NDB>(C, o, l > 0.f ? 1.0f / l : 0.f, 32);
    asm volatile("s_waitcnt lgkmcnt(0)" ::: "memory"); __builtin_amdgcn_s_barrier(); asm volatile("" ::: "memory");
#undef ATT_DMA
}

struct FoxPol {
    const bf16 *K, *V; const float* cum; float ref; int qb, w, tq, tmin;
    __device__ __forceinline__ int first() const { return 4 * qb + 3; }
    __device__ __forceinline__ int next(int t) const { return t - 1 >= tmin ? t - 1 : -1; }
    __device__ __forceinline__ bool masked(int t) const { return t >= 4 * qb; }
    __device__ __forceinline__ bool valid(int t, int kvl) const { return 64 * t + kvl <= tq; }
    __device__ __forceinline__ bool wave_skip(int t) const { return 64 * (t - 4 * qb) > 32 * w + 31; }
    __device__ __forceinline__ bool lane_valid(int) const { return true; }
    __device__ __forceinline__ const bf16* kptr(int t) const { return K + (size_t)(64 * t) * 512; }
    __device__ __forceinline__ const bf16* vptr(int t) const { return V + (size_t)(64 * t) * 512; }
    __device__ __forceinline__ int kpitch() const { return 512; }
    __device__ __forceinline__ int vpitch() const { return 512; }
    __device__ __forceinline__ const float* biasptr(int t) const { return cum + 64 * t; }
    __device__ __forceinline__ float bias_ref() const { return ref; }
};
struct MemPol {
    const bf16 *K, *V;
    __device__ __forceinline__ int first() const { return 0; }
    __device__ __forceinline__ int next(int t) const { return t < 3 ? t + 1 : -1; }
    __device__ __forceinline__ bool masked(int) const { return false; }
    __device__ __forceinline__ bool valid(int, int) const { return true; }
    __device__ __forceinline__ bool wave_skip(int) const { return false; }
    __device__ __forceinline__ bool lane_valid(int) const { return true; }
    __device__ __forceinline__ const bf16* kptr(int t) const { return K + (size_t)(64 * t) * 512; }
    __device__ __forceinline__ const bf16* vptr(int t) const { return V + (size_t)(64 * t) * 512; }
    __device__ __forceinline__ int kpitch() const { return 512; }
    __device__ __forceinline__ int vpitch() const { return 512; }
    __device__ __forceinline__ const float* biasptr(int) const { return nullptr; }
    __device__ __forceinline__ float bias_ref() const { return 0.f; }
};
struct CmpPol {
    const bf16 *K, *V; int ntc, tq;
    __device__ __forceinline__ int first() const { return 0; }
    __device__ __forceinline__ int next(int t) const { return t + 1 < ntc ? t + 1 : -1; }
    __device__ __forceinline__ bool masked(int) const { return true; }
    __device__ __forceinline__ bool valid(int t, int kvl) const { return 16 * (64 * t + kvl) + 31 <= tq; }
    __device__ __forceinline__ bool wave_skip(int) const { return false; }
    __device__ __forceinline__ bool lane_valid(int) const { return true; }
    __device__ __forceinline__ const bf16* kptr(int t) const { return K + (size_t)(64 * t) * 64; }
    __device__ __forceinline__ const bf16* vptr(int t) const { return V + (size_t)(64 * t) * 128; }
    __device__ __forceinline__ int kpitch() const { return 64; }
    __device__ __forceinline__ int vpitch() const { return 128; }
    __device__ __forceinline__ const float* biasptr(int) const { return nullptr; }
    __device__ __forceinline__ float bias_ref() const { return 0.f; }
};
struct WinPol {
    const bf16 *K, *V; int T, tq;
    __device__ __forceinline__ int first() const { return T; }
    __device__ __forceinline__ int next(int t) const { return (t - 1 >= 0 && t - 1 >= T - 8) ? t - 1 : -1; }
    __device__ __forceinline__ bool masked(int t) const { return t == T || t == T - 8; }
    __device__ __forceinline__ bool valid(int t, int kvl) const { const int d = tq - (64 * t + kvl); return d >= 0 && d < 512; }
    __device__ __forceinline__ bool wave_skip(int) const { return false; }
    __device__ __forceinline__ bool lane_valid(int) const { return true; }
    __device__ __forceinline__ const bf16* kptr(int t) const { return K + (size_t)(64 * t) * 128; }
    __device__ __forceinline__ const bf16* vptr(int t) const { return V + (size_t)(64 * t) * 128; }
    __device__ __forceinline__ int kpitch() const { return 128; }
    __device__ __forceinline__ int vpitch() const { return 128; }
    __device__ __forceinline__ const float* biasptr(int) const { return nullptr; }
    __device__ __forceinline__ float bias_ref() const { return 0.f; }
};
struct SelPol {
    const bf16 *K, *V; unsigned long long uni, mine; int T, tq;
    __device__ __forceinline__ int first() const { return 63 - __clzll(uni); }
    __device__ __forceinline__ int next(int t) const { const unsigned long long m = uni & ((1ull << t) - 1ull); return m ? 63 - __clzll(m) : -1; }
    __device__ __forceinline__ bool masked(int t) const { return t == T; }
    __device__ __forceinline__ bool valid(int t, int kvl) const { return 64 * t + kvl <= tq; }
    __device__ __forceinline__ bool wave_skip(int) const { return false; }
    __device__ __forceinline__ bool lane_valid(int t) const { return (mine >> t) & 1ull; }
    __device__ __forceinline__ const bf16* kptr(int t) const { return K + (size_t)(64 * t) * 128; }
    __device__ __forceinline__ const bf16* vptr(int t) const { return V + (size_t)(64 * t) * 128; }
    __device__ __forceinline__ int kpitch() const { return 128; }
    __device__ __forceinline__ int vpitch() const { return 128; }
    __device__ __forceinline__ const float* biasptr(int) const { return nullptr; }
    __device__ __forceinline__ float bias_ref() const { return 0.f; }
};

template <int NDB, class RowF> __device__ __forceinline__ void store_o(const AttnCtx& C, const f32x16 (&o)[NDB], bf16* dst, RowF rowoff) {
#pragma unroll
    for (int r = 0; r < 16; ++r) { const int q = crow(r, C.hi); bf16* p = dst + rowoff(q) + C.r32;
#pragma unroll
        for (int db = 0; db < NDB; ++db) p[32 * db] = (bf16)(cvtpk(o[db][r], 0.f) & 0xffffu); }
}

__device__ __forceinline__ void fox_unit(Frame& F0, int bh, int qb) {
    const AttnCtx C = make_ctx(F0.lds);
    struct { unsigned char* ws; } F; { unsigned long long w_ = (unsigned long long)F0.ws; asm volatile("" : "+s"(w_)); F.ws = (unsigned char*)w_; }
    const int b = bh >> 3, h = bh & 7, tq = 256 * qb + 32 * C.w + C.r32;
    const bf16* Q = WSP(bf16, WS_QF) + ((size_t)(b * SEQ + tq)) * 512 + h * 64;
    bf16x8 qf[4];
#pragma unroll
    for (int d0 = 0; d0 < 4; ++d0) qf[d0] = *(const bf16x8*)(Q + 16 * d0 + 8 * C.hi);
    const float* cum = WSP(float, WS_CUM) + (size_t)bh * SEQ;
    int tmin = 0;
    { float qn = 0.f;
#pragma unroll
      for (int d0 = 0; d0 < 4; ++d0)
#pragma unroll
          for (int j = 0; j < 8; ++j) { const float v = bf2f((unsigned short)qf[d0][j]); qn += v * v; }
      qn += __shfl_xor(qn, 32);
#pragma unroll
      for (int o = 16; o >= 1; o >>= 1) qn = fmaxf(qn, __shfl_xor(qn, o));
      LAS float* qmx = (LAS float*)(C.lds + AL_SELB);
      __syncthreads();
      if (C.lane == 0) qmx[C.w] = qn;
      __syncthreads();
      float qm = qmx[0];
#pragma unroll
      for (int i = 1; i < 8; ++i) qm = fmaxf(qm, qmx[i]);
      const float B = sqrtf(qm) * WSP(float, WS_KMAX)[bh];
      const float thr = -(40.0f + 2.0f * B), c0 = cum[256 * qb];
      const bool cond = (C.lane < 4 * qb) && (c0 - cum[64 * C.lane + 63] < thr);
      const unsigned long long bal = __ballot(cond);
      tmin = bal ? 64 - __clzll(bal) : 0; }
    FoxPol P{WSP(bf16, WS_KF) + (size_t)b * SEQ * 512 + h * 64, WSP(bf16, WS_VF) + (size_t)b * SEQ * 512 + h * 64, cum, cum[256 * qb + 255], qb, C.w, tq, tmin};
    f32x16 o[2];
    attn_core<64, 64, true>(C, P, qf, o);
    bf16* dst = WSP(bf16, WS_OBR) + (size_t)1 * NTOK * 512 + h * 64;
    const size_t rb = (size_t)(b * SEQ + 256 * qb + 32 * C.w);
    store_o<2>(C, o, dst, [&](int q) { return (rb + q) * 512; });
}
__device__ __forceinline__ void mem_unit(Frame& F0, int bh, int qb) {
    const AttnCtx C = make_ctx(F0.lds);
    struct { unsigned char* ws; } F; { unsigned long long w_ = (unsigned long long)F0.ws; asm volatile("" : "+s"(w_)); F.ws = (unsigned char*)w_; }
    const int b = bh >> 2, h = bh & 3, tq = 256 * qb + 32 * C.w + C.r32;
    const bf16* Q = WSP(bf16, WS_QM) + ((size_t)(b * SEQ + tq)) * 512 + h * 128;
    bf16x8 qf[8];
#pragma unroll
    for (int d0 = 0; d0 < 8; ++d0) qf[d0] = *(const bf16x8*)(Q + 16 * d0 + 8 * C.hi);
    MemPol P{WSP(bf16, WS_KMEM) + (size_t)b * MEMLEN * 512 + h * 128, WSP(bf16, WS_VMEM) + (size_t)b * MEMLEN * 512 + h * 128};
    f32x16 o[4];
    attn_core<128, 128, false>(C, P, qf, o);
    bf16* dst = WSP(bf16, WS_OBR) + (size_t)2 * NTOK * 512 + h * 128;
    const size_t rb = (size_t)(b * SEQ + 256 * qb + 32 * C.w);
    store_o<4>(C, o, dst, [&](int q) { return (rb + q) * 512; });
}
__device__ __forceinline__ void nsa_unit(Frame& F0, int bg, int T, int parts) {
    const AttnCtx C = make_ctx(F0.lds);
    struct { unsigned char* ws; } F; { unsigned long long w_ = (unsigned long long)F0.ws; asm volatile("" : "+s"(w_)); F.ws = (unsigned char*)w_; }
    const int b = bg >> 1, g = bg & 1, q = C.r32, tokl = 8 * C.w + (q >> 2), tq = 64 * T + tokl, head = 4 * g + (q & 3);
    const bf16* Q = WSP(bf16, WS_QA) + ((size_t)(b * SEQ + tq)) * 512 + head * 64;
    bf16x8 qf[4];
#pragma unroll
    for (int d0 = 0; d0 < 4; ++d0) qf[d0] = *(const bf16x8*)(Q + 16 * d0 + 8 * C.hi);
    const float* lg = WSP(float, WS_LG) + (size_t)(b * SEQ + tq) * 32 + head * 3;
    LAS float* oacc = (LAS float*)(C.lds + AL_OACC) + C.w * 2048 + C.lane;
    LAS float* imp = (LAS float*)(C.lds + AL_IMP);
    LAS unsigned long long* selb = (LAS unsigned long long*)(C.lds + AL_SELB);
    LAS unsigned long long* unip = (LAS unsigned long long*)(C.lds + AL_UNI);
#ifndef NSA_CORES
#define NSA_CORES 7
#endif
    if (NSA_CORES & 1) {
        CmpPol P{WSP(bf16, WS_KCMP) + (size_t)bg * 256 * 64, WSP(bf16, WS_VCMP) + (size_t)bg * 256 * 128, (4 * T + 2) / 64 + 1, tq};
        f32x16 o2[2];
        attn_core<64, 64, false>(C, P, qf, o2);
        scale_rows<2>(C, o2, (parts & 1) ? fast_sigmoid(lg[0]) : 0.f, 0);
#pragma unroll
        for (int db = 0; db < 2; ++db)
#pragma unroll
            for (int r = 0; r < 16; ++r) oacc[(db * 16 + r) * 64] = o2[db][r];
        P.V += 64;
        attn_core<64, 64, false>(C, P, qf, o2);
#pragma unroll
        for (int db = 0; db < 2; ++db)
#pragma unroll
            for (int rg = 0; rg < 4; ++rg) imp[(8 * C.w + 2 * rg + C.hi) * 65 + 32 * db + C.r32] = (o2[db][4 * rg] + o2[db][4 * rg + 1]) + (o2[db][4 * rg + 2] + o2[db][4 * rg + 3]);
    }
    __syncthreads();
    {
        const int tk = C.tid >> 3, sub = C.tid & 7;
        float mine[8]; int rank[8];
#pragma unroll
        for (int i = 0; i < 8; ++i) { const int j = 8 * sub + i; const float v = imp[tk * 65 + j];
            mine[i] = (j == 0 || j == T || j == T - 1) ? 1e4f : (j > T ? -1e4f : v); rank[i] = 0; }
        for (int jj = 0; jj < 64; ++jj) { const float v0 = imp[tk * 65 + jj]; const float v = (jj == 0 || jj == T || jj == T - 1) ? 1e4f : (jj > T ? -1e4f : v0);
#pragma unroll
            for (int i = 0; i < 8; ++i) { const int j = 8 * sub + i; rank[i] += (v > mine[i] || (v == mine[i] && jj < j)) ? 1 : 0; } }
        unsigned byte = 0;
#pragma unroll
        for (int i = 0; i < 8; ++i) { const int j = 8 * sub + i; if (rank[i] < 16 && j <= T) byte |= 1u << i; }
        ((LAS unsigned char*)selb)[tk * 8 + sub] = (unsigned char)byte;
    }
    __syncthreads();
    if (C.w == 0) { unsigned long long m = selb[C.lane]; unsigned lo = (unsigned)m, hh = (unsigned)(m >> 32);
#pragma unroll
        for (int o = 1; o < 64; o <<= 1) { lo |= __shfl_xor(lo, o); hh |= __shfl_xor(hh, o); }
        if (C.lane == 0) unip[0] = ((unsigned long long)hh << 32) | lo; }
    __syncthreads();
    const unsigned long long mymask = selb[tokl]; unsigned long long uni = unip[0];
    uni = ((unsigned long long)__builtin_amdgcn_readfirstlane((unsigned)(uni >> 32)) << 32) | (unsigned)__builtin_amdgcn_readfirstlane((unsigned)uni);
    if (NSA_CORES & 2) {
        SelPol P{WSP(bf16, WS_KV6) + (size_t)2 * NTOK * 128 + (size_t)b * SEQ * 128 + g * 64, WSP(bf16, WS_KV6) + (size_t)3 * NTOK * 128 + (size_t)b * SEQ * 128 + g * 64, uni, mymask, T, tq};
        f32x16 o2[2];
        attn_core<64, 64, false>(C, P, qf, o2);
        scale_rows<2>(C, o2, (parts & 2) ? fast_sigmoid(lg[1]) : 0.f, 0);
#pragma unroll
        for (int db = 0; db < 2; ++db)
#pragma unroll
            for (int r = 0; r < 16; ++r) oacc[(db * 16 + r) * 64] += o2[db][r];
    }
    if (NSA_CORES & 4) {
        WinPol P{WSP(bf16, WS_KV6) + (size_t)4 * NTOK * 128 + (size_t)b * SEQ * 128 + g * 64, WSP(bf16, WS_KV6) + (size_t)5 * NTOK * 128 + (size_t)b * SEQ * 128 + g * 64, T, tq};
        f32x16 o2[2];
        attn_core<64, 64, false>(C, P, qf, o2);
        scale_rows<2>(C, o2, (parts & 4) ? fast_sigmoid(lg[2]) : 0.f, 0);
#pragma unroll
        for (int db = 0; db < 2; ++db)
#pragma unroll
            for (int r = 0; r < 16; ++r) o2[db][r] += oacc[(db * 16 + r) * 64];
        bf16* dst = WSP(bf16, WS_OBR) + g * 256;
        const size_t rb = (size_t)(b * SEQ + 64 * T + 8 * C.w);
        store_o<2>(C, o2, dst, [&](int qq) { return (rb + (qq >> 2)) * 512 + (qq & 3) * 64; });
    }
}

__device__ __forceinline__ void p3_phase(Frame& F, int parts, int rep) {
    LAS int* ticket = (LAS int*)(F.lds + AL_TICKET);
    unsigned* ctl = WSP(unsigned, WS_CTL);
    unsigned* qhead = ctl + CW_QATTN + 64 * rep; const unsigned* order = WSP(unsigned, WS_ORDER);
    for (;;) {
        __syncthreads();
        if (F.tid == 0) ticket[0] = (int)atomicAdd(qhead, 1u);
        __syncthreads();
        const int tk = __builtin_amdgcn_readfirstlane(ticket[0]);
        if (tk >= N_QUEUE) break;
        const unsigned d = __builtin_amdgcn_readfirstlane(order[tk]); const int type = d & 7, a = (d >> 3) & 255, bb = d >> 11;
#ifdef REP_ATTN_ONLY
        if (rep > 0 && type >= 3) continue;
#endif
#ifdef REP_CVT_ONLY
        if (rep > 0 && type != 5) continue;
#endif
        if (type == 0) { q_wait(ctl + CW_CMPDONE + 64 * a, 16u, F.tid); nsa_unit(F, a, bb, parts); }
        else if (type == 1) { q_wait(ctl + CW_CUMDONE + 64 * (a >> 3), 1u, F.tid); fox_unit(F, a, bb); }
        else if (type == 2) mem_unit(F, a, bb);
#ifndef QDIS
#define QDIS 0
#endif
        else if (type == 3) { if (!(QDIS & 1)) p2_compress_unit(F, a, bb); q_signal(ctl + CW_CMPDONE + 64 * (bb >> 3), F.tid); }
        else if (type == 4) { if (!(QDIS & 2)) p2_cumsum_unit(F, 8 * a + F.wave); q_signal(ctl + CW_CUMDONE + 64 * a, F.tid); }
        else { if (!(QDIS & 4)) convert_unit(F, bb); }
    }
}
#define XB_TMO      128
#define XB_XCNT(j)  (256  + 64 * (j))
#define XB_XSUB(j)  (1280 + 64 * (j))
#define XB_XGEN(j)  (2304 + 64 * (j))
#define XB_TOP      3328
#define XB_TOPGEN   3392
#define XCD_BAR_WORDS 3456
#define XB_SPIN_CAP (1u << 18)

__device__ __forceinline__ unsigned xb_ld(unsigned* p)              { return __hip_atomic_load(p, __ATOMIC_RELAXED, __HIP_MEMORY_SCOPE_AGENT); }
__device__ __forceinline__ unsigned xb_add(unsigned* p, unsigned v) { return __hip_atomic_fetch_add(p, v, __ATOMIC_RELAXED, __HIP_MEMORY_SCOPE_AGENT); }
__device__ __forceinline__ unsigned xb_xcc_id() { return (unsigned)__builtin_amdgcn_s_getreg((3 << 11) | 20) & 0xFu; }
#define XB_SPIN(cond, bar) do { unsigned _sp = 0; while (cond) { __builtin_amdgcn_s_sleep(1); \
    if ((++_sp & 255u) == 0u) { if (xb_ld(&(bar)[XB_TMO])) break; if (_sp > XB_SPIN_CAP) { atomicAdd(&(bar)[XB_TMO], 1u); break; } } } } while (0)

struct XcdBarrier {
    unsigned* bar; unsigned x;
    volatile LAS unsigned* st;
};

__device__ __forceinline__ XcdBarrier xcd_barrier_post(unsigned* bar, volatile LAS unsigned* st) {
    XcdBarrier b; b.bar = bar; b.x = xb_xcc_id(); b.st = st;
    if (threadIdx.x == 0) (void)xb_add(&bar[XB_XCNT(b.x)], 1u);
    return b;
}
__device__ __forceinline__ void xcd_barrier_complete(unsigned* bar, unsigned x, unsigned& nloc, unsigned& nx) {
    const unsigned G = gridDim.x * gridDim.y * gridDim.z;
    unsigned sum, cnt, mine, sp = 0u;
    for (;;) {
        sum = 0u; cnt = 0u; mine = 0u;
#pragma unroll
        for (unsigned j = 0; j < 16; ++j) { const unsigned c = xb_ld(&bar[XB_XCNT(j)]); sum += c; cnt += (c > 0u) ? 1u : 0u; mine = (j == x) ? c : mine; }
        if (sum == G) break;
        __builtin_amdgcn_s_sleep(1);
        if ((++sp & 255u) == 0u) { if (xb_ld(&bar[XB_TMO])) break; if (sp > XB_SPIN_CAP) { atomicAdd(&bar[XB_TMO], 1u); break; } }
    }
    nloc = mine > 0u ? mine : 1u; nx = cnt > 0u ? cnt : 1u;
}

__device__ __forceinline__ void xcd_barrier(const XcdBarrier& b) {
    asm volatile("s_waitcnt vmcnt(0)" ::: "memory");
    __syncthreads();
    if (threadIdx.x == 0) {
        unsigned* bar = b.bar;
        __builtin_amdgcn_s_waitcnt(0);
        unsigned nloc = b.st[0], nx = b.st[1];
        if (nloc == 0u) { xcd_barrier_complete(bar, b.x, nloc, nx); b.st[0] = nloc; b.st[1] = nx; }
        const unsigned old = xb_add(&bar[XB_XSUB(b.x)], 1u);
        const unsigned gen = old / nloc;
        if (old + 1u == (gen + 1u) * nloc) {
            __builtin_amdgcn_fence(__ATOMIC_RELEASE, "agent");
            asm volatile("s_waitcnt vmcnt(0)" ::: "memory");
            const unsigned og = xb_add(&bar[XB_TOP], 1u);
            const unsigned tg = og / nx;
            if (og + 1u == (tg + 1u) * nx) xb_add(&bar[XB_TOPGEN], 1u);
            else XB_SPIN(xb_ld(&bar[XB_TOPGEN]) == tg, bar);
            __builtin_amdgcn_fence(__ATOMIC_ACQUIRE, "agent");
            xb_add(&bar[XB_XGEN(b.x)], 1u);
            asm volatile("s_waitcnt vmcnt(0)" ::: "memory");
        } else {
            XB_SPIN(xb_ld(&bar[XB_XGEN(b.x)]) == gen, bar);
            __builtin_amdgcn_fence(__ATOMIC_ACQUIRE, "agent");
            asm volatile("s_waitcnt vmcnt(0)" ::: "memory");
        }
    }
    __syncthreads();
}
#ifndef ABL_PARTS
#define ABL_PARTS 31
#endif
#ifndef PH_MAX
#define PH_MAX 10
#endif
typedef KArgs Args;
static_assert(sizeof(Args) == 26 * 8 + 8 + 8 + 8, "Args has no padding");

__global__ void __launch_bounds__(NTHREADS, 2) fwd_megakernel(Args args) {
    extern __shared__ __attribute__((aligned(16))) unsigned char lds_raw[];
    Frame F;
    F.lds = (LAS unsigned char*)lds_raw;
    F.tid = threadIdx.x; F.lane = F.tid & 63; F.wave = __builtin_amdgcn_readfirstlane(F.tid >> 6);
    F.G = gridDim.x; F.bid = blockIdx.x; F.vcu = (F.G % 8 == 0) ? (F.bid % 8) * (F.G / 8) + F.bid / 8 : F.bid;
    F.ka = (const KArgs __attribute__((address_space(4)))*)__builtin_amdgcn_kernarg_segment_ptr();
    F.out = args.out; F.ws = args.ws;
    const int lo = args.ph_lo, hi = args.ph_hi;
    volatile LAS unsigned* xst = (volatile LAS unsigned*)(F.lds + LDS_BYTES - 64);
    if (F.tid < 2) xst[F.tid] = 0u;
    __syncthreads();
    XcdBarrier xbar = xcd_barrier_post((unsigned*)(F.ws + WS_CTL) + CW_XBAR, xst);
#ifndef PHASE_MASK
#define PHASE_MASK 0x7ff
#endif
#define IN(k) (((PHASE_MASK >> (k)) & 1) && lo <= (k) && (k) < hi)
#ifndef REP_MASK
#define REP_MASK 0
#endif
#define REPS(k) for (int rep_ = 0; rep_ < 1 + ((REP_MASK >> (k)) & 1); ++rep_)
#define SEAM(k) do { if (lo <= (k) && (k) + 1 < hi) { xcd_barrier(xbar); } } while (0)
#define FIT_GRID(n) ((F.G % 8 == 0) ? ({ const int n_ = (n), R_ = (n_ + F.G - 1) / F.G, g_ = 8 * (((n_ + R_ - 1) / R_ + 7) / 8); g_ < F.G ? g_ : F.G; }) : F.G)

    if (IN(0)) REPS(0) p0_prologue(F);
    SEAM(0);
    if (IN(1)) REPS(1) {
        const int g1 = FIT_GRID(1680);
        if (F.bid < g1) {
        SchedIn S{(const char*)(F.ws + WS_HA), (const char*)(F.ws + WS_WIN_T), g1, F.bid};
        EpiIn E{WSP(bf16, WS_QA), WSP(bf16, WS_KV6), WSP(bf16, WS_QF), WSP(bf16, WS_KF), WSP(bf16, WS_VF), WSP(bf16, WS_QM), WSP(bf16, WS_GATES), WSP(bf16, WS_KMEM), WSP(bf16, WS_VMEM), WSP(float, WS_LG),
                WSP(float, WS_ROPE_C), WSP(float, WS_ROPE_S), F.ka->in[5]};
        pg8::gemm_phase<false>(F.lds, 1024, S, E);
        }
    }
    SEAM(1);
    if (IN(3)) REPS(3) p3_phase(F, ABL_PARTS, rep_);
    SEAM(3);
    if (IN(4)) REPS(4) {
        SchedBr S{(const char*)(F.ws + WS_OBR), (const char*)(F.ws + WS_WBR_T), F.G, F.bid};
        EpiBr E{WSP(bf16, WS_GATES), WSP(bf16, WS_MERGED)};
        pg8::gemm_phase<false>(F.lds, 512, S, E);
    }
    SEAM(4);
    if (IN(5)) REPS(5) {
        SchedOut S{(const char*)(F.ws + WS_MERGED), (const char*)(F.ws + WS_WOUT_T), F.G, F.bid};
        EpiOut E{F.ka->in[0], F.out, WSP(unsigned char, WS_H2)};
        pg8::gemm_phase<false>(F.lds, 1024, S, E);
    }
    SEAM(5);
    if (IN(6)) REPS(6) p6_phase(F);
    SEAM(6);
    const bool moe_split = (F.G % 8 == 0);
    const LAS int* te = (const LAS int*)(F.lds + MT_OFF);
    if (IN(8)) REPS(8) {
        { LAS int* mt = (LAS int*)(F.lds + MT_OFF);
          if (F.tid < 64) { const int e = F.tid & 31; const int c = (int)__hip_atomic_load(WSP(unsigned, WS_CTL) + CW_GCNT + 32 * e, __ATOMIC_RELAXED, __HIP_MEMORY_SCOPE_AGENT);
              const int padc = (c + 255) & ~255; int inc = padc;
#pragma unroll
              for (int o = 1; o < 32; o <<= 1) { const int up = __shfl_up(inc, o); if (e >= o) inc += up; }
              const int start = inc - padc;
              if (F.tid < 32) { mt[320 + e] = start; mt[352 + e] = c; for (int q = 0; q < (padc >> 8); ++q) mt[(start >> 8) + q] = e | (q << 5); if (e == 31) mt[300] = inc >> 8; } }
          __syncthreads(); }
        const int nmt = __builtin_amdgcn_readfirstlane(te[300]), F8 = moe_split ? (nmt * 8) / F.G : (1 << 20);
        SchedMoE<true> S{(const char*)(F.ws + WS_H2), (const char*)(F.ws + WS_WGU_T), te, WSP(int, WS_ETOK), nmt, 8, F.G, F.vcu, (size_t)2048 * 1024, 0, F8};
        EpiGU E{F.ka->in[22], te, WSP(unsigned char, WS_ACT), WSP(float, WS_ERSTD)};
        pg8::gemm_phase<true>(F.lds, 512, S, E);
    }
    SEAM(8);
    if (IN(9)) REPS(9) {
        unsigned* done8 = WSP(unsigned, WS_CTL) + CW_DONE8;
        const int nmt = __builtin_amdgcn_readfirstlane(te[300]), n9 = nmt * 4, F8 = moe_split ? (nmt * 8) / F.G : (1 << 20), T = moe_split ? nmt * 8 - F8 * F.G : 0, v = F.vcu;
        if (v < T) {
            SchedMoE<true> S{(const char*)(F.ws + WS_H2), (const char*)(F.ws + WS_WGU_T), te, WSP(int, WS_ETOK), nmt, 8, F.G, v, (size_t)2048 * 1024, F8, F8 + 1};
            EpiGU E{F.ka->in[22], te, WSP(unsigned char, WS_ACT), WSP(float, WS_ERSTD)};
            pg8::gemm_phase<true>(F.lds, 512, S, E);
            if (F.tid == 0) { __builtin_amdgcn_fence(__ATOMIC_RELEASE, "agent"); asm volatile("s_waitcnt vmcnt(0)" ::: "memory");
                __hip_atomic_fetch_add(done8 + ((F8 * F.G + v) >> 3), 1u, __ATOMIC_RELAXED, __HIP_MEMORY_SCOPE_AGENT); }
        }
        const int vb = v - T + (v < T ? F.G : 0), pmT = moe_split ? (F8 * F.G) / 8 : (1 << 20), lim = n9 < 4 * pmT ? n9 : 4 * pmT;
        const int nseg1 = vb < lim ? (lim - 1 - vb) / F.G + 1 : 0;
        EpiDn E{F.ka->in[24], te, WSP(bf16, WS_AMOE)};
        { SchedMoE<false> S{(const char*)(F.ws + WS_ACT), (const char*)(F.ws + WS_WD_T), te, nullptr, nmt, 4, F.G, vb, (size_t)1024 * 1024, 0, nseg1};
          pg8::gemm_phase<true>(F.lds, 512, S, E); }
        if (nseg1 * F.G + vb < n9) {
            for (int L = nseg1 * F.G + vb; L < n9; L += F.G) q_wait(done8 + (L >> 2), 8u, F.tid);
            SchedMoE<false> S{(const char*)(F.ws + WS_ACT), (const char*)(F.ws + WS_WD_T), te, nullptr, nmt, 4, F.G, vb, (size_t)1024 * 1024, nseg1, 1 << 20};
            pg8::gemm_phase<true>(F.lds, 512, S, E);
        }
    }
    SEAM(9);
    if (IN(10)) { if ((REP_MASK >> 10) & 1) p10_phase(F, PH_MAX >= 9, WSP(float, WS_GATES)); p10_phase(F, PH_MAX >= 9, F.out); }
#undef IN
#undef SEAM
}

extern "C" void kernel_launch(void* const* d_in, const int* in_sizes, int n_in, void* d_out, int out_size, void* d_ws, size_t ws_size, hipStream_t stream) {
    static int grid = 0;
    if (grid == 0) {
        if (n_in != 26 || out_size != NTOK * DM || ws_size < WS_END) { fprintf(stderr, "kernel_launch: unexpected sizes n_in %d out %d ws %zu (need %zu)\n", n_in, out_size, ws_size, (size_t)WS_END); grid = -1; return; }
        int dev = 0, cus = 0, per_cu = 0;
        hipGetDevice(&dev); hipDeviceGetAttribute(&cus, hipDeviceAttributeMultiprocessorCount, dev);
        if (hipFuncSetAttribute((const void*)fwd_megakernel, hipFuncAttributeMaxDynamicSharedMemorySize, LDS_BYTES) != hipSuccess) { fprintf(stderr, "kernel_launch: hipFuncSetAttribute failed\n"); grid = -1; return; }
        if (hipOccupancyMaxActiveBlocksPerMultiprocessor(&per_cu, (const void*)fwd_megakernel, NTHREADS, LDS_BYTES) != hipSuccess || per_cu < 1) { fprintf(stderr, "kernel_launch: occupancy query says %d\n", per_cu); per_cu = 1; }
        (void)hipGetLastError();
        grid = cus * 1;
        if (grid > 256) grid = 256;
    }
    if (grid < 0) return;
    (void)hipMemsetAsync((char*)d_ws + WS_CTL, 0, CTL_BYTES, stream);
    Args a{};
    for (int i = 0; i < 26; ++i) a.in[i] = (const float*)d_in[i];
    a.out = (float*)d_out; a.ws = (unsigned char*)d_ws;
#if defined(MULTI_LAUNCH)
    for (int p = 0; p <= 10; ++p) { if (p > PH_MAX && p != 10) continue; a.ph_lo = p; a.ph_hi = p + 1; hipLaunchKernelGGL(fwd_megakernel, dim3(grid), dim3(NTHREADS), LDS_BYTES, stream, a); }
#else
    a.ph_lo = 0; a.ph_hi = 11;
    hipLaunchKernelGGL(fwd_megakernel, dim3(grid), dim3(NTHREADS), LDS_BYTES, stream, a);
#endif
}
```

```cpp
#include <hip/hip_runtime.h>
#include <hip/hip_cooperative_groups.h>
#include <cstdio>
#include <cstdint>
#include <cmath>
namespace cg = cooperative_groups;

#define LAS __attribute__((address_space(3)))
typedef unsigned short bf16;
typedef short bf16x8 __attribute__((ext_vector_type(8)));
typedef short s16x4 __attribute__((ext_vector_type(4)));
typedef float f32x4 __attribute__((ext_vector_type(4)));
typedef float f32x2 __attribute__((ext_vector_type(2)));
typedef float f32x16 __attribute__((ext_vector_type(16)));
typedef unsigned u32x4 __attribute__((ext_vector_type(4)));
typedef unsigned u32x2 __attribute__((ext_vector_type(2)));
typedef __bf16 bf16x2_t __attribute__((ext_vector_type(2)));

constexpr int NB = 4, SEQ = 4096, DM = 1024, NTOK = NB * SEQ;
constexpr int DIN = 6432, NIN = 6656;
constexpr int MEMLEN = 256, NMEMROW = NB * MEMLEN;
constexpr int NEXP = 32, TOPK = 4, FEXP = 1024;
constexpr int MAXSLOT = NTOK * TOPK + NEXP * 256;
constexpr float RMS_EPS = 1e-5f;
constexpr float LOG2E = 1.4426950408889634f;
constexpr float C2_64 = 0.125f * LOG2E;
constexpr float C2_128 = 0.08838834764831845f * LOG2E;
constexpr float NEGBIG = -1e30f;
constexpr float W8_SCALE = 32.0f, ACT8_SCALE = 4.0f;

constexpr size_t MiB = 1u << 20;
constexpr size_t WS_CTL = 0;
constexpr size_t CTL_BYTES = 64 * 1024;
constexpr size_t WS_ROPE_C = 1 * MiB, WS_ROPE_S = WS_ROPE_C + 512 * 1024;
constexpr size_t WS_W1T_K = 2 * MiB, WS_W1T_V = WS_W1T_K + 256 * 1024;
constexpr size_t WS_W2T_K = WS_W1T_V + 256 * 1024, WS_W2T_V = WS_W2T_K + 8192;
constexpr size_t WS_CPE = WS_W2T_V + 8192;
constexpr size_t WS_KCMP = 3 * MiB;
constexpr size_t WS_VCMP = WS_KCMP + 256 * 1024;
constexpr size_t WS_CUM = 4 * MiB;
constexpr size_t WS_KMAX = 4 * MiB + 512 * 1024;
constexpr size_t WS_KMEM = 5 * MiB, WS_VMEM = 6 * MiB;
constexpr size_t WS_ORDER = 7 * MiB;
constexpr size_t WS_BLKCNT = 7 * MiB + 64 * 1024;
constexpr size_t WS_TILE_E = 7 * MiB + 128 * 1024;
constexpr size_t WS_WRT = 7 * MiB + 256 * 1024;
constexpr size_t WS_RSTD = 7 * MiB + 512 * 1024;
constexpr size_t WS_RSLOT = 8 * MiB;
constexpr size_t WS_SLOTTOK = 8 * MiB + 512 * 1024;
constexpr size_t WS_WIN_T = 9 * MiB;
constexpr size_t WS_WBR_T = 24 * MiB;
constexpr size_t WS_WOUT_T = 27 * MiB;
constexpr size_t WS_WGU_T = 32 * MiB;
constexpr size_t WS_WD_T = 160 * MiB;
constexpr size_t WS_HA = 224 * MiB;
constexpr size_t WS_ETOK = 224 * MiB, WS_ERSTD = 226 * MiB;
constexpr int MT_OFF = 131072;
constexpr size_t WS_QA = 258 * MiB;
constexpr size_t WS_KV6 = 274 * MiB;
constexpr size_t WS_QM = 298 * MiB;
constexpr size_t WS_LG = 314 * MiB;
constexpr size_t WS_GATES = 316 * MiB;
constexpr size_t WS_QF = 412 * MiB, WS_KF = 428 * MiB, WS_VF = 444 * MiB;
constexpr size_t WS_ACT = 316 * MiB;
constexpr size_t WS_OBR = 460 * MiB;
constexpr size_t WS_MERGED = 508 * MiB;
constexpr size_t WS_H2 = 540 * MiB;
constexpr size_t WS_ROUTE = 572 * MiB;
constexpr size_t WS_AMOE = 576 * MiB;
constexpr size_t WS_END = 720 * MiB;
static_assert(WS_ACT + (size_t)MAXSLOT * 1024 * 2 <= WS_OBR && WS_AMOE + (size_t)MAXSLOT * 1024 * 2 <= WS_END, "ws map");
constexpr int CW_QATTN = 64;
constexpr int CW_DONE8 = 12288;
constexpr int CW_GCNT = 9216;
constexpr int CW_XBAR = 1024;

constexpr int LDS_BYTES = 155648;
constexpr int NWAVES = 8, NTHREADS = 512;

__device__ __forceinline__ unsigned cvtpk(float lo, float hi) { f32x2 v = {lo, hi}; bf16x2_t b = __builtin_convertvector(v, bf16x2_t); return __builtin_bit_cast(unsigned, b); }
__device__ __forceinline__ float bf2f(unsigned short h) { return __builtin_bit_cast(float, (unsigned)h << 16); }
__device__ __forceinline__ float bflo(unsigned u) { return __builtin_bit_cast(float, u << 16); }
__device__ __forceinline__ float bfhi(unsigned u) { return __builtin_bit_cast(float, u & 0xffff0000u); }
__device__ __forceinline__ float wave_sum(float v) {
#pragma unroll
    for (int o = 1; o < 64; o <<= 1) v += __shfl_xor(v, o);
    return v;
}
__device__ __forceinline__ float fast_sigmoid(float x) { return __builtin_amdgcn_rcpf(1.0f + __builtin_amdgcn_exp2f(-LOG2E * x)); }
__device__ __forceinline__ unsigned pk_fp8x4(float a, float b, float c, float d) {
    a = fminf(fmaxf(a, -448.f), 448.f); b = fminf(fmaxf(b, -448.f), 448.f); c = fminf(fmaxf(c, -448.f), 448.f); d = fminf(fmaxf(d, -448.f), 448.f);
    int p = __builtin_amdgcn_cvt_pk_fp8_f32(a, b, 0, false); p = __builtin_amdgcn_cvt_pk_fp8_f32(c, d, p, true); return (unsigned)p;
}
namespace pg8 {
#define PG8_LAS __attribute__((address_space(3)))
typedef unsigned short bf16_t;
typedef short bf16x8 __attribute__((ext_vector_type(8)));
typedef float f32x4 __attribute__((ext_vector_type(4)));
typedef unsigned u32x4 __attribute__((ext_vector_type(4)));
typedef unsigned u32x2 __attribute__((ext_vector_type(2)));
typedef int i32x8 __attribute__((ext_vector_type(8)));
typedef int i32x4 __attribute__((ext_vector_type(4)));
constexpr int BM = 256, BK = 64, HALF = 128, HTB = HALF * BK * 2  , STAGE_BYTES = 8 * HTB;

__host__ __device__ __forceinline__ int lds_byte(int r, int c) { const int st = (r >> 4) * 2 + (c >> 5), rr = r & 15, cc = c & 31, ob = rr * 64 + cc * 2; return st * 1024 + (ob ^ (((ob >> 9) & 1) << 5)); }
__host__ __device__ __forceinline__ void stage_rc(int b, int& R, int& C) { const int st = b / 1024, sb = b % 1024, swz = sb ^ (((sb >> 9) & 1) << 5); R = (st >> 1) * 16 + swz / 64; C = (st & 1) * 32 + (swz % 64) / 2; }
__host__ __device__ __forceinline__ int perm32(int rho) { const int n = rho >> 4, i = rho & 15; return 8 * (i >> 2) + 4 * n + (i & 3); }

struct Unit { int pm, pn; };

template <bool F8, class Epi, class Sched>
__device__ __forceinline__ void gemm_phase(PG8_LAS unsigned char* lds, const int K, const Sched& S, const Epi& E) {
    const int tid = threadIdx.x, wid = __builtin_amdgcn_readfirstlane(tid >> 6), lane = tid & 63, wr = wid >> 2, wc = wid & 3, fr = lane & 15, fq = lane >> 4;
    const int nt = K / BK;
    unsigned voffB[2]; int RA[2], CA[2];
    { int R, C; stage_rc(tid * 16, R, C); const int Rb = (R & ~31) + perm32(R & 31);
      RA[0] = R; CA[0] = C; RA[1] = R + 64; CA[1] = C; voffB[0] = (unsigned)(Rb * K + C) * 2u; voffB[1] = voffB[0] + (unsigned)(64 * K * 2); }
    constexpr bool GATHER = Sched::GATHER;
    unsigned cofA[2][2], nofA[2][2];
#define PG8_AOFF(dst, u) do { _Pragma("unroll") for (int h_ = 0; h_ < 2; ++h_) _Pragma("unroll") for (int i_ = 0; i_ < 2; ++i_) dst[h_][i_] = S.a_voff(u, h_, RA[i_], CA[i_], K); } while (0)
    const size_t kstep = (size_t)(BK * 2);
    const size_t hstep = (size_t)HALF * K * 2;
    const unsigned ldsw = (unsigned)wid * 1024u;
    const int aoff = lds_byte(wr * 64 + fr, fq * 8), boff = lds_byte(wc * 32 + fr, fq * 8);
    const int aoff8 = lds_byte(wr * 64 + fr, fq * 16) + 16 * (fq & 1), boff8 = lds_byte(wc * 32 + fr, fq * 16) + 16 * (fq & 1), aoff8x = aoff8 ^ 16, boff8x = boff8 ^ 16;
#define PG8_SA(b, h) (((b) * 2 + (h)) * HTB)
#define PG8_SB(b, h) ((4 + (b) * 2 + (h)) * HTB)
#define PG8_STAGE(bufoff, gbase, voff) do { _Pragma("unroll") for (int _i = 0; _i < 2; ++_i) \
        __builtin_amdgcn_global_load_lds((const unsigned*)((const char*)(gbase) + (voff)[_i]), (PG8_LAS unsigned*)(lds + (bufoff) + ldsw + _i * 8192), 16, 0, 0); } while (0)
#define PG8_LDA(dst, b, h) do { _Pragma("unroll") for (int m = 0; m < 4; ++m) _Pragma("unroll") for (int k = 0; k < 2; ++k) dst[m][k] = *(const PG8_LAS bf16x8*)(lds + PG8_SA(b, h) + aoff + m * 2048 + k * 1024); } while (0)
#define PG8_LDB(dst, b, h) do { _Pragma("unroll") for (int n = 0; n < 2; ++n) _Pragma("unroll") for (int k = 0; k < 2; ++k) dst[n][k] = *(const PG8_LAS bf16x8*)(lds + PG8_SB(b, h) + boff + n * 2048 + k * 1024); } while (0)
#define PG8_MMA(ai, bj, At, Bt) do { __builtin_amdgcn_s_setprio(1); _Pragma("unroll") for (int m = 0; m < 4; ++m) _Pragma("unroll") for (int n = 0; n < 2; ++n) _Pragma("unroll") for (int k = 0; k < 2; ++k) \
        acc[ai][bj][m][n] = __builtin_amdgcn_mfma_f32_16x16x32_bf16(Bt[n][k], At[m][k], acc[ai][bj][m][n], 0, 0, 0); __builtin_amdgcn_s_setprio(0); } while (0)
#define PG8_LD8(dst, base, o0, cnt) do { _Pragma("unroll") for (int q_ = 0; q_ < cnt; ++q_) { const i32x4 lo_ = *(const PG8_LAS i32x4*)(lds + (base) + (o0) + q_ * 2048), hi_ = *(const PG8_LAS i32x4*)(lds + (base) + (o0##x) + q_ * 2048); \
        dst[q_] = (i32x8){lo_[0], lo_[1], lo_[2], lo_[3], hi_[0], hi_[1], hi_[2], hi_[3]}; } } while (0)
#define PG8_MMA8(ai, bj, At, Bt) do { __builtin_amdgcn_s_setprio(1); _Pragma("unroll") for (int m = 0; m < 4; ++m) _Pragma("unroll") for (int n = 0; n < 2; ++n) \
        asm volatile("v_mfma_scale_f32_16x16x128_f8f6f4 %0, %1, %2, %0, %3, %3 op_sel_hi:[0,0,0]" : "+v"(acc[ai][bj][m][n]) : "v"(Bt[n]), "v"(At[m]), "v"(sc8)); asm volatile("s_nop 7" ::: "memory"); __builtin_amdgcn_s_setprio(0); } while (0)
#define PG8_WAIT_V(n) asm volatile("s_waitcnt vmcnt(" #n ")" ::: "memory")
#define PG8_WAIT_L(n) asm volatile("s_waitcnt lgkmcnt(" #n ")" ::: "memory")
#define PG8_BAR __builtin_amdgcn_s_barrier()
#define PG8_SCHED __builtin_amdgcn_sched_barrier(0)
    Unit cur, nxt; int ui = 0;
    if (!S.next(0, cur)) return;
    f32x4 acc[2][2][4][2];
#pragma unroll
    for (int a = 0; a < 2; ++a)
#pragma unroll
        for (int b = 0; b < 2; ++b)
#pragma unroll
            for (int m = 0; m < 4; ++m)
#pragma unroll
                for (int n = 0; n < 2; ++n) acc[a][b][m][n] = (f32x4){0.f, 0.f, 0.f, 0.f};
    bf16x8 At[4][2], B0[2][2], B1[2][2]; i32x8 At8[4], B08[2], B18[2]; int sc8 = 0x7f7f7f7f; asm volatile("" : "+v"(sc8));
    const char* cA = S.a_base(cur); const char* cB = S.b_base(cur);
    PG8_AOFF(cofA, cur);
    PG8_STAGE(PG8_SB(0, 0), cB, voffB); PG8_STAGE(PG8_SB(0, 1), cB + hstep, voffB); PG8_STAGE(PG8_SA(0, 0), cA, cofA[0]); PG8_STAGE(PG8_SA(0, 1), cA, cofA[1]);
    if (wr == 1) PG8_BAR;
    PG8_WAIT_V(2); PG8_BAR;
    PG8_STAGE(PG8_SB(1, 0), cB + kstep, voffB); PG8_STAGE(PG8_SA(1, 0), cA + kstep, cofA[0]); PG8_STAGE(PG8_SB(1, 1), cB + hstep + kstep, voffB);
    PG8_WAIT_V(6); PG8_BAR;
    for (;;) {
        const bool has_next = S.next(ui + 1, nxt);
        const char* nA = has_next ? S.a_base(nxt) : cA; const char* nB = has_next ? S.b_base(nxt) : cB;
        if constexpr (GATHER) { if (has_next) PG8_AOFF(nofA, nxt); else { _Pragma("unroll") for (int h_ = 0; h_ < 2; ++h_) _Pragma("unroll") for (int i_ = 0; i_ < 2; ++i_) nofA[h_][i_] = cofA[h_][i_]; } }
#pragma clang loop unroll(disable)
        for (int t = 0; t < nt; t += 2) {
            const bool last = (t == nt - 2);
            const char* a1 = cA + (size_t)(t + 1) * kstep;
            const char* a2 = last ? nA : cA + (size_t)(t + 2) * kstep; const char* b2 = last ? nB : cB + (size_t)(t + 2) * kstep;
            const char* a3 = a2 + kstep; const char* b3 = b2 + kstep;
            unsigned sofA[2][2];
            _Pragma("unroll") for (int h_ = 0; h_ < 2; ++h_) _Pragma("unroll") for (int i_ = 0; i_ < 2; ++i_) sofA[h_][i_] = (GATHER && last) ? nofA[h_][i_] : cofA[h_][i_];
            if constexpr (!F8) {
            PG8_LDB(B0, 0, 0); PG8_LDB(B1, 0, 1); PG8_SCHED; PG8_LDA(At, 0, 0); PG8_STAGE(PG8_SA(1, 1), a1, cofA[1]);
            PG8_WAIT_V(8); PG8_WAIT_L(0); PG8_BAR; PG8_MMA(0, 0, At, B0); PG8_MMA(0, 1, At, B1); PG8_BAR; PG8_SCHED;
            PG8_LDA(At, 0, 1); PG8_STAGE(PG8_SB(0, 0), b2, voffB); PG8_STAGE(PG8_SB(0, 1), b2 + hstep, voffB); PG8_STAGE(PG8_SA(0, 0), a2, sofA[0]);
            PG8_WAIT_V(8); PG8_WAIT_L(0); PG8_BAR; PG8_MMA(1, 0, At, B0); PG8_MMA(1, 1, At, B1); PG8_BAR; PG8_SCHED;
            PG8_LDB(B0, 1, 0); PG8_LDB(B1, 1, 1); PG8_SCHED; PG8_LDA(At, 1, 0); PG8_STAGE(PG8_SA(0, 1), a2, sofA[1]);
            PG8_WAIT_V(8); PG8_WAIT_L(0); PG8_BAR; PG8_MMA(0, 0, At, B0); PG8_MMA(0, 1, At, B1); PG8_BAR; PG8_SCHED;
            PG8_LDA(At, 1, 1); PG8_STAGE(PG8_SB(1, 0), b3, voffB); PG8_STAGE(PG8_SB(1, 1), b3 + hstep, voffB); PG8_STAGE(PG8_SA(1, 0), a3, sofA[0]);
            PG8_WAIT_V(8); PG8_WAIT_L(0); PG8_BAR; PG8_MMA(1, 0, At, B0); PG8_MMA(1, 1, At, B1); PG8_BAR; PG8_SCHED;
            } else {
            PG8_LD8(B08, PG8_SB(0, 0), boff8, 2); PG8_LD8(B18, PG8_SB(0, 1), boff8, 2); PG8_SCHED; PG8_LD8(At8, PG8_SA(0, 0), aoff8, 4); PG8_STAGE(PG8_SA(1, 1), a1, cofA[1]);
            PG8_WAIT_V(8); PG8_WAIT_L(0); PG8_BAR; PG8_MMA8(0, 0, At8, B08); PG8_MMA8(0, 1, At8, B18); PG8_BAR; PG8_SCHED;
            PG8_LD8(At8, PG8_SA(0, 1), aoff8, 4); PG8_STAGE(PG8_SB(0, 0), b2, voffB); PG8_STAGE(PG8_SB(0, 1), b2 + hstep, voffB); PG8_STAGE(PG8_SA(0, 0), a2, sofA[0]);
            PG8_WAIT_V(8); PG8_WAIT_L(0); PG8_BAR; PG8_MMA8(1, 0, At8, B08); PG8_MMA8(1, 1, At8, B18); PG8_BAR; PG8_SCHED;
            PG8_LD8(B08, PG8_SB(1, 0), boff8, 2); PG8_LD8(B18, PG8_SB(1, 1), boff8, 2); PG8_SCHED; PG8_LD8(At8, PG8_SA(1, 0), aoff8, 4); PG8_STAGE(PG8_SA(0, 1), a2, sofA[1]);
            PG8_WAIT_V(8); PG8_WAIT_L(0); PG8_BAR; PG8_MMA8(0, 0, At8, B08); PG8_MMA8(0, 1, At8, B18); PG8_BAR; PG8_SCHED;
            PG8_LD8(At8, PG8_SA(1, 1), aoff8, 4); PG8_STAGE(PG8_SB(1, 0), b3, voffB); PG8_STAGE(PG8_SB(1, 1), b3 + hstep, voffB); PG8_STAGE(PG8_SA(1, 0), a3, sofA[0]);
            PG8_WAIT_V(8); PG8_WAIT_L(0); PG8_BAR; PG8_MMA8(1, 0, At8, B08); PG8_MMA8(1, 1, At8, B18); PG8_BAR; PG8_SCHED;
            }
        }
        if constexpr (F8) asm volatile("s_nop 15\n\ts_nop 15" ::: "memory");
        if (wr == 0) PG8_BAR;
        E(acc, cur, wr, wc, fr, fq);
        if (!has_next) break;
        cur = nxt; cA = nA; cB = nB; ++ui;
        if constexpr (GATHER) { _Pragma("unroll") for (int h_ = 0; h_ < 2; ++h_) _Pragma("unroll") for (int i_ = 0; i_ < 2; ++i_) cofA[h_][i_] = nofA[h_][i_]; }
        if (wr == 1) PG8_BAR;
    }
    PG8_WAIT_V(0);
    PG8_BAR;
#undef PG8_AOFF
#undef PG8_SA
#undef PG8_SB
#undef PG8_STAGE
#undef PG8_LDA
#undef PG8_LDB
#undef PG8_MMA
#undef PG8_MMA8
#undef PG8_LD8
#undef PG8_WAIT_V
#undef PG8_WAIT_L
#undef PG8_BAR
#undef PG8_SCHED
}
}
typedef float acc_t[2][2][4][2] __attribute__((unused));
#define ACC_ARG pg8::f32x4 (&acc)[2][2][4][2]
#define ZERO_ACC() do { _Pragma("unroll") for (int a_ = 0; a_ < 2; ++a_) _Pragma("unroll") for (int b_ = 0; b_ < 2; ++b_) _Pragma("unroll") for (int m_ = 0; m_ < 4; ++m_) _Pragma("unroll") for (int n_ = 0; n_ < 2; ++n_) acc[a_][b_][m_][n_] = (pg8::f32x4){0.f, 0.f, 0.f, 0.f}; } while (0)

__device__ __forceinline__ bool static_unit(int L, int nM, int nN, pg8::Unit& u) {
    const int nwg = nM * nN; if (L >= nwg) return false;
    int wgid = L; { const int q = nwg / 8, r = nwg % 8, xcd = wgid % 8, off = wgid / 8; wgid = (xcd < r ? xcd * (q + 1) : r * (q + 1) + (xcd - r) * q) + off; }
    const int nig = 8 * nN, gid = wgid / nig, fm = gid * 8, gsz = (nM - fm) < 8 ? (nM - fm) : 8;
    u.pm = fm + ((wgid % nig) % gsz); u.pn = (wgid % nig) / gsz; return true;
}

struct SchedIn {
    static constexpr bool GATHER = false;
    const char* A; const char* Bt; int G, c;
    __device__ __forceinline__ bool next(int i, pg8::Unit& u) const {
        const int L = i * G + c;
        if (L < 1664) return static_unit(L, 64, 26, u);
        if (L < 1680) { const int j = L - 1664; u.pm = 64 + (j >> 2); u.pn = 26 + (j & 3); return true; }
        return false;
    }
    __device__ __forceinline__ const char* a_base(const pg8::Unit& u) const { return A + (size_t)u.pm * (256 * 1024 * 2); }
    __device__ __forceinline__ const char* b_base(const pg8::Unit& u) const { return Bt + (size_t)u.pn * (256 * 1024 * 2); }
    __device__ __forceinline__ unsigned a_voff(const pg8::Unit&, int h, int R, int C, int K) const { return (unsigned)(((h * 128 + R) * K + C) * 2); }
};
struct SchedBr {
    static constexpr bool GATHER = false;
    const char* A; const char* Bt; int G, c;
    __device__ __forceinline__ bool next(int i, pg8::Unit& u) const {
        const int rnd = i / 3, br = i - rnd * 3; pg8::Unit t;
        if (!static_unit(rnd * G + c, 64, 4, t)) return false;
        u.pm = 64 * br + t.pm; u.pn = 4 * br + t.pn; return true;
    }
    __device__ __forceinline__ const char* a_base(const pg8::Unit& u) const { return A + (size_t)u.pm * (256 * 512 * 2); }
    __device__ __forceinline__ const char* b_base(const pg8::Unit& u) const { return Bt + (size_t)u.pn * (256 * 512 * 2); }
    __device__ __forceinline__ unsigned a_voff(const pg8::Unit&, int h, int R, int C, int K) const { return (unsigned)(((h * 128 + R) * K + C) * 2); }
};
struct SchedOut {
    static constexpr bool GATHER = false;
    const char* A; const char* Bt; int G, c;
    __device__ __forceinline__ bool next(int i, pg8::Unit& u) const { return static_unit(i * G + c, 64, 4, u); }
    __device__ __forceinline__ const char* a_base(const pg8::Unit& u) const { return A + (size_t)u.pm * (256 * 1024 * 2); }
    __device__ __forceinline__ const char* b_base(const pg8::Unit& u) const { return Bt + (size_t)u.pn * (256 * 1024 * 2); }
    __device__ __forceinline__ unsigned a_voff(const pg8::Unit&, int h, int R, int C, int K) const { return (unsigned)(((h * 128 + R) * K + C) * 2); }
};
__device__ __forceinline__ void moe_stage_tokens(LAS unsigned char* lds, const LAS int* tile_e, const int* __restrict__ etok, int nmt, int G, int v, int i0, int i1, int tid) {
    LAS int* tokl = (LAS int*)(lds + MT_OFF + 2048);
    for (int i = i0 + (tid >> 8); i < i1; i += 2) { const int L = i * G + v; if (L >= nmt * 8) break;
        const int te_ = tile_e[L >> 3]; unsigned t = (unsigned)etok[(te_ & 31) * NTOK + (te_ >> 5) * 256 + (tid & 255)]; t = t < (unsigned)NTOK ? t : 0u;
        tokl[(i - i0) * 256 + (tid & 255)] = (int)t; }
    __syncthreads();
}
template <bool G_> struct SchedMoE {
    static constexpr bool GATHER = G_;
    const char* A; const char* Bt; const LAS int* tile_e; const LAS int* tokl; int nmt, nN, G, v; size_t estride; int i0, i1;
    __device__ __forceinline__ bool next(int i, pg8::Unit& u) const {
        if (i + i0 >= i1) return false;
        const int L = (i + i0) * G + v; if (L < 0 || L >= nmt * nN) return false;
        u.pm = L / nN; u.pn = L - u.pm * nN; return true;
    }
    __device__ __forceinline__ const char* a_base(const pg8::Unit& u) const { return G_ ? A : A + (size_t)u.pm * (256 * 1024); }
    __device__ __forceinline__ const char* b_base(const pg8::Unit& u) const { return Bt + (size_t)(__builtin_amdgcn_readfirstlane(tile_e[u.pm]) & 31) * estride + (size_t)u.pn * (256 * 1024); }
    __device__ __forceinline__ unsigned a_voff(const pg8::Unit& u, int h, int R, int C, int K) const {
        if (!G_) return (unsigned)(((h * 128 + R) * K + C) * 2);
        const int il = ((u.pm * nN + u.pn) - v) / G - i0;
        const unsigned t = (unsigned)tokl[il * 256 + h * 128 + R];
        return (t * (unsigned)K + (unsigned)C) * 2u;
    }
};


struct EpiIn {
    bf16 *QA, *KV6, *QF, *KF, *VF, *QM, *GATES, *KMEM, *VMEM; float* LG;
    const float *ropeC, *ropeS, *b_merge;
    __device__ __forceinline__ void operator()(ACC_ARG, const pg8::Unit& u, int wr, int wc, int fr, int fq) const {
        const int pn = u.pn, rowb = u.pm * 256 + wr * 64 + fr;
        if (pn < 13) {
#pragma unroll
            for (int bj = 0; bj < 2; ++bj) {
                const int L0 = (4 * pn + 2 * bj + (wc >> 1)) * 64, a4 = 4 * (4 * (wc & 1) + fq);
                bf16* dst; int pitch, col0; bool rope = false; float sc = 1.f;
                if (L0 < 512) { dst = QA; pitch = 512; col0 = L0; rope = true; sc = C2_64; }
                else if (L0 < 1280) { const int kk = (L0 - 512) >> 7; dst = KV6 + (size_t)kk * NTOK * 128; pitch = 128; col0 = (L0 - 512) & 127; rope = !(kk & 1); }
                else if (L0 < 1792) { dst = QF; pitch = 512; col0 = L0 - 1280; sc = C2_64; }
                else if (L0 < 2304) { dst = KF; pitch = 512; col0 = L0 - 1792; }
                else if (L0 < 2816) { dst = VF; pitch = 512; col0 = L0 - 2304; }
                else { dst = QM; pitch = 512; col0 = L0 - 2816; sc = C2_128; }
                pg8::f32x4 cv[2][4], sv[2][4];
                if (rope) {
#pragma unroll
                    for (int ai = 0; ai < 2; ++ai)
#pragma unroll
                        for (int m = 0; m < 4; ++m) { const int t = (rowb + 128 * ai + 16 * m) & (SEQ - 1); cv[ai][m] = *(const pg8::f32x4*)(ropeC + t * 32 + a4); sv[ai][m] = *(const pg8::f32x4*)(ropeS + t * 32 + a4); }
                }
                __builtin_amdgcn_sched_barrier(0);
#pragma unroll
                for (int ai = 0; ai < 2; ++ai)
#pragma unroll
                    for (int m = 0; m < 4; ++m) {
                        const int r = rowb + 128 * ai + 16 * m;
                        pg8::f32x4 x1 = acc[ai][bj][m][0], x2 = acc[ai][bj][m][1];
                        if (rope) { const pg8::f32x4 c4 = cv[ai][m], s4 = sv[ai][m];
                            const pg8::f32x4 y1 = x1 * c4 - x2 * s4, y2 = x2 * c4 + x1 * s4; x1 = y1; x2 = y2; }
                        x1 = x1 * sc; x2 = x2 * sc;
                        bf16* p = dst + (size_t)r * pitch + col0 + a4;
                        *(u32x2*)p = (u32x2){cvtpk(x1[0], x1[1]), cvtpk(x1[2], x1[3])};
                        *(u32x2*)(p + 32) = (u32x2){cvtpk(x2[0], x2[1]), cvtpk(x2[2], x2[3])};
                    }
            }
        } else if (pn < 25) {
            pg8::f32x4 bv[2][2];
#pragma unroll
            for (int bj = 0; bj < 2; ++bj) { const int cg = 256 * (pn - 13) + 128 * bj + 32 * wc + 8 * fq; bv[bj][0] = *(const pg8::f32x4*)(b_merge + cg); bv[bj][1] = *(const pg8::f32x4*)(b_merge + cg + 4); }
            __builtin_amdgcn_sched_barrier(0);
#pragma unroll
            for (int bj = 0; bj < 2; ++bj) {
                const int cg = 256 * (pn - 13) + 128 * bj + 32 * wc + 8 * fq;
                const pg8::f32x4 b0 = bv[bj][0], b1 = bv[bj][1];
#pragma unroll
                for (int ai = 0; ai < 2; ++ai)
#pragma unroll
                    for (int m = 0; m < 4; ++m) {
                        const int r = rowb + 128 * ai + 16 * m;
                        const pg8::f32x4 nb0 = b0 * (-LOG2E), nb1 = b1 * (-LOG2E);
                        u32x2 w; unsigned p = 0u;
#pragma unroll
                        for (int k = 0; k < 4; ++k) { const float e_ = __builtin_amdgcn_exp2f(__builtin_fmaf(acc[ai][bj][m][0][k], -LOG2E, nb0[k]));
                            p = __builtin_amdgcn_cvt_pk_u8_f32(fmaxf(__builtin_amdgcn_rcpf(__builtin_fmaf(e_, 1.f / 255.f, 1.f / 255.f)), 1.f), k, p); }
                        w.x = p; p = 0u;
#pragma unroll
                        for (int k = 0; k < 4; ++k) { const float e_ = __builtin_amdgcn_exp2f(__builtin_fmaf(acc[ai][bj][m][1][k], -LOG2E, nb1[k]));
                            p = __builtin_amdgcn_cvt_pk_u8_f32(fmaxf(__builtin_amdgcn_rcpf(__builtin_fmaf(e_, 1.f / 255.f, 1.f / 255.f)), 1.f), k, p); }
                        w.y = p;
                        *(u32x2*)((unsigned char*)GATES + (size_t)r * 3072 + cg) = w;
                    }
            }
        } else if (pn == 25) {
            if (wc == 0) {
#pragma unroll
                for (int ai = 0; ai < 2; ++ai)
#pragma unroll
                    for (int m = 0; m < 4; ++m) {
                        const int r = rowb + 128 * ai + 16 * m;
                        float* p = LG + (size_t)r * 32 + 8 * fq;
                        *(pg8::f32x4*)p = acc[ai][0][m][0]; *(pg8::f32x4*)(p + 4) = acc[ai][0][m][1];
                    }
            }
        } else {
#pragma unroll
            for (int bj = 0; bj < 2; ++bj) {
                const int cgl = 256 * (pn - 26) + 128 * bj + 32 * wc + 8 * fq;
                bf16* dst = (cgl < 512) ? KMEM : VMEM; const int col = cgl & 511;
#pragma unroll
                for (int ai = 0; ai < 2; ++ai)
#pragma unroll
                    for (int m = 0; m < 4; ++m) {
                        const int r = rowb + 128 * ai + 16 * m - NTOK;
                        const pg8::f32x4 v0 = acc[ai][bj][m][0], v1 = acc[ai][bj][m][1];
                        u32x4 w; w.x = cvtpk(v0[0], v0[1]); w.y = cvtpk(v0[2], v0[3]); w.z = cvtpk(v1[0], v1[1]); w.w = cvtpk(v1[2], v1[3]);
                        *(u32x4*)(dst + (size_t)r * 512 + col) = w;
                    }
            }
        }
        ZERO_ACC();
    }
};

struct EpiBr {
    const bf16* GATES; bf16* MERGED;
    __device__ __forceinline__ void operator()(ACC_ARG, const pg8::Unit& u, int wr, int wc, int fr, int fq) const {
        const int br = u.pn >> 2, tn = u.pn & 3, tm = u.pm & 63, rowb = tm * 256 + wr * 64 + fr;
        const unsigned char* gp = (const unsigned char*)GATES + (size_t)rowb * 3072 + 1024 * br + 256 * tn + 32 * wc + 8 * fq;
        u32x2 GA[2][4][2], GB[2][4][2];
#pragma unroll
        for (int ai = 0; ai < 2; ++ai)
#pragma unroll
            for (int m = 0; m < 4; ++m)
#pragma unroll
                for (int bj = 0; bj < 2; ++bj) { const unsigned char* p = gp + (size_t)(128 * ai + 16 * m) * 3072 + 128 * bj;
                    GA[ai][m][bj] = *(const u32x2*)p; GB[ai][m][bj] = (br < 2) ? *(const u32x2*)(p + 1024) : (u32x2){0u, 0u}; }
        __builtin_amdgcn_sched_barrier(0);
#pragma unroll
        for (int ai = 0; ai < 2; ++ai)
#pragma unroll
            for (int m = 0; m < 4; ++m) {
                const int r = rowb + 128 * ai + 16 * m;
#pragma unroll
                for (int bj = 0; bj < 2; ++bj) {
                    const int c0 = 256 * tn + 128 * bj + 32 * wc + 8 * fq;
                    const u32x2 ga = GA[ai][m][bj];
                    pg8::f32x4 g0 = {(float)(ga.x & 255u), (float)((ga.x >> 8) & 255u), (float)((ga.x >> 16) & 255u), (float)(ga.x >> 24)}, g1 = {(float)(ga.y & 255u), (float)((ga.y >> 8) & 255u), (float)((ga.y >> 16) & 255u), (float)(ga.y >> 24)};
#if defined(ABL_BR)
                    if (!((ABL_BR >> br) & 1)) { acc[ai][bj][m][0] = acc[ai][bj][m][0] * 0.f; acc[ai][bj][m][1] = acc[ai][bj][m][1] * 0.f; }
#endif
                    if (br < 2) {
                        const u32x2 gb = GB[ai][m][bj];
                        const pg8::f32x4 h0 = {(float)(gb.x & 255u), (float)((gb.x >> 8) & 255u), (float)((gb.x >> 16) & 255u), (float)(gb.x >> 24)}, h1 = {(float)(gb.y & 255u), (float)((gb.y >> 8) & 255u), (float)((gb.y >> 16) & 255u), (float)(gb.y >> 24)};
#pragma unroll
                        for (int k = 0; k < 4; ++k) { g0[k] = g0[k] * __builtin_amdgcn_rcpf(h0[k]); g1[k] = g1[k] * __builtin_amdgcn_rcpf(h1[k]); }
                        acc[ai][bj][m][0] = acc[ai][bj][m][0] * g0; acc[ai][bj][m][1] = acc[ai][bj][m][1] * g1;
                    } else {
                        const pg8::f32x4 v0 = acc[ai][bj][m][0] * g0 * (1.f / 255.f), v1 = acc[ai][bj][m][1] * g1 * (1.f / 255.f);
                        u32x4 w; w.x = cvtpk(v0[0], v0[1]); w.y = cvtpk(v0[2], v0[3]); w.z = cvtpk(v1[0], v1[1]); w.w = cvtpk(v1[2], v1[3]);
                        *(u32x4*)(MERGED + (size_t)r * 1024 + c0) = w;
                        acc[ai][bj][m][0] = (pg8::f32x4){0.f, 0.f, 0.f, 0.f}; acc[ai][bj][m][1] = (pg8::f32x4){0.f, 0.f, 0.f, 0.f};
                    }
                }
            }
    }
};

struct EpiOut {
    const float* X; float* X1; unsigned char* XB8;
    __device__ __forceinline__ void operator()(ACC_ARG, const pg8::Unit& u, int wr, int wc, int fr, int fq) const {
        const int rowb = u.pm * 256 + wr * 64 + fr;
        const size_t ob = (size_t)rowb * 1024 + 256 * u.pn + 32 * wc + 8 * fq;
#pragma unroll
        for (int ai = 0; ai < 2; ++ai) {
            pg8::f32x4 xs[4][2][2];
#pragma unroll
            for (int m = 0; m < 4; ++m)
#pragma unroll
                for (int bj = 0; bj < 2; ++bj) { const float* p = X + ob + (size_t)(128 * ai + 16 * m) * 1024 + 128 * bj; xs[m][bj][0] = *(const pg8::f32x4*)p; xs[m][bj][1] = *(const pg8::f32x4*)(p + 4); }
            __builtin_amdgcn_sched_barrier(0);
#pragma unroll
            for (int m = 0; m < 4; ++m)
#pragma unroll
                for (int bj = 0; bj < 2; ++bj) {
                    const size_t o = ob + (size_t)(128 * ai + 16 * m) * 1024 + 128 * bj;
                    const pg8::f32x4 y0 = xs[m][bj][0] + acc[ai][bj][m][0], y1 = xs[m][bj][1] + acc[ai][bj][m][1];
                    *(pg8::f32x4*)(X1 + o) = y0; *(pg8::f32x4*)(X1 + o + 4) = y1;
                    *(u32x2*)(XB8 + o) = (u32x2){pk_fp8x4(y0[0], y0[1], y0[2], y0[3]), pk_fp8x4(y1[0], y1[1], y1[2], y1[3])};
                }
            __builtin_amdgcn_sched_barrier(0);
        }
        ZERO_ACC();
    }
};

__device__ __forceinline__ float swiglu(float g, float uu) {
    g = fminf(g, 7.0f); uu = fminf(fmaxf(uu, -7.0f), 7.0f);
    return (uu + 1.0f) * g * __builtin_amdgcn_rcpf(1.0f + __builtin_amdgcn_exp2f(-1.702f * LOG2E * g));
}
__device__ __forceinline__ float swiglu4(float g, float uu) {
    g = fminf(g, 7.0f); uu = fminf(fmaxf(uu, -7.0f), 7.0f);
    const float e = __builtin_amdgcn_exp2f(-1.702f * LOG2E * g);
    return __builtin_fmaf(uu, g, g) * __builtin_amdgcn_rcpf(__builtin_fmaf(e, 0.25f, 0.25f));
}
__device__ __forceinline__ unsigned pk_fp8x4_nc(float a, float b, float c, float d) {
    int p = __builtin_amdgcn_cvt_pk_fp8_f32(a, b, 0, false); p = __builtin_amdgcn_cvt_pk_fp8_f32(c, d, p, true); return (unsigned)p;
}
struct EpiGU {
    const float* bias; const LAS int* tile_e; unsigned char* ACT8; const float* erstd;
    __device__ __forceinline__ void operator()(ACC_ARG, const pg8::Unit& u, int wr, int wc, int fr, int fq) const {
        const int te_ = __builtin_amdgcn_readfirstlane(tile_e[u.pm]), e = te_ & 31, rowb = u.pm * 256 + wr * 64 + fr;
        const float* rslot = erstd + (size_t)e * NTOK + (te_ >> 5) * 256 - u.pm * 256;
        float rsv[2][4]; pg8::f32x4 bv[2][2];
#pragma unroll
        for (int ai = 0; ai < 2; ++ai)
#pragma unroll
            for (int m = 0; m < 4; ++m) rsv[ai][m] = rslot[rowb + 128 * ai + 16 * m];
#pragma unroll
        for (int bj = 0; bj < 2; ++bj) { const int c0 = 256 * u.pn + 128 * bj + 32 * wc + 8 * fq; bv[bj][0] = *(const pg8::f32x4*)(bias + (size_t)e * 2048 + c0); bv[bj][1] = *(const pg8::f32x4*)(bias + (size_t)e * 2048 + c0 + 4); }
        __builtin_amdgcn_sched_barrier(0);
#pragma unroll
        for (int bj = 0; bj < 2; ++bj) {
            const int c0 = 256 * u.pn + 128 * bj + 32 * wc + 8 * fq;
            const pg8::f32x4 b0 = bv[bj][0], b1 = bv[bj][1];
#pragma unroll
            for (int ai = 0; ai < 2; ++ai)
#pragma unroll
                for (int m = 0; m < 4; ++m) {
                    const int r = rowb + 128 * ai + 16 * m; const float rs = rsv[ai][m] * (1.0f / W8_SCALE);
                    const pg8::f32x4 v0 = acc[ai][bj][m][0] * rs + b0, v1 = acc[ai][bj][m][1] * rs + b1;
                    *(unsigned*)(ACT8 + (size_t)r * 1024 + (c0 >> 1)) = pk_fp8x4_nc(swiglu4(v0[0], v0[1]), swiglu4(v0[2], v0[3]), swiglu4(v1[0], v1[1]), swiglu4(v1[2], v1[3]));
                }
        }
        ZERO_ACC();
    }
};
struct EpiDn {
    const float* bias; const LAS int* tile_e; bf16* OS;
    __device__ __forceinline__ void operator()(ACC_ARG, const pg8::Unit& u, int wr, int wc, int fr, int fq) const {
        const int e = __builtin_amdgcn_readfirstlane(tile_e[u.pm]) & 31, rowb = u.pm * 256 + wr * 64 + fr;
        pg8::f32x4 bv[2][2];
#pragma unroll
        for (int bj = 0; bj < 2; ++bj) { const int c0 = 256 * u.pn + 128 * bj + 32 * wc + 8 * fq; bv[bj][0] = *(const pg8::f32x4*)(bias + (size_t)e * 1024 + c0); bv[bj][1] = *(const pg8::f32x4*)(bias + (size_t)e * 1024 + c0 + 4); }
        __builtin_amdgcn_sched_barrier(0);
#pragma unroll
        for (int bj = 0; bj < 2; ++bj) {
            const int c0 = 256 * u.pn + 128 * bj + 32 * wc + 8 * fq;
            const pg8::f32x4 b0 = bv[bj][0], b1 = bv[bj][1];
#pragma unroll
            for (int ai = 0; ai < 2; ++ai)
#pragma unroll
                for (int m = 0; m < 4; ++m) {
                    const int r = rowb + 128 * ai + 16 * m;
                    const pg8::f32x4 v0 = acc[ai][bj][m][0] * (1.0f / (W8_SCALE * ACT8_SCALE)) + b0, v1 = acc[ai][bj][m][1] * (1.0f / (W8_SCALE * ACT8_SCALE)) + b1;
                    u32x4 w; w.x = cvtpk(v0[0], v0[1]); w.y = cvtpk(v0[2], v0[3]); w.z = cvtpk(v1[0], v1[1]); w.w = cvtpk(v1[2], v1[3]);
                    *(u32x4*)(OS + (size_t)r * 1024 + c0) = w;
                }
        }
        ZERO_ACC();
    }
};
struct KArgs { const float* in[26]; float* out; unsigned char* ws; int ph_lo, ph_hi; };
struct Frame {
    LAS unsigned char* lds;
    int tid, lane, wave, G, bid, vcu;
    const KArgs __attribute__((address_space(4)))* ka; float* out; unsigned char* ws;
};
#define WSP(T, off) ((T*)(F.ws + (off)))

__device__ __forceinline__ int win_srccol(int n) {
    if (n < 3328) { const int p = n & 63, d = 4 * (p >> 3) + (p & 3) + 32 * ((p >> 2) & 1), L = (n & ~63) + d;
        if (L < 1280) return L; if (L < 1792) return 1304 + (L - 1280); if (L < 2304) return 1816 + (L - 1792); if (L < 2816) return 2328 + (L - 2304); return 2848 + (L - 2816); }
    if (n < 6400) return 3360 + (n - 3328);
    if (n < 6424) return 1280 + (n - 6400);
    if (n < 6432) return 2840 + (n - 6424);
    return -1;
}
__device__ __forceinline__ void transpose_item(const float* __restrict__ W, int N, bf16* __restrict__ Wt, int Kd, int n0, int k0, int sc, LAS float* scr, int lane, const float* __restrict__ kscale = nullptr) {
    const float* src = W + (size_t)k0 * N + (sc >= 0 ? sc : 0);
    float v[64];
#pragma unroll
    for (int kk = 0; kk < 64; ++kk) v[kk] = src[(size_t)kk * N];
    if (kscale) {
#pragma unroll
        for (int kk = 0; kk < 64; ++kk) v[kk] *= kscale[k0 + kk];
    }
#pragma unroll
    for (int kk = 0; kk < 64; ++kk) scr[kk * 65 + lane] = (sc >= 0) ? v[kk] : 0.f;
    asm volatile("s_waitcnt lgkmcnt(0)" ::: "memory");
    const int c = lane & 7;
#pragma unroll
    for (int j = 0; j < 8; ++j) { const int n = (lane >> 3) + 8 * j; const LAS float* s = scr + (8 * c) * 65 + n;
        u32x4 o; o.x = cvtpk(s[0], s[65]); o.y = cvtpk(s[2 * 65], s[3 * 65]); o.z = cvtpk(s[4 * 65], s[5 * 65]); o.w = cvtpk(s[6 * 65], s[7 * 65]);
        *(u32x4*)(Wt + (size_t)(n0 + n) * Kd + k0 + 8 * c) = o; }
    asm volatile("s_waitcnt lgkmcnt(0)" ::: "memory");
}
__device__ __forceinline__ void transpose_item8(const float* __restrict__ W, int N, unsigned char* __restrict__ Wt8, int Kd, int n0, int k0, LAS unsigned char* scr, int lane, const float* __restrict__ kscale, float mul) {
    const float* src = W + (size_t)k0 * N + n0 + lane;
#pragma unroll
    for (int half = 0; half < 2; ++half) {
        float v[64];
#pragma unroll
        for (int kk = 0; kk < 64; ++kk) v[kk] = src[(size_t)(64 * half + kk) * N];
#pragma unroll
        for (int kk = 0; kk < 64; ++kk) v[kk] *= kscale ? mul * kscale[k0 + 64 * half + kk] : mul;
#pragma unroll
        for (int j = 0; j < 32; ++j) { const float a = fminf(fmaxf(v[2 * j], -448.f), 448.f), b = fminf(fmaxf(v[2 * j + 1], -448.f), 448.f);
            *(LAS unsigned short*)(scr + lane * 132 + 64 * half + 2 * j) = (unsigned short)__builtin_amdgcn_cvt_pk_fp8_f32(a, b, 0, false); }
    }
    asm volatile("s_waitcnt lgkmcnt(0)" ::: "memory");
    const int c = lane & 7;
#pragma unroll
    for (int j = 0; j < 8; ++j) { const int n = (lane >> 3) + 8 * j; const LAS unsigned* s = (const LAS unsigned*)(scr + n * 132 + 16 * c);
        u32x4 o; o.x = s[0]; o.y = s[1]; o.z = s[2]; o.w = s[3];
        *(u32x4*)(Wt8 + (size_t)(n0 + n) * Kd + k0 + 16 * c) = o; }
    asm volatile("s_waitcnt lgkmcnt(0)" ::: "memory");
}
__device__ __forceinline__ void rms_row_bf16(const float* __restrict__ xrow, const float* __restrict__ g, bf16* __restrict__ orow, int lane) {
    const f32x4* xr = (const f32x4*)xrow + lane; const f32x4* gr = (const f32x4*)g + lane;
    f32x4 v[4]; float s = 0.f;
#pragma unroll
    for (int j = 0; j < 4; ++j) { v[j] = xr[64 * j]; s += (v[j].x * v[j].x + v[j].y * v[j].y) + (v[j].z * v[j].z + v[j].w * v[j].w); }
    const float rstd = 1.0f / sqrtf(wave_sum(s) * (1.f / 1024.f) + RMS_EPS);
    u32x2* o8 = (u32x2*)orow + lane;
#pragma unroll
    for (int j = 0; j < 4; ++j) { const f32x4 gg = gr[64 * j]; o8[64 * j] = (u32x2){cvtpk(v[j].x * rstd * gg.x, v[j].y * rstd * gg.y), cvtpk(v[j].z * rstd * gg.z, v[j].w * rstd * gg.w)}; }
}
__device__ __forceinline__ void sincos_big(float ang, float& s, float& c) {
    const double x = (double)ang; const double kf = __builtin_rint(x * 0.63661977236758134308); const int k = (int)kf;
    const double r = (x - kf * 1.57079632679489655800) - kf * 6.123233995736766036e-17, r2 = r * r;
    const double sp = r * (1.0 + r2 * (-1.0 / 6 + r2 * (1.0 / 120 + r2 * (-1.0 / 5040 + r2 * (1.0 / 362880 - r2 * (1.0 / 39916800))))));
    const double cp = 1.0 + r2 * (-0.5 + r2 * (1.0 / 24 + r2 * (-1.0 / 720 + r2 * (1.0 / 40320 + r2 * (-1.0 / 3628800 + r2 * (1.0 / 479001600))))));
    const double ss = (k & 1) ? cp : sp, cc = (k & 1) ? sp : cp;
    s = (float)((k & 2) ? -ss : ss); c = (float)(((k + 1) & 2) ? -cc : cc);
}
__device__ __forceinline__ void attn_unit_desc(int i, unsigned& desc, int& cost, const float* __restrict__ b_forget) {
    if (i < 512) { const int bg = i >> 6, T = i & 63; desc = 0u | (bg << 3) | (T << 11); cost = 14 + (T + 1) + (T < 8 ? T + 1 : 9) + ((4 * T + 2) / 64 + 1); }
    else { const int j = i - 512, bh = j >> 4, qb = j & 15; desc = 1u | (bh << 3) | (qb << 11);
        const float lf = log2f(1.0f + exp2f(-LOG2E * b_forget[bh & 7]));
        const float ex = fminf(80.0f / fmaxf(64.0f * lf, 1.0f), 64.0f);
        const int steps = min(4 * qb + 4, 5 + (int)ex); cost = 4 + steps; }
}
constexpr int N_SORTED = 1024, MAXCOST = 128, N_CVT_ITEMS = 3072, CVT_CHUNK = 12, N_CVT_BIG = 0, CVT_TAIL = 2, N_CVT_MIX = 1024, N_MIX4 = 448, N_CVT_TAIL = (N_CVT_ITEMS - 4 * N_MIX4 - 2 * (N_CVT_MIX - N_MIX4)) / CVT_TAIL;
constexpr int Q_CMP0 = 0, Q_CUM0 = 128, Q_CVT0 = 160, N_MEM_EARLY = 192, Q_SRT0 = Q_CVT0 + N_MEM_EARLY, Q_MEM0 = Q_SRT0 + N_SORTED + N_CVT_MIX, Q_TAIL0 = Q_MEM0 + 256 - N_MEM_EARLY, N_QUEUE = Q_TAIL0 + N_CVT_TAIL;
constexpr int CW_CMPDONE = 8192, CW_CUMDONE = 8192 + 64 * 8;

__device__ __forceinline__ void p0_prologue(Frame& F, const int part, const int b0, const int nb) {
    LAS float* scr = (LAS float*)(F.lds + F.wave * 16640);
    const bool do1 = part & 1, do2 = part & 2;
    const int gw = ((part == 2) ? (F.bid - b0) : F.vcu) * NWAVES + F.wave, NGW = nb * NWAVES, lane = F.lane, tlin = (F.bid - b0) * NTHREADS + F.tid, TLIN = nb * NTHREADS;
    bf16* HA = WSP(bf16, WS_HA);
    f32x4 gx[4], gmm[4];
#pragma unroll
    for (int j = 0; j < 4; ++j) { gx[j] = ((const f32x4*)F.ka->in[2])[64 * j + lane]; gmm[j] = ((const f32x4*)F.ka->in[12])[64 * j + lane]; }
    if (do1) for (int m0 = gw; m0 < NTOK + NMEMROW; m0 += 4 * NGW) {
        f32x4 v[4][4]; float ss[4]; const float* xr[4]; bool has[4];
#pragma unroll
        for (int q = 0; q < 4; ++q) { const int m = m0 + q * NGW; has[q] = m < NTOK + NMEMROW; const int mm = has[q] ? m : m0;
            xr[q] = (mm < NTOK) ? F.ka->in[0] + (size_t)mm * DM : F.ka->in[1] + (size_t)(mm - NTOK) * DM; }
#pragma unroll
        for (int j = 0; j < 4; ++j)
#pragma unroll
            for (int q = 0; q < 4; ++q) v[q][j] = ((const f32x4*)xr[q])[64 * j + lane];
#pragma unroll
        for (int q = 0; q < 4; ++q) { float s_ = 0.f;
#pragma unroll
            for (int j = 0; j < 4; ++j) s_ += (v[q][j].x * v[q][j].x + v[q][j].y * v[q][j].y) + (v[q][j].z * v[q][j].z + v[q][j].w * v[q][j].w);
            ss[q] = s_; }
#pragma unroll
        for (int o = 1; o < 64; o <<= 1) {
#pragma unroll
            for (int q = 0; q < 4; ++q) ss[q] += __shfl_xor(ss[q], o); }
#pragma unroll
        for (int q = 0; q < 4; ++q) { const int m = m0 + q * NGW; const float r = 1.0f / sqrtf(ss[q] * (1.f / 1024.f) + RMS_EPS);
            const bool isx = m < NTOK;
            if (has[q]) {
#pragma unroll
                for (int j = 0; j < 4; ++j) { const f32x4 a = isx ? gx[j] : gmm[j];
                    ((u32x2*)(HA + (size_t)m * DM))[64 * j + lane] = (u32x2){cvtpk(v[q][j].x * r * a.x, v[q][j].y * r * a.y), cvtpk(v[q][j].z * r * a.z, v[q][j].w * r * a.w)}; } } }
    }
    constexpr int I_WIN = 104 * 16, I_MKV = 16 * 16, I_BR = 16 * 8, I_OUT = 256, I_W1 = 32, I_W2 = 1;
    constexpr int NITEMS = I_WIN + I_MKV + 3 * I_BR + I_OUT + 2 * I_W1 + 2 * I_W2;
    for (int it = gw + (do1 ? 0 : I_WIN + I_MKV); it < (do2 ? NITEMS : I_WIN + I_MKV); it += NGW) {
        int r = it;
        if (r < I_WIN) { const int kt = r / 104, nt = r - kt * 104; transpose_item(F.ka->in[3], DIN, WSP(bf16, WS_WIN_T), 1024, nt * 64, kt * 64, win_srccol(nt * 64 + lane), scr, lane); continue; } r -= I_WIN;
        if (r < I_MKV) { const int kt = r >> 4, nt = r & 15; transpose_item(F.ka->in[13], 1024, WSP(bf16, WS_WIN_T) + (size_t)NIN * 1024, 1024, nt * 64, kt * 64, nt * 64 + lane, scr, lane); continue; } r -= I_MKV;
        if (r < 3 * I_BR) { const int b = r / I_BR, q = r - b * I_BR, kt = q >> 4, nt = q & 15; transpose_item(b == 0 ? F.ka->in[14] : (b == 1 ? F.ka->in[15] : F.ka->in[16]), 1024, WSP(bf16, WS_WBR_T) + (size_t)b * 1024 * 512, 512, nt * 64, kt * 64, nt * 64 + lane, scr, lane); continue; } r -= 3 * I_BR;
        if (r < I_OUT) { const int kt = r >> 4, nt = r & 15; transpose_item(F.ka->in[17], 1024, WSP(bf16, WS_WOUT_T), 1024, nt * 64, kt * 64, nt * 64 + lane, scr, lane); continue; } r -= I_OUT;
        if (r < 2 * I_W1) { const int b = r / I_W1, kt = r - b * I_W1; transpose_item(b ? F.ka->in[10] : F.ka->in[7], 64, b ? WSP(bf16, WS_W1T_V) : WSP(bf16, WS_W1T_K), 2048, 0, kt * 64, lane, scr, lane); continue; } r -= 2 * I_W1;
        { transpose_item(r ? F.ka->in[11] : F.ka->in[8], 64, r ? WSP(bf16, WS_W2T_V) : WSP(bf16, WS_W2T_K), 64, 0, 0, lane, scr, lane); }
    }
    { float* rc = WSP(float, WS_ROPE_C); float* rs = WSP(float, WS_ROPE_S);
      if (do1) for (int idx = tlin; idx < SEQ * 32; idx += TLIN) { const int t = idx >> 5, i = idx & 31;
          const float inv = exp2f(-(float)i * (13.287712379549449f / 32.0f)); const float ang = (float)t * inv; float s, c; sincos_big(ang, s, c); rc[idx] = c; rs[idx] = s; } }
    { bf16* wrh = WSP(bf16, WS_WRT); const float* wr = F.ka->in[19]; const float* gf = F.ka->in[18];
      if (do2) for (int idx = tlin; idx < 32 * 1024; idx += TLIN) { const int e = idx >> 10, k = idx & 1023; const float v = wr[k * 32 + e] * gf[k];
          const unsigned h = cvtpk(v, 0.f) & 0xffffu; const float lo = v - bflo(h); wrh[idx] = (bf16)h; wrh[32 * 1024 + idx] = (bf16)(cvtpk(lo, 0.f) & 0xffffu); } }
    if (do2 && gw >= NGW - 128) { const int j = gw - (NGW - 128), kv = j >> 6, part = j & 63; const float* pe = kv ? F.ka->in[9] : F.ka->in[6]; const float* w1 = kv ? F.ka->in[10] : F.ka->in[7]; float a = 0.f;
#pragma unroll 16
        for (int k = part * 32; k < part * 32 + 32; ++k) a += pe[k] * w1[k * 64 + lane];
        WSP(float, WS_CPE)[(kv * 64 + part) * 64 + lane] = a; }
    if (do2 && F.bid == b0) {
        __syncthreads();
        LAS int* hist = (LAS int*)F.lds;
        LAS unsigned* sorted = (LAS unsigned*)(hist + 3 * MAXCOST);
        for (int i = F.tid; i < 3 * MAXCOST; i += NTHREADS) hist[i] = 0;
        __syncthreads();
        for (int i = F.tid; i < N_SORTED; i += NTHREADS) { unsigned d; int c; attn_unit_desc(i, d, c, F.ka->in[4]); atomicAdd((int*)(hist + c), 1); }
        __syncthreads();
        if (F.tid < MAXCOST) { int run = 0; for (int c = F.tid + 1; c < MAXCOST; ++c) run += hist[c]; hist[MAXCOST + F.tid] = run; }
        __syncthreads();
        for (int i = F.tid; i < N_SORTED; i += NTHREADS) { unsigned d; int c; attn_unit_desc(i, d, c, F.ka->in[4]); const int pos = hist[MAXCOST + c] + atomicAdd((int*)(hist + 2 * MAXCOST + c), 1); sorted[pos] = d; }
        __syncthreads();
        unsigned* order = WSP(unsigned, WS_ORDER);
        for (int i = F.tid; i < N_QUEUE; i += NTHREADS) {
            unsigned d;
            if (i < Q_CUM0) d = 3u | ((unsigned)(i >> 6) << 3) | ((unsigned)(i & 63) << 11);
            else if (i < Q_CVT0) d = 4u | ((unsigned)(i - Q_CUM0) << 3);
            else if (i < Q_SRT0) { const int j = i - Q_CVT0; d = 2u | ((unsigned)(j >> 4) << 3) | ((unsigned)(j & 15) << 11); }
            else if (i < Q_MEM0) { const int j = i - Q_SRT0; const int k = j >> 1; d = (j & 1) ? (k < N_MIX4 ? (5u | (4u << 3) | ((unsigned)(4 * k) << 11)) : (5u | (2u << 3) | ((unsigned)(4 * N_MIX4 + 2 * (k - N_MIX4)) << 11))) : sorted[k]; }
            else if (i < Q_TAIL0) { const int j = N_MEM_EARLY + i - Q_MEM0; d = 2u | ((unsigned)(j >> 4) << 3) | ((unsigned)(j & 15) << 11); }
            else d = 5u | (2u << 3) | ((unsigned)(4 * N_MIX4 + 2 * (N_CVT_MIX - N_MIX4) + 2 * (i - Q_TAIL0)) << 11);
            order[i] = d;
        }
        __syncthreads();
    }
}

struct CvtItem { const float* src; unsigned char* dst; const float* ks; int N; };
__device__ __forceinline__ CvtItem cvt_item(Frame& F, int g, int wv, int lane) {
    const int e = g / 96, q = g - e * 96; CvtItem I;
    if (q < 64) { const int kt = q >> 3, ng = (q + kt + e) & 7, k0 = kt * 128 + 16 * wv, n0 = ng * 256 + 4 * lane;
        I.src = F.ka->in[21] + (size_t)e * 1024 * 2048 + (size_t)k0 * 2048 + n0; I.N = 2048; I.dst = WSP(unsigned char, WS_WGU_T) + (size_t)e * 2048 * 1024 + (size_t)(ng * 256) * 1024 + kt * 128; I.ks = F.ka->in[18] + k0; }
    else { const int q2 = q - 64, kt = q2 >> 2, ng = (q2 + kt + e) & 3, k0 = kt * 128 + 16 * wv, n0 = ng * 256 + 4 * lane;
        I.src = F.ka->in[23] + (size_t)e * 1024 * 1024 + (size_t)k0 * 1024 + n0; I.N = 1024; I.dst = WSP(unsigned char, WS_WD_T) + (size_t)e * 1024 * 1024 + (size_t)(ng * 256) * 1024 + kt * 128; I.ks = nullptr; }
    return I;
}
__device__ __forceinline__ void cvt_load(f32x4 (&v)[16], const CvtItem& I) {
#pragma unroll
    for (int kk = 0; kk < 16; ++kk) v[kk] = *(const f32x4*)(I.src + (size_t)kk * I.N);
}
__device__ __forceinline__ void cvt_store(const f32x4 (&v)[16], const CvtItem& I, LAS unsigned char* tile, int tid, int lane, int wv) {
    float sc[16];
#pragma unroll
    for (int kk = 0; kk < 16; ++kk) sc[kk] = I.ks ? W8_SCALE * I.ks[kk] : W8_SCALE;
    u32x4 o[4];
#pragma unroll
    for (int j = 0; j < 4; ++j)
#pragma unroll
        for (int q = 0; q < 4; ++q) o[j][q] = pk_fp8x4(v[4 * q][j] * sc[4 * q], v[4 * q + 1][j] * sc[4 * q + 1], v[4 * q + 2][j] * sc[4 * q + 2], v[4 * q + 3][j] * sc[4 * q + 3]);
    __syncthreads();
#pragma unroll
    for (int j = 0; j < 4; ++j) *(LAS u32x4*)(tile + (j * 64 + lane) * 144 + 16 * wv) = o[j];
    __syncthreads();
#pragma unroll
    for (int i = 0; i < 4; ++i) { const int n = (tid >> 3) + 64 * i, c = tid & 7;
        const u32x4 w = *(const LAS u32x4*)(tile + ((n & 3) * 64 + (n >> 2)) * 144 + 16 * c);
        *(u32x4*)(I.dst + (size_t)n * 1024 + 16 * c) = w; }
}
__device__ __forceinline__ void convert_unit(Frame& F, int g0, int n) {
    int tid_ = threadIdx.x; asm volatile("" : "+v"(tid_)); const int lane = tid_ & 63, wv = __builtin_amdgcn_readfirstlane(tid_ >> 6);
    LAS unsigned char* tile = F.lds;
    f32x4 a[16], b[16];
    CvtItem Ia = cvt_item(F, g0, wv, lane), Ib; cvt_load(a, Ia);
#pragma clang loop unroll(disable)
    for (int bi = 0; bi < n; bi += 2) {
        Ib = cvt_item(F, g0 + bi + 1, wv, lane); cvt_load(b, Ib);
        cvt_store(a, Ia, tile, tid_, lane, wv);
        if (bi + 2 < n) { Ia = cvt_item(F, g0 + bi + 2, wv, lane); cvt_load(a, Ia); }
        cvt_store(b, Ib, tile, tid_, lane, wv);
    }
    __syncthreads();
}
__device__ __forceinline__ void q_signal(unsigned* p, int tid) {
    asm volatile("s_waitcnt vmcnt(0)" ::: "memory"); __syncthreads();
    if (tid == 0) { __builtin_amdgcn_fence(__ATOMIC_RELEASE, "agent"); asm volatile("s_waitcnt vmcnt(0)" ::: "memory"); __hip_atomic_fetch_add(p, 1u, __ATOMIC_RELAXED, __HIP_MEMORY_SCOPE_AGENT); }
}
__device__ __forceinline__ void q_wait(unsigned* p, unsigned want, int tid) {
    if (tid == 0) { unsigned sp = 0; while (__hip_atomic_load(p, __ATOMIC_RELAXED, __HIP_MEMORY_SCOPE_AGENT) < want && ++sp < (1u << 24)) __builtin_amdgcn_s_sleep(2);
        __builtin_amdgcn_fence(__ATOMIC_ACQUIRE, "agent"); asm volatile("s_waitcnt vmcnt(0)" ::: "memory"); }
    __syncthreads();
}

__device__ __forceinline__ void p2_compress_unit(Frame& F, int kv, int rt) {
    int tid_ = threadIdx.x; asm volatile("" : "+v"(tid_)); const int lane = tid_ & 63, w = __builtin_amdgcn_readfirstlane(tid_ >> 6), r32 = lane & 31, hi = lane >> 5;
    const bf16* src = WSP(bf16, WS_KV6) + (size_t)kv * NTOK * 128;
    const bf16* w1t = WSP(bf16, kv ? WS_W1T_V : WS_W1T_K); const bf16* w2t = WSP(bf16, kv ? WS_W2T_V : WS_W2T_K);
    const int R = rt * 32 + r32, bg = R >> 8, n = R & 255, b = bg >> 1, g = bg & 1;
    f32x16 acc0 = {}, acc1 = {};
#pragma unroll
    for (int half = 0; half < 2; ++half) {
        bf16x8 av[8], b0v[8], b1v[8];
#pragma unroll
        for (int s8 = 0; s8 < 8; ++s8) { const int step = w * 16 + 8 * half + s8, l = step >> 2, d = 16 * (step & 3) + 8 * hi;
            int tok = 16 * n + l; tok = tok < SEQ ? tok : SEQ - 1;
            av[s8] = *(const bf16x8*)(src + ((size_t)(b * SEQ + tok)) * 128 + g * 64 + d);
            b0v[s8] = *(const bf16x8*)(w1t + (size_t)r32 * 2048 + 16 * step + 8 * hi);
            b1v[s8] = *(const bf16x8*)(w1t + (size_t)(32 + r32) * 2048 + 16 * step + 8 * hi); }
        __builtin_amdgcn_sched_barrier(0);
#pragma unroll
        for (int s8 = 0; s8 < 8; ++s8) { acc0 = __builtin_amdgcn_mfma_f32_32x32x16_bf16(av[s8], b0v[s8], acc0, 0, 0, 0); acc1 = __builtin_amdgcn_mfma_f32_32x32x16_bf16(av[s8], b1v[s8], acc1, 0, 0, 0); }
        __builtin_amdgcn_sched_barrier(0);
    }
    LAS float* red = (LAS float*)F.lds;
    LAS bf16* zs = (LAS bf16*)(F.lds + 65536);
    __syncthreads();
#pragma unroll
    for (int r = 0; r < 16; ++r) { const int row = (r & 3) + 8 * (r >> 2) + 4 * hi; red[(w * 32 + row) * 64 + r32] = acc0[r]; red[(w * 32 + row) * 64 + 32 + r32] = acc1[r]; }
    LAS float* cpes = (LAS float*)(F.lds + 65536 + 4096);
    if (w == 0) { const float* cpe = WSP(float, WS_CPE) + kv * 4096; float pv[64];
#pragma unroll
        for (int pp = 0; pp < 64; ++pp) pv[pp] = cpe[pp * 64 + lane];
        __builtin_amdgcn_sched_barrier(0);
        float z0 = 0.f;
#pragma unroll
        for (int pp = 0; pp < 64; ++pp) z0 += pv[pp];
        cpes[lane] = z0; }
    __syncthreads();
    for (int idx = F.tid; idx < 2048; idx += NTHREADS) { float z = cpes[idx & 63];
#pragma unroll
        for (int ww = 0; ww < 8; ++ww) z += red[ww * 2048 + idx];
        const float sl = z * fast_sigmoid(z); zs[idx] = (bf16)(cvtpk(sl, 0.f) & 0xffffu); }
    __syncthreads();
    if (w < 2) {
        f32x16 o = {};
#pragma unroll
        for (int st = 0; st < 4; ++st) {
            const bf16x8 a = *(const LAS bf16x8*)(zs + r32 * 64 + 16 * st + 8 * hi);
            const bf16x8 bb = *(const bf16x8*)(w2t + (size_t)(32 * w + r32) * 64 + 16 * st + 8 * hi);
            o = __builtin_amdgcn_mfma_f32_32x32x16_bf16(a, bb, o, 0, 0, 0);
        }
        const int rbase = rt * 32;
#pragma unroll
        for (int r = 0; r < 16; ++r) { const int row = (r & 3) + 8 * (r >> 2) + 4 * hi, RR = rbase + row, nn = RR & 255;
            const float v = (nn == 255) ? 0.f : o[r];
            if (kv == 0) WSP(bf16, WS_KCMP)[(size_t)RR * 64 + 32 * w + r32] = (bf16)(cvtpk(v, 0.f) & 0xffffu);
            else WSP(bf16, WS_VCMP)[(size_t)RR * 128 + 32 * w + r32] = (bf16)(cvtpk(v, 0.f) & 0xffffu); }
    } else if (kv == 1) {
        for (int idx = F.tid - 128; idx < 2048; idx += NTHREADS - 128) { const int row = idx >> 6, j = idx & 63, RR = rt * 32 + row, nn = RR & 255;
            const bool ov = (nn != 255) && (nn >= 4 * j - 1) && (nn <= 4 * j + 3);
            WSP(bf16, WS_VCMP)[(size_t)RR * 128 + 64 + j] = ov ? (bf16)0x3f80 : (bf16)0; }
    }
    __syncthreads();
}
__device__ __forceinline__ float log_sigmoid_f(float x) { return fminf(x, 0.f) - log1pf(expf(-fabsf(x))); }
__device__ __forceinline__ void p2_cumsum_unit(Frame& F, int bh) {
    const int lane = F.lane, w = F.wave, b = bh >> 3, h = bh & 7; const float bf = F.ka->in[4][h];
    if (w == 0) {
        const float* lg = WSP(float, WS_LG) + (size_t)(b * SEQ + 64 * lane) * 32 + 24 + h;
        float ls[64];
#pragma unroll
        for (int i = 0; i < 64; ++i) ls[i] = lg[(size_t)i * 32];
        double tot = 0.0;
#pragma unroll
        for (int i = 0; i < 64; ++i) { ls[i] = log_sigmoid_f(ls[i] + bf); tot += (double)ls[i]; }
        double inc = tot;
#pragma unroll
        for (int o = 1; o < 64; o <<= 1) { const double v = __shfl_up(inc, o); if (lane >= o) inc += v; }
        double run = inc - tot;
        float* cum = WSP(float, WS_CUM) + (size_t)bh * SEQ + 64 * lane;
#pragma unroll
        for (int i = 0; i < 64; ++i) { run += (double)ls[i]; cum[i] = (float)(run * 1.4426950408889634); }
    }
    const bf16* kf = WSP(bf16, WS_KF) + (size_t)b * SEQ * 512 + h * 64; float km = 0.f;
#pragma unroll
    for (int i = 0; i < 8; ++i) { const u32x4* p = (const u32x4*)(kf + (size_t)(512 * w + 64 * i + lane) * 512); float s = 0.f;
#pragma unroll
        for (int c = 0; c < 8; ++c) { const u32x4 v = p[c]; s += (bflo(v.x) * bflo(v.x) + bfhi(v.x) * bfhi(v.x)) + (bflo(v.y) * bflo(v.y) + bfhi(v.y) * bfhi(v.y)) + (bflo(v.z) * bflo(v.z) + bfhi(v.z) * bfhi(v.z)) + (bflo(v.w) * bflo(v.w) + bfhi(v.w) * bfhi(v.w)); }
        km = fmaxf(km, s); }
#pragma unroll
    for (int o = 1; o < 64; o <<= 1) km = fmaxf(km, __shfl_xor(km, o));
    LAS float* red = (LAS float*)F.lds;
    __syncthreads();
    if (lane == 0) red[w] = km;
    __syncthreads();
    if (F.tid == 0) { float m = red[0];
#pragma unroll
        for (int i = 1; i < 8; ++i) m = fmaxf(m, red[i]);
        WSP(float, WS_KMAX)[bh] = sqrtf(m) * 1.001f; }
}

__device__ __forceinline__ void p6_phase(Frame& F) {
    const int lane = F.lane, w = F.wave, r32 = lane & 31, hi = lane >> 5, grp = w >> 2, kq = w & 3;
    LAS float* red = (LAS float*)F.lds;
    LAS float* ssl = (LAS float*)(F.lds + 32768);
    LAS int* lcnt = (LAS int*)(F.lds + 36864);
    const float* X1 = F.out; const float* brt = F.ka->in[20];
    const bf16* whT = WSP(bf16, WS_WRT); const bf16* wlT = whT + 32 * 1024;
    int* tope = WSP(int, WS_ROUTE); float* topg = (float*)(tope + NTOK * 4); int* lrank = tope + NTOK * 8; float* rstdg = WSP(float, WS_RSTD);
    for (int tile = F.bid; tile < NTOK / 64; tile += F.G) {
        if (F.tid < 32) lcnt[F.tid] = 0;
        const float* xrow = X1 + (size_t)(tile * 64 + grp * 32 + r32) * DM + 8 * hi + 256 * kq;
        const bf16* whp = whT + (size_t)r32 * 1024 + 8 * hi + 256 * kq; const bf16* wlp = wlT + (size_t)r32 * 1024 + 8 * hi + 256 * kq;
        f32x16 acc = f32x16{}; float ss = 0.f;
#pragma unroll
        for (int sb = 0; sb < 2; ++sb) {
            f32x4 xa[8], xb[8]; bf16x8 wh[8], wl[8];
#pragma unroll
            for (int s = 0; s < 8; ++s) { const int o = 16 * (8 * sb + s); xa[s] = *(const f32x4*)(xrow + o); xb[s] = *(const f32x4*)(xrow + o + 4); wh[s] = *(const bf16x8*)(whp + o); wl[s] = *(const bf16x8*)(wlp + o); }
#pragma unroll
            for (int s = 0; s < 8; ++s) {
                const f32x4 a = xa[s], b = xb[s];
                ss += (a.x * a.x + a.y * a.y) + (a.z * a.z + a.w * a.w) + (b.x * b.x + b.y * b.y) + (b.z * b.z + b.w * b.w);
                u32x4 h; h.x = cvtpk(a.x, a.y); h.y = cvtpk(a.z, a.w); h.z = cvtpk(b.x, b.y); h.w = cvtpk(b.z, b.w);
                u32x4 l; l.x = cvtpk(a.x - bflo(h.x), a.y - bfhi(h.x)); l.y = cvtpk(a.z - bflo(h.y), a.w - bfhi(h.y)); l.z = cvtpk(b.x - bflo(h.z), b.y - bfhi(h.z)); l.w = cvtpk(b.z - bflo(h.w), b.w - bfhi(h.w));
                const bf16x8 hv = __builtin_bit_cast(bf16x8, h), lv = __builtin_bit_cast(bf16x8, l);
                acc = __builtin_amdgcn_mfma_f32_32x32x16_bf16(hv, wh[s], acc, 0, 0, 0);
                acc = __builtin_amdgcn_mfma_f32_32x32x16_bf16(lv, wh[s], acc, 0, 0, 0);
                acc = __builtin_amdgcn_mfma_f32_32x32x16_bf16(hv, wl[s], acc, 0, 0, 0);
            }
        }
#pragma unroll
        for (int r = 0; r < 16; ++r) red[(w * 16 + r) * 64 + lane] = acc[r];
        ssl[w * 64 + lane] = ss;
        __syncthreads();
        LAS float* lgt = (LAS float*)(F.lds + 40960);
        LAS float* rsl = (LAS float*)(F.lds + 40960 + 64 * 33 * 4);
        LAS float* topv = rsl + 64;
        LAS int* tope_l = (LAS int*)(topv + 256);
        if (kq == 0) {
#pragma unroll
            for (int r = 0; r < 16; ++r) acc[r] = (red[(w * 16 + r) * 64 + lane] + red[((w + 1) * 16 + r) * 64 + lane]) + (red[((w + 2) * 16 + r) * 64 + lane] + red[((w + 3) * 16 + r) * 64 + lane]);
            ss = (ssl[w * 64 + lane] + ssl[(w + 1) * 64 + lane]) + (ssl[(w + 2) * 64 + lane] + ssl[(w + 3) * 64 + lane]);
            ss += __shfl_xor(ss, 32);
            const float rstd = 1.0f / sqrtf(ss * (1.f / 1024.f) + RMS_EPS);
            if (hi == 0) { rstdg[tile * 64 + grp * 32 + r32] = rstd; rsl[grp * 32 + r32] = rstd; }
#pragma unroll
            for (int r = 0; r < 16; ++r) { const int rowl = (r & 3) + 8 * (r >> 2) + 4 * hi; lgt[(grp * 32 + rowl) * 33 + r32] = acc[r]; }
        }
        __syncthreads();
#pragma unroll
        for (int it = 0; it < 4; ++it) {
            const int row = it * 16 + (F.tid >> 5), e = F.tid & 31;
            const float rs = rsl[row]; const float mine = lgt[row * 33 + e] * rs + brt[e];
            int rank = 0;
#pragma unroll
            for (int j = 0; j < 32; ++j) { const float v = lgt[row * 33 + j] * rs + brt[j]; rank += (v > mine || (v == mine && j < e)) ? 1 : 0; }
            if (rank < 4) { topv[row * 4 + rank] = mine; tope_l[row * 4 + rank] = e; }
        }
        __syncthreads();
        int ee4[4], lr4[4];
        if (F.tid < 64) { const int row = F.tid, t = tile * 64 + row;
            const float v0 = topv[row * 4], e1 = expf(topv[row * 4 + 1] - v0), e2 = expf(topv[row * 4 + 2] - v0), e3 = expf(topv[row * 4 + 3] - v0); const float inv = 1.0f / (1.0f + e1 + e2 + e3);
            const float gs[4] = {inv, e1 * inv, e2 * inv, e3 * inv};
#pragma unroll
            for (int k = 0; k < 4; ++k) { const int ee = tope_l[row * 4 + k]; tope[t * 4 + k] = ee; topg[t * 4 + k] = gs[k]; ee4[k] = ee; lr4[k] = atomicAdd((int*)(lcnt + ee), 1); } }
        __syncthreads();
        if (F.tid < 32) { const int c = lcnt[F.tid]; lcnt[32 + F.tid] = c ? (int)__hip_atomic_fetch_add(WSP(unsigned, WS_CTL) + CW_GCNT + 32 * F.tid, (unsigned)c, __ATOMIC_RELAXED, __HIP_MEMORY_SCOPE_AGENT) : 0; }
        __syncthreads();
        if (F.tid < 64) { const int row = F.tid, t = tile * 64 + row; const float rs_ = rsl[row];
#pragma unroll
            for (int k = 0; k < 4; ++k) { const int rk = lcnt[32 + ee4[k]] + lr4[k]; lrank[t * 4 + k] = rk; WSP(int, WS_ETOK)[ee4[k] * NTOK + rk] = t; WSP(float, WS_ERSTD)[ee4[k] * NTOK + rk] = rs_; } }
        __syncthreads();
    }
}

__device__ __forceinline__ void p7_phase(Frame& F) {
    LAS int* part = (LAS int*)F.lds;
    LAS int* tot = part + 1024; LAS int* pre = tot + 32; LAS int* pstart = pre + 32; LAS int* slotl = pstart + 32;
    const int* blkcnt = WSP(int, WS_BLKCNT);
    int* tope = WSP(int, WS_ROUTE); int* lrank = tope + NTOK * 8; int* slot = tope + NTOK * 12;
    const float* rstdg = WSP(float, WS_RSTD); float* rslot = WSP(float, WS_RSLOT); int* slottok = WSP(int, WS_SLOTTOK);
    for (int tile = F.bid; tile < NTOK / 64; tile += F.G) {
        __syncthreads();
        { const int e = F.tid & 31, p = F.tid >> 5; int st = 0, sp = 0;
          for (int tt = p; tt < NTOK / 64; tt += 16) { const int c = blkcnt[tt * 32 + e]; st += c; if (tt < tile) sp += c; }
          part[p * 32 + e] = st; part[512 + p * 32 + e] = sp; }
        __syncthreads();
        if (F.tid < 32) { int st = 0, sp = 0;
#pragma unroll
            for (int p = 0; p < 16; ++p) { st += part[p * 32 + F.tid]; sp += part[512 + p * 32 + F.tid]; }
            tot[F.tid] = st; pre[F.tid] = sp; }
        __syncthreads();
        if (F.tid == 0) { int run = 0; for (int e = 0; e < 32; ++e) { pstart[e] = run; run += (tot[e] + 255) & ~255; }
            if (tile == 0) { int* te = WSP(int, WS_TILE_E); int j = 0; for (int e = 0; e < 32; ++e) { const int nte = (tot[e] + 255) >> 8; for (int q = 0; q < nte; ++q) te[j++] = e; } te[500] = j; } }
        __syncthreads();
        if (F.tid < 256) { const int a = tile * 256 + F.tid; const int e = tope[a]; const int s = pstart[e] + pre[e] + lrank[a]; slot[a] = s; rslot[s] = rstdg[tile * 64 + (F.tid >> 2)]; slottok[s] = tile * 64 + (F.tid >> 2); }
    }
}

__device__ __forceinline__ void p10_phase(Frame& F, bool with_moe, float* dsto) {
    const int gw = F.vcu * NWAVES + F.wave, NGW = F.G * NWAVES, lane = F.lane;
    const int* tope = WSP(int, WS_ROUTE); const float* topg = (const float*)(tope + NTOK * 4); const int* rank = tope + NTOK * 8;
    const LAS int* pstart = (const LAS int*)(F.lds + MT_OFF) + 320;
    const bf16* OS = WSP(bf16, WS_AMOE); const float* gfin = F.ka->in[25];
    for (int t = gw; t < NTOK; t += NGW) {
        const f32x4* xr = (const f32x4*)((with_moe ? F.out : F.ka->in[0]) + (size_t)t * DM) + lane;
        f32x4 v[4];
#pragma unroll
        for (int j = 0; j < 4; ++j) v[j] = xr[64 * j];
        if (with_moe) {
#pragma unroll
            for (int k = 0; k < 4; ++k) { const float gk = topg[t * 4 + k]; const u32x2* orow = (const u32x2*)(OS + (size_t)(pstart[tope[t * 4 + k]] + rank[t * 4 + k]) * DM) + lane;
#pragma unroll
                for (int j = 0; j < 4; ++j) { const u32x2 o = orow[64 * j]; v[j].x += gk * bflo(o.x); v[j].y += gk * bfhi(o.x); v[j].z += gk * bflo(o.y); v[j].w += gk * bfhi(o.y); } }
        }
        float s = 0.f;
#pragma unroll
        for (int j = 0; j < 4; ++j) s += (v[j].x * v[j].x + v[j].y * v[j].y) + (v[j].z * v[j].z + v[j].w * v[j].w);
        const float rstd = 1.0f / sqrtf(wave_sum(s) * (1.f / 1024.f) + RMS_EPS);
        f32x4* orow = (f32x4*)(dsto + (size_t)t * DM) + lane;
#pragma unroll
        for (int j = 0; j < 4; ++j) orow[64 * j] = v[j] * rstd * ((const f32x4*)gfin)[64 * j + lane];
    }
}
constexpr int AL_RING = 0, AL_OACC = 49152, AL_BIAS = 114688, AL_WSF = AL_BIAS + 3 * 8 * 64 * 4, AL_IMP = AL_WSF + 8 * 64 * 4, AL_SELB = AL_IMP + 64 * 65 * 4, AL_UNI = AL_SELB + 512, AL_TICKET = AL_UNI + 16;
static_assert(AL_TICKET + 16 <= LDS_BYTES - 64 && AL_OACC + 65536 <= AL_BIAS, "attention LDS map");
__device__ __forceinline__ int crow(int r, int hi) { return (r & 3) + 8 * (r >> 2) + 4 * hi; }
__device__ __forceinline__ s16x4 vtr(const LAS char* p) { return __builtin_bit_cast(s16x4, __builtin_amdgcn_ds_read_tr16_b64_v4i16((LAS s16x4*)p)); }

__device__ __forceinline__ float max3f(float a, float b, float c) { float r; asm("v_max3_f32 %0, %1, %2, %3" : "=v"(r) : "v"(a), "v"(b), "v"(c)); return r; }
struct AttnCtx { LAS unsigned char* lds; int tid, lane, w, r32, hi; LAS float* wsf; };
__device__ __forceinline__ AttnCtx make_ctx(LAS unsigned char* lds) {
    int tid = threadIdx.x; asm volatile("" : "+v"(tid));
    AttnCtx C; C.lds = lds; C.tid = tid; C.lane = tid & 63; C.w = __builtin_amdgcn_readfirstlane(tid >> 6); C.r32 = tid & 31; C.hi = (tid >> 5) & 1; C.wsf = (LAS float*)(lds + AL_WSF) + C.w * 64;
    return C;
}

template <int NDB> __device__ __forceinline__ void scale_rows(const AttnCtx& C, f32x16 (&o)[NDB], float vq, int slot) {
    if (C.hi == 0) C.wsf[slot + C.r32] = vq;
#pragma unroll
    for (int rg = 0; rg < 4; ++rg) { const f32x4 a4 = *(const LAS f32x4*)(C.wsf + slot + 8 * rg + 4 * C.hi);
#pragma unroll
        for (int db = 0; db < NDB; ++db) { o[db][4 * rg + 0] *= a4.x; o[db][4 * rg + 1] *= a4.y; o[db][4 * rg + 2] *= a4.z; o[db][4 * rg + 3] *= a4.w; } }
}

__device__ __forceinline__ void dma16(const void* g, LAS unsigned char* lds_wave_base) { __builtin_amdgcn_global_load_lds((const unsigned*)g, (LAS unsigned*)lds_wave_base, 16, 0, 0); }
__device__ __forceinline__ void dma4(const void* g, LAS unsigned char* lds_wave_base) { __builtin_amdgcn_global_load_lds((const unsigned*)g, (LAS unsigned*)lds_wave_base, 4, 0, 0); }
template <int N> __device__ __forceinline__ void wait_vm() {
    if constexpr (N == 0) asm volatile("s_waitcnt vmcnt(0)" ::: "memory"); else if constexpr (N == 2) asm volatile("s_waitcnt vmcnt(2)" ::: "memory");
    else if constexpr (N == 3) asm volatile("s_waitcnt vmcnt(3)" ::: "memory"); else if constexpr (N == 4) asm volatile("s_waitcnt vmcnt(4)" ::: "memory"); else static_assert(N == 0, "wait_vm");
}
struct NoHook { static constexpr bool ON = false; __device__ __forceinline__ void tile(const f32x16&, const f32x16&, float) {} __device__ __forceinline__ void fin(float, float) {} };
struct ImpHook {
    static constexpr bool ON = true;
    LAS float* raw; int hi, ti; float carry, m_fin, l_fin;
    __device__ __forceinline__ void tile(const f32x16& p0, const f32x16& p1, float m_ref) {
        const float fac = __builtin_amdgcn_exp2f(m_ref);
        float bs[8], last[8], ol[8];
#pragma unroll
        for (int i = 0; i < 4; ++i) { bs[i] = (p0[4 * i] + p0[4 * i + 1]) + (p0[4 * i + 2] + p0[4 * i + 3]); last[i] = p0[4 * i + 3];
                                      bs[4 + i] = (p1[4 * i] + p1[4 * i + 1]) + (p1[4 * i + 2] + p1[4 * i + 3]); last[4 + i] = p1[4 * i + 3]; }
#pragma unroll
        for (int k = 0; k < 8; ++k) ol[k] = __shfl_xor(last[k], 32);
#pragma unroll
        for (int k = 0; k < 8; ++k) { const float extra = hi ? ol[k] : (k ? ol[k - 1] : 0.f); float v = (bs[k] + extra) * fac; if (k == 0 && !hi) v += carry; raw[(ti * 8 + k) * 64] = v; }
        carry = ol[7] * fac; ++ti;
    }
    __device__ __forceinline__ void fin(float m_ref, float l) { m_fin = m_ref; l_fin = l; }
};
template <int DQK, int DV, bool BIAS, class Pol, class Hook, int MODE = 0>
__device__ __forceinline__ void attn_core_h(const AttnCtx& C, const Pol& P, const bf16x8 (&qf)[DQK / 16], f32x16 (&o)[DV / 32], Hook& H);
template <int DQK, int DV, bool BIAS, class Pol>
__device__ __forceinline__ void attn_core(const AttnCtx& C, const Pol& P, const bf16x8 (&qf)[DQK / 16], f32x16 (&o)[DV / 32]) { NoHook H; attn_core_h<DQK, DV, BIAS>(C, P, qf, o, H); }
template <int DQK, int DV, bool BIAS, class Pol, class Hook, int MODE>
__device__ __forceinline__ void attn_core_h(const AttnCtx& C, const Pol& P, const bf16x8 (&qf)[DQK / 16], f32x16 (&o)[DV / 32], Hook& H) {
    constexpr int NKP = DQK / 64, NVP = DV / 64, NDB = DV / 32, ND0 = DQK / 16, KROW = DQK * 2, KCH = DQK / 8, VCH = DV / 8, KBYTES = DQK * 128, SLOT = (DQK + DV) * 128, PT = NKP + NVP + (BIAS ? 1 : 0);
    int tid = C.tid; asm volatile("" : "+v"(tid));
    const int lane = tid & 63, r32 = lane & 31, hi = lane >> 5, w = C.w;
    int ksrc[NKP], vsrc[NVP];
#pragma unroll
    for (int j = 0; j < NKP; ++j) { const int id = tid + 512 * j, key = id / KCH, slot = id % KCH; const int c = slot ^ (DQK == 64 ? ((key >> 1) & 7) : (key & 15)); ksrc[j] = key * P.kpitch() + c * 8; }
#pragma unroll
    for (int j = 0; j < NVP; ++j) { const int id = tid + 512 * j, db = id >> 8, rem = id & 255, key = 8 * (rem >> 5) + ((rem & 31) >> 2), pc = 4 * db + (rem & 3); vsrc[j] = key * P.vpitch() + pc * 8; }
    int koff[ND0];
#pragma unroll
    for (int d0 = 0; d0 < ND0; ++d0) koff[d0] = r32 * KROW + (((2 * d0 + hi) ^ (DQK == 64 ? ((r32 >> 1) & 7) : (r32 & 15))) << 4);
    const int vbase = ((lane >> 4) & 1) * 32 + (lane & 3) * 8 + (4 * hi + ((lane & 15) >> 2)) * 64;
    LAS unsigned char* lds = C.lds;
    LAS float* biasw = (LAS float*)(lds + AL_BIAS) + w * 64;
#define ATT_DMA(t, s) do { const bf16* kp_ = P.kptr(t); const bf16* vp_ = P.vptr(t); LAS unsigned char* sb_ = lds + AL_RING + (s) * SLOT + w * 1024; \
        _Pragma("unroll") for (int j = 0; j < NKP; ++j) dma16(kp_ + ksrc[j], sb_ + j * 8192); \
        _Pragma("unroll") for (int j = 0; j < NVP; ++j) dma16(vp_ + vsrc[j], sb_ + KBYTES + j * 8192); \
        if (BIAS) dma4(P.biasptr(t) + lane, (LAS unsigned char*)(biasw + (s) * 512)); } while (0)
    float m_ref = 0.f, l_part = 0.f; bool seen = false;
#pragma unroll
    for (int db = 0; db < NDB; ++db) o[db] = f32x16{};
    int t = P.first(), t1 = P.next(t);
    if constexpr (MODE != 2) {
        asm volatile("s_waitcnt vmcnt(0) lgkmcnt(0)" ::: "memory"); __builtin_amdgcn_s_barrier();
        ATT_DMA(t, 0);
        if (t1 >= 0) ATT_DMA(t1, 1);
    }
    if constexpr (MODE == 1) return;
    int s0 = 0;
    while (t >= 0) {
        const int t2 = (t1 >= 0) ? P.next(t1) : -1;
        if (t1 >= 0) wait_vm<PT>(); else wait_vm<0>();
        asm volatile("s_waitcnt lgkmcnt(0)" ::: "memory"); __builtin_amdgcn_s_barrier(); asm volatile("" ::: "memory");
        const int s2 = (s0 >= 1) ? s0 - 1 : 2;
        if (t2 >= 0) ATT_DMA(t2, s2);
        if (!P.wave_skip(t)) {
            const LAS unsigned char* Kb = lds + AL_RING + s0 * SLOT; const LAS unsigned char* Vb = Kb + KBYTES;
            const float cbase = P.lane_valid(t) ? -m_ref : NEGBIG;
            f32x16 p0, p1;
            if (BIAS) {
                const float cb = cbase + P.bias_ref();
#pragma unroll
                for (int rg = 0; rg < 4; ++rg) { const f32x4 b0 = *(const LAS f32x4*)(biasw + s0 * 512 + 8 * rg + 4 * hi), b1 = *(const LAS f32x4*)(biasw + s0 * 512 + 32 + 8 * rg + 4 * hi);
                    p0[4 * rg] = cb - b0.x; p0[4 * rg + 1] = cb - b0.y; p0[4 * rg + 2] = cb - b0.z; p0[4 * rg + 3] = cb - b0.w;
                    p1[4 * rg] = cb - b1.x; p1[4 * rg + 1] = cb - b1.y; p1[4 * rg + 2] = cb - b1.z; p1[4 * rg + 3] = cb - b1.w; }
            } else {
#pragma unroll
                for (int r = 0; r < 16; ++r) { p0[r] = cbase; p1[r] = cbase; }
            }
#pragma unroll
            for (int d0 = 0; d0 < ND0; ++d0) {
                const bf16x8 k0 = *(const LAS bf16x8*)(Kb + koff[d0]); const bf16x8 k1 = *(const LAS bf16x8*)(Kb + koff[d0] + 32 * KROW);
                p0 = __builtin_amdgcn_mfma_f32_32x32x16_bf16(k0, qf[d0], p0, 0, 0, 0);
                p1 = __builtin_amdgcn_mfma_f32_32x32x16_bf16(k1, qf[d0], p1, 0, 0, 0);
            }
            asm volatile("s_nop 15\n\ts_nop 7" : "+v"(p0), "+v"(p1));
            if (P.masked(t)) {
#pragma unroll
                for (int r = 0; r < 16; ++r) { const int kvl = crow(r, hi);
                    if (!P.valid(t, kvl)) p0[r] = NEGBIG;
                    if (!P.valid(t, kvl + 32)) p1[r] = NEGBIG; }
            }
            float rm = max3f(p0[0], p1[0], p0[1]), rm2 = max3f(p1[1], p0[2], p1[2]);
#pragma unroll
            for (int r = 3; r < 15; r += 2) { rm = max3f(rm, p0[r], p1[r]); rm2 = max3f(rm2, p0[r + 1], p1[r + 1]); }
            rm = max3f(rm, p0[15], p1[15]);
            rm = max3f(rm, rm2, rm2);
            rm = max3f(rm, __shfl_xor(rm, 32), rm);
            const bool any_valid = rm > -1e29f;
            const bool trig = (rm > 8.0f) || (!seen && any_valid);
            if (__any(trig)) {
                const float dl = trig ? rm : 0.f; const float alpha = (trig && seen) ? __builtin_amdgcn_exp2f(-dl) : 1.0f;
                m_ref += dl; l_part *= alpha;
#pragma unroll
                for (int r = 0; r < 16; ++r) { p0[r] -= dl; p1[r] -= dl; }
                scale_rows<NDB>(C, o, alpha, 0);
            }
            seen = seen || any_valid;
            float ls = 0.f;
#pragma unroll
            for (int r = 0; r < 16; ++r) { const float e0 = __builtin_amdgcn_exp2f(p0[r]), e1 = __builtin_amdgcn_exp2f(p1[r]); p0[r] = e0; p1[r] = e1; ls += e0 + e1; }
            l_part += ls;
            if constexpr (Hook::ON) H.tile(p0, p1, m_ref);
            u32x4 pw[4];
#pragma unroll
            for (int k = 0; k < 4; ++k) { pw[0][k] = cvtpk(p0[2 * k], p0[2 * k + 1]); pw[1][k] = cvtpk(p0[8 + 2 * k], p0[9 + 2 * k]); pw[2][k] = cvtpk(p1[2 * k], p1[2 * k + 1]); pw[3][k] = cvtpk(p1[8 + 2 * k], p1[9 + 2 * k]); }
#pragma unroll
            for (int db = 0; db < NDB; ++db) {
#pragma unroll
                for (int s = 0; s < 4; ++s) {
                    const s16x4 lo = vtr((const LAS char*)Vb + vbase + db * 4096 + s * 1024), hh = vtr((const LAS char*)Vb + vbase + db * 4096 + s * 1024 + 512);
                    const bf16x8 vf = {lo[0], lo[1], lo[2], lo[3], hh[0], hh[1], hh[2], hh[3]};
                    o[db] = __builtin_amdgcn_mfma_f32_32x32x16_bf16(__builtin_bit_cast(bf16x8, pw[s]), vf, o[db], 0, 0, 0);
                }
            }
        }
        s0 = (s0 == 2) ? 0 : s0 + 1; t = t1; t1 = t2;
    }
    const float l = l_part + __shfl_xor(l_part, 32);
    if constexpr (Hook::ON) H.fin(m_ref, l);
    scale_rows<NDB>(C, o, l > 0.f ? 1.0f / l : 0.f, 32);
    asm volatile("s_waitcnt lgkmcnt(0)" ::: "memory"); __builtin_amdgcn_s_barrier(); asm volatile("" ::: "memory");
#undef ATT_DMA
}

struct FoxPol {
    const bf16 *K, *V; const float* cum; float ref; int qb, w, tq, tmin;
    __device__ __forceinline__ int first() const { return 4 * qb + 3; }
    __device__ __forceinline__ int next(int t) const { return t - 1 >= tmin ? t - 1 : -1; }
    __device__ __forceinline__ bool masked(int t) const { return t >= 4 * qb; }
    __device__ __forceinline__ bool valid(int t, int kvl) const { return 64 * t + kvl <= tq; }
    __device__ __forceinline__ bool wave_skip(int t) const { return 64 * (t - 4 * qb) > 32 * w + 31; }
    __device__ __forceinline__ bool lane_valid(int) const { return true; }
    __device__ __forceinline__ const bf16* kptr(int t) const { return K + (size_t)(64 * t) * 512; }
    __device__ __forceinline__ const bf16* vptr(int t) const { return V + (size_t)(64 * t) * 512; }
    __device__ __forceinline__ int kpitch() const { return 512; }
    __device__ __forceinline__ int vpitch() const { return 512; }
    __device__ __forceinline__ const float* biasptr(int t) const { return cum + 64 * t; }
    __device__ __forceinline__ float bias_ref() const { return ref; }
};
struct MemPol {
    const bf16 *K, *V;
    __device__ __forceinline__ int first() const { return 0; }
    __device__ __forceinline__ int next(int t) const { return t < 3 ? t + 1 : -1; }
    __device__ __forceinline__ bool masked(int) const { return false; }
    __device__ __forceinline__ bool valid(int, int) const { return true; }
    __device__ __forceinline__ bool wave_skip(int) const { return false; }
    __device__ __forceinline__ bool lane_valid(int) const { return true; }
    __device__ __forceinline__ const bf16* kptr(int t) const { return K + (size_t)(64 * t) * 512; }
    __device__ __forceinline__ const bf16* vptr(int t) const { return V + (size_t)(64 * t) * 512; }
    __device__ __forceinline__ int kpitch() const { return 512; }
    __device__ __forceinline__ int vpitch() const { return 512; }
    __device__ __forceinline__ const float* biasptr(int) const { return nullptr; }
    __device__ __forceinline__ float bias_ref() const { return 0.f; }
};
struct CmpPol {
    const bf16 *K, *V; int ntc, tq;
    __device__ __forceinline__ int first() const { return 0; }
    __device__ __forceinline__ int next(int t) const { return t + 1 < ntc ? t + 1 : -1; }
    __device__ __forceinline__ bool masked(int) const { return true; }
    __device__ __forceinline__ bool valid(int t, int kvl) const { return 16 * (64 * t + kvl) + 31 <= tq; }
    __device__ __forceinline__ bool wave_skip(int) const { return false; }
    __device__ __forceinline__ bool lane_valid(int) const { return true; }
    __device__ __forceinline__ const bf16* kptr(int t) const { return K + (size_t)(64 * t) * 64; }
    __device__ __forceinline__ const bf16* vptr(int t) const { return V + (size_t)(64 * t) * 128; }
    __device__ __forceinline__ int kpitch() const { return 64; }
    __device__ __forceinline__ int vpitch() const { return 128; }
    __device__ __forceinline__ const float* biasptr(int) const { return nullptr; }
    __device__ __forceinline__ float bias_ref() const { return 0.f; }
};
struct WinPol {
    const bf16 *K, *V; int T, tq;
    __device__ __forceinline__ int first() const { return T; }
    __device__ __forceinline__ int next(int t) const { return (t - 1 >= 0 && t - 1 >= T - 8) ? t - 1 : -1; }
    __device__ __forceinline__ bool masked(int t) const { return t == T || t == T - 8; }
    __device__ __forceinline__ bool valid(int t, int kvl) const { const int d = tq - (64 * t + kvl); return d >= 0 && d < 512; }
    __device__ __forceinline__ bool wave_skip(int) const { return false; }
    __device__ __forceinline__ bool lane_valid(int) const { return true; }
    __device__ __forceinline__ const bf16* kptr(int t) const { return K + (size_t)(64 * t) * 128; }
    __device__ __forceinline__ const bf16* vptr(int t) const { return V + (size_t)(64 * t) * 128; }
    __device__ __forceinline__ int kpitch() const { return 128; }
    __device__ __forceinline__ int vpitch() const { return 128; }
    __device__ __forceinline__ const float* biasptr(int) const { return nullptr; }
    __device__ __forceinline__ float bias_ref() const { return 0.f; }
};
struct SelPol {
    const bf16 *K, *V; unsigned long long uni, mine; int T, tq;
    __device__ __forceinline__ int first() const { return 63 - __clzll(uni); }
    __device__ __forceinline__ int next(int t) const { const unsigned long long m = uni & ((1ull << t) - 1ull); return m ? 63 - __clzll(m) : -1; }
    __device__ __forceinline__ bool masked(int t) const { return t == T; }
    __device__ __forceinline__ bool valid(int t, int kvl) const { return 64 * t + kvl <= tq; }
    __device__ __forceinline__ bool wave_skip(int) const { return false; }
    __device__ __forceinline__ bool lane_valid(int t) const { return (mine >> t) & 1ull; }
    __device__ __forceinline__ const bf16* kptr(int t) const { return K + (size_t)(64 * t) * 128; }
    __device__ __forceinline__ const bf16* vptr(int t) const { return V + (size_t)(64 * t) * 128; }
    __device__ __forceinline__ int kpitch() const { return 128; }
    __device__ __forceinline__ int vpitch() const { return 128; }
    __device__ __forceinline__ const float* biasptr(int) const { return nullptr; }
    __device__ __forceinline__ float bias_ref() const { return 0.f; }
};

template <int NDB, class RowF> __device__ __forceinline__ void store_o(const AttnCtx& C, const f32x16 (&o)[NDB], bf16* dst, RowF rowoff) {
#pragma unroll
    for (int r = 0; r < 16; ++r) { const int q = crow(r, C.hi); bf16* p = dst + rowoff(q) + C.r32;
#pragma unroll
        for (int db = 0; db < NDB; ++db) p[32 * db] = (bf16)(cvtpk(o[db][r], 0.f) & 0xffffu); }
}

__device__ __forceinline__ void fox_unit(Frame& F0, int bh, int qb) {
    const AttnCtx C = make_ctx(F0.lds);
    struct { unsigned char* ws; } F; { unsigned long long w_ = (unsigned long long)F0.ws; asm volatile("" : "+s"(w_)); F.ws = (unsigned char*)w_; }
    const int b = bh >> 3, h = bh & 7, tq = 256 * qb + 32 * C.w + C.r32;
    const bf16* Q = WSP(bf16, WS_QF) + ((size_t)(b * SEQ + tq)) * 512 + h * 64;
    bf16x8 qf[4];
#pragma unroll
    for (int d0 = 0; d0 < 4; ++d0) qf[d0] = *(const bf16x8*)(Q + 16 * d0 + 8 * C.hi);
    const float* cum = WSP(float, WS_CUM) + (size_t)bh * SEQ;
    int tmin = 0;
    { float qn = 0.f;
#pragma unroll
      for (int d0 = 0; d0 < 4; ++d0)
#pragma unroll
          for (int j = 0; j < 8; ++j) { const float v = bf2f((unsigned short)qf[d0][j]); qn += v * v; }
      qn += __shfl_xor(qn, 32);
#pragma unroll
      for (int o = 16; o >= 1; o >>= 1) qn = fmaxf(qn, __shfl_xor(qn, o));
      LAS float* qmx = (LAS float*)(C.lds + AL_SELB);
      __syncthreads();
      if (C.lane == 0) qmx[C.w] = qn;
      __syncthreads();
      float qm = qmx[0];
#pragma unroll
      for (int i = 1; i < 8; ++i) qm = fmaxf(qm, qmx[i]);
      const float B = sqrtf(qm) * WSP(float, WS_KMAX)[bh];
      const float thr = -(40.0f + 2.0f * B), c0 = cum[256 * qb];
      const bool cond = (C.lane < 4 * qb) && (c0 - cum[64 * C.lane + 63] < thr);
      const unsigned long long bal = __ballot(cond);
      tmin = bal ? 64 - __clzll(bal) : 0; }
    FoxPol P{WSP(bf16, WS_KF) + (size_t)b * SEQ * 512 + h * 64, WSP(bf16, WS_VF) + (size_t)b * SEQ * 512 + h * 64, cum, cum[256 * qb + 255], qb, C.w, tq, tmin};
    f32x16 o[2];
    attn_core<64, 64, true>(C, P, qf, o);
    bf16* dst = WSP(bf16, WS_OBR) + (size_t)1 * NTOK * 512 + h * 64;
    const size_t rb = (size_t)(b * SEQ + 256 * qb + 32 * C.w);
    store_o<2>(C, o, dst, [&](int q) { return (rb + q) * 512; });
}
__device__ __forceinline__ void mem_unit(Frame& F0, int bh, int qb) {
    const AttnCtx C = make_ctx(F0.lds);
    struct { unsigned char* ws; } F; { unsigned long long w_ = (unsigned long long)F0.ws; asm volatile("" : "+s"(w_)); F.ws = (unsigned char*)w_; }
    const int b = bh >> 2, h = bh & 3, tq = 256 * qb + 32 * C.w + C.r32;
    const bf16* Q = WSP(bf16, WS_QM) + ((size_t)(b * SEQ + tq)) * 512 + h * 128;
    bf16x8 qf[8];
#pragma unroll
    for (int d0 = 0; d0 < 8; ++d0) qf[d0] = *(const bf16x8*)(Q + 16 * d0 + 8 * C.hi);
    MemPol P{WSP(bf16, WS_KMEM) + (size_t)b * MEMLEN * 512 + h * 128, WSP(bf16, WS_VMEM) + (size_t)b * MEMLEN * 512 + h * 128};
    f32x16 o[4];
    attn_core<128, 128, false>(C, P, qf, o);
    bf16* dst = WSP(bf16, WS_OBR) + (size_t)2 * NTOK * 512 + h * 128;
    const size_t rb = (size_t)(b * SEQ + 256 * qb + 32 * C.w);
    store_o<4>(C, o, dst, [&](int q) { return (rb + q) * 512; });
}
__device__ __forceinline__ void nsa_unit(Frame& F0, int bg, int T, int parts) {
    const AttnCtx C = make_ctx(F0.lds);
    struct { unsigned char* ws; } F; { unsigned long long w_ = (unsigned long long)F0.ws; asm volatile("" : "+s"(w_)); F.ws = (unsigned char*)w_; }
    const int b = bg >> 1, g = bg & 1, q = C.r32, tokl = 8 * C.w + (q >> 2), tq = 64 * T + tokl, head = 4 * g + (q & 3);
    const bf16* Q = WSP(bf16, WS_QA) + ((size_t)(b * SEQ + tq)) * 512 + head * 64;
    bf16x8 qf[4];
#pragma unroll
    for (int d0 = 0; d0 < 4; ++d0) qf[d0] = *(const bf16x8*)(Q + 16 * d0 + 8 * C.hi);
    const float* lg = WSP(float, WS_LG) + (size_t)(b * SEQ + tq) * 32 + head * 3;
    LAS float* oacc = (LAS float*)(C.lds + AL_OACC) + C.w * 2048 + C.lane;
    LAS float* imp = (LAS float*)(C.lds + AL_IMP);
    LAS unsigned long long* selb = (LAS unsigned long long*)(C.lds + AL_SELB);
    LAS unsigned long long* unip = (LAS unsigned long long*)(C.lds + AL_UNI);
#ifndef NSA_CORES
#define NSA_CORES 7
#endif
    const WinPol PW{WSP(bf16, WS_KV6) + (size_t)4 * NTOK * 128 + (size_t)b * SEQ * 128 + g * 64, WSP(bf16, WS_KV6) + (size_t)5 * NTOK * 128 + (size_t)b * SEQ * 128 + g * 64, T, tq};
    if (NSA_CORES & 1) {
        CmpPol P{WSP(bf16, WS_KCMP) + (size_t)bg * 256 * 64, WSP(bf16, WS_VCMP) + (size_t)bg * 256 * 128, (4 * T + 2) / 64 + 1, tq};
        f32x16 o2[2];
        ImpHook H{oacc, C.hi, 0, 0.f, 0.f, 0.f};
        attn_core_h<64, 64, false>(C, P, qf, o2, H);
        { NoHook Hn; f32x16 od[2]; attn_core_h<64, 64, false, WinPol, NoHook, 1>(C, PW, qf, od, Hn); }
        {
            const float invL = H.l_fin > 0.f ? __builtin_amdgcn_exp2f(-H.m_fin) / H.l_fin : 0.f; const int nsl = 8 * H.ti;
#pragma unroll
            for (int sl = 0; sl < 32; ++sl) { float v = (sl < nsl) ? oacc[sl * 64] * invL : 0.f;
                v += __shfl_xor(v, 1); v += __shfl_xor(v, 2);
                if ((q & 3) == 0) imp[tokl * 65 + 2 * sl + C.hi] = v; }
            asm volatile("s_waitcnt lgkmcnt(0)" ::: "memory");
        }
        scale_rows<2>(C, o2, (parts & 1) ? fast_sigmoid(lg[0]) : 0.f, 0);
#pragma unroll
        for (int db = 0; db < 2; ++db)
#pragma unroll
            for (int r = 0; r < 16; ++r) oacc[(db * 16 + r) * 64] = o2[db][r];
    }
    __syncthreads();
    {
        const int tk = C.tid >> 3, sub = C.tid & 7;
        float mine[8]; int rank[8];
#pragma unroll
        for (int i = 0; i < 8; ++i) { const int j = 8 * sub + i; const float v = imp[tk * 65 + j];
            mine[i] = (j == 0 || j == T || j == T - 1) ? 1e4f : (j > T ? -1e4f : v); rank[i] = 0; }
        for (int jj = 0; jj <= T; ++jj) {   const float v0 = imp[tk * 65 + jj]; const float v = (jj == 0 || jj == T || jj == T - 1) ? 1e4f : (jj > T ? -1e4f : v0);
#pragma unroll
            for (int i = 0; i < 8; ++i) { const int j = 8 * sub + i; rank[i] += (v > mine[i] || (v == mine[i] && jj < j)) ? 1 : 0; } }
        unsigned byte = 0;
#pragma unroll
        for (int i = 0; i < 8; ++i) { const int j = 8 * sub + i; if (rank[i] < 16 && j <= T) byte |= 1u << i; }
        ((LAS unsigned char*)selb)[tk * 8 + sub] = (unsigned char)byte;
    }
    __syncthreads();
    if (C.w == 0) { unsigned long long m = selb[C.lane]; unsigned lo = (unsigned)m, hh = (unsigned)(m >> 32);
#pragma unroll
        for (int o = 1; o < 64; o <<= 1) { lo |= __shfl_xor(lo, o); hh |= __shfl_xor(hh, o); }
        if (C.lane == 0) unip[0] = ((unsigned long long)hh << 32) | lo; }
    __syncthreads();
    const unsigned long long mymask = selb[tokl]; unsigned long long uni = unip[0];
    uni = ((unsigned long long)__builtin_amdgcn_readfirstlane((unsigned)(uni >> 32)) << 32) | (unsigned)__builtin_amdgcn_readfirstlane((unsigned)uni);
    {
        f32x16 o2[2];
        { NoHook Hn; attn_core_h<64, 64, false, WinPol, NoHook, 2>(C, PW, qf, o2, Hn); }
        scale_rows<2>(C, o2, (parts & 4) ? fast_sigmoid(lg[2]) : 0.f, 0);
#pragma unroll
        for (int db = 0; db < 2; ++db)
#pragma unroll
            for (int r = 0; r < 16; ++r) oacc[(db * 16 + r) * 64] += o2[db][r];
    }
    {
        SelPol P{WSP(bf16, WS_KV6) + (size_t)2 * NTOK * 128 + (size_t)b * SEQ * 128 + g * 64, WSP(bf16, WS_KV6) + (size_t)3 * NTOK * 128 + (size_t)b * SEQ * 128 + g * 64, uni, mymask, T, tq};
        f32x16 o2[2];
        attn_core<64, 64, false>(C, P, qf, o2);
        scale_rows<2>(C, o2, (parts & 2) ? fast_sigmoid(lg[1]) : 0.f, 0);
#pragma unroll
        for (int db = 0; db < 2; ++db)
#pragma unroll
            for (int r = 0; r < 16; ++r) o2[db][r] += oacc[(db * 16 + r) * 64];
        bf16* dst = WSP(bf16, WS_OBR) + g * 256;
        const size_t rb = (size_t)(b * SEQ + 64 * T + 8 * C.w);
        store_o<2>(C, o2, dst, [&](int qq) { return (rb + (qq >> 2)) * 512 + (qq & 3) * 64; });
    }
}

__device__ __forceinline__ void p3_phase(Frame& F, int parts, int rep) {
    LAS int* ticket = (LAS int*)(F.lds + AL_TICKET);
    unsigned* ctl = WSP(unsigned, WS_CTL);
    unsigned* qhead = ctl + CW_QATTN + 64 * rep; const unsigned* order = WSP(unsigned, WS_ORDER);
    for (;;) {
        __syncthreads();
        if (F.tid == 0) ticket[0] = (int)atomicAdd(qhead, 1u);
        __syncthreads();
        const int tk = __builtin_amdgcn_readfirstlane(ticket[0]);
        if (tk >= N_QUEUE) break;
        const unsigned d = __builtin_amdgcn_readfirstlane(order[tk]); const int type = d & 7, a = (d >> 3) & 255, bb = d >> 11;
#ifdef REP_ATTN_ONLY
        if (rep > 0 && type >= 3) continue;
#endif
#ifdef REP_CVT_ONLY
        if (rep > 0 && type != 5) continue;
#endif
        if (type == 0) { q_wait(ctl + CW_CMPDONE + 64 * a, 16u, F.tid); nsa_unit(F, a, bb, parts); }
        else if (type == 1) { q_wait(ctl + CW_CUMDONE + 64 * (a >> 3), 8u, F.tid); fox_unit(F, a, bb); }
        else if (type == 2) mem_unit(F, a, bb);
#ifndef QDIS
#define QDIS 0
#endif
        else if (type == 3) { if (!(QDIS & 1)) p2_compress_unit(F, a, bb); q_signal(ctl + CW_CMPDONE + 64 * (bb >> 3), F.tid); }
        else if (type == 4) { if (!(QDIS & 2)) p2_cumsum_unit(F, a); q_signal(ctl + CW_CUMDONE + 64 * (a >> 3), F.tid); }
        else { if (!(QDIS & 4)) convert_unit(F, bb, a); }
    }
}
#define XB_TMO      128
#define XB_XCNT(j)  (256  + 64 * (j))
#define XB_XSUB(j)  (1280 + 64 * (j))
#define XB_XGEN(j)  (2304 + 64 * (j))
#define XB_TOP      3328
#define XB_TOPGEN   3392
#define XCD_BAR_WORDS 3456
#define XB_SPIN_CAP (1u << 18)

__device__ __forceinline__ unsigned xb_ld(unsigned* p)              { return __hip_atomic_load(p, __ATOMIC_RELAXED, __HIP_MEMORY_SCOPE_AGENT); }
__device__ __forceinline__ unsigned xb_add(unsigned* p, unsigned v) { return __hip_atomic_fetch_add(p, v, __ATOMIC_RELAXED, __HIP_MEMORY_SCOPE_AGENT); }
__device__ __forceinline__ unsigned xb_xcc_id() { return (unsigned)__builtin_amdgcn_s_getreg((3 << 11) | 20) & 0xFu; }
#define XB_SPIN(cond, bar) do { unsigned _sp = 0; while (cond) { __builtin_amdgcn_s_sleep(1); \
    if ((++_sp & 255u) == 0u) { if (xb_ld(&(bar)[XB_TMO])) break; if (_sp > XB_SPIN_CAP) { atomicAdd(&(bar)[XB_TMO], 1u); break; } } } } while (0)

struct XcdBarrier {
    unsigned* bar; unsigned x;
    volatile LAS unsigned* st;
};

__device__ __forceinline__ XcdBarrier xcd_barrier_post(unsigned* bar, volatile LAS unsigned* st) {
    XcdBarrier b; b.bar = bar; b.x = xb_xcc_id(); b.st = st;
    if (threadIdx.x == 0) (void)xb_add(&bar[XB_XCNT(b.x)], 1u);
    return b;
}
__device__ __forceinline__ void xcd_barrier_complete(unsigned* bar, unsigned x, unsigned& nloc, unsigned& nx) {
    const unsigned G = gridDim.x * gridDim.y * gridDim.z;
    unsigned sum, cnt, mine, sp = 0u;
    for (;;) {
        sum = 0u; cnt = 0u; mine = 0u;
#pragma unroll
        for (unsigned j = 0; j < 16; ++j) { const unsigned c = xb_ld(&bar[XB_XCNT(j)]); sum += c; cnt += (c > 0u) ? 1u : 0u; mine = (j == x) ? c : mine; }
        if (sum == G) break;
        __builtin_amdgcn_s_sleep(1);
        if ((++sp & 255u) == 0u) { if (xb_ld(&bar[XB_TMO])) break; if (sp > XB_SPIN_CAP) { atomicAdd(&bar[XB_TMO], 1u); break; } }
    }
    nloc = mine > 0u ? mine : 1u; nx = cnt > 0u ? cnt : 1u;
}

__device__ __forceinline__ void xcd_barrier(const XcdBarrier& b) {
    asm volatile("s_waitcnt vmcnt(0)" ::: "memory");
    __syncthreads();
    if (threadIdx.x == 0) {
        unsigned* bar = b.bar;
        __builtin_amdgcn_s_waitcnt(0);
        unsigned nloc = b.st[0], nx = b.st[1];
        if (nloc == 0u) { xcd_barrier_complete(bar, b.x, nloc, nx); b.st[0] = nloc; b.st[1] = nx; }
        const unsigned old = xb_add(&bar[XB_XSUB(b.x)], 1u);
        const unsigned gen = old / nloc;
        if (old + 1u == (gen + 1u) * nloc) {
            __builtin_amdgcn_fence(__ATOMIC_RELEASE, "agent");
            asm volatile("s_waitcnt vmcnt(0)" ::: "memory");
            const unsigned og = xb_add(&bar[XB_TOP], 1u);
            const unsigned tg = og / nx;
            if (og + 1u == (tg + 1u) * nx) xb_add(&bar[XB_TOPGEN], 1u);
            else XB_SPIN(xb_ld(&bar[XB_TOPGEN]) == tg, bar);
            __builtin_amdgcn_fence(__ATOMIC_ACQUIRE, "agent");
            xb_add(&bar[XB_XGEN(b.x)], 1u);
            asm volatile("s_waitcnt vmcnt(0)" ::: "memory");
        } else {
            XB_SPIN(xb_ld(&bar[XB_XGEN(b.x)]) == gen, bar);
            __builtin_amdgcn_fence(__ATOMIC_ACQUIRE, "agent");
            asm volatile("s_waitcnt vmcnt(0)" ::: "memory");
        }
    }
    __syncthreads();
}
#ifndef ABL_PARTS
#define ABL_PARTS 31
#endif
#ifndef PH_MAX
#define PH_MAX 10
#endif
typedef KArgs Args;
static_assert(sizeof(Args) == 26 * 8 + 8 + 8 + 8, "Args has no padding");

__global__ void __launch_bounds__(NTHREADS, 2) fwd_megakernel(Args args) {
    extern __shared__ __attribute__((aligned(16))) unsigned char lds_raw[];
    Frame F;
    F.lds = (LAS unsigned char*)lds_raw;
    F.tid = threadIdx.x; F.lane = F.tid & 63; F.wave = __builtin_amdgcn_readfirstlane(F.tid >> 6);
    F.G = gridDim.x; F.bid = blockIdx.x; F.vcu = (F.G % 8 == 0) ? (F.bid % 8) * (F.G / 8) + F.bid / 8 : F.bid;
    F.ka = (const KArgs __attribute__((address_space(4)))*)__builtin_amdgcn_kernarg_segment_ptr();
    F.out = args.out; F.ws = args.ws;
    const int lo = args.ph_lo, hi = args.ph_hi;
    volatile LAS unsigned* xst = (volatile LAS unsigned*)(F.lds + LDS_BYTES - 64);
    if (F.tid < 2) xst[F.tid] = 0u;
    __syncthreads();
    XcdBarrier xbar = xcd_barrier_post((unsigned*)(F.ws + WS_CTL) + CW_XBAR, xst);
#ifndef PHASE_MASK
#define PHASE_MASK 0x7ff
#endif
#define IN(k) (((PHASE_MASK >> (k)) & 1) && lo <= (k) && (k) < hi)
#ifndef REP_MASK
#define REP_MASK 0
#endif
#define REPS(k) for (int rep_ = 0; rep_ < 1 + ((REP_MASK >> (k)) & 1); ++rep_)
#define SEAM(k) do { if (lo <= (k) && (k) + 1 < hi) { xcd_barrier(xbar); } } while (0)
#define FIT_GRID(n) ((F.G % 8 == 0) ? ({ const int n_ = (n), R_ = (n_ + F.G - 1) / F.G, g_ = 8 * (((n_ + R_ - 1) / R_ + 7) / 8); g_ < F.G ? g_ : F.G; }) : F.G)

    const int g1 = FIT_GRID(1680);
    const bool p0_split = (F.G - g1) >= 16;
    if (IN(0)) REPS(0) p0_prologue(F, p0_split ? 1 : 3, 0, F.G);
    SEAM(0);
    if (IN(1)) REPS(1) {
        if (F.bid >= g1) { if (p0_split) p0_prologue(F, 2, g1, F.G - g1); }
        else {
        SchedIn S{(const char*)(F.ws + WS_HA), (const char*)(F.ws + WS_WIN_T), g1, F.bid};
        EpiIn E{WSP(bf16, WS_QA), WSP(bf16, WS_KV6), WSP(bf16, WS_QF), WSP(bf16, WS_KF), WSP(bf16, WS_VF), WSP(bf16, WS_QM), WSP(bf16, WS_GATES), WSP(bf16, WS_KMEM), WSP(bf16, WS_VMEM), WSP(float, WS_LG),
                WSP(float, WS_ROPE_C), WSP(float, WS_ROPE_S), F.ka->in[5]};
        pg8::gemm_phase<false>(F.lds, 1024, S, E);
        }
    }
    SEAM(1);
    if (IN(3)) REPS(3) p3_phase(F, ABL_PARTS, rep_);
    SEAM(3);
    if (IN(4)) REPS(4) {
        SchedBr S{(const char*)(F.ws + WS_OBR), (const char*)(F.ws + WS_WBR_T), F.G, F.bid};
        EpiBr E{WSP(bf16, WS_GATES), WSP(bf16, WS_MERGED)};
        pg8::gemm_phase<false>(F.lds, 512, S, E);
    }
    SEAM(4);
    if (IN(5)) REPS(5) {
        SchedOut S{(const char*)(F.ws + WS_MERGED), (const char*)(F.ws + WS_WOUT_T), F.G, F.bid};
        EpiOut E{F.ka->in[0], F.out, WSP(unsigned char, WS_H2)};
        pg8::gemm_phase<false>(F.lds, 1024, S, E);
    }
    SEAM(5);
    if (IN(6)) REPS(6) p6_phase(F);
    SEAM(6);
    const bool moe_split = (F.G % 8 == 0);
    const LAS int* te = (const LAS int*)(F.lds + MT_OFF);
    if (IN(8)) REPS(8) {
        { LAS int* mt = (LAS int*)(F.lds + MT_OFF);
          if (F.tid < 64) { const int e = F.tid & 31; const int c = (int)__hip_atomic_load(WSP(unsigned, WS_CTL) + CW_GCNT + 32 * e, __ATOMIC_RELAXED, __HIP_MEMORY_SCOPE_AGENT);
              const int padc = (c + 255) & ~255; int inc = padc;
#pragma unroll
              for (int o = 1; o < 32; o <<= 1) { const int up = __shfl_up(inc, o); if (e >= o) inc += up; }
              const int start = inc - padc;
              if (F.tid < 32) { mt[320 + e] = start; mt[352 + e] = c; for (int q = 0; q < (padc >> 8); ++q) mt[(start >> 8) + q] = e | (q << 5); if (e == 31) mt[300] = inc >> 8; } }
          __syncthreads(); }
        const int nmt = __builtin_amdgcn_readfirstlane(te[300]), F8 = moe_split ? (nmt * 8) / F.G : (1 << 20);
        { const int nr = (nmt * 8 + F.G - 1) / F.G; moe_stage_tokens(F.lds, te, WSP(int, WS_ETOK), nmt, F.G, F.vcu, 0, F8 < nr ? F8 : nr, F.tid); }
        SchedMoE<true> S{(const char*)(F.ws + WS_H2), (const char*)(F.ws + WS_WGU_T), te, (const LAS int*)(F.lds + MT_OFF + 2048), nmt, 8, F.G, F.vcu, (size_t)2048 * 1024, 0, F8};
        EpiGU E{F.ka->in[22], te, WSP(unsigned char, WS_ACT), WSP(float, WS_ERSTD)};
        pg8::gemm_phase<true>(F.lds, 512, S, E);
    }
    SEAM(8);
    if (IN(9)) REPS(9) {
        unsigned* done8 = WSP(unsigned, WS_CTL) + CW_DONE8;
        const int nmt = __builtin_amdgcn_readfirstlane(te[300]), n9 = nmt * 4, F8 = moe_split ? (nmt * 8) / F.G : (1 << 20), T = moe_split ? nmt * 8 - F8 * F.G : 0, v = F.vcu;
        if (v < T) {
            moe_stage_tokens(F.lds, te, WSP(int, WS_ETOK), nmt, F.G, v, F8, F8 + 1, F.tid);
            SchedMoE<true> S{(const char*)(F.ws + WS_H2), (const char*)(F.ws + WS_WGU_T), te, (const LAS int*)(F.lds + MT_OFF + 2048), nmt, 8, F.G, v, (size_t)2048 * 1024, F8, F8 + 1};
            EpiGU E{F.ka->in[22], te, WSP(unsigned char, WS_ACT), WSP(float, WS_ERSTD)};
            pg8::gemm_phase<true>(F.lds, 512, S, E);
            if (F.tid == 0) { __builtin_amdgcn_fence(__ATOMIC_RELEASE, "agent"); asm volatile("s_waitcnt vmcnt(0)" ::: "memory");
                __hip_atomic_fetch_add(done8 + ((F8 * F.G + v) >> 3), 1u, __ATOMIC_RELAXED, __HIP_MEMORY_SCOPE_AGENT); }
        }
        const int vb = v - T + (v < T ? F.G : 0), pmT = moe_split ? (F8 * F.G) / 8 : (1 << 20), lim = n9 < 4 * pmT ? n9 : 4 * pmT;
        const int nseg1 = vb < lim ? (lim - 1 - vb) / F.G + 1 : 0;
        EpiDn E{F.ka->in[24], te, WSP(bf16, WS_AMOE)};
        { SchedMoE<false> S{(const char*)(F.ws + WS_ACT), (const char*)(F.ws + WS_WD_T), te, nullptr, nmt, 4, F.G, vb, (size_t)1024 * 1024, 0, nseg1};
          pg8::gemm_phase<true>(F.lds, 512, S, E); }
        if (nseg1 * F.G + vb < n9) {
            for (int L = nseg1 * F.G + vb; L < n9; L += F.G) q_wait(done8 + (L >> 2), 8u, F.tid);
            SchedMoE<false> S{(const char*)(F.ws + WS_ACT), (const char*)(F.ws + WS_WD_T), te, nullptr, nmt, 4, F.G, vb, (size_t)1024 * 1024, nseg1, 1 << 20};
            pg8::gemm_phase<true>(F.lds, 512, S, E);
        }
    }
    SEAM(9);
    if (IN(10)) { if ((REP_MASK >> 10) & 1) p10_phase(F, PH_MAX >= 9, WSP(float, WS_GATES)); p10_phase(F, PH_MAX >= 9, F.out); }
#undef IN
#undef SEAM
}

extern "C" void kernel_launch(void* const* d_in, const int* in_sizes, int n_in, void* d_out, int out_size, void* d_ws, size_t ws_size, hipStream_t stream) {
    static int grid = 0;
    if (grid == 0) {
        if (n_in != 26 || out_size != NTOK * DM || ws_size < WS_END) { fprintf(stderr, "kernel_launch: unexpected sizes n_in %d out %d ws %zu (need %zu)\n", n_in, out_size, ws_size, (size_t)WS_END); grid = -1; return; }
        int dev = 0, cus = 0, per_cu = 0;
        hipGetDevice(&dev); hipDeviceGetAttribute(&cus, hipDeviceAttributeMultiprocessorCount, dev);
        if (hipFuncSetAttribute((const void*)fwd_megakernel, hipFuncAttributeMaxDynamicSharedMemorySize, LDS_BYTES) != hipSuccess) { fprintf(stderr, "kernel_launch: hipFuncSetAttribute failed\n"); grid = -1; return; }
        if (hipOccupancyMaxActiveBlocksPerMultiprocessor(&per_cu, (const void*)fwd_megakernel, NTHREADS, LDS_BYTES) != hipSuccess || per_cu < 1) { fprintf(stderr, "kernel_launch: occupancy query says %d\n", per_cu); per_cu = 1; }
        (void)hipGetLastError();
        grid = cus * 1;
        if (grid > 256) grid = 256;
    }
    if (grid < 0) return;
    (void)hipMemsetAsync((char*)d_ws + WS_CTL, 0, CTL_BYTES, stream);
    Args a{};
    for (int i = 0; i < 26; ++i) a.in[i] = (const float*)d_in[i];
    a.out = (float*)d_out; a.ws = (unsigned char*)d_ws;
#if defined(MULTI_LAUNCH)
    for (int p = 0; p <= 10; ++p) { if (p > PH_MAX && p != 10) continue; a.ph_lo = p; a.ph_hi = p + 1; hipLaunchKernelGGL(fwd_megakernel, dim3(grid), dim3(NTHREADS), LDS_BYTES, stream, a); }
#else
    a.ph_lo = 0; a.ph_hi = 11;
    hipLaunchKernelGGL(fwd_megakernel, dim3(grid), dim3(NTHREADS), LDS_BYTES, stream, a);
#endif
}
```
